# Optimizing an MI355X kernel written in HIP

```python
import math
import jax, jax.numpy as jnp
from jax import lax
import numpy as np

D_MODEL = 2048
BATCH = 8
SEQ = 2048
DEPTH = 1

HEAD_DIM = 128
N_GDN_HEADS = 8
N_MOBA_HEADS = 8
GDN_WIDTH = N_GDN_HEADS * HEAD_DIM
MOBA_WIDTH = N_MOBA_HEADS * HEAD_DIM
MIX_WIDTH = GDN_WIDTH + MOBA_WIDTH
IN_PROJ_WIDTH = 4 * GDN_WIDTH + 2 * N_GDN_HEADS + 3 * MOBA_WIDTH
GDN_CONV = 4
GDN_CHUNK = 64
MOBA_BLOCK = 256
MOBA_TOPK = 3
MOBA_Q_CHUNK = 64
REL_BUCKETS = 32
REL_MAX_DIST = 128
MEM_LEN = 256
N_XATTN_HEADS = 4
XATTN_WIDTH = N_XATTN_HEADS * HEAD_DIM
D_FF = 5632
FFN_CONV = 3
EPS = 1e-6
NEG = -1e30

kernel_name = "hybrid_gdn_moba_parallel_heads"


def rmsnorm(x, g):
    xf = x.astype(jnp.float32)
    y = xf * lax.rsqrt(jnp.mean(xf * xf, axis=-1, keepdims=True) + EPS)
    return (y * g.astype(jnp.float32)).astype(x.dtype)


def l2norm(x):
    xf = x.astype(jnp.float32)
    return (xf * lax.rsqrt(jnp.sum(xf * xf, axis=-1, keepdims=True) + EPS)).astype(x.dtype)


def causal_dwconv(x, w):
    K = w.shape[0]
    S = x.shape[1]
    xp = jnp.pad(x, ((0, 0), (K - 1, 0), (0, 0)))
    return sum(xp[:, j:j + S] * w[j] for j in range(K))


def rel_bucket(rel):
    n = jnp.maximum(-rel, 0)
    max_exact = REL_BUCKETS // 2
    nf = jnp.maximum(n, 1).astype(jnp.float32)
    large = max_exact + (jnp.log(nf / max_exact) / math.log(REL_MAX_DIST / max_exact)
                         * (REL_BUCKETS - max_exact)).astype(jnp.int32)
    large = jnp.minimum(large, REL_BUCKETS - 1)
    return jnp.where(n < max_exact, n, large)


def gated_delta_rule(q, k, v, g, beta):
    out_dtype = v.dtype
    B, H, S, Dk = q.shape
    Dv = v.shape[-1]
    C = GDN_CHUNK
    N = S // C
    f32 = jnp.float32
    q = (q.astype(f32) * Dk ** -0.5).reshape(B, H, N, C, Dk)
    k = k.astype(f32).reshape(B, H, N, C, Dk)
    v = v.astype(f32).reshape(B, H, N, C, Dv)
    g = g.astype(f32).reshape(B, H, N, C)
    beta = beta.astype(f32).reshape(B, H, N, C)
    G = jnp.cumsum(g, axis=-1)
    tri_incl = jnp.tril(jnp.ones((C, C), dtype=bool))
    tri_strict = jnp.tril(jnp.ones((C, C), dtype=bool), -1)
    decay = jnp.exp(jnp.where(tri_incl, G[..., :, None] - G[..., None, :], NEG))
    kb = k * beta[..., None]
    A = jnp.where(tri_strict, jnp.einsum('bhnid,bhnjd->bhnij', kb, k) * decay, 0.0)
    eye = jnp.eye(C, dtype=f32)
    T = lax.linalg.triangular_solve(eye + A, jnp.broadcast_to(eye, A.shape),
                                    left_side=True, lower=True)
    u = jnp.einsum('bhnij,bhnjd->bhnid', T, v * beta[..., None])
    w = jnp.einsum('bhnij,bhnjd->bhnid', T, kb * jnp.exp(G)[..., None])
    qk = jnp.einsum('bhnid,bhnjd->bhnij', q, k) * decay
    q_dec = q * jnp.exp(G)[..., None]
    k_dec = k * jnp.exp(G[..., -1:] - G)[..., None]
    g_last = jnp.exp(G[..., -1])

    def step(state, xs):
        q_i, k_i, u_i, w_i, qk_i, gl_i = xs
        v_new = u_i - jnp.einsum('bhck,bhkv->bhcv', w_i, state)
        o_i = (jnp.einsum('bhck,bhkv->bhcv', q_i, state)
               + jnp.einsum('bhij,bhjv->bhiv', qk_i, v_new))
        state = state * gl_i[..., None, None] + jnp.einsum('bhck,bhcv->bhkv', k_i, v_new)
        return state, o_i

    xs = tuple(jnp.moveaxis(t, 2, 0) for t in (q_dec, k_dec, u, w, qk, g_last))
    state0 = jnp.zeros((B, H, Dk, Dv), f32)
    _, o = lax.scan(step, state0, xs)
    o = jnp.moveaxis(o, 0, 2).reshape(B, H, S, Dv)
    return o.astype(out_dtype)


def moba_attention(q, k, v, rel_bias):
    B, H, S, Dh = q.shape
    nb = -(-S // MOBA_BLOCK)
    s_pad = nb * MOBA_BLOCK
    pad = ((0, 0), (0, 0), (0, s_pad - S), (0, 0))
    k_blocks = jnp.pad(k, pad).reshape(B, H, nb, MOBA_BLOCK, Dh)
    v_blocks = jnp.pad(v, pad).reshape(B, H, nb, MOBA_BLOCK, Dh)
    k_mean = jnp.mean(k_blocks.astype(jnp.float32), axis=3).astype(k.dtype)
    n_sel = min(MOBA_TOPK, nb)
    scale = Dh ** -0.5
    n_chunks = S // MOBA_Q_CHUNK
    offs = jnp.arange(MOBA_BLOCK)
    rb_t = rel_bias.T
    head_idx = jnp.arange(H)[:, None, None, None]

    def per_batch(args):
        qb, kb, vb, kmb = args

        def per_chunk(c):
            q0 = c * MOBA_Q_CHUNK
            qc = lax.dynamic_slice_in_dim(qb, q0, MOBA_Q_CHUNK, axis=1)
            q_pos = q0 + jnp.arange(MOBA_Q_CHUNK)
            own = q0 // MOBA_BLOCK
            gate = jnp.einsum('hqd,hnd->hqn', qc, kmb).astype(jnp.float32)
            gate = jnp.where(jnp.arange(nb) < own, gate, NEG)
            _, idx = lax.top_k(gate, n_sel)
            valid = jnp.arange(n_sel) < own
            k_sel = jax.vmap(lambda blk, ix: blk[ix])(kb, idx)
            v_sel = jax.vmap(lambda blk, ix: blk[ix])(vb, idx)
            pos_sel = idx[..., None] * MOBA_BLOCK + offs
            bias_sel = rb_t[head_idx, rel_bucket(pos_sel - q_pos[None, :, None, None])]
            logit_sel = (jnp.einsum('hqd,hqnkd->hqnk', qc, k_sel).astype(jnp.float32) * scale
                         + bias_sel.astype(jnp.float32))
            logit_sel = jnp.where(valid[None, None, :, None], logit_sel, NEG)
            k_own = lax.dynamic_index_in_dim(kb, own, axis=1, keepdims=False)
            v_own = lax.dynamic_index_in_dim(vb, own, axis=1, keepdims=False)
            pos_own = own * MOBA_BLOCK + offs
            rel_own = pos_own[None, :] - q_pos[:, None]
            logit_own = (jnp.einsum('hqd,hkd->hqk', qc, k_own).astype(jnp.float32) * scale
                         + rb_t[:, rel_bucket(rel_own)].astype(jnp.float32))
            logit_own = jnp.where((rel_own <= 0)[None], logit_own, NEG)
            logits = jnp.concatenate(
                [logit_sel.reshape(H, MOBA_Q_CHUNK, n_sel * MOBA_BLOCK), logit_own], axis=-1)
            p = jax.nn.softmax(logits, axis=-1).astype(v.dtype)
            p_sel = p[..., :n_sel * MOBA_BLOCK].reshape(H, MOBA_Q_CHUNK, n_sel, MOBA_BLOCK)
            p_own = p[..., n_sel * MOBA_BLOCK:]
            return (jnp.einsum('hqnk,hqnkd->hqd', p_sel, v_sel)
                    + jnp.einsum('hqk,hkd->hqd', p_own, v_own))

        o = lax.map(per_chunk, jnp.arange(n_chunks))
        return o.transpose(1, 0, 2, 3).reshape(H, S, Dh)

    return lax.map(per_batch, (q, k_blocks, v_blocks, k_mean))


def to_heads(t, n_heads):
    B, S, _ = t.shape
    return t.reshape(B, S, n_heads, HEAD_DIM).transpose(0, 2, 1, 3)


def hybrid_mixer(x, norm_g, w_in, gdn_conv_w, a_log, dt_bias, gdn_norm_g,
                 moba_norm_g, rel_bias, w_out):
    B, S, _ = x.shape
    h = rmsnorm(x, norm_g)
    proj = h @ w_in
    i0 = 3 * GDN_WIDTH
    i1 = i0 + GDN_WIDTH
    i2 = i1 + N_GDN_HEADS
    i3 = i2 + N_GDN_HEADS
    qkv_a, z_a, b_a, a_a, qkv_b = (proj[..., :i0], proj[..., i0:i1], proj[..., i1:i2],
                                   proj[..., i2:i3], proj[..., i3:])
    qkv_a = jax.nn.silu(causal_dwconv(qkv_a, gdn_conv_w))
    q_a, k_a, v_a = [to_heads(t, N_GDN_HEADS) for t in jnp.split(qkv_a, 3, axis=-1)]
    beta = jax.nn.sigmoid(b_a).transpose(0, 2, 1)
    g = (-jnp.exp(a_log) * jax.nn.softplus(a_a + dt_bias)).transpose(0, 2, 1)
    o_a = gated_delta_rule(l2norm(q_a), l2norm(k_a), v_a, g, beta).transpose(0, 2, 1, 3)
    o_a = rmsnorm(o_a, gdn_norm_g) * jax.nn.silu(z_a.reshape(B, S, N_GDN_HEADS, HEAD_DIM))
    q_b, k_b, v_b = [to_heads(t, N_MOBA_HEADS) for t in jnp.split(qkv_b, 3, axis=-1)]
    o_b = moba_attention(q_b, k_b, v_b, rel_bias).transpose(0, 2, 1, 3)
    o_b = rmsnorm(o_b, moba_norm_g)
    o = jnp.concatenate([o_a.reshape(B, S, GDN_WIDTH), o_b.reshape(B, S, MOBA_WIDTH)], axis=-1)
    return o @ w_out


def cross_attention(x, mem, norm_g, mem_norm_g, w_xq, w_xkv, w_xo):
    B, S, _ = x.shape
    M = mem.shape[1]
    q = (rmsnorm(x, norm_g) @ w_xq).reshape(B, S, N_XATTN_HEADS, HEAD_DIM)
    kv = rmsnorm(mem, mem_norm_g) @ w_xkv
    k, v = [t.reshape(B, M, N_XATTN_HEADS, HEAD_DIM) for t in jnp.split(kv, 2, axis=-1)]
    logits = jnp.einsum('bshd,bmhd->bhsm', q, k).astype(jnp.float32) * HEAD_DIM ** -0.5
    p = jax.nn.softmax(logits, axis=-1).astype(v.dtype)
    o = jnp.einsum('bhsm,bmhd->bshd', p, v).reshape(B, S, XATTN_WIDTH)
    return o @ w_xo


def conv_ffn(x, norm_g, w_gate, w_up, conv_w, conv_b, w_down):
    h = rmsnorm(x, norm_g)
    gate = causal_dwconv(h @ w_gate, conv_w) + conv_b
    return (jax.nn.silu(gate) * (h @ w_up)) @ w_down


def setup_inputs(seed: int = 0) -> dict:
    key = jax.random.key(seed)
    ks = jax.random.split(key, 24)
    f32 = jnp.float32
    L = DEPTH

    def nrm(k, shape, scale):
        return jax.random.normal(k, shape, f32) * scale

    def gain(k, shape):
        return 1.0 + 0.02 * jax.random.normal(k, shape, f32)

    dt = jnp.exp(jax.random.uniform(ks[6], (L, N_GDN_HEADS), f32, math.log(1e-3), math.log(1e-1)))
    return {
        "x": nrm(ks[0], (BATCH, SEQ, D_MODEL), 1.0),
        "mem": nrm(ks[1], (BATCH, MEM_LEN, D_MODEL), 1.0),
        "mix_norm_g": gain(ks[2], (L, D_MODEL)),
        "w_in": nrm(ks[3], (L, D_MODEL, IN_PROJ_WIDTH), D_MODEL ** -0.5),
        "gdn_conv_w": nrm(ks[4], (L, GDN_CONV, 3 * GDN_WIDTH), GDN_CONV ** -0.5),
        "gdn_a_log": jnp.log(jax.random.uniform(ks[5], (L, N_GDN_HEADS), f32, 1.0, 16.0)),
        "gdn_dt_bias": dt + jnp.log(-jnp.expm1(-dt)),
        "gdn_norm_g": gain(ks[7], (L, HEAD_DIM)),
        "moba_norm_g": gain(ks[8], (L, HEAD_DIM)),
        "rel_bias": nrm(ks[9], (REL_BUCKETS, N_MOBA_HEADS), 0.5),
        "w_out": nrm(ks[10], (L, MIX_WIDTH, D_MODEL), MIX_WIDTH ** -0.5),
        "xattn_norm_g": gain(ks[11], (L, D_MODEL)),
        "mem_norm_g": gain(ks[12], (L, D_MODEL)),
        "w_xq": nrm(ks[13], (L, D_MODEL, XATTN_WIDTH), D_MODEL ** -0.5),
        "w_xkv": nrm(ks[14], (L, D_MODEL, 2 * XATTN_WIDTH), D_MODEL ** -0.5),
        "w_xo": nrm(ks[15], (L, XATTN_WIDTH, D_MODEL), XATTN_WIDTH ** -0.5),
        "ffn_norm_g": gain(ks[16], (L, D_MODEL)),
        "w_gate": nrm(ks[17], (L, D_MODEL, D_FF), D_MODEL ** -0.5),
        "w_up": nrm(ks[18], (L, D_MODEL, D_FF), D_MODEL ** -0.5),
        "ffn_conv_w": nrm(ks[19], (L, FFN_CONV, D_FF), FFN_CONV ** -0.5),
        "ffn_conv_b": nrm(ks[20], (L, D_FF), 0.02),
        "w_down": nrm(ks[21], (L, D_FF, D_MODEL), D_FF ** -0.5),
        "final_norm_g": gain(ks[22], (D_MODEL,)),
    }


def reference(x, mem, mix_norm_g, w_in, gdn_conv_w, gdn_a_log, gdn_dt_bias, gdn_norm_g,
              moba_norm_g, rel_bias, w_out, xattn_norm_g, mem_norm_g, w_xq, w_xkv, w_xo,
              ffn_norm_g, w_gate, w_up, ffn_conv_w, ffn_conv_b, w_down, final_norm_g):
    for l in range(DEPTH):
        x = x + hybrid_mixer(x, mix_norm_g[l], w_in[l], gdn_conv_w[l], gdn_a_log[l],
                             gdn_dt_bias[l], gdn_norm_g[l], moba_norm_g[l], rel_bias, w_out[l])
        x = x + cross_attention(x, mem, xattn_norm_g[l], mem_norm_g[l], w_xq[l], w_xkv[l], w_xo[l])
        x = x + conv_ffn(x, ffn_norm_g[l], w_gate[l], w_up[l], ffn_conv_w[l], ffn_conv_b[l], w_down[l])
    return rmsnorm(x, final_norm_g)
```

```cpp
#include <hip/hip_runtime.h>
#include <hip/hip_cooperative_groups.h>
#include <cstdio>
#include <cstdint>
namespace cg = cooperative_groups;

#ifndef MK_MULTI
#define MK_MULTI 1
#endif

namespace pg8 {
#define PG8_LAS __attribute__((address_space(3)))
typedef unsigned short bf16_t;
typedef short bf16x8 __attribute__((ext_vector_type(8)));
typedef float f32x4 __attribute__((ext_vector_type(4)));
typedef unsigned u32x4 __attribute__((ext_vector_type(4)));
constexpr int BM = 256, BK = 64, HALF = 128, HTB = HALF * BK * 2  , STAGE_BYTES = 8 * HTB, NXCD = 8, WGM = 8;

__host__ __device__ __forceinline__ int lds_byte(int r, int c) { const int st = (r >> 4) * 2 + (c >> 5), rr = r & 15, cc = c & 31, ob = rr * 64 + cc * 2; return st * 1024 + (ob ^ (((ob >> 9) & 1) << 5)); }
__host__ __device__ __forceinline__ void stage_rc(int b, int& R, int& C) { const int st = b / 1024, sb = b % 1024, swz = sb ^ (((sb >> 9) & 1) << 5); R = (st >> 1) * 16 + swz / 64; C = (st & 1) * 32 + (swz % 64) / 2; }
__host__ __device__ __forceinline__ int perm32(int rho) { const int n = rho >> 4, i = rho & 15; return 8 * (i >> 2) + 4 * n + (i & 3); }

struct Unit { int pm, pn; };
struct Gemm { const bf16_t* A; const bf16_t* Bt; int M, N, K; };

struct StaticOrder {
    int nM, nN, nwg, G, c;
    __host__ __device__ void init(int M, int N, int G_, int c_) { nM = M / BM; nN = N / BM; nwg = nM * nN; G = G_; c = c_; }
    __host__ __device__ bool next(int i, Unit& u) const {
        const long L = (long)i * G + c; if (L >= nwg) return false;
        int wgid = (int)L; { const int q = nwg / NXCD, r = nwg % NXCD, xcd = wgid % NXCD, off = wgid / NXCD; wgid = (xcd < r ? xcd * (q + 1) : r * (q + 1) + (xcd - r) * q) + off; }
        const int nig = WGM * nN, gid = wgid / nig, fm = gid * WGM, gsz = (nM - fm) < WGM ? (nM - fm) : WGM;
        u.pm = fm + ((wgid % nig) % gsz); u.pn = (wgid % nig) / gsz; return true;
    }
    __device__ __forceinline__ void a_ready(const Unit&) const {}
    __device__ __forceinline__ void done(const Unit&) const {}
};


__device__ __forceinline__ unsigned cvt_pk_bf16(float lo, float hi) { unsigned r; asm volatile("v_cvt_pk_bf16_f32 %0, %1, %2" : "=v"(r) : "v"(lo), "v"(hi)); return r; }
__device__ __forceinline__ float silu_f(float v) { return v / (1.0f + __expf(-v)); }

struct EpiScaleBf16 {
    static constexpr bool PERM = true, AFTER_DRAIN = false;
    bf16_t* O; int ldc; const float* rs; int silu_lo, silu_hi; int split_cols; size_t split_stride;
    __device__ __forceinline__ void operator()(const f32x4 (&acc)[2][2][4][2], const Unit& u, int wr, int wc, int fr, int fq) const {
        int colt = u.pn * BM; bf16_t* base = O; if (split_cols && colt >= split_cols) { base += split_stride; colt -= split_cols; }
        const int row0 = u.pm * BM + wr * 64 + fr, col0 = colt + wc * 32 + 8 * fq;
        const bool act = (u.pn >= silu_lo && u.pn < silu_hi);
#pragma unroll
        for (int ai = 0; ai < 2; ++ai)
#pragma unroll
            for (int m = 0; m < 4; ++m) { const int row = row0 + ai * HALF + m * 16; const float r = rs ? rs[row] : 1.0f; bf16_t* rowp = base + (size_t)row * ldc + col0;
#pragma unroll
                for (int bj = 0; bj < 2; ++bj) { f32x4 v0 = acc[ai][bj][m][0] * r, v1 = acc[ai][bj][m][1] * r;
                    if (act) {
#pragma unroll
                        for (int j = 0; j < 4; ++j) { v0[j] = silu_f(v0[j]); v1[j] = silu_f(v1[j]); } }
                    u32x4 w; w.x = cvt_pk_bf16(v0[0], v0[1]); w.y = cvt_pk_bf16(v0[2], v0[3]); w.z = cvt_pk_bf16(v1[0], v1[1]); w.w = cvt_pk_bf16(v1[2], v1[3]);
                    *(u32x4*)(rowp + bj * HALF) = w; } }
    }
};
struct EpiResidF32 {
    static constexpr bool PERM = false, AFTER_DRAIN = false;
    const float* base; float* out; int ldc;
    __device__ __forceinline__ void operator()(const f32x4 (&acc)[2][2][4][2], const Unit& u, int wr, int wc, int fr, int fq) const {
        const int row0 = u.pm * BM + wr * 64 + fr, col0 = u.pn * BM + wc * 32 + 4 * fq;
#pragma unroll
        for (int ai = 0; ai < 2; ++ai)
#pragma unroll
            for (int m = 0; m < 4; ++m) { const size_t off = (size_t)(row0 + ai * HALF + m * 16) * ldc + col0;
#pragma unroll
                for (int bj = 0; bj < 2; ++bj)
#pragma unroll
                    for (int n = 0; n < 2; ++n) { const f32x4 bs = *(const f32x4*)(base + off + bj * HALF + n * 16); *(f32x4*)(out + off + bj * HALF + n * 16) = bs + acc[ai][bj][m][n]; } }
    }
};

template <class Epi, class Sched, bool ALIGN_EPI = false, bool SP2 = false>
__device__ __forceinline__ void gemm_phase(PG8_LAS unsigned char* lds, const Gemm g, const Sched& S, const Epi& E) {
    const int tid = threadIdx.x, wid = __builtin_amdgcn_readfirstlane(tid >> 6), lane = tid & 63, wr = wid >> 2, wc = wid & 3, fr = lane & 15, fq = lane >> 4;
    const int K = g.K, nt = K / BK;
    unsigned voffA[2], voffB[2];
#pragma unroll
    for (int i = 0; i < 2; ++i) { int R, C; stage_rc(tid * 16 + i * 8192, R, C); const int Rb = Epi::PERM ? ((R & ~31) + perm32(R & 31)) : R;
        voffA[i] = (unsigned)(R * K + C) * 2u; voffB[i] = (unsigned)(Rb * K + C) * 2u; }
    const size_t kstep = (size_t)(BK * 2);
    const size_t hstep = (size_t)HALF * K * 2;
    const size_t tstep = 2 * hstep;
    const unsigned ldsw = (unsigned)wid * 1024u;
    const int aoff = lds_byte(wr * 64 + fr, fq * 8), boff = lds_byte(wc * 32 + fr, fq * 8);
#define PG8_SA(b, h) (((b) * 2 + (h)) * HTB)
#define PG8_SB(b, h) ((4 + (b) * 2 + (h)) * HTB)
#define PG8_STAGE(bufoff, gbase, voff) do { _Pragma("unroll") for (int _i = 0; _i < 2; ++_i) \
        __builtin_amdgcn_global_load_lds((const unsigned*)((const char*)(gbase) + (voff)[_i]), (PG8_LAS unsigned*)(lds + (bufoff) + ldsw + _i * 8192), 16, 0, 0); } while (0)
#define PG8_LDA(dst, b, h) do { _Pragma("unroll") for (int m = 0; m < 4; ++m) _Pragma("unroll") for (int k = 0; k < 2; ++k) dst[m][k] = *(const PG8_LAS bf16x8*)(lds + PG8_SA(b, h) + aoff + m * 2048 + k * 1024); } while (0)
#define PG8_LDB(dst, b, h) do { _Pragma("unroll") for (int n = 0; n < 2; ++n) _Pragma("unroll") for (int k = 0; k < 2; ++k) dst[n][k] = *(const PG8_LAS bf16x8*)(lds + PG8_SB(b, h) + boff + n * 2048 + k * 1024); } while (0)
#define PG8_MMA(ai, bj, At, Bt) do { __builtin_amdgcn_s_setprio(1); _Pragma("unroll") for (int m = 0; m < 4; ++m) _Pragma("unroll") for (int n = 0; n < 2; ++n) _Pragma("unroll") for (int k = 0; k < 2; ++k) \
        acc[ai][bj][m][n] = __builtin_amdgcn_mfma_f32_16x16x32_bf16(Bt[n][k], At[m][k], acc[ai][bj][m][n], 0, 0, 0); __builtin_amdgcn_s_setprio(0); } while (0)
#define PG8_WAIT_V(n) asm volatile("s_waitcnt vmcnt(" #n ")" ::: "memory")
#define PG8_WAIT_L(n) asm volatile("s_waitcnt lgkmcnt(" #n ")" ::: "memory")
#define PG8_BAR __builtin_amdgcn_s_barrier()
#define PG8_SCHED __builtin_amdgcn_sched_barrier(0)
    Unit cur, nxt; int ui = 0;
    if (!S.next(0, cur)) return;
    f32x4 acc[2][2][4][2];
#pragma unroll
    for (int a = 0; a < 2; ++a)
#pragma unroll
        for (int b = 0; b < 2; ++b)
#pragma unroll
            for (int m = 0; m < 4; ++m)
#pragma unroll
                for (int n = 0; n < 2; ++n) acc[a][b][m][n] = (f32x4){0.f, 0.f, 0.f, 0.f};
    bf16x8 At[4][2], B0[2][2], B1[2][2];
    const char* cA = (const char*)g.A + (size_t)cur.pm * tstep; const char* cB = (const char*)g.Bt + (size_t)cur.pn * tstep;
    S.a_ready(cur);
    if constexpr (SP2) {
        PG8_STAGE(PG8_SB(0, 0), cB, voffB); PG8_STAGE(PG8_SB(0, 1), cB + hstep, voffB); PG8_STAGE(PG8_SA(0, 0), cA, voffA); PG8_STAGE(PG8_SA(0, 1), cA + hstep, voffA);
        if (wr == 1) PG8_BAR;
        PG8_WAIT_V(2); PG8_BAR;
        PG8_STAGE(PG8_SB(1, 0), cB + kstep, voffB); PG8_STAGE(PG8_SA(1, 0), cA + kstep, voffA); PG8_STAGE(PG8_SB(1, 1), cB + hstep + kstep, voffB);
        PG8_WAIT_V(6); PG8_BAR;
    } else {
        PG8_STAGE(PG8_SB(0, 0), cB, voffB); PG8_STAGE(PG8_SA(0, 0), cA, voffA); PG8_STAGE(PG8_SB(0, 1), cB + hstep, voffB); PG8_STAGE(PG8_SA(0, 1), cA + hstep, voffA);
        if (wr == 1) PG8_BAR;
        PG8_WAIT_V(4); PG8_BAR;
        PG8_STAGE(PG8_SB(1, 0), cB + kstep, voffB); PG8_STAGE(PG8_SA(1, 0), cA + kstep, voffA); PG8_STAGE(PG8_SB(1, 1), cB + hstep + kstep, voffB);
        PG8_WAIT_V(6); PG8_BAR;
    }
    for (;;) {
        const bool has_next = S.next(ui + 1, nxt);
        const char* nA = has_next ? (const char*)g.A + (size_t)nxt.pm * tstep : cA; const char* nB = has_next ? (const char*)g.Bt + (size_t)nxt.pn * tstep : cB;
        for (int t = 0; t < nt; t += 2) {
            const bool last = (t == nt - 2);
            const char* a1 = cA + (size_t)(t + 1) * kstep;
            const char* a2 = last ? nA : cA + (size_t)(t + 2) * kstep; const char* b2 = last ? nB : cB + (size_t)(t + 2) * kstep;
            const char* a3 = a2 + kstep; const char* b3 = b2 + kstep;
            if (last && has_next) S.a_ready(nxt);
            if constexpr (SP2) {
            PG8_LDB(B0, 0, 0); PG8_LDB(B1, 0, 1); PG8_SCHED; PG8_LDA(At, 0, 0); PG8_STAGE(PG8_SA(1, 1), a1 + hstep, voffA);
            PG8_WAIT_V(8); PG8_WAIT_L(0); PG8_BAR; PG8_MMA(0, 0, At, B0); PG8_MMA(0, 1, At, B1); PG8_BAR; PG8_SCHED;
            PG8_LDA(At, 0, 1); PG8_STAGE(PG8_SB(0, 0), b2, voffB); PG8_STAGE(PG8_SB(0, 1), b2 + hstep, voffB); PG8_STAGE(PG8_SA(0, 0), a2, voffA);
            PG8_WAIT_V(8); PG8_WAIT_L(0); PG8_BAR; PG8_MMA(1, 0, At, B0); PG8_MMA(1, 1, At, B1); PG8_BAR; PG8_SCHED;
            PG8_LDB(B0, 1, 0); PG8_LDB(B1, 1, 1); PG8_SCHED; PG8_LDA(At, 1, 0); PG8_STAGE(PG8_SA(0, 1), a2 + hstep, voffA);
            PG8_WAIT_V(8); PG8_WAIT_L(0); PG8_BAR; PG8_MMA(0, 0, At, B0); PG8_MMA(0, 1, At, B1); PG8_BAR; PG8_SCHED;
            PG8_LDA(At, 1, 1); PG8_STAGE(PG8_SB(1, 0), b3, voffB); PG8_STAGE(PG8_SB(1, 1), b3 + hstep, voffB); PG8_STAGE(PG8_SA(1, 0), a3, voffA);
            PG8_WAIT_V(8); PG8_WAIT_L(0); PG8_BAR; PG8_MMA(1, 0, At, B0); PG8_MMA(1, 1, At, B1); PG8_BAR; PG8_SCHED;
            } else {
            PG8_LDB(B0, 0, 0); PG8_SCHED; PG8_LDA(At, 0, 0); PG8_STAGE(PG8_SA(1, 1), a1 + hstep, voffA);
            PG8_WAIT_L(8); PG8_BAR; PG8_WAIT_L(0); PG8_MMA(0, 0, At, B0); PG8_BAR; PG8_SCHED;
            PG8_LDB(B1, 0, 1); PG8_STAGE(PG8_SB(0, 0), b2, voffB);
            PG8_BAR; PG8_WAIT_L(0); PG8_MMA(0, 1, At, B1); PG8_BAR;
            PG8_LDA(At, 0, 1); PG8_STAGE(PG8_SA(0, 0), a2, voffA);
            PG8_BAR; PG8_WAIT_L(0); PG8_MMA(1, 0, At, B0); PG8_BAR; PG8_SCHED;
            PG8_STAGE(PG8_SB(0, 1), b2 + hstep, voffB);
            PG8_WAIT_V(6); PG8_BAR; PG8_MMA(1, 1, At, B1); PG8_BAR;
            PG8_LDB(B0, 1, 0); PG8_SCHED; PG8_LDA(At, 1, 0); PG8_STAGE(PG8_SA(0, 1), a2 + hstep, voffA);
            PG8_WAIT_L(8); PG8_BAR; PG8_WAIT_L(0); PG8_MMA(0, 0, At, B0); PG8_BAR; PG8_SCHED;
            PG8_LDB(B1, 1, 1); PG8_STAGE(PG8_SB(1, 0), b3, voffB);
            PG8_BAR; PG8_WAIT_L(0); PG8_MMA(0, 1, At, B1); PG8_BAR;
            PG8_LDA(At, 1, 1); PG8_STAGE(PG8_SA(1, 0), a3, voffA);
            PG8_BAR; PG8_WAIT_L(0); PG8_MMA(1, 0, At, B0); PG8_BAR; PG8_SCHED;
            PG8_STAGE(PG8_SB(1, 1), b3 + hstep, voffB);
            PG8_WAIT_V(6); PG8_BAR; PG8_MMA(1, 1, At, B1); PG8_BAR;
            }
        }
        if constexpr (ALIGN_EPI) { if (wr == 0) PG8_BAR; }
        if constexpr (!Epi::AFTER_DRAIN) { E(acc, cur, wr, wc, fr, fq); S.done(cur); }
        if (!has_next) break;
#pragma unroll
        for (int a = 0; a < 2; ++a)
#pragma unroll
            for (int b = 0; b < 2; ++b)
#pragma unroll
                for (int m = 0; m < 4; ++m)
#pragma unroll
                    for (int n = 0; n < 2; ++n) acc[a][b][m][n] = (f32x4){0.f, 0.f, 0.f, 0.f};
        cur = nxt; cA = nA; cB = nB; ++ui;
        if constexpr (ALIGN_EPI) { if (wr == 1) PG8_BAR; }
    }
    PG8_WAIT_V(0);
    if constexpr (!ALIGN_EPI) { if (wr == 0) PG8_BAR; }
    PG8_BAR;
    if constexpr (Epi::AFTER_DRAIN) { E.fused(acc, cur, wr, wc, fr, fq, lds, wid, lane); S.done(cur); }
#undef PG8_SA
#undef PG8_SB
#undef PG8_STAGE
#undef PG8_LDA
#undef PG8_LDB
#undef PG8_MMA
#undef PG8_WAIT_V
#undef PG8_WAIT_L
#undef PG8_BAR
#undef PG8_SCHED
}
}

constexpr int NB = 8, SEQ = 2048, DM = 2048, MTOK = NB * SEQ;
constexpr int HD = 128, NPROJ = 7168;
constexpr int DFF = 5632, MEMLEN = 256, MROWS = NB * MEMLEN, XW = 512;
constexpr float EPS = 1e-6f;
constexpr int NWAVES = 8, NTHREADS = 512;
constexpr int LDS_BYTES = 147456;

constexpr size_t MiB = 1u << 20;
constexpr size_t WS_WGU = 1 * MiB, WS_WDOWN = 45 * MiB, WS_SMALL = 67 * MiB, WS_XB = 70 * MiB;
constexpr size_t WS_GATE = 134 * MiB, WS_UP = 310 * MiB;
constexpr size_t WS_WIN = 134 * MiB, WS_PROJ = 162 * MiB, WS_O = 386 * MiB;
constexpr size_t WS_QX = 162 * MiB, WS_OX = 178 * MiB, WS_KVX = 194 * MiB;
constexpr size_t WS_WXQ = 486 * MiB, WS_WXKV = 488 * MiB, WS_WXO = 492 * MiB, WS_WOUT = 494 * MiB, WS_MEMB = 502 * MiB, WS_END = 510 * MiB;
constexpr size_t SM_RSTD1 = 0, SM_RSTD2 = 65536, SM_RSTD3 = 131072, SM_RSTDM = 196608, SM_W16 = 262144, SM_KMEAN = 327680, SM_BETA = 1 * MiB, SM_G = 1 * MiB + 524288;

#define LAS __attribute__((address_space(3)))
typedef unsigned short bf16_t;
typedef float f32x4 __attribute__((ext_vector_type(4)));
typedef unsigned u32x4 __attribute__((ext_vector_type(4)));
typedef unsigned u32x2 __attribute__((ext_vector_type(2)));

__device__ __forceinline__ float bf2f(unsigned v) { return __uint_as_float(v << 16); }
__device__ __forceinline__ unsigned f2bf(float f) { unsigned u = __float_as_uint(f); return (u + 0x7fffu + ((u >> 16) & 1u)) >> 16; }
__device__ __forceinline__ unsigned pk2(float lo, float hi) { return f2bf(lo) | (f2bf(hi) << 16); }
__device__ __forceinline__ float wave_sum(float v) {
#pragma unroll
    for (int o = 1; o < 64; o <<= 1) v += __shfl_xor(v, o);
    return v;
}
__device__ __forceinline__ float silu_acc(float v) { return v / (1.0f + expf(-v)); }

struct Frame {
    LAS unsigned char* lds;
    int tid, lane, wave, G, bid;
    const float* in[23];
    float* out; unsigned char* ws;
};

__device__ __forceinline__ void transpose_item(const float* W, int ldw, int col0, int K, const float* gain, bf16_t* WT, int row_off, int nblk, LAS float* scr, int item, int lane) {
    const int kb = item / nblk, nb = item % nblk, k0 = 64 * kb, n0 = 32 * nb;
#pragma unroll 8
    for (int i = 0; i < 32; ++i) { const int kk = 2 * i + (lane >> 5); float w = W[(size_t)(k0 + kk) * ldw + col0 + n0 + (lane & 31)]; if (gain) w *= gain[k0 + kk]; scr[kk * 33 + (lane & 31)] = w; }
    asm volatile("s_waitcnt lgkmcnt(0)" ::: "memory");
    const int c = lane & 7;
#pragma unroll
    for (int j = 0; j < 4; ++j) { const int n = (lane >> 3) + 8 * j; const LAS float* s = scr + (8 * c) * 33 + n;
        u32x4 o; o.x = pk2(s[0 * 33], s[1 * 33]); o.y = pk2(s[2 * 33], s[3 * 33]); o.z = pk2(s[4 * 33], s[5 * 33]); o.w = pk2(s[6 * 33], s[7 * 33]);
        *(u32x4*)(WT + (size_t)(row_off + n0 + n) * K + k0 + 8 * c) = o; }
    asm volatile("s_waitcnt lgkmcnt(0)" ::: "memory");
}
__device__ __forceinline__ void row_to_bf16(const float* xrow, bf16_t* orow, float* rstd_out, int lane) {
    const f32x4* xr = (const f32x4*)xrow + lane;
    f32x4 v[8]; float s = 0.f;
#pragma unroll
    for (int j = 0; j < 8; ++j) { v[j] = xr[64 * j]; s += (v[j].x * v[j].x + v[j].y * v[j].y) + (v[j].z * v[j].z + v[j].w * v[j].w); }
    s = wave_sum(s);
    if (lane == 0) *rstd_out = rsqrtf(s * (1.0f / DM) + EPS);
    u32x2* o8 = (u32x2*)orow + lane;
#pragma unroll
    for (int j = 0; j < 8; ++j) { u32x2 w; w.x = pk2(v[j].x, v[j].y); w.y = pk2(v[j].z, v[j].w); o8[64 * j] = w; }
}
__device__ __forceinline__ void phase_prologue(const Frame& F) {
    LAS float* scr = (LAS float*)(F.lds + F.wave * 16384);
    const int gw = F.bid * NWAVES + F.wave, NGW = F.G * NWAVES;
    bf16_t* Win_t = (bf16_t*)(F.ws + WS_WIN); bf16_t* Wout_t = (bf16_t*)(F.ws + WS_WOUT); bf16_t* Wxq_t = (bf16_t*)(F.ws + WS_WXQ); bf16_t* Wxkv_t = (bf16_t*)(F.ws + WS_WXKV);
    bf16_t* Wxo_t = (bf16_t*)(F.ws + WS_WXO); bf16_t* Wgu_t = (bf16_t*)(F.ws + WS_WGU); bf16_t* Wdown_t = (bf16_t*)(F.ws + WS_WDOWN);
    constexpr int I_INA = 32 * 128, I_INB = 32 * 96, I_OUT = 32 * 64, I_XQ = 32 * 16, I_XKV = 32 * 32, I_XO = 8 * 64, I_G = 32 * 176, I_D = 88 * 64;
    constexpr int NITEMS = I_INA + I_INB + I_OUT + I_XQ + I_XKV + I_XO + 2 * I_G + I_D;
    for (int it = gw; it < NITEMS; it += NGW) {
        int r = it;
        if (r < I_INA) { transpose_item(F.in[3], 7184, 0, DM, F.in[2], Win_t, 0, 128, scr, r, F.lane); continue; } r -= I_INA;
        if (r < I_INB) { transpose_item(F.in[3], 7184, 4112, DM, F.in[2], Win_t, 4096, 96, scr, r, F.lane); continue; } r -= I_INB;
        if (r < I_OUT) { transpose_item(F.in[10], DM, 0, DM, nullptr, Wout_t, 0, 64, scr, r, F.lane); continue; } r -= I_OUT;
        if (r < I_XQ) { transpose_item(F.in[13], XW, 0, DM, F.in[11], Wxq_t, 0, 16, scr, r, F.lane); continue; } r -= I_XQ;
        if (r < I_XKV) { transpose_item(F.in[14], 2 * XW, 0, DM, F.in[12], Wxkv_t, 0, 32, scr, r, F.lane); continue; } r -= I_XKV;
        if (r < I_XO) { transpose_item(F.in[15], DM, 0, XW, nullptr, Wxo_t, 0, 64, scr, r, F.lane); continue; } r -= I_XO;
        if (r < I_G) { transpose_item(F.in[17], DFF, 0, DM, F.in[16], Wgu_t, 0, 176, scr, r, F.lane); continue; } r -= I_G;
        if (r < I_G) { transpose_item(F.in[18], DFF, 0, DM, F.in[16], Wgu_t, DFF, 176, scr, r, F.lane); continue; } r -= I_G;
        transpose_item(F.in[21], DM, 0, DFF, nullptr, Wdown_t, 0, 64, scr, r, F.lane);
    }
    { bf16_t* W16 = (bf16_t*)(F.ws + WS_SMALL + SM_W16);
      for (int i = F.bid * NTHREADS + F.tid; i < 16 * DM; i += F.G * NTHREADS) { const int j = i >> 11, k = i & 2047; W16[i] = (bf16_t)f2bf(F.in[3][(size_t)k * 7184 + 4096 + j] * F.in[2][k]); } }
    { bf16_t* xb = (bf16_t*)(F.ws + WS_XB); float* rstd1 = (float*)(F.ws + WS_SMALL + SM_RSTD1);
      for (int m = gw; m < MTOK; m += NGW) row_to_bf16(F.in[0] + (size_t)m * DM, xb + (size_t)m * DM, rstd1 + m, F.lane);
      bf16_t* memb = (bf16_t*)(F.ws + WS_MEMB); float* rstdm = (float*)(F.ws + WS_SMALL + SM_RSTDM);
      for (int m = gw; m < MROWS; m += NGW) row_to_bf16(F.in[1] + (size_t)m * DM, memb + (size_t)m * DM, rstdm + m, F.lane); }
}
__device__ __forceinline__ void phase_rownorm(const Frame& F, float* rstd) {
    const int gw = F.bid * NWAVES + F.wave, NGW = F.G * NWAVES; bf16_t* xb = (bf16_t*)(F.ws + WS_XB);
    for (int m = gw; m < MTOK; m += NGW) row_to_bf16(F.out + (size_t)m * DM, xb + (size_t)m * DM, rstd + m, F.lane);
}
__device__ __forceinline__ void phase_final_norm(const Frame& F) {
    const int gw = F.bid * NWAVES + F.wave, NGW = F.G * NWAVES; const f32x4* g4 = (const f32x4*)F.in[22] + F.lane;
    for (int m = gw; m < MTOK; m += NGW) {
        f32x4* xr = (f32x4*)(F.out + (size_t)m * DM) + F.lane; f32x4 v[8]; float s = 0.f;
#pragma unroll
        for (int j = 0; j < 8; ++j) { v[j] = xr[64 * j]; s += (v[j].x * v[j].x + v[j].y * v[j].y) + (v[j].z * v[j].z + v[j].w * v[j].w); }
        const float r = rsqrtf(wave_sum(s) * (1.0f / DM) + EPS);
#pragma unroll
        for (int j = 0; j < 8; ++j) xr[64 * j] = v[j] * r * g4[64 * j];
    }
}
__device__ __forceinline__ void phase_ba_kmean(const Frame& F) {
    const int gw = F.bid * NWAVES + F.wave, NGW = F.G * NWAVES, lane = F.lane;
    const bf16_t* xb = (const bf16_t*)(F.ws + WS_XB); const bf16_t* W16 = (const bf16_t*)(F.ws + WS_SMALL + SM_W16);
    const float* rstd1 = (const float*)(F.ws + WS_SMALL + SM_RSTD1); float* beta = (float*)(F.ws + WS_SMALL + SM_BETA); float* gg = (float*)(F.ws + WS_SMALL + SM_G);
    for (int m = gw; m < MTOK; m += NGW) {
        float xv[32];
#pragma unroll
        for (int j = 0; j < 4; ++j) { const u32x4 a = *(const u32x4*)(xb + (size_t)m * DM + j * 512 + lane * 8);
            xv[8 * j + 0] = bf2f(a.x & 0xffffu); xv[8 * j + 1] = bf2f(a.x >> 16); xv[8 * j + 2] = bf2f(a.y & 0xffffu); xv[8 * j + 3] = bf2f(a.y >> 16);
            xv[8 * j + 4] = bf2f(a.z & 0xffffu); xv[8 * j + 5] = bf2f(a.z >> 16); xv[8 * j + 6] = bf2f(a.w & 0xffffu); xv[8 * j + 7] = bf2f(a.w >> 16); }
        float mine = 0.f;
#pragma unroll 1
        for (int c = 0; c < 16; ++c) { float d = 0.f;
#pragma unroll
            for (int j = 0; j < 4; ++j) { const u32x4 a = *(const u32x4*)(W16 + (size_t)c * DM + j * 512 + lane * 8);
                d += xv[8 * j + 0] * bf2f(a.x & 0xffffu) + xv[8 * j + 1] * bf2f(a.x >> 16) + xv[8 * j + 2] * bf2f(a.y & 0xffffu) + xv[8 * j + 3] * bf2f(a.y >> 16)
                   + xv[8 * j + 4] * bf2f(a.z & 0xffffu) + xv[8 * j + 5] * bf2f(a.z >> 16) + xv[8 * j + 6] * bf2f(a.w & 0xffffu) + xv[8 * j + 7] * bf2f(a.w >> 16); }
            d = wave_sum(d); if (lane == c) mine = d; }
        if (lane < 16) { const float y = mine * rstd1[m]; const int h = lane & 7;
            if (lane < 8) beta[(size_t)m * 8 + h] = 1.0f / (1.0f + expf(-y));
            else { const float z = y + F.in[6][h]; const float sp = z > 20.f ? z : log1pf(expf(z)); gg[(size_t)m * 8 + h] = -expf(F.in[5][h]) * sp; } }
    }
    const bf16_t* proj = (const bf16_t*)(F.ws + WS_PROJ); float* km = (float*)(F.ws + WS_SMALL + SM_KMEAN);
    for (int i = F.bid * NTHREADS + F.tid; i < NB * 8 * 1024; i += F.G * NTHREADS) { const int c = i & 1023, bn = i >> 10;
        const bf16_t* p = proj + (size_t)(bn * 256) * NPROJ + 5120 + c; float s = 0.f;
        for (int t = 0; t < 256; ++t) s += bf2f(p[(size_t)t * NPROJ]);
        km[i] = s * (1.0f / 256.0f); }
}
__device__ __forceinline__ void gdn_naive(const Frame& F, int bh) {
    const int b = bh >> 3, h = bh & 7, tid = F.tid, lane = F.lane, v = tid >> 2, part = tid & 3;
    LAS float* raw = (LAS float*)F.lds;
    LAS float* nrm = raw + 16 * 384;
    LAS float* obuf = nrm + 32;
    const bf16_t* proj = (const bf16_t*)(F.ws + WS_PROJ); const float* beta = (const float*)(F.ws + WS_SMALL + SM_BETA); const float* gg = (const float*)(F.ws + WS_SMALL + SM_G);
    bf16_t* ob = (bf16_t*)(F.ws + WS_O);
    float s[32];
#pragma unroll
    for (int i = 0; i < 32; ++i) s[i] = 0.f;
    float cw0 = 0.f, cw1 = 0.f, cw2 = 0.f, cw3 = 0.f; int pcol = 0;
    if (tid < 384) { pcol = (tid >> 7) * 1024 + h * 128 + (tid & 127); const float* cw = F.in[4]; cw0 = cw[pcol]; cw1 = cw[3072 + pcol]; cw2 = cw[2 * 3072 + pcol]; cw3 = cw[3 * 3072 + pcol]; }
    float x0 = 0.f, x1 = 0.f, x2 = 0.f;
    for (int t0 = 0; t0 < SEQ; t0 += 16) {
        if (tid < 384) {
#pragma unroll 4
            for (int i = 0; i < 16; ++i) { const float x3 = bf2f(proj[(size_t)(b * SEQ + t0 + i) * NPROJ + pcol]); const float y = cw0 * x0 + cw1 * x1 + cw2 * x2 + cw3 * x3;
                raw[i * 384 + tid] = silu_acc(y); x0 = x1; x1 = x2; x2 = x3; } }
        __syncthreads();
#pragma unroll
        for (int rr = 0; rr < 4; ++rr) { const int r = F.wave * 4 + rr, tok = r >> 1, which = r & 1; const float a0 = raw[tok * 384 + which * 128 + lane], a1 = raw[tok * 384 + which * 128 + 64 + lane];
            const float ss = wave_sum(a0 * a0 + a1 * a1); if (lane == 0) nrm[r] = rsqrtf(ss + EPS) * (which == 0 ? 0.08838834764831845f : 1.0f); }
        __syncthreads();
#pragma unroll 1
        for (int i = 0; i < 16; ++i) {
            const int row = b * SEQ + t0 + i; const float bt = beta[(size_t)row * 8 + h], al = expf(gg[(size_t)row * 8 + h]);
            const float nq = nrm[i * 2], nk = nrm[i * 2 + 1], vv = raw[i * 384 + 256 + v];
            float kp[32]; float kS = 0.f;
#pragma unroll
            for (int j = 0; j < 32; ++j) { kp[j] = raw[i * 384 + 128 + part * 32 + j] * nk; kS += kp[j] * s[j]; }
            kS += __shfl_xor(kS, 1); kS += __shfl_xor(kS, 2);
            const float d = bt * (vv - al * kS); float o = 0.f;
#pragma unroll
            for (int j = 0; j < 32; ++j) { s[j] = al * s[j] + kp[j] * d; o += raw[i * 384 + part * 32 + j] * s[j]; }
            o *= nq; o += __shfl_xor(o, 1); o += __shfl_xor(o, 2);
            if (part == 0) obuf[i * 128 + v] = o;
        }
        __syncthreads();
#pragma unroll
        for (int rr = 0; rr < 2; ++rr) { const int tok = F.wave * 2 + rr, row = b * SEQ + t0 + tok; const float a0 = obuf[tok * 128 + lane], a1 = obuf[tok * 128 + 64 + lane];
            const float r = rsqrtf(wave_sum(a0 * a0 + a1 * a1) * (1.0f / HD) + EPS);
            const bf16_t* zp = proj + (size_t)row * NPROJ + 3072 + h * 128;
            ob[(size_t)row * DM + h * 128 + lane] = (bf16_t)f2bf(a0 * r * F.in[7][lane] * bf2f(zp[lane]));
            ob[(size_t)row * DM + h * 128 + 64 + lane] = (bf16_t)f2bf(a1 * r * F.in[7][64 + lane] * bf2f(zp[64 + lane])); }
        __syncthreads();
    }
}
__device__ __forceinline__ void load_tile_f32(LAS float* dst, int stride, const bf16_t* src, int ld, int tid) {
    const int r = tid >> 3, c = (tid & 7) * 16;
    const u32x4 a = *(const u32x4*)(src + (size_t)r * ld + c), bq = *(const u32x4*)(src + (size_t)r * ld + c + 8);
    LAS f32x4* d = (LAS f32x4*)(dst + r * stride + c);
    d[0] = (f32x4){bf2f(a.x & 0xffffu), bf2f(a.x >> 16), bf2f(a.y & 0xffffu), bf2f(a.y >> 16)};
    d[1] = (f32x4){bf2f(a.z & 0xffffu), bf2f(a.z >> 16), bf2f(a.w & 0xffffu), bf2f(a.w >> 16)};
    d[2] = (f32x4){bf2f(bq.x & 0xffffu), bf2f(bq.x >> 16), bf2f(bq.y & 0xffffu), bf2f(bq.y >> 16)};
    d[3] = (f32x4){bf2f(bq.z & 0xffffu), bf2f(bq.z >> 16), bf2f(bq.w & 0xffffu), bf2f(bq.w >> 16)};
}
__device__ __forceinline__ int rel_bucket_dev(int n) {
    if (n < 16) return n;
    const int l = 16 + (int)(logf((float)n * 0.0625f) / 2.0794415416798357f * 16.0f);
    return l < 31 ? l : 31;
}
template <int MODE>
__device__ __forceinline__ void attn_naive_item(const Frame& F, int item) {
    constexpr int QS = 132, PS = 68;
    LAS float* Qs = (LAS float*)F.lds; LAS float* Ks = Qs + 64 * QS; LAS float* Vs = Ks + 64 * QS; LAS float* Ps = Vs + 64 * QS; LAS float* Bt = Ps + 64 * PS;
    const int tid = F.tid, lane = F.lane, q = tid >> 3, sub = tid & 7;
    const bf16_t* proj = (const bf16_t*)(F.ws + WS_PROJ);
    int b, h, qt, ldq, ldk; const bf16_t *Qp, *Kp, *Vp;
    if (MODE == 0) { qt = item & 31; h = (item >> 5) & 7; b = item >> 8; ldq = ldk = NPROJ; Qp = proj + (size_t)(b * SEQ + qt * 64) * NPROJ + 4096 + h * 128; Kp = proj + (size_t)(b * SEQ) * NPROJ + 5120 + h * 128; Vp = Kp + 1024; }
    else { qt = item & 31; h = (item >> 5) & 3; b = item >> 7; ldq = XW; ldk = 2 * XW; Qp = (const bf16_t*)(F.ws + WS_QX) + (size_t)(b * SEQ + qt * 64) * XW + h * 128; Kp = (const bf16_t*)(F.ws + WS_KVX) + (size_t)(b * MEMLEN) * (2 * XW) + h * 128; Vp = Kp + XW; }
    const int own = qt >> 2;
    __syncthreads();
    load_tile_f32(Qs, QS, Qp, ldq, tid);
    if (MODE == 0) { if (tid < 128) Bt[tid] = F.in[9][rel_bucket_dev(tid) * 8 + h]; if (tid == 128) Bt[128] = F.in[9][31 * 8 + h]; }
    __syncthreads();
    int mask = 0;
    if (MODE == 0) {
        const float* km = (const float*)(F.ws + WS_SMALL + SM_KMEAN) + (size_t)(b * 8 + sub) * 1024 + h * 128; float g = -1e30f;
        if (sub < own) { g = 0.f; for (int d = 0; d < 128; ++d) g += Qs[q * QS + d] * km[d]; }
        int cnt = 0;
#pragma unroll
        for (int m = 0; m < 8; ++m) { const float gm = __shfl(g, (lane & ~7) | m); cnt += (gm > g || (gm == g && m < sub)) ? 1 : 0; }
        mask = (sub < own && cnt < 3) ? (1 << sub) : 0;
        mask |= __shfl_xor(mask, 1); mask |= __shfl_xor(mask, 2); mask |= __shfl_xor(mask, 4);
    }
    float m_run = -1e30f, l_run = 0.f; float o[16];
#pragma unroll
    for (int c = 0; c < 16; ++c) o[c] = 0.f;
    const int n_own = (qt & 3) + 1, ntiles = (MODE == 0) ? n_own + 4 * own : 4;
    const float scale = 0.08838834764831845f;
    for (int it = 0; it < ntiles; ++it) {
        int j = 0, keybase;
        if (MODE == 0) { int kt; if (it == 0) { j = own; kt = qt & 3; } else if (it < n_own) { j = own; kt = it - 1; } else { const int r = it - n_own; j = r >> 2; kt = r & 3; } keybase = j * 256 + kt * 64; }
        else keybase = it * 64;
        __syncthreads();
        load_tile_f32(Ks, QS, Kp + (size_t)keybase * ldk, ldk, tid);
        load_tile_f32(Vs, QS, Vp + (size_t)keybase * ldk, ldk, tid);
        __syncthreads();
        float acc[8];
#pragma unroll
        for (int i = 0; i < 8; ++i) acc[i] = 0.f;
#pragma unroll 4
        for (int d4 = 0; d4 < 32; ++d4) { const f32x4 qv = *(const LAS f32x4*)(Qs + q * QS + 4 * d4);
#pragma unroll
            for (int i = 0; i < 8; ++i) { const f32x4 kv = *(const LAS f32x4*)(Ks + (sub + 8 * i) * QS + 4 * d4); acc[i] += (qv.x * kv.x + qv.y * kv.y) + (qv.z * kv.z + qv.w * kv.w); } }
        float tmax = -1e30f; bool valid[8];
#pragma unroll
        for (int i = 0; i < 8; ++i) {
            if (MODE == 0) { const int kpos = keybase + sub + 8 * i, qpos = qt * 64 + q; int n = qpos - kpos; valid[i] = (j == own) ? (n >= 0) : (((mask >> j) & 1) != 0); n = n < 0 ? 0 : (n > 128 ? 128 : n);
                acc[i] = valid[i] ? acc[i] * scale + Bt[n] : -1e30f; }
            else { valid[i] = true; acc[i] *= scale; }
            tmax = fmaxf(tmax, acc[i]); }
        tmax = fmaxf(tmax, __shfl_xor(tmax, 1)); tmax = fmaxf(tmax, __shfl_xor(tmax, 2)); tmax = fmaxf(tmax, __shfl_xor(tmax, 4));
        const float m_new = fmaxf(m_run, tmax), alpha = expf(m_run - m_new); float psum = 0.f;
#pragma unroll
        for (int i = 0; i < 8; ++i) { const float p = valid[i] ? expf(acc[i] - m_new) : 0.f; psum += p; Ps[q * PS + sub + 8 * i] = p; }
        psum += __shfl_xor(psum, 1); psum += __shfl_xor(psum, 2); psum += __shfl_xor(psum, 4);
        l_run = l_run * alpha + psum; m_run = m_new;
#pragma unroll
        for (int c = 0; c < 16; ++c) o[c] *= alpha;
        __syncthreads();
#pragma unroll 4
        for (int k = 0; k < 64; ++k) { const float p = Ps[q * PS + k]; const LAS f32x4* vr = (const LAS f32x4*)(Vs + k * QS + sub * 16);
#pragma unroll
            for (int c4 = 0; c4 < 4; ++c4) { const f32x4 vv = vr[c4]; o[4 * c4 + 0] += p * vv.x; o[4 * c4 + 1] += p * vv.y; o[4 * c4 + 2] += p * vv.z; o[4 * c4 + 3] += p * vv.w; } }
    }
    const float inv = 1.0f / l_run;
#pragma unroll
    for (int c = 0; c < 16; ++c) o[c] *= inv;
    const size_t row = (size_t)b * SEQ + qt * 64 + q;
    bf16_t* dst;
    if (MODE == 0) { float ss = 0.f;
#pragma unroll
        for (int c = 0; c < 16; ++c) ss += o[c] * o[c];
        ss += __shfl_xor(ss, 1); ss += __shfl_xor(ss, 2); ss += __shfl_xor(ss, 4);
        const float r = rsqrtf(ss * (1.0f / HD) + EPS);
#pragma unroll
        for (int c = 0; c < 16; ++c) o[c] *= r * F.in[8][sub * 16 + c];
        dst = (bf16_t*)(F.ws + WS_O) + row * DM + 1024 + h * 128 + sub * 16; }
    else dst = (bf16_t*)(F.ws + WS_OX) + row * XW + h * 128 + sub * 16;
    u32x4 w0, w1; w0.x = pk2(o[0], o[1]); w0.y = pk2(o[2], o[3]); w0.z = pk2(o[4], o[5]); w0.w = pk2(o[6], o[7]); w1.x = pk2(o[8], o[9]); w1.y = pk2(o[10], o[11]); w1.z = pk2(o[12], o[13]); w1.w = pk2(o[14], o[15]);
    *(u32x4*)dst = w0; *(u32x4*)(dst + 8) = w1;
}
__device__ __forceinline__ void phase_ffn_act(const Frame& F) {
    const bf16_t* gate = (const bf16_t*)(F.ws + WS_GATE); bf16_t* up = (bf16_t*)(F.ws + WS_UP);
    const float* cw = F.in[19]; const float* cb = F.in[20];
    constexpr int CH = DFF / 8;
    for (size_t i = (size_t)F.bid * NTHREADS + F.tid; i < (size_t)MTOK * CH; i += (size_t)F.G * NTHREADS) {
        const int row = (int)(i / CH), c = (int)(i % CH) * 8, t = row & (SEQ - 1);
        const u32x4 g2 = *(const u32x4*)(gate + (size_t)row * DFF + c);
        u32x4 g1 = (u32x4){0u, 0u, 0u, 0u}, g0 = (u32x4){0u, 0u, 0u, 0u};
        if (t >= 1) g1 = *(const u32x4*)(gate + (size_t)(row - 1) * DFF + c);
        if (t >= 2) g0 = *(const u32x4*)(gate + (size_t)(row - 2) * DFF + c);
        const u32x4 uu = *(const u32x4*)(up + (size_t)row * DFF + c);
        const unsigned a0[4] = {g0.x, g0.y, g0.z, g0.w}, a1[4] = {g1.x, g1.y, g1.z, g1.w}, a2[4] = {g2.x, g2.y, g2.z, g2.w}, au[4] = {uu.x, uu.y, uu.z, uu.w};
        unsigned res[4];
#pragma unroll
        for (int k = 0; k < 4; ++k) { float r2[2];
#pragma unroll
            for (int e = 0; e < 2; ++e) { const int ch = c + 2 * k + e; const unsigned sh = e ? 16u : 0u;
                const float x0 = bf2f((a0[k] >> sh) & 0xffffu), x1 = bf2f((a1[k] >> sh) & 0xffffu), x2 = bf2f((a2[k] >> sh) & 0xffffu), u1 = bf2f((au[k] >> sh) & 0xffffu);
                const float y = cw[ch] * x0 + cw[DFF + ch] * x1 + cw[2 * DFF + ch] * x2 + cb[ch];
                r2[e] = silu_acc(y) * u1; }
            res[k] = pk2(r2[0], r2[1]); }
        *(u32x4*)(up + (size_t)row * DFF + c) = (u32x4){res[0], res[1], res[2], res[3]};
    }
}

struct Args { const float* in[23]; float* out; unsigned char* ws; int ph_lo, ph_hi; };
constexpr int N_PHASES = 14;

__global__ void __launch_bounds__(NTHREADS, 2) mk_fwd(Args args) {
    extern __shared__ __attribute__((aligned(16))) unsigned char lds_raw[];
    Frame F;
    F.lds = (LAS unsigned char*)lds_raw;
    F.tid = threadIdx.x; F.lane = F.tid & 63; F.wave = __builtin_amdgcn_readfirstlane(F.tid >> 6);
    F.G = gridDim.x; F.bid = blockIdx.x;
#pragma unroll
    for (int i = 0; i < 23; ++i) F.in[i] = args.in[i];
    F.out = args.out; F.ws = args.ws;
    const int lo = args.ph_lo, hi = args.ph_hi;
    unsigned char* ws = args.ws;
    const float* rstd1 = (const float*)(ws + WS_SMALL + SM_RSTD1); float* rstd2 = (float*)(ws + WS_SMALL + SM_RSTD2); float* rstd3 = (float*)(ws + WS_SMALL + SM_RSTD3);
    const float* rstdm = (const float*)(ws + WS_SMALL + SM_RSTDM);
    bf16_t* xb = (bf16_t*)(ws + WS_XB);
#define IN(k) (lo <= (k) && (k) < hi)
#define SEAM(k) do { if (IN(k) && IN((k) + 1)) { cg::this_grid().sync(); } } while (0)

    if (IN(0)) { phase_prologue(F); } SEAM(0);
    if (IN(1)) {
        pg8::Gemm g{xb, (const bf16_t*)(ws + WS_WIN), MTOK, NPROJ, DM}; pg8::StaticOrder S; S.init(MTOK, NPROJ, F.G, F.bid);
        pg8::EpiScaleBf16 E{(bf16_t*)(ws + WS_PROJ), NPROJ, rstd1, 12, 16, 0, 0};
        pg8::gemm_phase<pg8::EpiScaleBf16, pg8::StaticOrder, true, true>(F.lds, g, S, E);
    } SEAM(1);
    if (IN(2)) { phase_ba_kmean(F); } SEAM(2);
    if (IN(3)) {
        if (F.bid < 64) gdn_naive(F, F.bid);
        else for (int it = F.bid - 64; it < NB * 8 * 32; it += F.G - 64) attn_naive_item<0>(F, it);
    } SEAM(3);
    if (IN(4)) {
        pg8::Gemm g{(const bf16_t*)(ws + WS_O), (const bf16_t*)(ws + WS_WOUT), MTOK, DM, DM}; pg8::StaticOrder S; S.init(MTOK, DM, F.G, F.bid);
        pg8::EpiResidF32 E{F.in[0], F.out, DM};
        pg8::gemm_phase<pg8::EpiResidF32, pg8::StaticOrder, true, true>(F.lds, g, S, E);
    } SEAM(4);
    if (IN(5)) { phase_rownorm(F, rstd2); } SEAM(5);
    if (IN(6)) {
        { pg8::Gemm g{xb, (const bf16_t*)(ws + WS_WXQ), MTOK, XW, DM}; pg8::StaticOrder S; S.init(MTOK, XW, F.G, F.bid);
          pg8::EpiScaleBf16 E{(bf16_t*)(ws + WS_QX), XW, rstd2, 0, 0, 0, 0};
          pg8::gemm_phase<pg8::EpiScaleBf16, pg8::StaticOrder, true, true>(F.lds, g, S, E); }
        { pg8::Gemm g{(const bf16_t*)(ws + WS_MEMB), (const bf16_t*)(ws + WS_WXKV), MROWS, 2 * XW, DM}; pg8::StaticOrder S; S.init(MROWS, 2 * XW, F.G, (F.bid + F.G - 128) % F.G);
          pg8::EpiScaleBf16 E{(bf16_t*)(ws + WS_KVX), 2 * XW, rstdm, 0, 0, 0, 0};
          pg8::gemm_phase<pg8::EpiScaleBf16, pg8::StaticOrder, true, true>(F.lds, g, S, E); }
    } SEAM(6);
    if (IN(7)) { for (int it = F.bid; it < NB * 4 * 32; it += F.G) attn_naive_item<1>(F, it); } SEAM(7);
    if (IN(8)) {
        pg8::Gemm g{(const bf16_t*)(ws + WS_OX), (const bf16_t*)(ws + WS_WXO), MTOK, DM, XW}; pg8::StaticOrder S; S.init(MTOK, DM, F.G, F.bid);
        pg8::EpiResidF32 E{F.out, F.out, DM};
        pg8::gemm_phase<pg8::EpiResidF32, pg8::StaticOrder, true, true>(F.lds, g, S, E);
    } SEAM(8);
    if (IN(9)) { phase_rownorm(F, rstd3); } SEAM(9);
    if (IN(10)) {
        pg8::Gemm g{xb, (const bf16_t*)(ws + WS_WGU), MTOK, 2 * DFF, DM}; pg8::StaticOrder S; S.init(MTOK, 2 * DFF, F.G, F.bid);
        pg8::EpiScaleBf16 E{(bf16_t*)(ws + WS_GATE), DFF, rstd3, 0, 0, DFF, (size_t)(WS_UP - WS_GATE) / 2};
        pg8::gemm_phase<pg8::EpiScaleBf16, pg8::StaticOrder, true, true>(F.lds, g, S, E);
    } SEAM(10);
    if (IN(11)) { phase_ffn_act(F); } SEAM(11);
    if (IN(12)) {
        pg8::Gemm g{(const bf16_t*)(ws + WS_UP), (const bf16_t*)(ws + WS_WDOWN), MTOK, DM, DFF}; pg8::StaticOrder S; S.init(MTOK, DM, F.G, F.bid);
        pg8::EpiResidF32 E{F.out, F.out, DM};
        pg8::gemm_phase<pg8::EpiResidF32, pg8::StaticOrder, true, true>(F.lds, g, S, E);
    } SEAM(12);
    if (IN(13)) { phase_final_norm(F); }
#undef IN
#undef SEAM
}

extern "C" void kernel_launch(void* const* d_in, const int* in_sizes, int n_in, void* d_out, int out_size, void* d_ws, size_t ws_size, hipStream_t stream) {
    static int grid = 0;
    if (grid == 0) {
        if (n_in != 23 || in_sizes[0] != MTOK * DM || out_size != MTOK * DM || ws_size < WS_END) {
            fprintf(stderr, "kernel_launch: unexpected shapes: n_in %d, in0 %d, out %d, ws %zu (need >= %zu); nothing launched\n", n_in, n_in > 0 ? in_sizes[0] : -1, out_size, ws_size, (size_t)WS_END); grid = -1; return; }
        int dev = 0, cus = 0, per_cu = 0;
        if (hipGetDevice(&dev) != hipSuccess || hipDeviceGetAttribute(&cus, hipDeviceAttributeMultiprocessorCount, dev) != hipSuccess) { fprintf(stderr, "kernel_launch: device query failed\n"); grid = -1; return; }
        if (hipFuncSetAttribute((const void*)mk_fwd, hipFuncAttributeMaxDynamicSharedMemorySize, LDS_BYTES) != hipSuccess) { fprintf(stderr, "kernel_launch: hipFuncSetAttribute failed\n"); grid = -1; return; }
        if (hipOccupancyMaxActiveBlocksPerMultiprocessor(&per_cu, (const void*)mk_fwd, NTHREADS, LDS_BYTES) != hipSuccess || per_cu < 1) { fprintf(stderr, "kernel_launch: occupancy query says %d blocks per CU\n", per_cu); per_cu = 1; }
        (void)hipGetLastError();
        if (per_cu > 1) per_cu = 1;
        grid = cus * per_cu;
    }
    if (grid < 0) return;
    Args a{};
    for (int i = 0; i < 23; ++i) a.in[i] = (const float*)d_in[i];
    a.out = (float*)d_out; a.ws = (unsigned char*)d_ws;
#if MK_MULTI
    for (int p = 0; p < N_PHASES; ++p) { a.ph_lo = p; a.ph_hi = p + 1; hipLaunchKernelGGL(mk_fwd, dim3(grid), dim3(NTHREADS), LDS_BYTES, stream, a); }
#else
    a.ph_lo = 0; a.ph_hi = N_PHASES;
    void* kargs[] = {&a};
    hipError_t e = hipLaunchCooperativeKernel((const void*)mk_fwd, dim3(grid), dim3(NTHREADS), kargs, LDS_BYTES, stream);
    if (e != hipSuccess) fprintf(stderr, "kernel_launch: cooperative launch failed: %s (grid %d)\n", hipGetErrorString(e), grid);
#endif
}
```

```cpp
#include <hip/hip_runtime.h>
#include <hip/hip_cooperative_groups.h>
#include <cstdio>
#include <cstdint>
namespace cg = cooperative_groups;

#ifndef MK_MULTI
#define MK_MULTI 0
#endif

namespace pg8 {
#define PG8_LAS __attribute__((address_space(3)))
typedef unsigned short bf16_t;
typedef short bf16x8 __attribute__((ext_vector_type(8)));
typedef float f32x4 __attribute__((ext_vector_type(4)));
typedef unsigned u32x4 __attribute__((ext_vector_type(4)));
typedef int pg8_v4i __attribute__((ext_vector_type(4)));
typedef int pg8_v8i __attribute__((ext_vector_type(8)));
constexpr int BM = 256, BK = 64, HALF = 128, HTB = HALF * BK * 2  , STAGE_BYTES = 8 * HTB, NXCD = 8, WGM = 8;

__host__ __device__ __forceinline__ int lds_byte(int r, int c) { const int st = (r >> 4) * 2 + (c >> 5), rr = r & 15, cc = c & 31, ob = rr * 64 + cc * 2; return st * 1024 + (ob ^ (((ob >> 9) & 1) << 5)); }
__host__ __device__ __forceinline__ void stage_rc(int b, int& R, int& C) { const int st = b / 1024, sb = b % 1024, swz = sb ^ (((sb >> 9) & 1) << 5); R = (st >> 1) * 16 + swz / 64; C = (st & 1) * 32 + (swz % 64) / 2; }
__host__ __device__ __forceinline__ int perm32(int rho) { const int n = rho >> 4, i = rho & 15; return 8 * (i >> 2) + 4 * n + (i & 3); }

struct Unit { int pm, pn; };
struct Gemm { const bf16_t* A; const bf16_t* Bt; int M, N, K; };

struct StaticOrder {
    int nM, nN, nwg, G, c;
    __host__ __device__ __forceinline__ void init(int M, int N, int G_, int c_) { nM = M / BM; nN = N / BM; nwg = nM * nN; G = G_; c = c_; }
    __host__ __device__ __forceinline__ bool next(int i, Unit& u) const {
        const long L = (long)i * G + c; if (L >= nwg) return false;
        int wgid = (int)L; { const int q = nwg / NXCD, r = nwg % NXCD, xcd = wgid % NXCD, off = wgid / NXCD; wgid = (xcd < r ? xcd * (q + 1) : r * (q + 1) + (xcd - r) * q) + off; }
        const int nig = WGM * nN, gid = wgid / nig, fm = gid * WGM, gsz = (nM - fm) < WGM ? (nM - fm) : WGM;
        u.pm = fm + ((wgid % nig) % gsz); u.pn = (wgid % nig) / gsz; return true;
    }
    __device__ __forceinline__ void a_ready(const Unit&) const {}
    __device__ __forceinline__ void done(const Unit&) const {}
};


__device__ __forceinline__ unsigned cvt_pk_bf16(float lo, float hi) { unsigned r; asm volatile("v_cvt_pk_bf16_f32 %0, %1, %2" : "=v"(r) : "v"(lo), "v"(hi)); return r; }
typedef __bf16 hw_bf16x2 __attribute__((ext_vector_type(2)));
typedef float hw_f32x2 __attribute__((ext_vector_type(2)));
__device__ __forceinline__ unsigned cvt_pk_bf16_acc(float lo, float hi) { const hw_bf16x2 r = __builtin_convertvector((hw_f32x2){lo, hi}, hw_bf16x2); return __builtin_bit_cast(unsigned, r); }
__device__ __forceinline__ float silu_f(float v) { return v * __builtin_amdgcn_rcpf(1.0f + __expf(-v)); }

struct EpiScaleBf16 {
    static constexpr bool PERM = true, AFTER_DRAIN = false;
    bf16_t* O; int ldc; const float* rs; int silu_lo, silu_hi; int split_cols; size_t split_stride; float* km; int km_lo, km_hi; int rs_sumsq; float oscale; int qs_lo, qs_hi; float qscale;
    __device__ __forceinline__ void operator()(const f32x4 (&acc)[2][2][4][2], const Unit& u, int wr, int wc, int fr, int fq) const {
        int colt = u.pn * BM; bf16_t* base = O; if (split_cols && colt >= split_cols) { base += split_stride; colt -= split_cols; }
        const int row0 = u.pm * BM + wr * 64 + fr, col0 = colt + wc * 32 + 8 * fq;
        const bool act = (u.pn >= silu_lo && u.pn < silu_hi); const float tscale = (u.pn >= qs_lo && u.pn < qs_hi) ? oscale * qscale : oscale;
        const bool dokm = km && u.pn >= km_lo && u.pn < km_hi; float cs[2][8];
#pragma unroll
        for (int a_ = 0; a_ < 2; ++a_)
#pragma unroll
            for (int b_ = 0; b_ < 8; ++b_) cs[a_][b_] = 0.f;
        float rsv[2][4];
#pragma unroll
        for (int ai = 0; ai < 2; ++ai)
#pragma unroll
            for (int m = 0; m < 4; ++m) rsv[ai][m] = rs ? rs[row0 + ai * HALF + m * 16] : 1.0f;
#pragma unroll
        for (int ai = 0; ai < 2; ++ai)
#pragma unroll
            for (int m = 0; m < 4; ++m) { const int row = row0 + ai * HALF + m * 16; float r = rsv[ai][m]; if (rs_sumsq) r = rsqrtf(r * (1.0f / 2048.0f) + 1e-6f); r *= tscale; bf16_t* rowp = base + (size_t)row * ldc + col0;
#pragma unroll
                for (int bj = 0; bj < 2; ++bj) { f32x4 v0 = acc[ai][bj][m][0] * r, v1 = acc[ai][bj][m][1] * r;
                    if (act) {
#pragma unroll
                        for (int j = 0; j < 4; ++j) { v0[j] = silu_f(v0[j]); v1[j] = silu_f(v1[j]); } }
                    if (dokm) {
#pragma unroll
                        for (int j = 0; j < 4; ++j) { cs[bj][j] += v0[j]; cs[bj][4 + j] += v1[j]; } }
                    u32x4 w; w.x = cvt_pk_bf16(v0[0], v0[1]); w.y = cvt_pk_bf16(v0[2], v0[3]); w.z = cvt_pk_bf16(v1[0], v1[1]); w.w = cvt_pk_bf16(v1[2], v1[3]);
                    *(u32x4*)(rowp + bj * HALF) = w; } }
        if (dokm) {
#pragma unroll
            for (int bj = 0; bj < 2; ++bj)
#pragma unroll
                for (int c = 0; c < 8; ++c) { float s = cs[bj][c]; s += __shfl_xor(s, 1); s += __shfl_xor(s, 2); s += __shfl_xor(s, 4); s += __shfl_xor(s, 8);
                    if (fr == 0) atomicAdd(km + (size_t)u.pm * 1024 + (u.pn - km_lo) * BM + bj * HALF + wc * 32 + 8 * fq + c, s * (1.0f / 256.0f)); } }
    }
};
struct EpiResidBf16 {
    static constexpr bool PERM = true, AFTER_DRAIN = false;
    const bf16_t* baseh; bf16_t* out; int ldc; float* rowsq; float accscale; unsigned char* q8;
    __device__ __forceinline__ void operator()(const f32x4 (&acc)[2][2][4][2], const Unit& u, int wr, int wc, int fr, int fq) const {
        const int row0 = u.pm * BM + wr * 64 + fr, col0 = u.pn * BM + wc * 32 + 8 * fq;
#pragma unroll
        for (int ai = 0; ai < 2; ++ai) {
            u32x4 hb[4][2];
#pragma unroll
            for (int m = 0; m < 4; ++m)
#pragma unroll
                for (int bj = 0; bj < 2; ++bj) hb[m][bj] = *(const u32x4*)(baseh + (size_t)(row0 + ai * HALF + m * 16) * ldc + col0 + bj * HALF);
#pragma unroll
            for (int m = 0; m < 4; ++m) { const int row = row0 + ai * HALF + m * 16; const size_t off = (size_t)row * ldc + col0; float ss = 0.f;
#pragma unroll
                for (int bj = 0; bj < 2; ++bj) { const u32x4 h = hb[m][bj];
                    const f32x4 b0 = (f32x4){__uint_as_float(h.x << 16), __uint_as_float(h.x & 0xffff0000u), __uint_as_float(h.y << 16), __uint_as_float(h.y & 0xffff0000u)};
                    const f32x4 b1 = (f32x4){__uint_as_float(h.z << 16), __uint_as_float(h.z & 0xffff0000u), __uint_as_float(h.w << 16), __uint_as_float(h.w & 0xffff0000u)};
                    const f32x4 v0 = b0 + acc[ai][bj][m][0] * accscale, v1 = b1 + acc[ai][bj][m][1] * accscale;
                    ss += (v0[0] * v0[0] + v0[1] * v0[1]) + (v0[2] * v0[2] + v0[3] * v0[3]) + (v1[0] * v1[0] + v1[1] * v1[1]) + (v1[2] * v1[2] + v1[3] * v1[3]);
                    u32x4 w; w.x = cvt_pk_bf16(v0[0], v0[1]); w.y = cvt_pk_bf16(v0[2], v0[3]); w.z = cvt_pk_bf16(v1[0], v1[1]); w.w = cvt_pk_bf16(v1[2], v1[3]);
                    *(u32x4*)(out + off + bj * HALF) = w;
                    if (q8) { int q0 = __builtin_amdgcn_cvt_pk_fp8_f32(v0[0], v0[1], 0, false); q0 = __builtin_amdgcn_cvt_pk_fp8_f32(v0[2], v0[3], q0, true);
                        int q1 = __builtin_amdgcn_cvt_pk_fp8_f32(v1[0], v1[1], 0, false); q1 = __builtin_amdgcn_cvt_pk_fp8_f32(v1[2], v1[3], q1, true);
                        typedef unsigned u32x2_ __attribute__((ext_vector_type(2))); *(u32x2_*)(q8 + off + bj * HALF) = (u32x2_){(unsigned)q0, (unsigned)q1}; } }
                ss += __shfl_xor(ss, 16); ss += __shfl_xor(ss, 32);
                if (fq == 0) atomicAdd(rowsq + row, ss); } }
    }
};

struct EpiFfn {
    static constexpr bool PERM = true, AFTER_DRAIN = false;
    unsigned char* H8; const float* rsq; const float* cw; const float* cb; bf16_t* halo; PG8_LAS float* X;
    float oscale;
    __device__ __forceinline__ void operator()(f32x4 (&acc)[2][2][4][2], const Unit& u, int wr, int wc, int fr_in, int fq_in) const {
        int fr = fr_in, fq = fq_in; asm volatile("" : "+v"(fr), "+v"(fq));
        const int wid = wr * 4 + wc, ch = u.pn * 128 + wc * 32 + 8 * fq, lane = fq * 16 + fr;
#pragma unroll
        for (int ai = 0; ai < 2; ++ai)
#pragma unroll
            for (int m = 0; m < 4; ++m) { const int row = u.pm * BM + ai * HALF + wr * 64 + m * 16 + fr; const float r = rsqrtf(rsq[row] * (1.0f / 2048.0f) + 1e-6f) * oscale;
#pragma unroll
                for (int bj = 0; bj < 2; ++bj) { acc[ai][bj][m][0] = acc[ai][bj][m][0] * r; acc[ai][bj][m][1] = acc[ai][bj][m][1] * r; } }
        if (fr >= 14) {
#pragma unroll
            for (int ai = 0; ai < 2; ++ai) { PG8_LAS f32x4* xp = (PG8_LAS f32x4*)(X + ((wid * 2 + ai) * 2 + (fr - 14)) * 64 + fq * 8); xp[0] = acc[ai][0][3][0]; xp[1] = acc[ai][0][3][1]; } }
        { bf16_t* hp = halo + (size_t)u.pm * 6 * 5632 + ch;
          if (wr == 1 && fr >= 14) { u32x4 w = {cvt_pk_bf16(acc[1][0][3][0][0], acc[1][0][3][0][1]), cvt_pk_bf16(acc[1][0][3][0][2], acc[1][0][3][0][3]), cvt_pk_bf16(acc[1][0][3][1][0], acc[1][0][3][1][1]), cvt_pk_bf16(acc[1][0][3][1][2], acc[1][0][3][1][3])};
              *(u32x4*)(hp + (size_t)(fr - 14) * 5632) = w; }
          if (wr == 0 && fr < 2) { u32x4 w = {cvt_pk_bf16(acc[0][0][0][0][0], acc[0][0][0][0][1]), cvt_pk_bf16(acc[0][0][0][0][2], acc[0][0][0][0][3]), cvt_pk_bf16(acc[0][0][0][1][0], acc[0][0][0][1][1]), cvt_pk_bf16(acc[0][0][0][1][2], acc[0][0][0][1][3])};
              *(u32x4*)(hp + (size_t)(2 + fr) * 5632) = w;
              u32x4 w2 = {cvt_pk_bf16(acc[0][1][0][0][0], acc[0][1][0][0][1]), cvt_pk_bf16(acc[0][1][0][0][2], acc[0][1][0][0][3]), cvt_pk_bf16(acc[0][1][0][1][0], acc[0][1][0][1][1]), cvt_pk_bf16(acc[0][1][0][1][2], acc[0][1][0][1][3])};
              *(u32x4*)(hp + (size_t)(4 + fr) * 5632) = w2; } }
        const f32x4 w0a = *(const f32x4*)(cw + ch), w0b = *(const f32x4*)(cw + ch + 4), w1a = *(const f32x4*)(cw + 5632 + ch), w1b = *(const f32x4*)(cw + 5632 + ch + 4);
        const f32x4 w2a = *(const f32x4*)(cw + 2 * 5632 + ch), w2b = *(const f32x4*)(cw + 2 * 5632 + ch + 4), ba = *(const f32x4*)(cb + ch), bb = *(const f32x4*)(cb + ch + 4);
        asm volatile("s_waitcnt lgkmcnt(0)" ::: "memory"); __builtin_amdgcn_s_barrier(); asm volatile("" ::: "memory");
#pragma unroll
        for (int ai = 1; ai >= 0; --ai)
#pragma unroll
            for (int m = 3; m >= 0; --m) {
                f32x4 pv0, pv1;
                if (m > 0) { pv0 = acc[ai][0][m - 1][0]; pv1 = acc[ai][0][m - 1][1]; }
                else { pv0 = (f32x4){0.f, 0.f, 0.f, 0.f}; pv1 = pv0;
                    if (!(wr == 0 && ai == 0) && fr >= 14) { const int pw = (1 - wr) * 4 + wc, pai = (wr == 1) ? ai : 0;
                        const PG8_LAS f32x4* xp = (const PG8_LAS f32x4*)(X + ((pw * 2 + pai) * 2 + (fr - 14)) * 64 + fq * 8); pv0 = xp[0]; pv1 = xp[1]; } }
                const f32x4 g0 = acc[ai][0][m][0], g1 = acc[ai][0][m][1], u0 = acc[ai][1][m][0], u1 = acc[ai][1][m][1];
                float hv[8];
#pragma unroll
                for (int c = 0; c < 8; ++c) { const float gc = c < 4 ? g0[c & 3] : g1[c & 3], pc = c < 4 ? pv0[c & 3] : pv1[c & 3];
                    const float x1 = __int_as_float(__builtin_amdgcn_update_dpp(0, __float_as_int(fr == 15 ? pc : gc), 0x121, 0xf, 0xf, false)), x2 = __int_as_float(__builtin_amdgcn_update_dpp(0, __float_as_int(fr >= 14 ? pc : gc), 0x122, 0xf, 0xf, false));
                    const float y = (c < 4 ? w0a[c & 3] : w0b[c & 3]) * x2 + (c < 4 ? w1a[c & 3] : w1b[c & 3]) * x1 + (c < 4 ? w2a[c & 3] : w2b[c & 3]) * gc + (c < 4 ? ba[c & 3] : bb[c & 3]);
                    hv[c] = y * __builtin_amdgcn_rcpf(1.0f + __expf(-y)) * (c < 4 ? u0[c & 3] : u1[c & 3]); }
                int q0 = __builtin_amdgcn_cvt_pk_fp8_f32(hv[0], hv[1], 0, false); q0 = __builtin_amdgcn_cvt_pk_fp8_f32(hv[2], hv[3], q0, true);
                int q1 = __builtin_amdgcn_cvt_pk_fp8_f32(hv[4], hv[5], 0, false); q1 = __builtin_amdgcn_cvt_pk_fp8_f32(hv[6], hv[7], q1, true);
                typedef unsigned u32x2_ __attribute__((ext_vector_type(2)));
                *(u32x2_*)(H8 + (size_t)(u.pm * BM + ai * HALF + wr * 64 + m * 16 + fr) * 5632 + ch) = (u32x2_){(unsigned)q0, (unsigned)q1}; }
    }
};

template <class Epi, class Sched, bool ALIGN_EPI = false, bool SP2 = false, bool F8 = false>
__device__ __forceinline__ void gemm_phase(PG8_LAS unsigned char* lds, const Gemm g, const Sched& S, const Epi& E, const int tid, const int wid) {
    const int lane = tid & 63, wr = wid >> 2, wc = wid & 3, fr = lane & 15, fq = lane >> 4;
    const int K = g.K, nt = K / BK;
    unsigned voffA[2], voffB[2];
#pragma unroll
    for (int i = 0; i < 2; ++i) { int R, C; stage_rc(tid * 16 + i * 8192, R, C); const int Rb = Epi::PERM ? ((R & ~31) + perm32(R & 31)) : R;
        voffA[i] = (unsigned)(R * K + C) * 2u; voffB[i] = (unsigned)(Rb * K + C) * 2u; }
    const size_t kstep = (size_t)(BK * 2);
    const size_t hstep = (size_t)HALF * K * 2;
    const size_t tstep = 2 * hstep;
    const unsigned ldsw = (unsigned)wid * 1024u;
    const int aoff = lds_byte(wr * 64 + fr, fq * 8), boff = lds_byte(wc * 32 + fr, fq * 8);
#define PG8_SA(b, h) (((b) * 2 + (h)) * HTB)
#define PG8_SB(b, h) ((4 + (b) * 2 + (h)) * HTB)
#define PG8_STAGE(bufoff, gbase, voff) do { _Pragma("unroll") for (int _i = 0; _i < 2; ++_i) { unsigned vo_ = (voff)[_i]; if constexpr (F8) asm volatile("" : "+v"(vo_));     \
        __builtin_amdgcn_global_load_lds((const unsigned*)((const char*)(gbase) + vo_), (PG8_LAS unsigned*)(lds + (bufoff) + ldsw + _i * 8192), 16, 0, 0); } } while (0)
#define PG8_LDA(dst, b, h) do { if constexpr (F8) { _Pragma("unroll") for (int m = 0; m < 4; ++m) { const pg8_v4i l_ = *(const PG8_LAS pg8_v4i*)(lds + PG8_SA(b, h) + aoff + m * 2048), h_ = *(const PG8_LAS pg8_v4i*)(lds + PG8_SA(b, h) + aoff + m * 2048 + 1024); \
            dst##8[m] = __builtin_shufflevector(l_, h_, 0, 1, 2, 3, 4, 5, 6, 7); } } \
        else { _Pragma("unroll") for (int m = 0; m < 4; ++m) _Pragma("unroll") for (int k = 0; k < 2; ++k) dst[m][k] = *(const PG8_LAS bf16x8*)(lds + PG8_SA(b, h) + aoff + m * 2048 + k * 1024); } } while (0)
#define PG8_LDB(dst, b, h) do { if constexpr (F8) { _Pragma("unroll") for (int n = 0; n < 2; ++n) { const pg8_v4i l_ = *(const PG8_LAS pg8_v4i*)(lds + PG8_SB(b, h) + boff + n * 2048), h_ = *(const PG8_LAS pg8_v4i*)(lds + PG8_SB(b, h) + boff + n * 2048 + 1024); \
            dst##8[n] = __builtin_shufflevector(l_, h_, 0, 1, 2, 3, 4, 5, 6, 7); } } \
        else { _Pragma("unroll") for (int n = 0; n < 2; ++n) _Pragma("unroll") for (int k = 0; k < 2; ++k) dst[n][k] = *(const PG8_LAS bf16x8*)(lds + PG8_SB(b, h) + boff + n * 2048 + k * 1024); } } while (0)
#define PG8_MMA(ai, bj, At, Bt) do { __builtin_amdgcn_s_setprio(1); \
        if constexpr (F8) { _Pragma("unroll") for (int m = 0; m < 4; ++m) _Pragma("unroll") for (int n = 0; n < 2; ++n) \
            acc[ai][bj][m][n] = __builtin_amdgcn_mfma_scale_f32_16x16x128_f8f6f4(Bt##8[n], At##8[m], acc[ai][bj][m][n], 0, 0, 0, 0x7f7f7f7f, 0, 0x7f7f7f7f); } \
        else { _Pragma("unroll") for (int m = 0; m < 4; ++m) _Pragma("unroll") for (int n = 0; n < 2; ++n) _Pragma("unroll") for (int k = 0; k < 2; ++k) \
            acc[ai][bj][m][n] = __builtin_amdgcn_mfma_f32_16x16x32_bf16(Bt[n][k], At[m][k], acc[ai][bj][m][n], 0, 0, 0); } \
        __builtin_amdgcn_s_setprio(0); } while (0)
#define PG8_WAIT_V(n) asm volatile("s_waitcnt vmcnt(" #n ")" ::: "memory")
#define PG8_WAIT_L(n) asm volatile("s_waitcnt lgkmcnt(" #n ")" ::: "memory")
#define PG8_BAR __builtin_amdgcn_s_barrier()
#define PG8_SCHED __builtin_amdgcn_sched_barrier(0)
    Unit cur, nxt; int ui = 0;
    if (!S.next(0, cur)) return;
    f32x4 acc[2][2][4][2];
#pragma unroll
    for (int a = 0; a < 2; ++a)
#pragma unroll
        for (int b = 0; b < 2; ++b)
#pragma unroll
            for (int m = 0; m < 4; ++m)
#pragma unroll
                for (int n = 0; n < 2; ++n) acc[a][b][m][n] = (f32x4){0.f, 0.f, 0.f, 0.f};
    bf16x8 At[4][2], B0[2][2], B1[2][2];
    pg8_v8i At8[4], B08[2], B18[2];
    const char* cA = (const char*)g.A + (size_t)cur.pm * tstep; const char* cB = (const char*)g.Bt + (size_t)cur.pn * tstep;
    S.a_ready(cur);
    if constexpr (SP2) {
        PG8_STAGE(PG8_SB(0, 0), cB, voffB); PG8_STAGE(PG8_SB(0, 1), cB + hstep, voffB); PG8_STAGE(PG8_SA(0, 0), cA, voffA); PG8_STAGE(PG8_SA(0, 1), cA + hstep, voffA);
        if (wr == 1) PG8_BAR;
        PG8_WAIT_V(2); PG8_BAR;
        PG8_STAGE(PG8_SB(1, 0), cB + kstep, voffB); PG8_STAGE(PG8_SA(1, 0), cA + kstep, voffA); PG8_STAGE(PG8_SB(1, 1), cB + hstep + kstep, voffB);
        PG8_WAIT_V(6); PG8_BAR;
    } else {
        PG8_STAGE(PG8_SB(0, 0), cB, voffB); PG8_STAGE(PG8_SA(0, 0), cA, voffA); PG8_STAGE(PG8_SB(0, 1), cB + hstep, voffB); PG8_STAGE(PG8_SA(0, 1), cA + hstep, voffA);
        if (wr == 1) PG8_BAR;
        PG8_WAIT_V(4); PG8_BAR;
        PG8_STAGE(PG8_SB(1, 0), cB + kstep, voffB); PG8_STAGE(PG8_SA(1, 0), cA + kstep, voffA); PG8_STAGE(PG8_SB(1, 1), cB + hstep + kstep, voffB);
        PG8_WAIT_V(6); PG8_BAR;
    }
    for (;;) {
        const bool has_next = S.next(ui + 1, nxt);
        const char* nA = has_next ? (const char*)g.A + (size_t)nxt.pm * tstep : cA; const char* nB = has_next ? (const char*)g.Bt + (size_t)nxt.pn * tstep : cB;
        for (int t = 0; t < nt; t += 2) {
            const bool last = (t == nt - 2);
            const char* a1 = cA + (size_t)(t + 1) * kstep;
            const char* a2 = last ? nA : cA + (size_t)(t + 2) * kstep; const char* b2 = last ? nB : cB + (size_t)(t + 2) * kstep;
            const char* a3 = a2 + kstep; const char* b3 = b2 + kstep;
            if (last && has_next) S.a_ready(nxt);
            if constexpr (SP2) {
            PG8_LDB(B0, 0, 0); PG8_LDB(B1, 0, 1); PG8_SCHED; PG8_LDA(At, 0, 0); PG8_STAGE(PG8_SA(1, 1), a1 + hstep, voffA);
            PG8_WAIT_V(8); PG8_WAIT_L(0); PG8_BAR; PG8_MMA(0, 0, At, B0); PG8_MMA(0, 1, At, B1); PG8_BAR; PG8_SCHED;
            PG8_LDA(At, 0, 1); PG8_STAGE(PG8_SB(0, 0), b2, voffB); PG8_STAGE(PG8_SB(0, 1), b2 + hstep, voffB); PG8_STAGE(PG8_SA(0, 0), a2, voffA);
            PG8_WAIT_V(8); PG8_WAIT_L(0); PG8_BAR; PG8_MMA(1, 0, At, B0); PG8_MMA(1, 1, At, B1); PG8_BAR; PG8_SCHED;
            PG8_LDB(B0, 1, 0); PG8_LDB(B1, 1, 1); PG8_SCHED; PG8_LDA(At, 1, 0); PG8_STAGE(PG8_SA(0, 1), a2 + hstep, voffA);
            PG8_WAIT_V(8); PG8_WAIT_L(0); PG8_BAR; PG8_MMA(0, 0, At, B0); PG8_MMA(0, 1, At, B1); PG8_BAR; PG8_SCHED;
            PG8_LDA(At, 1, 1); PG8_STAGE(PG8_SB(1, 0), b3, voffB); PG8_STAGE(PG8_SB(1, 1), b3 + hstep, voffB); PG8_STAGE(PG8_SA(1, 0), a3, voffA);
            PG8_WAIT_V(8); PG8_WAIT_L(0); PG8_BAR; PG8_MMA(1, 0, At, B0); PG8_MMA(1, 1, At, B1); PG8_BAR; PG8_SCHED;
            } else {
            PG8_LDB(B0, 0, 0); PG8_SCHED; PG8_LDA(At, 0, 0); PG8_STAGE(PG8_SA(1, 1), a1 + hstep, voffA);
            PG8_WAIT_L(8); PG8_BAR; PG8_WAIT_L(0); PG8_MMA(0, 0, At, B0); PG8_BAR; PG8_SCHED;
            PG8_LDB(B1, 0, 1); PG8_STAGE(PG8_SB(0, 0), b2, voffB);
            PG8_BAR; PG8_WAIT_L(0); PG8_MMA(0, 1, At, B1); PG8_BAR;
            PG8_LDA(At, 0, 1); PG8_STAGE(PG8_SA(0, 0), a2, voffA);
            PG8_BAR; PG8_WAIT_L(0); PG8_MMA(1, 0, At, B0); PG8_BAR; PG8_SCHED;
            PG8_STAGE(PG8_SB(0, 1), b2 + hstep, voffB);
            PG8_WAIT_V(6); PG8_BAR; PG8_MMA(1, 1, At, B1); PG8_BAR;
            PG8_LDB(B0, 1, 0); PG8_SCHED; PG8_LDA(At, 1, 0); PG8_STAGE(PG8_SA(0, 1), a2 + hstep, voffA);
            PG8_WAIT_L(8); PG8_BAR; PG8_WAIT_L(0); PG8_MMA(0, 0, At, B0); PG8_BAR; PG8_SCHED;
            PG8_LDB(B1, 1, 1); PG8_STAGE(PG8_SB(1, 0), b3, voffB);
            PG8_BAR; PG8_WAIT_L(0); PG8_MMA(0, 1, At, B1); PG8_BAR;
            PG8_LDA(At, 1, 1); PG8_STAGE(PG8_SA(1, 0), a3, voffA);
            PG8_BAR; PG8_WAIT_L(0); PG8_MMA(1, 0, At, B0); PG8_BAR; PG8_SCHED;
            PG8_STAGE(PG8_SB(1, 1), b3 + hstep, voffB);
            PG8_WAIT_V(6); PG8_BAR; PG8_MMA(1, 1, At, B1); PG8_BAR;
            }
        }
        if constexpr (ALIGN_EPI) { if (wr == 0) PG8_BAR; }
        if constexpr (!Epi::AFTER_DRAIN) { E(acc, cur, wr, wc, fr, fq); S.done(cur); }
        if (!has_next) break;
#pragma unroll
        for (int a = 0; a < 2; ++a)
#pragma unroll
            for (int b = 0; b < 2; ++b)
#pragma unroll
                for (int m = 0; m < 4; ++m)
#pragma unroll
                    for (int n = 0; n < 2; ++n) acc[a][b][m][n] = (f32x4){0.f, 0.f, 0.f, 0.f};
        cur = nxt; cA = nA; cB = nB; ++ui;
        if constexpr (ALIGN_EPI) { if (wr == 1) PG8_BAR; }
    }
    PG8_WAIT_V(0);
    if constexpr (!ALIGN_EPI) { if (wr == 0) PG8_BAR; }
    PG8_BAR;
    if constexpr (Epi::AFTER_DRAIN) { E.fused(acc, cur, wr, wc, fr, fq, lds, wid, lane); S.done(cur); }
#undef PG8_SA
#undef PG8_SB
#undef PG8_STAGE
#undef PG8_LDA
#undef PG8_LDB
#undef PG8_MMA
#undef PG8_WAIT_V
#undef PG8_WAIT_L
#undef PG8_BAR
#undef PG8_SCHED
}
}

namespace moba {
constexpr float SCALE = 0.08838834764831845f;
constexpr int NW = 8, QBLK = 32, KVBLK = 64, QB = NW * QBLK, D = 128;
struct CfgMoba { static constexpr int LDQ = 7232, LDK = 7232, LDO = 2048; static constexpr bool MOBA = true; };
struct CfgX { static constexpr int LDQ = 512, LDK = 1024, LDO = 512; static constexpr bool MOBA = false; };
constexpr int SHM_V = KVBLK * D * 2, SHM_K = KVBLK * D * 2;
constexpr int OFF_WS = 2 * SHM_V + 2 * SHM_K, OFF_BT = OFF_WS + NW * 64 * 4;
constexpr int OFF_KM = OFF_BT + 1024;
constexpr int OFF_Q = OFF_KM + 8192;
constexpr int LDS_BYTES = OFF_Q + NW * 8192;
constexpr float THR = 8.f;
constexpr float LOG2E = 1.4426950408889634f, QSCALE = LOG2E * SCALE, THR2 = THR * LOG2E;
typedef short bf16x8 __attribute__((ext_vector_type(8)));
typedef short s16x4 __attribute__((ext_vector_type(4)));
typedef float f32x16 __attribute__((ext_vector_type(16)));
typedef float f32x4 __attribute__((ext_vector_type(4)));
typedef unsigned u32x4 __attribute__((ext_vector_type(4)));
typedef unsigned short bf16;

#define KSWZ(row, colB) ((row) * 256 + ((colB) ^ (((row) & 7) << 4)))
#define SBAR() __builtin_amdgcn_sched_barrier(0)
__device__ __forceinline__ int v_st(int k, int c) { const int kk = (k & ~0xC) | ((k & 4) << 1) | ((k & 8) >> 1); return ((kk >> 3) * 4 + (c >> 5)) * 512 + ((kk & 7) * 32 + (c & 31)) * 2; }
__device__ __forceinline__ int v_rd_base(int lane) { return ((lane & 3) << 3) | (((lane >> 2) & 3) << 6) | (((lane >> 4) & 1) << 5) | (((lane >> 5) & 1) << 8); }
constexpr int v_rd_off(int d0, int ks, int half) { return d0 * 512 + ks * 4096 + half * 2048; }
__device__ __forceinline__ int crow(int r, int hi) { return (r & 3) + 8 * (r >> 2) + 4 * hi; }
__device__ __forceinline__ unsigned cvtpk(float lo, float hi) { unsigned r; asm volatile("v_cvt_pk_bf16_f32 %0, %1, %2" : "=v"(r) : "v"(lo), "v"(hi)); return r; }
__device__ __forceinline__ bf16x8 load8(const bf16* p) { return *reinterpret_cast<const bf16x8*>(p); }
__device__ __forceinline__ void mask_tile(f32x16& p0, f32x16& p1, int dq) {
    const float NEG = -__builtin_inff();
#pragma unroll
    for (int r = 0; r < 16; ++r) { const int c = (r & 3) + 8 * (r >> 2); if (dq - c < 0) p0[r] = NEG; if (dq - c - 32 < 0) p1[r] = NEG; }
}
__device__ __forceinline__ void bias_tile(f32x16& p0, f32x16& p1, int dq, const float* bt) {
#pragma unroll
    for (int r = 0; r < 16; ++r) { const int c = (r & 3) + 8 * (r >> 2); int n0 = dq - c, n1 = dq - c - 32; n0 = n0 < 0 ? 0 : n0; n1 = n1 < 0 ? 0 : n1; p0[r] += bt[n0]; p1[r] += bt[n1]; }
}
__device__ __forceinline__ void sel_tile(f32x16& p0, f32x16& p1, bool sel) {
    const float NEG = -__builtin_inff();
#pragma unroll
    for (int r = 0; r < 16; ++r) { p0[r] = sel ? p0[r] : NEG; p1[r] = sel ? p1[r] : NEG; }
}
template <bool FIRST>
__device__ __forceinline__ void partialSM(f32x16& p0, f32x16& p1, float& m_reg, float& alpha) {
    float pmax = p0[0]; for (int r = 1; r < 16; ++r) pmax = fmaxf(pmax, p0[r]); for (int r = 0; r < 16; ++r) pmax = fmaxf(pmax, p1[r]);
    { auto rr = __builtin_amdgcn_permlane32_swap(__float_as_uint(pmax), __float_as_uint(pmax), false, false);
      pmax = fmaxf(__uint_as_float(rr[0]), __uint_as_float(rr[1])); }
    if (!FIRST && __builtin_expect(__all(pmax <= THR2), 1)) { alpha = 1.f; }
    else { const float d = FIRST ? (pmax > -3.0e38f ? pmax : 0.f) : fmaxf(pmax, 0.f);
        alpha = __builtin_amdgcn_exp2f(-d); m_reg += d;
        for (int r = 0; r < 16; ++r) { p0[r] -= d; p1[r] -= d; } }
    for (int r = 0; r < 16; ++r) p0[r] = __builtin_amdgcn_exp2f(p0[r]);
}
__device__ __forceinline__ void finishSM(f32x16& p0, f32x16& p1, float alpha, float& l_reg, bf16x8& pa0, bf16x8& pa1, bf16x8& pa2, bf16x8& pa3) {
    for (int r = 0; r < 16; ++r) p1[r] = __builtin_amdgcn_exp2f(p1[r]);
    float ps;
    { typedef float f32x8_ __attribute__((ext_vector_type(8))); typedef float f32x2_ __attribute__((ext_vector_type(2)));
      const f32x16 t = p0 + p1; const f32x8_ a = __builtin_shufflevector(t, t, 0, 1, 2, 3, 4, 5, 6, 7) + __builtin_shufflevector(t, t, 8, 9, 10, 11, 12, 13, 14, 15);
      const f32x4 b = __builtin_shufflevector(a, a, 0, 1, 2, 3) + __builtin_shufflevector(a, a, 4, 5, 6, 7); const f32x2_ c = __builtin_shufflevector(b, b, 0, 1) + __builtin_shufflevector(b, b, 2, 3); ps = c.x + c.y; }
    { auto rr = __builtin_amdgcn_permlane32_swap(__float_as_uint(ps), __float_as_uint(ps), false, false);
      ps = __uint_as_float(rr[0]) + __uint_as_float(rr[1]); }
    l_reg = l_reg * alpha + ps;
#define PK4(P, B_, OUT) do { unsigned a0 = cvtpk(P[B_+0], P[B_+1]), a1 = cvtpk(P[B_+2], P[B_+3]);                          \
        unsigned b0 = cvtpk(P[B_+4], P[B_+5]), b1 = cvtpk(P[B_+6], P[B_+7]);                                             \
        auto r0 = __builtin_amdgcn_permlane32_swap(a0, b0, false, false); auto r1 = __builtin_amdgcn_permlane32_swap(a1, b1, false, false); \
        u32x4 w = {r0[0], r1[0], r0[1], r1[1]}; OUT = *reinterpret_cast<bf16x8*>(&w); } while (0)
    PK4(p0, 0, pa0); PK4(p0, 8, pa1); PK4(p1, 0, pa2); PK4(p1, 8, pa3);
#undef PK4
}
template <int KB>
__device__ __forceinline__ void qkt(f32x16& p0, f32x16& p1, const char* K_lds, int r32, int hi, const char* qf, float init) {
#pragma unroll
    for (int r = 0; r < 16; ++r) { p0[r] = init; p1[r] = init; }
    const char* kb[4];
#pragma unroll
    for (int dd = 0; dd < 4; ++dd) kb[dd] = K_lds + KB * SHM_K + KSWZ(r32, (dd * 16 + hi * 8) * 2);
#pragma unroll
    for (int d0 = 0; d0 < 8; ++d0) { const char* a = kb[d0 & 3] + (d0 >> 2) * 128;
        bf16x8 b0 = *reinterpret_cast<const bf16x8*>(a);
        bf16x8 b1 = *reinterpret_cast<const bf16x8*>(a + 32 * 256);
        const bf16x8 qv = *reinterpret_cast<const bf16x8*>(qf + d0 * 1024);
        p0 = __builtin_amdgcn_mfma_f32_32x32x16_bf16(b0, qv, p0, 0, 0, 0);
        p1 = __builtin_amdgcn_mfma_f32_32x32x16_bf16(b1, qv, p1, 0, 0, 0); }
}
template <int VB>
__device__ __forceinline__ void pv_tile(f32x16* o, int vb0, bf16x8 pa0, bf16x8 pa1, bf16x8 pa2, bf16x8 pa3) {
#define TRRD(dst, off) asm volatile("ds_read_b64_tr_b16 %0, %1 offset:%2" : "=&v"(dst) : "v"(vb0), "i"(off) : "memory")
#define PV_D0(d0) do { s16x4 l0, l1, l2, l3, h0, h1, h2, h3; constexpr int b_ = VB * SHM_V + v_rd_off(d0, 0, 0); \
        TRRD(l0, b_); TRRD(h0, b_ + 2048); TRRD(l1, b_ + 4096); TRRD(h1, b_ + 6144); TRRD(l2, b_ + 8192); TRRD(h2, b_ + 10240); TRRD(l3, b_ + 12288); TRRD(h3, b_ + 14336); \
        asm volatile("s_waitcnt lgkmcnt(0)" ::: "memory"); SBAR();   \
        o[d0] = __builtin_amdgcn_mfma_f32_32x32x16_bf16(pa0, (bf16x8){l0[0], l0[1], l0[2], l0[3], h0[0], h0[1], h0[2], h0[3]}, o[d0], 0, 0, 0);   \
        o[d0] = __builtin_amdgcn_mfma_f32_32x32x16_bf16(pa1, (bf16x8){l1[0], l1[1], l1[2], l1[3], h1[0], h1[1], h1[2], h1[3]}, o[d0], 0, 0, 0);   \
        o[d0] = __builtin_amdgcn_mfma_f32_32x32x16_bf16(pa2, (bf16x8){l2[0], l2[1], l2[2], l2[3], h2[0], h2[1], h2[2], h2[3]}, o[d0], 0, 0, 0);   \
        o[d0] = __builtin_amdgcn_mfma_f32_32x32x16_bf16(pa3, (bf16x8){l3[0], l3[1], l3[2], l3[3], h3[0], h3[1], h3[2], h3[3]}, o[d0], 0, 0, 0); } while (0)
    PV_D0(0); PV_D0(1); PV_D0(2); PV_D0(3);
#undef PV_D0
#undef TRRD
}
struct Head { const bf16* Q0; const bf16* K0; const bf16* V0; bf16* O0; const float* km; };
struct Seam { bf16x8 st_v0, st_v1, st_k0, st_k1; };
#define VMW() asm volatile("s_waitcnt vmcnt(0)" ::: "memory")
#define VMWN(n) asm volatile("s_waitcnt vmcnt(%0)" :: "i"(n) : "memory")
#define SLOAD_H(Kp, Vp, k0) do { const bf16* k_ = (Kp) + (size_t)(k0) * Cfg::LDK; const bf16* v_ = (Vp) + (size_t)(k0) * Cfg::LDK; unsigned vo_ = voff; asm volatile("" : "+v"(vo_));     \
                         S.st_v0 = load8(v_ + vo_); S.st_v1 = load8(v_ + 32 * Cfg::LDK + vo_);                                       \
                         S.st_k0 = load8(k_ + vo_); S.st_k1 = load8(k_ + 32 * Cfg::LDK + vo_); } while (0)
#define SWRITE_HK(bf) do { *(bf16x8*)(K_lds + (bf) * SHM_K + kws) = S.st_k0; *(bf16x8*)(K_lds + (bf) * SHM_K + kws + 32 * 256) = S.st_k1; } while (0)
#define SWRITE_HV(bf) do { *(bf16x8*)(V_lds + (bf) * SHM_V + vst0) = S.st_v0; *(bf16x8*)(V_lds + (bf) * SHM_V + vst1) = S.st_v1; } while (0)
#define SWRITE_H(bf) do { SWRITE_HV(bf); SWRITE_HK(bf); } while (0)
template <class Cfg>
__device__ __forceinline__ void prime(const Head& H, int P0, char* lds, Seam& S, const int tid, const int wid) {
    const int lane = tid & 63, r32 = lane & 31, hi = lane >> 5;
    const int sr = tid >> 4, sc = (tid & 15) * 8, kws = KSWZ(sr, sc * 2); char* K_lds = lds + 2 * SHM_V; const unsigned voff = (unsigned)(sr * Cfg::LDK + sc);
    SLOAD_H(H.K0, H.V0, 0);
    { const bf16* qb = H.Q0 + (size_t)(P0 + wid * QBLK) * Cfg::LDQ; const unsigned qoff = (unsigned)(r32 * Cfg::LDQ + hi * 8); char* qf = lds + OFF_Q + wid * 8192 + lane * 16;
      bf16x8 tq[8];
#pragma unroll
      for (int d0 = 0; d0 < 8; ++d0) tq[d0] = load8(qb + qoff + d0 * 16);
      VMW();
#pragma unroll
      for (int d0 = 0; d0 < 8; ++d0) *(bf16x8*)(qf + d0 * 1024) = tq[d0]; }
    SWRITE_HK(0);
    __syncthreads();
}
template <class Cfg>
__device__ __forceinline__ void block(const Head& H, int P0, int P0n, const float* rel_bias, int h, const float* gn, char* lds, Seam& S, const int tid_in, const int wid) {
    int tid = tid_in; asm volatile("" : "+v"(tid));
    const int lane = tid & 63, r32 = lane & 31, hi = lane >> 5;
    const int own = Cfg::MOBA ? (P0 >> 8) : 0;
    const int NT = Cfg::MOBA ? (P0 + QB) / KVBLK : 4;
    const int qlo = P0 + wid * QBLK, qm = qlo + r32 - 4 * hi;
    char* V_lds = lds; char* K_lds = lds + 2 * SHM_V;
    float* ws = (float*)(lds + OFF_WS) + wid * 64; float* li_l = ws, * al_l = ws + 32;
    float* bt = (float*)(lds + OFF_BT);
    char* qf = lds + OFF_Q + wid * 8192 + lane * 16;
    float m_reg = 0.f, l_reg = 0; f32x16 o[4] = {};
    const int sr = tid >> 4, sc = (tid & 15) * 8, vst0 = v_st(sr, sc), vst1 = v_st(32 + sr, sc), kws = KSWZ(sr, sc * 2); const unsigned voff = (unsigned)(sr * Cfg::LDK + sc);
    const int vb0 = (int)(uintptr_t)V_lds + v_rd_base(lane);
    const bf16* Kh = H.K0; const bf16* Vh = H.V0;
    const float b31 = Cfg::MOBA ? rel_bias[31 * 8 + h] : 0.f; const float cinit = b31 * LOG2E;
    if (Cfg::MOBA && tid < 256) { int bk = 31; if (tid < 16) bk = tid; else if (tid < 128) { const int l = 16 + (int)(logf((float)tid * 0.0625f) * 7.694155931f); bk = l < 31 ? l : 31; }
        bt[tid] = (rel_bias[bk * 8 + h] - b31) * LOG2E; }
    if (own >= 4 && tid < 128) { int t_ = tid; asm volatile("" : "+v"(t_));
        const int n = t_ >> 4, c = t_ & 15; const float* kp = H.km + (unsigned)(n * 1024 + c * 8); const f32x4 k0 = *(const f32x4*)kp, k1 = *(const f32x4*)(kp + 4);
        u32x4 w = {cvtpk(k0[0], k0[1]), cvtpk(k0[2], k0[3]), cvtpk(k1[0], k1[1]), cvtpk(k1[2], k1[3])}; *(u32x4*)(lds + OFF_KM + KSWZ(n, c * 16)) = w; }
    int mask = 0;
#define RESC(a) do { if (__any((a) < 1.f)) { if (hi == 0) al_l[r32] = (a); asm volatile("s_waitcnt lgkmcnt(0)" ::: "memory");              \
                     for (int d_ = 0; d_ < 4; ++d_) for (int r = 0; r < 16; ++r) o[d_][r] *= al_l[crow(r, hi)]; } } while (0)
#define KBASE(t) ((t) * KVBLK)
#define MASKT(P0_, P1_, t, SEL0) do { if (Cfg::MOBA) { const int kb_ = KBASE(t); \
        if (qlo - kb_ < 176) bias_tile(P0_, P1_, qm - kb_, bt); \
        if (SEL0 && own >= 4 && kb_ < P0) sel_tile(P0_, P1_, ((mask >> (kb_ >> 8)) & 1) != 0); \
        if (kb_ + KVBLK - 1 > qlo) mask_tile(P0_, P1_, qm - kb_); } } while (0)
#define AINIT(t) ((Cfg::MOBA && own >= 4 && KBASE(t) < P0 && (((mask >> (KBASE(t) >> 8)) & 1) == 0)) ? -__builtin_inff() : cinit - m_reg)
    constexpr int NQL = 8;
#define SEAM_K0() do { VMWN(NQL); SWRITE_HK(0); SBAR(); } while (0)
    f32x16 pA0, pA1, pB0, pB1; float alA, alB; bf16x8 pa0, pa1, pa2, pa3;
    SWRITE_HV(0); SBAR();
    if (NT > 1) { SLOAD_H(Kh, Vh, KBASE(1)); }
    SBAR(); qkt<0>(pA0, pA1, K_lds, r32, hi, qf, cinit);
    __syncthreads();
    if (own >= 4) {
        f32x16 gacc = {};
        const char* kmb[4];
#pragma unroll
        for (int dd = 0; dd < 4; ++dd) kmb[dd] = lds + OFF_KM + KSWZ(r32, (dd * 16 + hi * 8) * 2);
#pragma unroll
        for (int d0 = 0; d0 < 8; ++d0) { const bf16x8 b0 = *reinterpret_cast<const bf16x8*>(kmb[d0 & 3] + (d0 >> 2) * 128); gacc = __builtin_amdgcn_mfma_f32_32x32x16_bf16(b0, *reinterpret_cast<const bf16x8*>(qf + d0 * 1024), gacc, 0, 0, 0); }
        float g[8];
#pragma unroll
        for (int i = 0; i < 4; ++i) { const float mine = gacc[i], oth = __shfl_xor(mine, 32); g[i] = hi ? oth : mine; g[4 + i] = hi ? mine : oth; }
#pragma unroll
        for (int n = 0; n < 7; ++n) { int cnt = 0;
#pragma unroll
            for (int m = 0; m < 7; ++m) cnt += (m != n && m < own && (g[m] > g[n] || (g[m] == g[n] && m < n))) ? 1 : 0;
            mask |= (n < own && cnt < 3) ? (1 << n) : 0; }
    }
    MASKT(pA0, pA1, 0, true); partialSM<true>(pA0, pA1, m_reg, alA);
    if (NT > 1) { VMW(); SWRITE_HK(1); }
    __syncthreads();
#define HALF_STEP(PX0, PX1, alX, PY0, PY1, alY, t, KB, VB, SB) do {                                                      \
        SWRITE_HV(KB); SBAR();                                                                                                \
        if ((t) + 1 < NT) { SLOAD_H(Kh, Vh, KBASE((t) + 1)); SBAR(); }                                               \
        SBAR(); qkt<KB>(PX0, PX1, K_lds, r32, hi, qf, AINIT(t));                                          \
        finishSM(PY0, PY1, alY, l_reg, pa0, pa1, pa2, pa3); SBAR();                                                           \
        pv_tile<VB>(o, vb0, pa0, pa1, pa2, pa3); MASKT(PX0, PX1, (t), false); partialSM<false>(PX0, PX1, m_reg, alX);                                        \
        if ((t) + 1 < NT) { VMW(); SWRITE_HK(SB); }                                                                         \
        RESC(alX); __syncthreads(); } while (0)
    for (int t = 1; t + 1 < NT; t += 2) {
        HALF_STEP(pB0, pB1, alB, pA0, pA1, alA, t, 1, 0, 0);
        HALF_STEP(pA0, pA1, alA, pB0, pB1, alB, t + 1, 0, 1, 1);
    }
    SWRITE_HV(1); SBAR();
    { SBAR(); qkt<1>(pB0, pB1, K_lds, r32, hi, qf, AINIT(NT - 1)); SBAR(); }
    SLOAD_H(Kh, Vh, 0); SBAR();
    bf16x8 tq[8];
    { const bf16* qb = H.Q0 + (size_t)(P0n + wid * QBLK) * Cfg::LDQ; unsigned qoff = (unsigned)(r32 * Cfg::LDQ + hi * 8); asm volatile("" : "+v"(qoff));
#pragma unroll
      for (int d0 = 0; d0 < 8; ++d0) tq[d0] = load8(qb + qoff + d0 * 16); }
    SBAR();
    finishSM(pA0, pA1, alA, l_reg, pa0, pa1, pa2, pa3); SBAR();
    pv_tile<0>(o, vb0, pa0, pa1, pa2, pa3);
    { MASKT(pB0, pB1, NT - 1, false); partialSM<false>(pB0, pB1, m_reg, alB); __syncthreads(); RESC(alB);
      finishSM(pB0, pB1, alB, l_reg, pa0, pa1, pa2, pa3); SBAR(); pv_tile<1>(o, vb0, pa0, pa1, pa2, pa3); }
    SBAR(); SEAM_K0();
    if (hi == 0) li_l[r32] = l_reg; asm volatile("s_waitcnt lgkmcnt(0)" ::: "memory");
    float gnr[4];
    { unsigned go_ = (unsigned)r32; asm volatile("" : "+v"(go_));
#pragma unroll
      for (int d0 = 0; d0 < 4; ++d0) gnr[d0] = Cfg::MOBA ? (gn + go_)[d0 * 32] : 1.0f; }
    bf16* Ow = H.O0 + (size_t)(P0 + wid * QBLK) * Cfg::LDO;
#pragma unroll
    for (int r = 0; r < 16; ++r) { int orow = crow(r, hi); asm volatile("" : "+v"(orow));
        const float rl = __builtin_amdgcn_rcpf(li_l[orow]);
        float v0 = o[0][r] * rl, v1 = o[1][r] * rl, v2 = o[2][r] * rl, v3 = o[3][r] * rl;
        float ss = (v0 * v0 + v1 * v1) + (v2 * v2 + v3 * v3);
        ss += __shfl_xor(ss, 1); ss += __shfl_xor(ss, 2); ss += __shfl_xor(ss, 4); ss += __shfl_xor(ss, 8); ss += __shfl_xor(ss, 16);
        if (Cfg::MOBA) { const float rs = rsqrtf(ss * (1.0f / 128.0f) + 1e-6f); v0 *= rs * gnr[0]; v1 *= rs * gnr[1]; v2 *= rs * gnr[2]; v3 *= rs * gnr[3]; }
        const float n0 = __shfl_xor(v0, 1), n1 = __shfl_xor(v1, 1), n2 = __shfl_xor(v2, 1), n3 = __shfl_xor(v3, 1);
        if ((r32 & 1) == 0) { bf16* op = Ow + (unsigned)(orow * Cfg::LDO + r32);
            *(unsigned*)(op) = cvtpk(v0, n0); *(unsigned*)(op + 32) = cvtpk(v1, n1); *(unsigned*)(op + 64) = cvtpk(v2, n2); *(unsigned*)(op + 96) = cvtpk(v3, n3); } }
    VMW();
#pragma unroll
    for (int d0 = 0; d0 < 8; ++d0) *(bf16x8*)(qf + d0 * 1024) = tq[d0];
    __syncthreads();
#undef RESC
#undef KBASE
#undef MASKT
#undef AINIT
#undef SEAM_K0
#undef HALF_STEP
}
#undef ROW
#undef VMW
#undef VMWN
#undef SLOAD_H
#undef SWRITE_HK
#undef SWRITE_HV
#undef SWRITE_H
#undef KSWZ
#undef SBAR
}

namespace gdn {
typedef short bf16x8 __attribute__((ext_vector_type(8)));
typedef float f32x16 __attribute__((ext_vector_type(16)));
typedef float f32x4 __attribute__((ext_vector_type(4)));
typedef unsigned u32x4 __attribute__((ext_vector_type(4)));
typedef unsigned u32x2 __attribute__((ext_vector_type(2)));
typedef _Float16 f16x4 __attribute__((ext_vector_type(4)));
typedef _Float16 f16x8 __attribute__((ext_vector_type(8)));
#define GLAS __attribute__((address_space(3)))
constexpr int IMG_BYTES = 75776, IMG_W = 0, IMG_U = 16384, IMG_QD = 32768, IMG_KDT = 49152, IMG_QK = 65536, IMG_GL = 73728;
constexpr int IMG_IN_OUT = 1771;
__device__ __forceinline__ int sw256(int row, int cb) { return row * 256 + (cb ^ ((row & 15) << 4)); }
__device__ __forceinline__ int sw128(int row, int cb) { return row * 128 + (cb ^ (((row >> 1) & 7) << 4)); }
__device__ __forceinline__ unsigned cvtpk(float lo, float hi) { unsigned r; asm volatile("v_cvt_pk_bf16_f32 %0, %1, %2" : "=v"(r) : "v"(lo), "v"(hi)); return r; }
__device__ __forceinline__ float bfl(unsigned w) { return __uint_as_float(w << 16); }
__device__ __forceinline__ float bfh(unsigned w) { return __uint_as_float(w & 0xffff0000u); }
__device__ __forceinline__ unsigned char* img_ptr(unsigned char* out_bytes, unsigned char* ws_img, int chunk) {
    return chunk < IMG_IN_OUT ? out_bytes + (size_t)chunk * IMG_BYTES : ws_img + (size_t)(chunk - IMG_IN_OUT) * IMG_BYTES;
}
#define LBAR() asm volatile("s_waitcnt lgkmcnt(0)\n\ts_barrier" ::: "memory")
#define MFMA32(a, b, c) __builtin_amdgcn_mfma_f32_32x32x16_bf16((a), (b), (c), 0, 0, 0)

constexpr int RAWP = 784;
__device__ __forceinline__ void conv16(float (&a)[16], const GLAS unsigned char* rp, const GLAS float* wl) {
    typedef float f32x2 __attribute__((ext_vector_type(2)));
    f32x2 acc[8];
#pragma unroll
    for (int p = 0; p < 8; ++p) acc[p] = (f32x2){0.f, 0.f};
#pragma unroll
    for (int j = 0; j < 4; ++j) { const u32x4 x0 = *(const GLAS u32x4*)(rp + j * RAWP), x1 = *(const GLAS u32x4*)(rp + j * RAWP + 16);
        const GLAS f32x2* wv = (const GLAS f32x2*)(wl + j * 384);
        const unsigned xw[8] = {x0.x, x0.y, x0.z, x0.w, x1.x, x1.y, x1.z, x1.w};
#pragma unroll
        for (int p = 0; p < 8; ++p) { const f32x2 xv = {bfl(xw[p]), bfh(xw[p])}; acc[p] = __builtin_elementwise_fma(wv[p], xv, acc[p]); }
        __builtin_amdgcn_sched_barrier(0); }
#pragma unroll
    for (int p = 0; p < 8; ++p) { a[2 * p] = acc[p].x; a[2 * p + 1] = acc[p].y; }
#pragma unroll
    for (int e = 0; e < 16; ++e) a[e] = a[e] * __builtin_amdgcn_rcpf(1.0f + __expf(-a[e]));
}
__device__ __forceinline__ void raw_load(u32x4 (&rg)[7], const unsigned short* proj, int b, int h, int n, int tid) {
#pragma unroll
    for (int kq = 0; kq < 7; ++kq) { int p = tid + 512 * kq; p = p < 3216 ? p : 3215; const int r = p / 48, q = p - r * 48, pos = n * 64 - 3 + r, posc = pos < 0 ? 0 : pos;
        const u32x4 v = __builtin_nontemporal_load((const u32x4*)(proj + ((size_t)b * 2048 + posc) * 7232 + (q >> 4) * 1024 + h * 128 + (q & 15) * 8));
        rg[kq] = pos < 0 ? (u32x4){0u, 0u, 0u, 0u} : v; }
}
__device__ __forceinline__ void raw_store(const u32x4 (&rg)[7], GLAS unsigned char* raw, int tid) {
#pragma unroll
    for (int kq = 0; kq < 7; ++kq) { const int p = tid + 512 * kq; const int r = p / 48, q = p - r * 48; if (p < 3216) *(GLAS u32x4*)(raw + r * RAWP + q * 16) = rg[kq]; }
}
typedef _Float16 f16x2 __attribute__((ext_vector_type(2)));
template <int I, int K8> __device__ __forceinline__ void inv_k8(float& acc, float& acc1, const float (&tc)[64], const f16x2 (&tn)[32], const GLAS unsigned char* slot) {
    if constexpr (K8 * 8 < I) { const f16x8 av = *(const GLAS f16x8*)(slot + I * 128 + K8 * 16);
#pragma unroll
        for (int p = 0; p < 4; ++p) { const int k = K8 * 8 + 2 * p;
            if (k + 1 < I) { if (p & 1) acc1 = __builtin_amdgcn_fdot2((f16x2){av[2 * p], av[2 * p + 1]}, tn[k >> 1], acc1, false); else acc = __builtin_amdgcn_fdot2((f16x2){av[2 * p], av[2 * p + 1]}, tn[k >> 1], acc, false); }
            else if (k < I) acc1 -= (float)av[2 * p] * tc[k]; }
        inv_k8<I, K8 + 1>(acc, acc1, tc, tn, slot); }
}
template <int I> __device__ __forceinline__ void inv_row(float (&tc)[64], f16x2 (&tn)[32], const GLAS unsigned char* slot, int lane) {
    if constexpr (I < 64) { float acc = (I == lane) ? 1.0f : 0.0f, acc1 = 0.f; inv_k8<I, 0>(acc, acc1, tc, tn, slot); acc += acc1; tc[I] = acc;
        if constexpr (I & 1) tn[I >> 1] = (f16x2){(_Float16)(-tc[I - 1]), (_Float16)(-acc)};
        __builtin_amdgcn_sched_barrier(0);
        inv_row<I + 1>(tc, tn, slot, lane); }
}
__device__ __forceinline__ void prep(GLAS unsigned char* L, int tid, int lane, int wave, int wg, const unsigned short* proj, const float* beta, const float* gg, const float* conv_w,
                                     unsigned char* out_bytes, unsigned char* ws_img, unsigned char* scr) {
    const int r32 = lane & 31, hi = lane >> 5;
    const int bh = wg >> 2, b = bh >> 3, h = bh & 7, cg0 = (wg & 3) * 8;
    GLAS unsigned char* Kt = L; GLAS unsigned char* Qt = L + 16384; GLAS unsigned char* Vt = L + 32768;
    GLAS unsigned char* raw = L;
    GLAS float* Gs = (GLAS float*)(L + 53248); GLAS float* Bs = Gs + 64; GLAS float* gls = Gs + 128; GLAS float* cwL = Gs + 192;
    GLAS float* eRs = Gs + 192 + 1536; GLAS float* bgs = eRs + 64;
    GLAS unsigned char* As = L + 61440;
    for (int i = tid; i < 1536; i += 512) { const int j = i / 384, rem = i - j * 384; cwL[i] = conv_w[j * 3072 + (rem >> 7) * 1024 + h * 128 + (rem & 127)]; }
    u32x4 rg[7];
    raw_load(rg, proj, b, h, cg0, tid);
    float gpf = gg[((size_t)b * 2048 + cg0 * 64 + lane) * 8 + h], bpf = beta[((size_t)b * 2048 + cg0 * 64 + (tid >> 3)) * 8 + h];
    __syncthreads();
#pragma unroll 1
    for (int c = 0; c < 8; ++c) {
        int tt_ = tid; asm volatile("" : "+v"(tt_));
        const int t = tt_ >> 3, seg = tt_ & 7;
        const int n = cg0 + c, chunk = bh * 32 + n, pos = n * 64 + t; const size_t row = (size_t)b * 2048 + pos;
        unsigned char* img = img_ptr(out_bytes, ws_img, chunk);
        unsigned short* vbt = (unsigned short*)(scr + (size_t)chunk * 32768); unsigned short* kgt = vbt + 8192;
        raw_store(rg, raw, tid);
        if (wave == 0) { float g = gpf;
#pragma unroll
            for (int o = 1; o < 64; o <<= 1) { const float y = __shfl_up(g, o); if (lane >= o) g += y; }
            Gs[lane] = g; if (lane == 63) gls[c] = g; }
        if (seg == 0) Bs[t] = bpf;
        LBAR();
        const float G = Gs[t], GL = Gs[63], eG = __expf(G), eR = __expf(GL - G), bt = Bs[t], bg = bt * eG;
        float xq[16], xk[16], xv[16];
        { const GLAS unsigned char* rp = raw + t * RAWP + seg * 32;
          conv16(xq, rp, cwL + seg * 16); conv16(xk, rp + 256, cwL + 128 + seg * 16); conv16(xv, rp + 512, cwL + 256 + seg * 16); }
        { float sq = 0.f, sk = 0.f;
#pragma unroll
          for (int e = 0; e < 16; ++e) { sq += xq[e] * xq[e]; sk += xk[e] * xk[e]; }
          sq += __shfl_xor(sq, 1); sq += __shfl_xor(sq, 2); sq += __shfl_xor(sq, 4); sk += __shfl_xor(sk, 1); sk += __shfl_xor(sk, 2); sk += __shfl_xor(sk, 4);
          const float nq = rsqrtf(sq + 1e-6f) * 0.08838834764831845f, nk = rsqrtf(sk + 1e-6f);
#pragma unroll
          for (int e = 0; e < 16; ++e) { xq[e] *= nq; xk[e] *= nk; xv[e] *= bt; } }
        LBAR();
        { u32x4 w0, w1;
          w0 = (u32x4){cvtpk(xv[0], xv[1]), cvtpk(xv[2], xv[3]), cvtpk(xv[4], xv[5]), cvtpk(xv[6], xv[7])}; w1 = (u32x4){cvtpk(xv[8], xv[9]), cvtpk(xv[10], xv[11]), cvtpk(xv[12], xv[13]), cvtpk(xv[14], xv[15])};
          *(GLAS u32x4*)(Vt + sw256(t, seg * 32)) = w0; *(GLAS u32x4*)(Vt + sw256(t, seg * 32 + 16)) = w1;
          w0 = (u32x4){cvtpk(xk[0], xk[1]), cvtpk(xk[2], xk[3]), cvtpk(xk[4], xk[5]), cvtpk(xk[6], xk[7])}; w1 = (u32x4){cvtpk(xk[8], xk[9]), cvtpk(xk[10], xk[11]), cvtpk(xk[12], xk[13]), cvtpk(xk[14], xk[15])};
          *(GLAS u32x4*)(Kt + sw256(t, seg * 32)) = w0; *(GLAS u32x4*)(Kt + sw256(t, seg * 32 + 16)) = w1;
          w0 = (u32x4){cvtpk(xq[0], xq[1]), cvtpk(xq[2], xq[3]), cvtpk(xq[4], xq[5]), cvtpk(xq[6], xq[7])}; w1 = (u32x4){cvtpk(xq[8], xq[9]), cvtpk(xq[10], xq[11]), cvtpk(xq[12], xq[13]), cvtpk(xq[14], xq[15])};
          *(GLAS u32x4*)(Qt + sw256(t, seg * 32)) = w0; *(GLAS u32x4*)(Qt + sw256(t, seg * 32 + 16)) = w1;
          w0 = (u32x4){cvtpk(xq[0] * eG, xq[1] * eG), cvtpk(xq[2] * eG, xq[3] * eG), cvtpk(xq[4] * eG, xq[5] * eG), cvtpk(xq[6] * eG, xq[7] * eG)};
          w1 = (u32x4){cvtpk(xq[8] * eG, xq[9] * eG), cvtpk(xq[10] * eG, xq[11] * eG), cvtpk(xq[12] * eG, xq[13] * eG), cvtpk(xq[14] * eG, xq[15] * eG)};
          *(u32x4*)(img + IMG_QD + sw256(t, seg * 32)) = w0; *(u32x4*)(img + IMG_QD + sw256(t, seg * 32 + 16)) = w1; }
        if (seg == 0) { eRs[t] = eR; bgs[t] = bg; }
        raw_load(rg, proj, b, h, n < 31 ? n + 1 : n, tid);
        { const int n1 = n < 31 ? n + 1 : n; gpf = gg[((size_t)b * 2048 + n1 * 64 + (tt_ & 63)) * 8 + h]; bpf = beta[((size_t)b * 2048 + n1 * 64 + t) * 8 + h]; }
        LBAR();
        { const int prod = wave >> 2, mj = (wave >> 1) & 1, ni = wave & 1;
          f32x16 acc = {};
          if (!(mj == 1 && ni == 0)) { GLAS unsigned char* Xb = prod ? Qt : Kt;
#pragma unroll
              for (int s = 0; s < 8; ++s) { const bf16x8 a = *(const GLAS bf16x8*)(Kt + sw256(mj * 32 + r32, (16 * s + 8 * hi) * 2)); const bf16x8 bb = *(const GLAS bf16x8*)(Xb + sw256(ni * 32 + r32, (16 * s + 8 * hi) * 2));
                  acc = MFMA32(a, bb, acc); } }
          const int i = ni * 32 + r32; const float Gi = Gs[i], bi = prod ? 1.0f : Bs[i];
#pragma unroll
          for (int g4 = 0; g4 < 4; ++g4) { const int j0 = mj * 32 + 8 * g4 + 4 * hi; float v[4];
#pragma unroll
              for (int e = 0; e < 4; ++e) { const int j = j0 + e; const bool ok = prod ? (j <= i) : (j < i); const float d = ok ? __expf(Gi - Gs[j]) * bi : 0.f; v[e] = ok ? acc[4 * g4 + e] * d : 0.f; }
              if (prod == 0) { f16x4 hv = {(_Float16)v[0], (_Float16)v[1], (_Float16)v[2], (_Float16)v[3]}; *(GLAS f16x4*)(As + c * 8192 + i * 128 + j0 * 2) = hv; }
              else { u32x2 w = {cvtpk(v[0], v[1]), cvtpk(v[2], v[3])}; *(u32x2*)(img + IMG_QK + sw128(i, j0 * 2)) = w; } } }
        { const int ch = tt_ >> 2, tq = tt_ & 3; float kk[16], vk[16];
#pragma unroll
          for (int e = 0; e < 16; ++e) { const int tk = tq * 16 + e; kk[e] = bfl(*(const GLAS unsigned short*)(Kt + sw256(tk, ch * 2))); vk[e] = bfl(*(const GLAS unsigned short*)(Vt + sw256(tk, ch * 2))); }
          unsigned wa[8], wb[8], wc[8];
#pragma unroll
          for (int p = 0; p < 8; ++p) { const int t0 = tq * 16 + 2 * p; wa[p] = cvtpk(kk[2 * p] * eRs[t0], kk[2 * p + 1] * eRs[t0 + 1]); wb[p] = cvtpk(kk[2 * p] * bgs[t0], kk[2 * p + 1] * bgs[t0 + 1]); wc[p] = cvtpk(vk[2 * p], vk[2 * p + 1]); }
          *(u32x4*)(img + IMG_KDT + sw128(ch, tq * 32)) = (u32x4){wa[0], wa[1], wa[2], wa[3]}; *(u32x4*)(img + IMG_KDT + sw128(ch, tq * 32 + 16)) = (u32x4){wa[4], wa[5], wa[6], wa[7]};
          *(u32x4*)(kgt + ch * 64 + tq * 16) = (u32x4){wb[0], wb[1], wb[2], wb[3]}; *(u32x4*)(kgt + ch * 64 + tq * 16 + 8) = (u32x4){wb[4], wb[5], wb[6], wb[7]};
          *(u32x4*)(vbt + ch * 64 + tq * 16) = (u32x4){wc[0], wc[1], wc[2], wc[3]}; *(u32x4*)(vbt + ch * 64 + tq * 16 + 8) = (u32x4){wc[4], wc[5], wc[6], wc[7]}; }
        LBAR();
    }
    GLAS unsigned char* slot = As + wave * 8192;
    int lane2 = lane; asm volatile("" : "+v"(lane2));
    const int r32b = lane2 & 31, hib = lane2 >> 5;
    { float tc[64]; f16x2 tn[32];
      inv_row<0>(tc, tn, slot, lane2);
      asm volatile("s_waitcnt lgkmcnt(0)" ::: "memory");
#pragma unroll
      for (int i = 0; i < 64; ++i) *(GLAS unsigned short*)(slot + sw128(i, lane2 * 2)) = (unsigned short)(cvtpk(tc[i], 0.f) & 0xffffu); }
    asm volatile("s_waitcnt vmcnt(0) lgkmcnt(0)" ::: "memory");
    __syncthreads();
    { const int chunk = bh * 32 + cg0 + wave; unsigned char* img = img_ptr(out_bytes, ws_img, chunk);
      const unsigned short* vbt = (const unsigned short*)(scr + (size_t)chunk * 32768); const unsigned short* kgt = vbt + 8192;
      bf16x8 gf[4][4], gk[4][4];
#pragma unroll
      for (int dvt = 0; dvt < 4; ++dvt)
#pragma unroll
          for (int s = 0; s < 4; ++s) gf[dvt][s] = *(const bf16x8*)(vbt + (dvt * 32 + r32b) * 64 + 16 * s + 8 * hib);
#pragma unroll
      for (int dkt = 0; dkt < 4; ++dkt)
#pragma unroll
          for (int s = 0; s < 4; ++s) gk[dkt][s] = *(const bf16x8*)(kgt + (dkt * 32 + r32b) * 64 + 16 * s + 8 * hib);
#pragma unroll
      for (int tile = 0; tile < 8; ++tile) { const int ti = tile >> 2, dvt = tile & 3; f32x16 acc = {};
#pragma unroll
          for (int s = 0; s < 4; ++s) { if (s < 2 * (ti + 1)) { const bf16x8 a = *(const GLAS bf16x8*)(slot + sw128(ti * 32 + r32b, (16 * s + 8 * hib) * 2)); acc = MFMA32(a, gf[dvt][s], acc); } }
          u32x4 w0 = {pg8::cvt_pk_bf16_acc(acc[0], acc[1]), pg8::cvt_pk_bf16_acc(acc[2], acc[3]), pg8::cvt_pk_bf16_acc(acc[4], acc[5]), pg8::cvt_pk_bf16_acc(acc[6], acc[7])}, w1 = {pg8::cvt_pk_bf16_acc(acc[8], acc[9]), pg8::cvt_pk_bf16_acc(acc[10], acc[11]), pg8::cvt_pk_bf16_acc(acc[12], acc[13]), pg8::cvt_pk_bf16_acc(acc[14], acc[15])};
          *(u32x4*)(img + IMG_U + tile * 2048 + lane2 * 32) = w0; *(u32x4*)(img + IMG_U + tile * 2048 + lane2 * 32 + 16) = w1; }
#pragma unroll
      for (int tile = 0; tile < 8; ++tile) { const int dkt = tile >> 1, ni = tile & 1; f32x16 acc = {};
#pragma unroll
          for (int s = 0; s < 4; ++s) { if (s < 2 * (ni + 1)) { const bf16x8 bb = *(const GLAS bf16x8*)(slot + sw128(ni * 32 + r32b, (16 * s + 8 * hib) * 2)); acc = MFMA32(gk[dkt][s], bb, acc); } }
          { const unsigned a0 = pg8::cvt_pk_bf16_acc(acc[0], acc[1]), a1 = pg8::cvt_pk_bf16_acc(acc[2], acc[3]), b0 = pg8::cvt_pk_bf16_acc(acc[4], acc[5]), b1 = pg8::cvt_pk_bf16_acc(acc[6], acc[7]);
            const auto r0 = __builtin_amdgcn_permlane32_swap(a0, b0, false, false), r1 = __builtin_amdgcn_permlane32_swap(a1, b1, false, false);
            *(u32x4*)(img + IMG_W + ((ni * 8 + 2 * dkt) * 64 + lane2) * 16) = (u32x4){r0[0], r1[0], r0[1], r1[1]}; }
          { const unsigned a0 = pg8::cvt_pk_bf16_acc(acc[8], acc[9]), a1 = pg8::cvt_pk_bf16_acc(acc[10], acc[11]), b0 = pg8::cvt_pk_bf16_acc(acc[12], acc[13]), b1 = pg8::cvt_pk_bf16_acc(acc[14], acc[15]);
            const auto r0 = __builtin_amdgcn_permlane32_swap(a0, b0, false, false), r1 = __builtin_amdgcn_permlane32_swap(a1, b1, false, false);
            *(u32x4*)(img + IMG_W + ((ni * 8 + 2 * dkt + 1) * 64 + lane2) * 16) = (u32x4){r0[0], r1[0], r0[1], r1[1]}; } }
      if (lane2 == 0) *(float*)(img + IMG_GL) = __expf(gls[wave]); }
}

__device__ __forceinline__ void scan(GLAS unsigned char* L, int tid, int lane, int wave, int bh, unsigned char* out_bytes, unsigned char* ws_img, const unsigned short* proj, const float* gn, unsigned short* ob) {
    const int r32 = lane & 31, hi = lane >> 5, b = bh >> 3, h = bh & 7;
    GLAS unsigned char* ST = L + 75776; GLAS unsigned char* VNT = L + 108544; GLAS float* RED = (GLAS float*)(L + 124928); GLAS float* OT = (GLAS float*)L;
    const int ti = wave >> 2, dvt = wave & 3, dk0t = 2 * (wave >> 2);
    f32x16 s0 = {}, s1 = {};
    for (int i = tid; i < 2048; i += 512) ((GLAS u32x4*)ST)[i] = (u32x4){0u, 0u, 0u, 0u};
    const int tok = tid & 63, part = wave;
    float gnr[16];
#pragma unroll
    for (int e = 0; e < 16; ++e) gnr[e] = gn[part * 16 + e];
    u32x4 pf[10];
    { const u32x4* img0 = (const u32x4*)img_ptr(out_bytes, ws_img, bh * 32);
#pragma unroll
      for (int i = 0; i < 10; ++i) { const int p = tid + 512 * i; pf[i] = img0[p < 4624 ? p : 4623]; } }
#pragma unroll 1
    for (int n = 0; n < 32; ++n) {
#pragma unroll
        for (int i = 0; i < 10; ++i) { const int p = tid + 512 * i; if (p < 4624) ((GLAS u32x4*)L)[p] = pf[i]; }
        LBAR();
        { const u32x4* imgn = (const u32x4*)img_ptr(out_bytes, ws_img, bh * 32 + (n < 31 ? n + 1 : n));
#pragma unroll
          for (int i = 0; i < 10; ++i) { const int p = tid + 512 * i; pf[i] = imgn[p < 4624 ? p : 4623]; } }
        const size_t row = (size_t)b * 2048 + n * 64 + tok;
        const unsigned short* zp = proj + row * 7232 + 3072 + h * 128 + part * 16; const u32x4 z0 = *(const u32x4*)zp, z1 = *(const u32x4*)(zp + 8);
        { f32x16 acc = {};
#pragma unroll
          for (int s = 0; s < 8; ++s) { const bf16x8 a = *(const GLAS bf16x8*)(L + IMG_W + ((ti * 8 + s) * 64 + lane) * 16); const bf16x8 bb = *(const GLAS bf16x8*)(ST + sw256(dvt * 32 + r32, (16 * s + 8 * hi) * 2)); acc = MFMA32(a, bb, acc); }
          const u32x4 u0 = *(const GLAS u32x4*)(L + IMG_U + wave * 2048 + lane * 32), u1 = *(const GLAS u32x4*)(L + IMG_U + wave * 2048 + lane * 32 + 16);
          const unsigned uw[8] = {u0.x, u0.y, u0.z, u0.w, u1.x, u1.y, u1.z, u1.w};
#pragma unroll
          for (int g4 = 0; g4 < 4; ++g4) { const float v0 = bfl(uw[2 * g4]) - acc[4 * g4], v1 = bfh(uw[2 * g4]) - acc[4 * g4 + 1], v2 = bfl(uw[2 * g4 + 1]) - acc[4 * g4 + 2], v3 = bfh(uw[2 * g4 + 1]) - acc[4 * g4 + 3];
              u32x2 w = {cvtpk(v0, v1), cvtpk(v2, v3)}; *(GLAS u32x2*)(VNT + sw128(dvt * 32 + r32, (ti * 32 + 8 * g4 + 4 * hi) * 2)) = w; } }
        LBAR();
        { f32x16 acc = {};
#pragma unroll
          for (int s = 0; s < 8; ++s) { const bf16x8 a = *(const GLAS bf16x8*)(L + IMG_QD + sw256(ti * 32 + r32, (16 * s + 8 * hi) * 2)); const bf16x8 bb = *(const GLAS bf16x8*)(ST + sw256(dvt * 32 + r32, (16 * s + 8 * hi) * 2)); acc = MFMA32(a, bb, acc); }
#pragma unroll
          for (int s = 0; s < 4; ++s) { if (s < 2 * (ti + 1)) { const bf16x8 a = *(const GLAS bf16x8*)(L + IMG_QK + sw128(ti * 32 + r32, (16 * s + 8 * hi) * 2)); const bf16x8 bb = *(const GLAS bf16x8*)(VNT + sw128(dvt * 32 + r32, (16 * s + 8 * hi) * 2)); acc = MFMA32(a, bb, acc); } }
#pragma unroll
          for (int g4 = 0; g4 < 4; ++g4) { const f32x4 w = {acc[4 * g4], acc[4 * g4 + 1], acc[4 * g4 + 2], acc[4 * g4 + 3]}; const int dv = dvt * 32 + r32, chk = ti * 8 + 2 * g4 + hi;
              *(GLAS f32x4*)(OT + dv * 64 + ((chk ^ (dv & 15)) << 2)) = w; } }
        LBAR();
        float ov[16]; float ss = 0.f;
#pragma unroll
        for (int e = 0; e < 16; ++e) { const int dv = part * 16 + e; ov[e] = OT[dv * 64 + ((((tok >> 2) ^ (dv & 15)) << 2) | (tok & 3))]; ss += ov[e] * ov[e]; }
        RED[part * 64 + tok] = ss;
        { const float gl = *(const GLAS float*)(L + IMG_GL);
          s0 = s0 * gl; s1 = s1 * gl;
#pragma unroll
          for (int s = 0; s < 4; ++s) { const bf16x8 bb = *(const GLAS bf16x8*)(VNT + sw128(dvt * 32 + r32, (16 * s + 8 * hi) * 2));
              const bf16x8 a0 = *(const GLAS bf16x8*)(L + IMG_KDT + sw128(dk0t * 32 + r32, (16 * s + 8 * hi) * 2)), a1 = *(const GLAS bf16x8*)(L + IMG_KDT + sw128(dk0t * 32 + 32 + r32, (16 * s + 8 * hi) * 2));
              s0 = MFMA32(a0, bb, s0); s1 = MFMA32(a1, bb, s1); }
#pragma unroll
          for (int g4 = 0; g4 < 4; ++g4) { u32x2 w = {pg8::cvt_pk_bf16_acc(s0[4 * g4], s0[4 * g4 + 1]), pg8::cvt_pk_bf16_acc(s0[4 * g4 + 2], s0[4 * g4 + 3])}; *(GLAS u32x2*)(ST + sw256(dvt * 32 + r32, (dk0t * 32 + 8 * g4 + 4 * hi) * 2)) = w;
              u32x2 w2 = {pg8::cvt_pk_bf16_acc(s1[4 * g4], s1[4 * g4 + 1]), pg8::cvt_pk_bf16_acc(s1[4 * g4 + 2], s1[4 * g4 + 3])}; *(GLAS u32x2*)(ST + sw256(dvt * 32 + r32, (dk0t * 32 + 32 + 8 * g4 + 4 * hi) * 2)) = w2; } }
        LBAR();
        { float tot = 0.f;
#pragma unroll
          for (int p = 0; p < 8; ++p) tot += RED[p * 64 + tok];
          const float rs = rsqrtf(tot * (1.0f / 128.0f) + 1e-6f);
          const unsigned zw[8] = {z0.x, z0.y, z0.z, z0.w, z1.x, z1.y, z1.z, z1.w}; unsigned res[8];
#pragma unroll
          for (int k = 0; k < 8; ++k) res[k] = cvtpk(ov[2 * k] * rs * gnr[2 * k] * bfl(zw[k]), ov[2 * k + 1] * rs * gnr[2 * k + 1] * bfh(zw[k]));
          unsigned short* op = ob + row * 2048 + h * 128 + part * 16;
          *(u32x4*)op = (u32x4){res[0], res[1], res[2], res[3]}; *(u32x4*)(op + 8) = (u32x4){res[4], res[5], res[6], res[7]}; }
        LBAR();
    }
}
#undef MFMA32
#undef LBAR
#undef GLAS
}

constexpr int NB = 8, SEQ = 2048, DM = 2048, MTOK = NB * SEQ;
constexpr int HD = 128, NPROJ = 7168, PROJ_LD = 7232;
constexpr int DFF = 5632, MEMLEN = 256, MROWS = NB * MEMLEN, XW = 512;
constexpr float EPS = 1e-6f;
constexpr int NWAVES = 8, NTHREADS = 512;
constexpr int LDS_BYTES = 147456;
constexpr int LDS_MISC = 147200;
constexpr int CW_BAR = 4096;

constexpr size_t MiB = 1u << 20;
constexpr size_t WS_RSQ2 = 768 * 1024, WS_RSQ3 = 832 * 1024, WS_RSQ4 = 896 * 1024;
constexpr size_t WS_KMEAN = 512 * 1024;
constexpr size_t WS_WGU = 1 * MiB, WS_WDOWN = 23 * MiB, WS_X2Q = 34 * MiB, WS_SMALL = 67 * MiB, WS_XB = 70 * MiB;
constexpr float WGU_SCALE = 32.0f, WDOWN_SCALE = 64.0f;
constexpr size_t WS_GATE = 134 * MiB;
constexpr size_t WS_WINB = 142 * MiB;
constexpr size_t WS_WIN = 134 * MiB, WS_PROJ = 162 * MiB, WS_O = 388 * MiB;
constexpr size_t WS_QX = 162 * MiB, WS_OX = 178 * MiB, WS_KVX = 194 * MiB;
constexpr size_t WS_WXQ = 486 * MiB, WS_WXKV = 488 * MiB, WS_WXO = 492 * MiB, WS_WOUT = 494 * MiB, WS_MEMB = 502 * MiB, WS_END = 510 * MiB;
constexpr size_t SM_RSTD1 = 0, SM_RSTD2 = 65536, SM_RSTD3 = 131072, SM_RSTDM = 196608, SM_W16 = 262144, SM_KMEAN = 327680, SM_BETA = 1 * MiB, SM_G = 1 * MiB + 524288;

#define LAS __attribute__((address_space(3)))
typedef unsigned short bf16_t;
typedef float f32x4 __attribute__((ext_vector_type(4)));
typedef unsigned u32x4 __attribute__((ext_vector_type(4)));
typedef unsigned u32x2 __attribute__((ext_vector_type(2)));

__device__ __forceinline__ float bf2f(unsigned v) { return __uint_as_float(v << 16); }
__device__ __forceinline__ unsigned f2bf(float f) { unsigned u = __float_as_uint(f); return (u + 0x7fffu + ((u >> 16) & 1u)) >> 16; }
__device__ __forceinline__ unsigned pk2(float lo, float hi) { return f2bf(lo) | (f2bf(hi) << 16); }
__device__ __forceinline__ float wave_sum(float v) {
#pragma unroll
    for (int o = 1; o < 64; o <<= 1) v += __shfl_xor(v, o);
    return v;
}
__device__ __forceinline__ float silu_acc(float v) { return v * __builtin_amdgcn_rcpf(1.0f + __expf(-v)); }

#define XB_TMO      128
#define XB_XCNT(j)  (256  + 64 * (j))
#define XB_XSUB(j)  (1280 + 64 * (j))
#define XB_XGEN(j)  (2304 + 64 * (j))
#define XB_TOP      3328
#define XB_TOPGEN   3392
#define XCD_BAR_WORDS 3456
#define XB_SPIN_CAP (1u << 18)

__device__ __forceinline__ unsigned xb_ld(unsigned* p)              { return __hip_atomic_load(p, __ATOMIC_RELAXED, __HIP_MEMORY_SCOPE_AGENT); }
__device__ __forceinline__ unsigned xb_add(unsigned* p, unsigned v) { return __hip_atomic_fetch_add(p, v, __ATOMIC_RELAXED, __HIP_MEMORY_SCOPE_AGENT); }
__device__ __forceinline__ unsigned xb_xcc_id() { return (unsigned)__builtin_amdgcn_s_getreg((3 << 11) | 20) & 0xFu; }
#define XB_SPIN(cond, bar) do { unsigned _sp = 0; while (cond) { __builtin_amdgcn_s_sleep(1); \
    if ((++_sp & 255u) == 0u) { if (xb_ld(&(bar)[XB_TMO])) break; if (_sp > XB_SPIN_CAP) { atomicAdd(&(bar)[XB_TMO], 1u); break; } } } } while (0)

struct XcdBarrier {
    unsigned* bar; unsigned x;
    volatile LAS unsigned* st;
};

__device__ __forceinline__ XcdBarrier xcd_barrier_post(unsigned* bar, volatile LAS unsigned* st, int tid) {
    XcdBarrier b; b.bar = bar; b.x = xb_xcc_id(); b.st = st;
    if (tid == 0) (void)xb_add(&bar[XB_XCNT(b.x)], 1u);
    return b;
}
__device__ __forceinline__ void xcd_barrier_complete(unsigned* bar, unsigned x, unsigned& nloc, unsigned& nx) {
    const unsigned G = gridDim.x * gridDim.y * gridDim.z;
    unsigned sum, cnt, mine, sp = 0u;
    for (;;) {
        sum = 0u; cnt = 0u; mine = 0u;
#pragma unroll
        for (unsigned j = 0; j < 16; ++j) { const unsigned c = xb_ld(&bar[XB_XCNT(j)]); sum += c; cnt += (c > 0u) ? 1u : 0u; mine = (j == x) ? c : mine; }
        if (sum == G) break;
        __builtin_amdgcn_s_sleep(1);
        if ((++sp & 255u) == 0u) { if (xb_ld(&bar[XB_TMO])) break; if (sp > XB_SPIN_CAP) { atomicAdd(&bar[XB_TMO], 1u); break; } }
    }
    nloc = mine > 0u ? mine : 1u; nx = cnt > 0u ? cnt : 1u;
}

__device__ __forceinline__ void xcd_barrier(const XcdBarrier& b, int tid) {
    asm volatile("s_waitcnt vmcnt(0)" ::: "memory");
    __syncthreads();
    if (tid == 0) {
        unsigned* bar = b.bar;
        __builtin_amdgcn_s_waitcnt(0);
        unsigned nloc = b.st[0], nx = b.st[1];
        if (nloc == 0u) { xcd_barrier_complete(bar, b.x, nloc, nx); b.st[0] = nloc; b.st[1] = nx; }
        const unsigned seq = b.st[2]; b.st[2] = seq + 1u;
        const unsigned old = xb_add(&bar[XB_XSUB(b.x)], 1u);
        const unsigned gen = old / nloc;
        if (old + 1u == (gen + 1u) * nloc) {
            __builtin_amdgcn_fence(__ATOMIC_RELEASE, "agent");
            asm volatile("s_waitcnt vmcnt(0)" ::: "memory");
            const unsigned og = xb_add(&bar[XB_TOP], 1u);
            const unsigned tg = og / nx;
            if (og + 1u == (tg + 1u) * nx) xb_add(&bar[XB_TOPGEN], 1u);
        }
        XB_SPIN(xb_ld(&bar[XB_TOPGEN]) <= seq, bar);
        __builtin_amdgcn_fence(__ATOMIC_ACQUIRE, "agent");
        asm volatile("s_waitcnt vmcnt(0)" ::: "memory");
    }
    __syncthreads();
}


struct Args { const float* in[23]; float* out; unsigned char* ws; int ph_lo, ph_hi; };
#define ARGP(A, k) ((A).in[k])
#define TABP(F, k) ((const float*)(((const __attribute__((address_space(1))) float* const*)((F).ws + 256))[k]))
struct Frame {
    LAS unsigned char* lds;
    int tid, lane, wave, G, bid;
    float* out; unsigned char* ws;
};

__device__ __forceinline__ void transpose_item(const float* W, int ldw, int col0, int K, const float* gain, bf16_t* WT, int row_off, int nblk, LAS float* scr, int item, int lane) {
    const int kb = item / nblk, nb = item % nblk, k0 = 64 * kb, n0 = 64 * nb;
    const float* src = W + (size_t)(k0 + (lane >> 4)) * ldw + col0 + n0 + (lane & 15) * 4;
    f32x4 v[16];
#pragma unroll
    for (int i = 0; i < 16; ++i) v[i] = __builtin_nontemporal_load((const f32x4*)(src + (size_t)(4 * i) * ldw));
#pragma unroll
    for (int i = 0; i < 16; ++i) { const int kk = 4 * i + (lane >> 4); const float g = gain ? gain[k0 + kk] : 1.0f; LAS float* d = scr + kk * 65 + (lane & 15) * 4;
        d[0] = v[i].x * g; d[1] = v[i].y * g; d[2] = v[i].z * g; d[3] = v[i].w * g; }
    asm volatile("s_waitcnt lgkmcnt(0)" ::: "memory");
    const int c = lane & 7;
#pragma unroll
    for (int j = 0; j < 8; ++j) { const int n = (lane >> 3) + 8 * j; const LAS float* s = scr + (8 * c) * 65 + n;
        u32x4 o; o.x = pk2(s[0 * 65], s[1 * 65]); o.y = pk2(s[2 * 65], s[3 * 65]); o.z = pk2(s[4 * 65], s[5 * 65]); o.w = pk2(s[6 * 65], s[7 * 65]);
        *(u32x4*)(WT + (size_t)(row_off + n0 + n) * K + k0 + 8 * c) = o; }
    asm volatile("s_waitcnt lgkmcnt(0)" ::: "memory");
}
__device__ __forceinline__ void transpose_item8(const float* W, int ldw, int col0, int K, const float* gain, float scale, unsigned char* WT8, int row_off, int nblk, LAS float* scr, int item, int lane) {
    const int kb = item / nblk, nb = item % nblk, k0 = 64 * kb, n0 = 64 * nb;
    const float* src = W + (size_t)(k0 + (lane >> 4)) * ldw + col0 + n0 + (lane & 15) * 4;
    f32x4 v[16];
#pragma unroll
    for (int i = 0; i < 16; ++i) v[i] = __builtin_nontemporal_load((const f32x4*)(src + (size_t)(4 * i) * ldw));
#pragma unroll
    for (int i = 0; i < 16; ++i) { const int kk = 4 * i + (lane >> 4); const float g = (gain ? gain[k0 + kk] : 1.0f) * scale; LAS float* d = scr + kk * 65 + (lane & 15) * 4;
        d[0] = v[i].x * g; d[1] = v[i].y * g; d[2] = v[i].z * g; d[3] = v[i].w * g; }
    asm volatile("s_waitcnt lgkmcnt(0)" ::: "memory");
    const int c = lane & 7;
#pragma unroll
    for (int j = 0; j < 8; ++j) { const int n = (lane >> 3) + 8 * j; const LAS float* s = scr + (8 * c) * 65 + n;
        int w0 = __builtin_amdgcn_cvt_pk_fp8_f32(s[0 * 65], s[1 * 65], 0, false); w0 = __builtin_amdgcn_cvt_pk_fp8_f32(s[2 * 65], s[3 * 65], w0, true);
        int w1 = __builtin_amdgcn_cvt_pk_fp8_f32(s[4 * 65], s[5 * 65], 0, false); w1 = __builtin_amdgcn_cvt_pk_fp8_f32(s[6 * 65], s[7 * 65], w1, true);
        *(u32x2*)(WT8 + (size_t)(row_off + n0 + n) * K + k0 + 8 * c) = (u32x2){(unsigned)w0, (unsigned)w1}; }
    asm volatile("s_waitcnt lgkmcnt(0)" ::: "memory");
}
__device__ __forceinline__ void row_to_bf16(const float* xrow, bf16_t* orow, float* rstd_out, int lane, unsigned char* q8row = nullptr) {
    const f32x4* xr = (const f32x4*)xrow + lane;
    f32x4 v[8]; float s = 0.f;
#pragma unroll
    for (int j = 0; j < 8; ++j) { v[j] = __builtin_nontemporal_load(xr + 64 * j); s += (v[j].x * v[j].x + v[j].y * v[j].y) + (v[j].z * v[j].z + v[j].w * v[j].w); }
    s = wave_sum(s);
    if (lane == 0) *rstd_out = rsqrtf(s * (1.0f / DM) + EPS);
    u32x2* o8 = (u32x2*)orow + lane;
#pragma unroll
    for (int j = 0; j < 8; ++j) { u32x2 w; w.x = pk2(v[j].x, v[j].y); w.y = pk2(v[j].z, v[j].w); o8[64 * j] = w; }
    if (q8row) { unsigned* q4 = (unsigned*)q8row + lane;
#pragma unroll
        for (int j = 0; j < 8; ++j) { int q = __builtin_amdgcn_cvt_pk_fp8_f32(v[j].x, v[j].y, 0, false); q = __builtin_amdgcn_cvt_pk_fp8_f32(v[j].z, v[j].w, q, true); q4[64 * j] = (unsigned)q; } }
}
__device__ __forceinline__ void phase_prologue(const Frame& F, const Args& A) {
    if (F.bid == 0 && F.tid < 23) ((const float**)(F.ws + 256))[F.tid] = A.in[F.tid];
    LAS float* scr = (LAS float*)(F.lds + F.wave * 17408);
    const int gw = F.bid * NWAVES + F.wave, NGW = F.G * NWAVES;
    bf16_t* Win_t = (bf16_t*)(F.ws + WS_WIN); bf16_t* Wout_t = (bf16_t*)(F.ws + WS_WOUT); bf16_t* Wxq_t = (bf16_t*)(F.ws + WS_WXQ); bf16_t* Wxkv_t = (bf16_t*)(F.ws + WS_WXKV);
    bf16_t* Wxo_t = (bf16_t*)(F.ws + WS_WXO); bf16_t* Wgu_t = (bf16_t*)(F.ws + WS_WGU); bf16_t* Wdown_t = (bf16_t*)(F.ws + WS_WDOWN);
    constexpr int I_INA = 32 * 64, I_INB = 32 * 48, I_OUT = 32 * 32, I_XQ = 32 * 8, I_XKV = 32 * 16, I_XO = 8 * 32, I_G = 32 * 88, I_D = 88 * 32;
    constexpr int NITEMS = I_INA + I_INB + I_OUT + I_XQ + I_XKV + I_XO;
    for (int it = gw; it < NITEMS; it += NGW) {
        int r = it;
        if (r < I_INA) { transpose_item8(ARGP(A, 3), 7184, 0, DM, ARGP(A, 2), WGU_SCALE, (unsigned char*)Win_t, 0, 64, scr, r, F.lane); continue; } r -= I_INA;
        if (r < I_INB) { transpose_item(ARGP(A, 3), 7184, 4112, DM, ARGP(A, 2), (bf16_t*)(F.ws + WS_WINB), 0, 48, scr, r, F.lane); continue; } r -= I_INB;
        if (r < I_OUT) { transpose_item(ARGP(A, 10), DM, 0, DM, nullptr, Wout_t, 0, 32, scr, r, F.lane); continue; } r -= I_OUT;
        if (r < I_XQ) { transpose_item(ARGP(A, 13), XW, 0, DM, ARGP(A, 11), Wxq_t, 0, 8, scr, r, F.lane); continue; } r -= I_XQ;
        if (r < I_XKV) { transpose_item(ARGP(A, 14), 2 * XW, 0, DM, ARGP(A, 12), Wxkv_t, 0, 16, scr, r, F.lane); continue; } r -= I_XKV;
        transpose_item(ARGP(A, 15), DM, 0, XW, nullptr, Wxo_t, 0, 32, scr, r, F.lane);
    }
    { bf16_t* W16 = (bf16_t*)(F.ws + WS_SMALL + SM_W16);
      for (int i = F.bid * NTHREADS + F.tid; i < 16 * DM; i += F.G * NTHREADS) { const int j = i >> 11, k = i & 2047; W16[i] = (bf16_t)f2bf(ARGP(A, 3)[(size_t)k * 7184 + 4096 + j] * ARGP(A, 2)[k]); } }
    { bf16_t* xb = (bf16_t*)(F.ws + WS_XB); float* rstd1 = (float*)(F.ws + WS_SMALL + SM_RSTD1);
      for (int m = gw; m < MTOK; m += NGW) row_to_bf16(ARGP(A, 0) + (size_t)m * DM, xb + (size_t)m * DM, rstd1 + m, F.lane, F.ws + WS_X2Q + (size_t)m * DM);
      bf16_t* memb = (bf16_t*)(F.ws + WS_MEMB); float* rstdm = (float*)(F.ws + WS_SMALL + SM_RSTDM);
      for (int m = gw; m < MROWS; m += NGW) row_to_bf16(ARGP(A, 1) + (size_t)m * DM, memb + (size_t)m * DM, rstdm + m, F.lane); }
}
__device__ __forceinline__ void phase_ffn_weights(const Frame& F, int iw, int nwg) {
    LAS float* scr = (LAS float*)(F.lds + F.wave * 17408);
    unsigned char* Wgu8 = F.ws + WS_WGU; unsigned char* Wdown8 = F.ws + WS_WDOWN;
    constexpr int I_G = 32 * 88, I_D = 88 * 32;
    for (int it = iw * NWAVES + F.wave; it < 2 * I_G + I_D; it += nwg * NWAVES) {
        int r = it;
        if (r < I_G) { const int c0 = 64 * (r % 88); transpose_item8(TABP(F, 17), DFF, 0, DM, TABP(F, 16), WGU_SCALE, Wgu8, ((c0 >> 7) << 8) + (c0 & 127) - c0, 88, scr, r, F.lane); continue; } r -= I_G;
        if (r < I_G) { const int c0 = 64 * (r % 88); transpose_item8(TABP(F, 18), DFF, 0, DM, TABP(F, 16), WGU_SCALE, Wgu8, ((c0 >> 7) << 8) + (c0 & 127) - c0 + 128, 88, scr, r, F.lane); continue; } r -= I_G;
        transpose_item8(TABP(F, 21), DM, 0, DFF, nullptr, WDOWN_SCALE, Wdown8, 0, 32, scr, r, F.lane);
    }
}
__device__ __forceinline__ void phase_final_norm(const Frame& F, const Args& A) {
    const int gw = F.bid * NWAVES + F.wave, NGW = F.G * NWAVES; const f32x4* g4 = (const f32x4*)TABP(F, 22) + 2 * F.lane;
    const bf16_t* xb = (const bf16_t*)(F.ws + WS_XB); const float* rsq = (const float*)(F.ws + WS_RSQ4);
    for (int m = gw; m < MTOK; m += NGW) {
        const float r = rsqrtf(rsq[m] * (1.0f / DM) + EPS);
        const u32x4* xr = (const u32x4*)(xb + (size_t)m * DM) + F.lane; f32x4* orow = (f32x4*)(F.out + (size_t)m * DM) + 2 * F.lane;
#pragma unroll
        for (int j = 0; j < 4; ++j) { const u32x4 h = __builtin_nontemporal_load(xr + 64 * j);
            const f32x4 a = {bf2f(h.x & 0xffffu), bf2f(h.x >> 16), bf2f(h.y & 0xffffu), bf2f(h.y >> 16)}, b = {bf2f(h.z & 0xffffu), bf2f(h.z >> 16), bf2f(h.w & 0xffffu), bf2f(h.w >> 16)};
            orow[128 * j] = a * r * g4[128 * j]; orow[128 * j + 1] = b * r * g4[128 * j + 1]; }
    }
}
typedef short mk_bf16x8 __attribute__((ext_vector_type(8)));
__device__ __forceinline__ void ba_item(const Frame& F, int item, int khalf) {
    const int lane = F.lane, r = lane & 15, q = lane >> 4, row0 = item * 16;
    const bf16_t* xa = (const bf16_t*)(F.ws + WS_XB) + (size_t)(row0 + r) * DM + khalf * 1024 + q * 8; const bf16_t* wb = (const bf16_t*)(F.ws + WS_SMALL + SM_W16) + (size_t)r * DM + khalf * 1024 + q * 8;
    f32x4 acc = {0.f, 0.f, 0.f, 0.f};
#pragma unroll 16
    for (int s = 0; s < 32; ++s) { const mk_bf16x8 a = *(const mk_bf16x8*)(xa + 32 * s), b = *(const mk_bf16x8*)(wb + 32 * s); acc = __builtin_amdgcn_mfma_f32_16x16x32_bf16(a, b, acc, 0, 0, 0); }
    LAS f32x4* xch = (LAS f32x4*)F.lds + (F.wave & 3) * 64 + lane;
    if (khalf) *xch = acc;
    __syncthreads();
    if (khalf) return;
    acc += *xch;
    const float* rstd1 = (const float*)(F.ws + WS_SMALL + SM_RSTD1); float* beta = (float*)(F.ws + WS_SMALL + SM_BETA); float* gg = (float*)(F.ws + WS_SMALL + SM_G);
    const int c = lane & 15, h = c & 7; const float alog = TABP(F, 5)[h], dtb = TABP(F, 6)[h];
#pragma unroll
    for (int i = 0; i < 4; ++i) { const int row = row0 + 4 * q + i; const float y = acc[i] * rstd1[row];
        if (c < 8) beta[(size_t)row * 8 + h] = 1.0f / (1.0f + expf(-y));
        else { const float z = y + dtb; const float sp = z > 20.f ? z : log1pf(expf(z)); gg[(size_t)row * 8 + h] = -expf(alog) * sp; } }
}
__device__ __forceinline__ void phase_moba(const Frame& F, const Args& A, char* lds, int cu) {
    const int grp = cu >> 6, bh = cu & 63, b = bh >> 3, h = bh & 7;
    const unsigned list = grp == 0 ? 0x37u : (grp == 1 ? 0x46u : 0x0125u); const int cnt = grp == 2 ? 4 : 2;
    moba::Head H; H.Q0 = (const bf16_t*)(F.ws + WS_PROJ) + (size_t)(b * SEQ) * PROJ_LD + 4096 + h * 128; H.K0 = H.Q0 + 1024; H.V0 = H.Q0 + 2048; H.O0 = (bf16_t*)(F.ws + WS_O) + (size_t)(b * SEQ) * DM + 1024 + h * 128;
    H.km = (const float*)(F.ws + WS_KMEAN) + (size_t)(b * 8) * 1024 + h * 128;
    moba::Seam S; int P0 = (int)(list & 15u) * 256;
    moba::prime<moba::CfgMoba>(H, P0, lds, S, F.tid, F.wave);
    for (int i = 0; i < cnt; ++i) { const int P0n = (i + 1 < cnt) ? (int)((list >> (4 * (i + 1))) & 15u) * 256 : P0; moba::block<moba::CfgMoba>(H, P0, P0n, TABP(F, 9), h, TABP(F, 8), lds, S, F.tid, F.wave); P0 = P0n; }
}
__device__ __forceinline__ void phase_xattn(const Frame& F, char* lds, int item) {
    const int qb = item & 7, h = (item >> 3) & 3, b = item >> 5;
    moba::Head H; H.Q0 = (const bf16_t*)(F.ws + WS_QX) + (size_t)(b * SEQ) * XW + h * 128; H.K0 = (const bf16_t*)(F.ws + WS_KVX) + (size_t)(b * MEMLEN) * (2 * XW) + h * 128; H.V0 = H.K0 + XW;
    H.O0 = (bf16_t*)(F.ws + WS_OX) + (size_t)(b * SEQ) * XW + h * 128; H.km = nullptr;
    moba::Seam S; const int P0 = qb * 256;
    moba::prime<moba::CfgX>(H, P0, lds, S, F.tid, F.wave);
    moba::block<moba::CfgX>(H, P0, P0, nullptr, h, nullptr, lds, S, F.tid, F.wave);
}
static_assert(moba::LDS_BYTES <= LDS_MISC && LDS_MISC + 128 <= LDS_BYTES, "LDS map");

__device__ __forceinline__ void ffn_fixup(const Frame& F, int pm) {
    const bf16_t* halo = (const bf16_t*)(F.ws + WS_GATE); const float* cw = TABP(F, 19); const float* cb = TABP(F, 20); unsigned char* H8 = (unsigned char*)F.out;
    u32x4 a2[3], a1[3], a0[3], au[3];
#pragma unroll
    for (int k = 0; k < 3; ++k) { int idx = F.tid + k * NTHREADS; idx = idx < 2 * 704 ? idx : 2 * 704 - 1; const int R = idx / 704, c = (idx - R * 704) * 8;
        const bf16_t* hp = halo + (size_t)(pm - 1) * 6 * 5632 + c; const bf16_t* hc = halo + (size_t)pm * 6 * 5632 + c;
        a2[k] = *(const u32x4*)(hp + (R == 0 ? 0 : 1) * 5632); a1[k] = *(const u32x4*)(R == 0 ? hp + 5632 : hc + 2 * 5632); a0[k] = *(const u32x4*)(hc + (2 + R) * 5632); au[k] = *(const u32x4*)(hc + (4 + R) * 5632); }
#pragma unroll
    for (int k = 0; k < 3; ++k) { const int idx = F.tid + k * NTHREADS; if (idx >= 2 * 704) break; const int R = idx / 704, c = (idx - R * 704) * 8;
        const unsigned v2[4] = {a2[k].x, a2[k].y, a2[k].z, a2[k].w}, v1[4] = {a1[k].x, a1[k].y, a1[k].z, a1[k].w}, v0[4] = {a0[k].x, a0[k].y, a0[k].z, a0[k].w}, vu[4] = {au[k].x, au[k].y, au[k].z, au[k].w}; float hv[8];
#pragma unroll
        for (int e = 0; e < 8; ++e) { const unsigned sh = (e & 1) ? 16u : 0u; const int kq = e >> 1, chn = c + e;
            const float x2 = bf2f((v2[kq] >> sh) & 0xffffu), x1 = bf2f((v1[kq] >> sh) & 0xffffu), gc = bf2f((v0[kq] >> sh) & 0xffffu), uu = bf2f((vu[kq] >> sh) & 0xffffu);
            const float y = cw[chn] * x2 + cw[DFF + chn] * x1 + cw[2 * DFF + chn] * gc + cb[chn]; hv[e] = y * __builtin_amdgcn_rcpf(1.0f + __expf(-y)) * uu; }
        int q0 = __builtin_amdgcn_cvt_pk_fp8_f32(hv[0], hv[1], 0, false); q0 = __builtin_amdgcn_cvt_pk_fp8_f32(hv[2], hv[3], q0, true);
        int q1 = __builtin_amdgcn_cvt_pk_fp8_f32(hv[4], hv[5], 0, false); q1 = __builtin_amdgcn_cvt_pk_fp8_f32(hv[6], hv[7], q1, true);
        *(u32x2*)(H8 + (size_t)(pm * 256 + R) * DFF + c) = (u32x2){(unsigned)q0, (unsigned)q1}; }
}
constexpr int N_PHASES = 14;

__global__ void __launch_bounds__(NTHREADS, 2) mk_fwd(Args args) {
    const Args& A = args;
    extern __shared__ __attribute__((aligned(16))) unsigned char lds_raw[];
    Frame F;
    F.lds = (LAS unsigned char*)lds_raw;
    F.wave = __builtin_amdgcn_readfirstlane((int)threadIdx.x >> 6); F.lane = 0; F.tid = 0;
#define FRESH_IDS() do { int l_; asm volatile("v_mbcnt_lo_u32_b32 %0, -1, 0\n\tv_mbcnt_hi_u32_b32 %0, -1, %0" : "=v"(l_)); F.lane = l_; F.tid = F.wave * 64 + l_; } while (0)
    F.G = gridDim.x; F.bid = blockIdx.x;
    F.out = args.out; F.ws = args.ws;
    const int lo = args.ph_lo, hi = args.ph_hi;
    unsigned char* ws = args.ws;
    const float* rstd1 = (const float*)(ws + WS_SMALL + SM_RSTD1); float* rstd2 = (float*)(ws + WS_SMALL + SM_RSTD2); float* rstd3 = (float*)(ws + WS_SMALL + SM_RSTD3);
    const float* rstdm = (const float*)(ws + WS_SMALL + SM_RSTDM);
    bf16_t* xb = (bf16_t*)(ws + WS_XB);
#define IN(k) (lo <= (k) && (k) < hi)
    volatile LAS unsigned* MISC = (volatile LAS unsigned*)(F.lds + LDS_MISC);
    XcdBarrier bar; bar.bar = (unsigned*)ws + CW_BAR; bar.x = 0; bar.st = nullptr;
    if (hi - lo > 1) { FRESH_IDS(); if (F.tid < 32) MISC[F.tid] = 0u; __syncthreads(); bar = xcd_barrier_post((unsigned*)ws + CW_BAR, MISC + 8, F.tid); }
#define SEAM(k) do { if (IN(k) && IN((k) + 1)) { FRESH_IDS(); xcd_barrier(bar, F.tid); } } while (0)

    if (IN(0)) { FRESH_IDS(); phase_prologue(F, A); }
    if (lo < 0) cg::this_grid().sync();
    SEAM(0);
    if (IN(1)) { FRESH_IDS();
        if ((F.bid & 1) == 0) { ba_item(F, (F.wave & 3) * 256 + F.bid, F.wave >> 2);
            __syncthreads();
            FRESH_IDS(); }
        { pg8::Gemm g{(const bf16_t*)(ws + WS_X2Q), (const bf16_t*)(ws + WS_WIN), MTOK, 4096, DM / 2}; pg8::StaticOrder S; S.init(MTOK, 4096, F.G, F.bid);
          pg8::EpiScaleBf16 E{(bf16_t*)(ws + WS_PROJ), PROJ_LD, rstd1, 12, 16, 0, 0, nullptr, 0, 0, 0, 1.0f / WGU_SCALE};
          pg8::gemm_phase<pg8::EpiScaleBf16, pg8::StaticOrder, true, true, true>(F.lds, g, S, E, F.tid, F.wave); }
        FRESH_IDS();
        { pg8::Gemm g{xb, (const bf16_t*)(ws + WS_WINB), MTOK, 3072, DM}; pg8::StaticOrder S; S.init(MTOK, 3072, F.G, F.bid);
          pg8::EpiScaleBf16 E{(bf16_t*)(ws + WS_PROJ) + 4096, PROJ_LD, rstd1, 0, 0, 0, 0, (float*)(ws + WS_KMEAN), 4, 8, 0, 1.0f, 0, 4, moba::QSCALE};
          pg8::gemm_phase<pg8::EpiScaleBf16, pg8::StaticOrder, true, true>(F.lds, g, S, E, F.tid, F.wave); }
        if (F.bid & 1) { __syncthreads(); FRESH_IDS(); ba_item(F, (F.wave & 3) * 256 + F.bid, F.wave >> 2); }
    } SEAM(1);
    if (IN(2)) { FRESH_IDS();
        gdn::prep((__attribute__((address_space(3))) unsigned char*)F.lds, F.tid, F.lane, F.wave, F.bid, (const unsigned short*)(ws + WS_PROJ), (const float*)(ws + WS_SMALL + SM_BETA), (const float*)(ws + WS_SMALL + SM_G), TABP(F, 4),
                  (unsigned char*)F.out, ws + WS_WIN, ws + WS_O); } SEAM(2);
    if (IN(3)) { FRESH_IDS();
        if (F.bid < 64) gdn::scan((__attribute__((address_space(3))) unsigned char*)F.lds, F.tid, F.lane, F.wave, F.bid, (unsigned char*)F.out, ws + WS_WIN, (const unsigned short*)(ws + WS_PROJ), TABP(F, 7), (unsigned short*)(ws + WS_O));
        else if (F.bid < 256) phase_moba(F, A, (char*)lds_raw, F.bid - 64);
    } SEAM(3);
    if (IN(4)) { FRESH_IDS();
        pg8::Gemm g{(const bf16_t*)(ws + WS_O), (const bf16_t*)(ws + WS_WOUT), MTOK, DM, DM}; pg8::StaticOrder S; S.init(MTOK, DM, F.G, F.bid);
        pg8::EpiResidBf16 E{xb, xb, DM, (float*)(ws + WS_RSQ2), 1.0f, nullptr};
        pg8::gemm_phase<pg8::EpiResidBf16, pg8::StaticOrder, true, true>(F.lds, g, S, E, F.tid, F.wave);
    } SEAM(4);
    if (IN(6)) { FRESH_IDS();
        { pg8::Gemm g{xb, (const bf16_t*)(ws + WS_WXQ), MTOK, XW, DM}; pg8::StaticOrder S; S.init(MTOK, XW, F.G, F.bid);
          pg8::EpiScaleBf16 E{(bf16_t*)(ws + WS_QX), XW, (const float*)(ws + WS_RSQ2), 0, 0, 0, 0, nullptr, 0, 0, 1, moba::QSCALE};
          pg8::gemm_phase<pg8::EpiScaleBf16, pg8::StaticOrder, true, true>(F.lds, g, S, E, F.tid, F.wave); }
        { pg8::Gemm g{(const bf16_t*)(ws + WS_MEMB), (const bf16_t*)(ws + WS_WXKV), MROWS, 2 * XW, DM}; pg8::StaticOrder S; S.init(MROWS, 2 * XW, F.G, (F.bid + F.G - 128) % F.G);
          pg8::EpiScaleBf16 E{(bf16_t*)(ws + WS_KVX), 2 * XW, rstdm, 0, 0, 0, 0, nullptr, 0, 0, 0, 1.0f};
          pg8::gemm_phase<pg8::EpiScaleBf16, pg8::StaticOrder, true, true>(F.lds, g, S, E, F.tid, F.wave); }
        if (F.bid >= 160 && F.bid < 256) { FRESH_IDS(); phase_ffn_weights(F, F.bid - 160, 96); }
    } SEAM(6);
    if (IN(7)) { FRESH_IDS(); if (F.bid < 256) phase_xattn(F, (char*)lds_raw, F.bid); } SEAM(7);
    if (IN(8)) { FRESH_IDS();
        pg8::Gemm g{(const bf16_t*)(ws + WS_OX), (const bf16_t*)(ws + WS_WXO), MTOK, DM, XW}; pg8::StaticOrder S; S.init(MTOK, DM, F.G, F.bid);
        pg8::EpiResidBf16 E{xb, xb, DM, (float*)(ws + WS_RSQ3), 1.0f, ws + WS_X2Q};
        pg8::gemm_phase<pg8::EpiResidBf16, pg8::StaticOrder, true, true>(F.lds, g, S, E, F.tid, F.wave);
    } SEAM(8);
    if (IN(10)) { FRESH_IDS();
        pg8::Gemm g{(const bf16_t*)(ws + WS_X2Q), (const bf16_t*)(ws + WS_WGU), MTOK, 2 * DFF, DM / 2}; pg8::StaticOrder S; S.init(MTOK, 2 * DFF, F.G, F.bid);
        pg8::EpiFfn E{(unsigned char*)F.out, (const float*)(ws + WS_RSQ3), TABP(F, 19), TABP(F, 20), (bf16_t*)(ws + WS_GATE), (__attribute__((address_space(3))) float*)(F.lds + 131072), 1.0f / WGU_SCALE};
        pg8::gemm_phase<pg8::EpiFfn, pg8::StaticOrder, true, true, true>(F.lds, g, S, E, F.tid, F.wave);
    } SEAM(10);
    if (IN(12)) { FRESH_IDS();
        { pg8::StaticOrder S0; S0.init(MTOK, DM, F.G, F.bid); pg8::Unit u0;
          if (S0.next(0, u0) && (u0.pm & 7)) ffn_fixup(F, u0.pm);
          if (S0.next(1, u0) && (u0.pm & 7)) ffn_fixup(F, u0.pm);
          asm volatile("s_waitcnt vmcnt(0)" ::: "memory"); __syncthreads(); FRESH_IDS(); }
        pg8::Gemm g{(const bf16_t*)F.out, (const bf16_t*)(ws + WS_WDOWN), MTOK, DM, DFF / 2};     pg8::StaticOrder S; S.init(MTOK, DM, F.G, F.bid);
        pg8::EpiResidBf16 E{xb, xb, DM, (float*)(ws + WS_RSQ4), 1.0f / WDOWN_SCALE, nullptr};
        pg8::gemm_phase<pg8::EpiResidBf16, pg8::StaticOrder, true, true, true>(F.lds, g, S, E, F.tid, F.wave);
    } SEAM(12);
    if (IN(13)) { FRESH_IDS(); phase_final_norm(F, A); }
#undef IN
#undef SEAM
}

extern "C" void kernel_launch(void* const* d_in, const int* in_sizes, int n_in, void* d_out, int out_size, void* d_ws, size_t ws_size, hipStream_t stream) {
    static int grid = 0;
    if (grid == 0) {
        if (n_in != 23 || in_sizes[0] != MTOK * DM || out_size != MTOK * DM || ws_size < WS_END) {
            fprintf(stderr, "kernel_launch: unexpected shapes: n_in %d, in0 %d, out %d, ws %zu (need >= %zu); nothing launched\n", n_in, n_in > 0 ? in_sizes[0] : -1, out_size, ws_size, (size_t)WS_END); grid = -1; return; }
        int dev = 0, cus = 0, per_cu = 0;
        if (hipGetDevice(&dev) != hipSuccess || hipDeviceGetAttribute(&cus, hipDeviceAttributeMultiprocessorCount, dev) != hipSuccess) { fprintf(stderr, "kernel_launch: device query failed\n"); grid = -1; return; }
        if (hipFuncSetAttribute((const void*)mk_fwd, hipFuncAttributeMaxDynamicSharedMemorySize, LDS_BYTES) != hipSuccess) { fprintf(stderr, "kernel_launch: hipFuncSetAttribute failed\n"); grid = -1; return; }
        if (hipOccupancyMaxActiveBlocksPerMultiprocessor(&per_cu, (const void*)mk_fwd, NTHREADS, LDS_BYTES) != hipSuccess || per_cu < 1) { fprintf(stderr, "kernel_launch: occupancy query says %d blocks per CU\n", per_cu); per_cu = 1; }
        (void)hipGetLastError();
        if (per_cu > 1) per_cu = 1;
        grid = cus * per_cu;
        if (grid != 256) { fprintf(stderr, "kernel_launch: built for a 256-CU device (grid %d); nothing launched\n", grid); grid = -1; return; }
    }
    if (grid < 0) return;
    if (hipMemsetAsync(d_ws, 0, 1u << 20, stream) != hipSuccess) { fprintf(stderr, "kernel_launch: hipMemsetAsync failed\n"); return; }
    Args a{};
    for (int i = 0; i < 23; ++i) a.in[i] = (const float*)d_in[i];
    a.out = (float*)d_out; a.ws = (unsigned char*)d_ws;
#if MK_MULTI
    for (int p = 0; p < N_PHASES; ++p) { a.ph_lo = p; a.ph_hi = p + 1; hipLaunchKernelGGL(mk_fwd, dim3(grid), dim3(NTHREADS), LDS_BYTES, stream, a); }
#else
    a.ph_lo = 0; a.ph_hi = N_PHASES;
    void* kargs[] = {&a};
    hipError_t e = hipLaunchCooperativeKernel((const void*)mk_fwd, dim3(grid), dim3(NTHREADS), kargs, LDS_BYTES, stream);
    if (e != hipSuccess) fprintf(stderr, "kernel_launch: cooperative launch failed: %s (grid %d)\n", hipGetErrorString(e), grid);
#endif
}
```

```cpp
#include <hip/hip_runtime.h>
#include <hip/hip_cooperative_groups.h>
#include <cstdio>
#include <cstdint>
namespace cg = cooperative_groups;

#ifndef MK_MULTI
#define MK_MULTI 0
#endif

namespace pg8 {
#define PG8_LAS __attribute__((address_space(3)))
typedef unsigned short bf16_t;
typedef short bf16x8 __attribute__((ext_vector_type(8)));
typedef float f32x4 __attribute__((ext_vector_type(4)));
typedef unsigned u32x4 __attribute__((ext_vector_type(4)));
typedef int pg8_v4i __attribute__((ext_vector_type(4)));
typedef int pg8_v8i __attribute__((ext_vector_type(8)));
constexpr int BM = 256, BK = 64, HALF = 128, HTB = HALF * BK * 2  , STAGE_BYTES = 8 * HTB, NXCD = 8, WGM = 8;

__host__ __device__ __forceinline__ int lds_byte(int r, int c) { const int st = (r >> 4) * 2 + (c >> 5), rr = r & 15, cc = c & 31, ob = rr * 64 + cc * 2; return st * 1024 + (ob ^ (((ob >> 9) & 1) << 5)); }
__host__ __device__ __forceinline__ void stage_rc(int b, int& R, int& C) { const int st = b / 1024, sb = b % 1024, swz = sb ^ (((sb >> 9) & 1) << 5); R = (st >> 1) * 16 + swz / 64; C = (st & 1) * 32 + (swz % 64) / 2; }
__host__ __device__ __forceinline__ int perm32(int rho) { const int n = rho >> 4, i = rho & 15; return 8 * (i >> 2) + 4 * n + (i & 3); }

struct Unit { int pm, pn; };
struct Gemm { const bf16_t* A; const bf16_t* Bt; int M, N, K; };

struct StaticOrder {
    int nM, nN, nwg, G, c;
    __host__ __device__ __forceinline__ void init(int M, int N, int G_, int c_) { nM = M / BM; nN = N / BM; nwg = nM * nN; G = G_; c = c_; }
    __host__ __device__ __forceinline__ bool next(int i, Unit& u) const {
        const long L = (long)i * G + c; if (L >= nwg) return false;
        int wgid = (int)L; { const int q = nwg / NXCD, r = nwg % NXCD, xcd = wgid % NXCD, off = wgid / NXCD; wgid = (xcd < r ? xcd * (q + 1) : r * (q + 1) + (xcd - r) * q) + off; }
        const int nig = WGM * nN, gid = wgid / nig, fm = gid * WGM, gsz = (nM - fm) < WGM ? (nM - fm) : WGM;
        u.pm = fm + ((wgid % nig) % gsz); u.pn = (wgid % nig) / gsz; return true;
    }
    __device__ __forceinline__ void a_ready(const Unit&) const {}
    __device__ __forceinline__ void done(const Unit&) const {}
};


__device__ __forceinline__ unsigned cvt_pk_bf16(float lo, float hi) { unsigned r; asm volatile("v_cvt_pk_bf16_f32 %0, %1, %2" : "=v"(r) : "v"(lo), "v"(hi)); return r; }
typedef __bf16 hw_bf16x2 __attribute__((ext_vector_type(2)));
typedef float hw_f32x2 __attribute__((ext_vector_type(2)));
__device__ __forceinline__ unsigned cvt_pk_bf16_acc(float lo, float hi) { const hw_bf16x2 r = __builtin_convertvector((hw_f32x2){lo, hi}, hw_bf16x2); return __builtin_bit_cast(unsigned, r); }
__device__ __forceinline__ float silu_f(float v) { return v * __builtin_amdgcn_rcpf(1.0f + __expf(-v)); }

struct EpiScaleBf16 {
    static constexpr bool PERM = true, AFTER_DRAIN = false;
    bf16_t* O; int ldc; const float* rs; int silu_lo, silu_hi; int split_cols; size_t split_stride; float* km; int km_lo, km_hi; int rs_sumsq; float oscale; int qs_lo, qs_hi; float qscale;
    __device__ __forceinline__ void operator()(const f32x4 (&acc)[2][2][4][2], const Unit& u, int wr, int wc, int fr, int fq) const {
        int colt = u.pn * BM; bf16_t* base = O; if (split_cols && colt >= split_cols) { base += split_stride; colt -= split_cols; }
        const int row0 = u.pm * BM + wr * 64 + fr, col0 = colt + wc * 32 + 8 * fq;
        const bool act = (u.pn >= silu_lo && u.pn < silu_hi); const float tscale = (u.pn >= qs_lo && u.pn < qs_hi) ? oscale * qscale : oscale;
        const bool dokm = km && u.pn >= km_lo && u.pn < km_hi; float cs[2][8];
#pragma unroll
        for (int a_ = 0; a_ < 2; ++a_)
#pragma unroll
            for (int b_ = 0; b_ < 8; ++b_) cs[a_][b_] = 0.f;
        float rsv[2][4];
#pragma unroll
        for (int ai = 0; ai < 2; ++ai)
#pragma unroll
            for (int m = 0; m < 4; ++m) rsv[ai][m] = rs ? rs[row0 + ai * HALF + m * 16] : 1.0f;
#pragma unroll
        for (int ai = 0; ai < 2; ++ai)
#pragma unroll
            for (int m = 0; m < 4; ++m) { const int row = row0 + ai * HALF + m * 16; float r = rsv[ai][m]; if (rs_sumsq) r = rsqrtf(r * (1.0f / 2048.0f) + 1e-6f); r *= tscale; bf16_t* rowp = base + (size_t)row * ldc + col0;
#pragma unroll
                for (int bj = 0; bj < 2; ++bj) { f32x4 v0 = acc[ai][bj][m][0] * r, v1 = acc[ai][bj][m][1] * r;
                    if (act) {
#pragma unroll
                        for (int j = 0; j < 4; ++j) { v0[j] = silu_f(v0[j]); v1[j] = silu_f(v1[j]); } }
                    if (dokm) {
#pragma unroll
                        for (int j = 0; j < 4; ++j) { cs[bj][j] += v0[j]; cs[bj][4 + j] += v1[j]; } }
                    u32x4 w; w.x = cvt_pk_bf16(v0[0], v0[1]); w.y = cvt_pk_bf16(v0[2], v0[3]); w.z = cvt_pk_bf16(v1[0], v1[1]); w.w = cvt_pk_bf16(v1[2], v1[3]);
                    *(u32x4*)(rowp + bj * HALF) = w; } }
        if (dokm) {
#pragma unroll
            for (int bj = 0; bj < 2; ++bj)
#pragma unroll
                for (int c = 0; c < 8; ++c) { float s = cs[bj][c]; s += __shfl_xor(s, 1); s += __shfl_xor(s, 2); s += __shfl_xor(s, 4); s += __shfl_xor(s, 8);
                    if (fr == 0) atomicAdd(km + (size_t)u.pm * 1024 + (u.pn - km_lo) * BM + bj * HALF + wc * 32 + 8 * fq + c, s * (1.0f / 256.0f)); } }
    }
};
struct EpiResidBf16 {
    static constexpr bool PERM = true, AFTER_DRAIN = false;
    const bf16_t* baseh; bf16_t* out; int ldc; float* rowsq; float accscale; unsigned char* q8;
    __device__ __forceinline__ void operator()(const f32x4 (&acc)[2][2][4][2], const Unit& u, int wr, int wc, int fr, int fq) const {
        const int row0 = u.pm * BM + wr * 64 + fr, col0 = u.pn * BM + wc * 32 + 8 * fq;
#pragma unroll
        for (int ai = 0; ai < 2; ++ai) {
            u32x4 hb[4][2];
#pragma unroll
            for (int m = 0; m < 4; ++m)
#pragma unroll
                for (int bj = 0; bj < 2; ++bj) hb[m][bj] = *(const u32x4*)(baseh + (size_t)(row0 + ai * HALF + m * 16) * ldc + col0 + bj * HALF);
#pragma unroll
            for (int m = 0; m < 4; ++m) { const int row = row0 + ai * HALF + m * 16; const size_t off = (size_t)row * ldc + col0; float ss = 0.f;
#pragma unroll
                for (int bj = 0; bj < 2; ++bj) { const u32x4 h = hb[m][bj];
                    const f32x4 b0 = (f32x4){__uint_as_float(h.x << 16), __uint_as_float(h.x & 0xffff0000u), __uint_as_float(h.y << 16), __uint_as_float(h.y & 0xffff0000u)};
                    const f32x4 b1 = (f32x4){__uint_as_float(h.z << 16), __uint_as_float(h.z & 0xffff0000u), __uint_as_float(h.w << 16), __uint_as_float(h.w & 0xffff0000u)};
                    const f32x4 v0 = b0 + acc[ai][bj][m][0] * accscale, v1 = b1 + acc[ai][bj][m][1] * accscale;
                    ss += (v0[0] * v0[0] + v0[1] * v0[1]) + (v0[2] * v0[2] + v0[3] * v0[3]) + (v1[0] * v1[0] + v1[1] * v1[1]) + (v1[2] * v1[2] + v1[3] * v1[3]);
                    u32x4 w; w.x = cvt_pk_bf16(v0[0], v0[1]); w.y = cvt_pk_bf16(v0[2], v0[3]); w.z = cvt_pk_bf16(v1[0], v1[1]); w.w = cvt_pk_bf16(v1[2], v1[3]);
                    *(u32x4*)(out + off + bj * HALF) = w;
                    if (q8) { int q0 = __builtin_amdgcn_cvt_pk_fp8_f32(v0[0], v0[1], 0, false); q0 = __builtin_amdgcn_cvt_pk_fp8_f32(v0[2], v0[3], q0, true);
                        int q1 = __builtin_amdgcn_cvt_pk_fp8_f32(v1[0], v1[1], 0, false); q1 = __builtin_amdgcn_cvt_pk_fp8_f32(v1[2], v1[3], q1, true);
                        typedef unsigned u32x2_ __attribute__((ext_vector_type(2))); *(u32x2_*)(q8 + off + bj * HALF) = (u32x2_){(unsigned)q0, (unsigned)q1}; } }
                ss += __shfl_xor(ss, 16); ss += __shfl_xor(ss, 32);
                if (fq == 0) atomicAdd(rowsq + row, ss); } }
    }
};

struct EpiFfn {
    static constexpr bool PERM = true, AFTER_DRAIN = false;
    unsigned char* H8; const float* rsq; const float* cw; const float* cb; bf16_t* halo; PG8_LAS float* X;
    float oscale;
    __device__ __forceinline__ void operator()(f32x4 (&acc)[2][2][4][2], const Unit& u, int wr, int wc, int fr_in, int fq_in) const {
        int fr = fr_in, fq = fq_in; asm volatile("" : "+v"(fr), "+v"(fq));
        const int wid = wr * 4 + wc, ch = u.pn * 128 + wc * 32 + 8 * fq, lane = fq * 16 + fr;
#pragma unroll
        for (int ai = 0; ai < 2; ++ai)
#pragma unroll
            for (int m = 0; m < 4; ++m) { const int row = u.pm * BM + ai * HALF + wr * 64 + m * 16 + fr; const float r = rsqrtf(rsq[row] * (1.0f / 2048.0f) + 1e-6f) * oscale;
#pragma unroll
                for (int bj = 0; bj < 2; ++bj) { acc[ai][bj][m][0] = acc[ai][bj][m][0] * r; acc[ai][bj][m][1] = acc[ai][bj][m][1] * r; } }
        if (fr >= 14) {
#pragma unroll
            for (int ai = 0; ai < 2; ++ai) { PG8_LAS f32x4* xp = (PG8_LAS f32x4*)(X + ((wid * 2 + ai) * 2 + (fr - 14)) * 64 + fq * 8); xp[0] = acc[ai][0][3][0]; xp[1] = acc[ai][0][3][1]; } }
        { bf16_t* hp = halo + (size_t)u.pm * 6 * 5632 + ch;
          if (wr == 1 && fr >= 14) { u32x4 w = {cvt_pk_bf16(acc[1][0][3][0][0], acc[1][0][3][0][1]), cvt_pk_bf16(acc[1][0][3][0][2], acc[1][0][3][0][3]), cvt_pk_bf16(acc[1][0][3][1][0], acc[1][0][3][1][1]), cvt_pk_bf16(acc[1][0][3][1][2], acc[1][0][3][1][3])};
              *(u32x4*)(hp + (size_t)(fr - 14) * 5632) = w; }
          if (wr == 0 && fr < 2) { u32x4 w = {cvt_pk_bf16(acc[0][0][0][0][0], acc[0][0][0][0][1]), cvt_pk_bf16(acc[0][0][0][0][2], acc[0][0][0][0][3]), cvt_pk_bf16(acc[0][0][0][1][0], acc[0][0][0][1][1]), cvt_pk_bf16(acc[0][0][0][1][2], acc[0][0][0][1][3])};
              *(u32x4*)(hp + (size_t)(2 + fr) * 5632) = w;
              u32x4 w2 = {cvt_pk_bf16(acc[0][1][0][0][0], acc[0][1][0][0][1]), cvt_pk_bf16(acc[0][1][0][0][2], acc[0][1][0][0][3]), cvt_pk_bf16(acc[0][1][0][1][0], acc[0][1][0][1][1]), cvt_pk_bf16(acc[0][1][0][1][2], acc[0][1][0][1][3])};
              *(u32x4*)(hp + (size_t)(4 + fr) * 5632) = w2; } }
        const f32x4 w0a = *(const f32x4*)(cw + ch), w0b = *(const f32x4*)(cw + ch + 4), w1a = *(const f32x4*)(cw + 5632 + ch), w1b = *(const f32x4*)(cw + 5632 + ch + 4);
        const f32x4 w2a = *(const f32x4*)(cw + 2 * 5632 + ch), w2b = *(const f32x4*)(cw + 2 * 5632 + ch + 4), ba = *(const f32x4*)(cb + ch), bb = *(const f32x4*)(cb + ch + 4);
        asm volatile("s_waitcnt lgkmcnt(0)" ::: "memory"); __builtin_amdgcn_s_barrier(); asm volatile("" ::: "memory");
#pragma unroll
        for (int ai = 1; ai >= 0; --ai)
#pragma unroll
            for (int m = 3; m >= 0; --m) {
                f32x4 pv0, pv1;
                if (m > 0) { pv0 = acc[ai][0][m - 1][0]; pv1 = acc[ai][0][m - 1][1]; }
                else { pv0 = (f32x4){0.f, 0.f, 0.f, 0.f}; pv1 = pv0;
                    if (!(wr == 0 && ai == 0) && fr >= 14) { const int pw = (1 - wr) * 4 + wc, pai = (wr == 1) ? ai : 0;
                        const PG8_LAS f32x4* xp = (const PG8_LAS f32x4*)(X + ((pw * 2 + pai) * 2 + (fr - 14)) * 64 + fq * 8); pv0 = xp[0]; pv1 = xp[1]; } }
                const f32x4 g0 = acc[ai][0][m][0], g1 = acc[ai][0][m][1], u0 = acc[ai][1][m][0], u1 = acc[ai][1][m][1];
                float hv[8];
#pragma unroll
                for (int c = 0; c < 8; ++c) { const float gc = c < 4 ? g0[c & 3] : g1[c & 3], pc = c < 4 ? pv0[c & 3] : pv1[c & 3];
                    const float x1 = __int_as_float(__builtin_amdgcn_update_dpp(0, __float_as_int(fr == 15 ? pc : gc), 0x121, 0xf, 0xf, false)), x2 = __int_as_float(__builtin_amdgcn_update_dpp(0, __float_as_int(fr >= 14 ? pc : gc), 0x122, 0xf, 0xf, false));
                    const float y = (c < 4 ? w0a[c & 3] : w0b[c & 3]) * x2 + (c < 4 ? w1a[c & 3] : w1b[c & 3]) * x1 + (c < 4 ? w2a[c & 3] : w2b[c & 3]) * gc + (c < 4 ? ba[c & 3] : bb[c & 3]);
                    hv[c] = y * __builtin_amdgcn_rcpf(1.0f + __expf(-y)) * (c < 4 ? u0[c & 3] : u1[c & 3]); }
                int q0 = __builtin_amdgcn_cvt_pk_fp8_f32(hv[0], hv[1], 0, false); q0 = __builtin_amdgcn_cvt_pk_fp8_f32(hv[2], hv[3], q0, true);
                int q1 = __builtin_amdgcn_cvt_pk_fp8_f32(hv[4], hv[5], 0, false); q1 = __builtin_amdgcn_cvt_pk_fp8_f32(hv[6], hv[7], q1, true);
                typedef unsigned u32x2_ __attribute__((ext_vector_type(2)));
                *(u32x2_*)(H8 + (size_t)(u.pm * BM + ai * HALF + wr * 64 + m * 16 + fr) * 5632 + ch) = (u32x2_){(unsigned)q0, (unsigned)q1}; }
    }
};

template <class Epi, class Sched, bool ALIGN_EPI = false, bool SP2 = false, bool F8 = false>
__device__ __forceinline__ void gemm_phase(PG8_LAS unsigned char* lds, const Gemm g, const Sched& S, const Epi& E, const int tid, const int wid) {
    const int lane = tid & 63, wr = wid >> 2, wc = wid & 3, fr = lane & 15, fq = lane >> 4;
    const int K = g.K, nt = K / BK;
    unsigned voffA[2], voffB[2];
#pragma unroll
    for (int i = 0; i < 2; ++i) { int R, C; stage_rc(tid * 16 + i * 8192, R, C); const int Rb = Epi::PERM ? ((R & ~31) + perm32(R & 31)) : R;
        voffA[i] = (unsigned)(R * K + C) * 2u; voffB[i] = (unsigned)(Rb * K + C) * 2u; }
    const size_t kstep = (size_t)(BK * 2);
    const size_t hstep = (size_t)HALF * K * 2;
    const size_t tstep = 2 * hstep;
    const unsigned ldsw = (unsigned)wid * 1024u;
    const int aoff = lds_byte(wr * 64 + fr, fq * 8), boff = lds_byte(wc * 32 + fr, fq * 8);
#define PG8_SA(b, h) (((b) * 2 + (h)) * HTB)
#define PG8_SB(b, h) ((4 + (b) * 2 + (h)) * HTB)
#define PG8_STAGE(bufoff, gbase, voff) do { _Pragma("unroll") for (int _i = 0; _i < 2; ++_i) { unsigned vo_ = (voff)[_i]; if constexpr (F8) asm volatile("" : "+v"(vo_));     \
        __builtin_amdgcn_global_load_lds((const unsigned*)((const char*)(gbase) + vo_), (PG8_LAS unsigned*)(lds + (bufoff) + ldsw + _i * 8192), 16, 0, 0); } } while (0)
#define PG8_LDA(dst, b, h) do { if constexpr (F8) { _Pragma("unroll") for (int m = 0; m < 4; ++m) { const pg8_v4i l_ = *(const PG8_LAS pg8_v4i*)(lds + PG8_SA(b, h) + aoff + m * 2048), h_ = *(const PG8_LAS pg8_v4i*)(lds + PG8_SA(b, h) + aoff + m * 2048 + 1024); \
            dst##8[m] = __builtin_shufflevector(l_, h_, 0, 1, 2, 3, 4, 5, 6, 7); } } \
        else { _Pragma("unroll") for (int m = 0; m < 4; ++m) _Pragma("unroll") for (int k = 0; k < 2; ++k) dst[m][k] = *(const PG8_LAS bf16x8*)(lds + PG8_SA(b, h) + aoff + m * 2048 + k * 1024); } } while (0)
#define PG8_LDB(dst, b, h) do { if constexpr (F8) { _Pragma("unroll") for (int n = 0; n < 2; ++n) { const pg8_v4i l_ = *(const PG8_LAS pg8_v4i*)(lds + PG8_SB(b, h) + boff + n * 2048), h_ = *(const PG8_LAS pg8_v4i*)(lds + PG8_SB(b, h) + boff + n * 2048 + 1024); \
            dst##8[n] = __builtin_shufflevector(l_, h_, 0, 1, 2, 3, 4, 5, 6, 7); } } \
        else { _Pragma("unroll") for (int n = 0; n < 2; ++n) _Pragma("unroll") for (int k = 0; k < 2; ++k) dst[n][k] = *(const PG8_LAS bf16x8*)(lds + PG8_SB(b, h) + boff + n * 2048 + k * 1024); } } while (0)
#define PG8_MMA(ai, bj, At, Bt) do { __builtin_amdgcn_s_setprio(1); \
        if constexpr (F8) { _Pragma("unroll") for (int m = 0; m < 4; ++m) _Pragma("unroll") for (int n = 0; n < 2; ++n) \
            acc[ai][bj][m][n] = __builtin_amdgcn_mfma_scale_f32_16x16x128_f8f6f4(Bt##8[n], At##8[m], acc[ai][bj][m][n], 0, 0, 0, 0x7f7f7f7f, 0, 0x7f7f7f7f); } \
        else { _Pragma("unroll") for (int m = 0; m < 4; ++m) _Pragma("unroll") for (int n = 0; n < 2; ++n) _Pragma("unroll") for (int k = 0; k < 2; ++k) \
            acc[ai][bj][m][n] = __builtin_amdgcn_mfma_f32_16x16x32_bf16(Bt[n][k], At[m][k], acc[ai][bj][m][n], 0, 0, 0); } \
        __builtin_amdgcn_s_setprio(0); } while (0)
#define PG8_WAIT_V(n) asm volatile("s_waitcnt vmcnt(" #n ")" ::: "memory")
#define PG8_WAIT_L(n) asm volatile("s_waitcnt lgkmcnt(" #n ")" ::: "memory")
#define PG8_BAR __builtin_amdgcn_s_barrier()
#define PG8_SCHED __builtin_amdgcn_sched_barrier(0)
    Unit cur, nxt; int ui = 0;
    if (!S.next(0, cur)) return;
    f32x4 acc[2][2][4][2];
#pragma unroll
    for (int a = 0; a < 2; ++a)
#pragma unroll
        for (int b = 0; b < 2; ++b)
#pragma unroll
            for (int m = 0; m < 4; ++m)
#pragma unroll
                for (int n = 0; n < 2; ++n) acc[a][b][m][n] = (f32x4){0.f, 0.f, 0.f, 0.f};
    bf16x8 At[4][2], B0[2][2], B1[2][2];
    pg8_v8i At8[4], B08[2], B18[2];
    const char* cA = (const char*)g.A + (size_t)cur.pm * tstep; const char* cB = (const char*)g.Bt + (size_t)cur.pn * tstep;
    S.a_ready(cur);
    if constexpr (SP2) {
        PG8_STAGE(PG8_SB(0, 0), cB, voffB); PG8_STAGE(PG8_SB(0, 1), cB + hstep, voffB); PG8_STAGE(PG8_SA(0, 0), cA, voffA); PG8_STAGE(PG8_SA(0, 1), cA + hstep, voffA);
        if (wr == 1) PG8_BAR;
        PG8_WAIT_V(2); PG8_BAR;
        PG8_STAGE(PG8_SB(1, 0), cB + kstep, voffB); PG8_STAGE(PG8_SA(1, 0), cA + kstep, voffA); PG8_STAGE(PG8_SB(1, 1), cB + hstep + kstep, voffB);
        PG8_WAIT_V(6); PG8_BAR;
    } else {
        PG8_STAGE(PG8_SB(0, 0), cB, voffB); PG8_STAGE(PG8_SA(0, 0), cA, voffA); PG8_STAGE(PG8_SB(0, 1), cB + hstep, voffB); PG8_STAGE(PG8_SA(0, 1), cA + hstep, voffA);
        if (wr == 1) PG8_BAR;
        PG8_WAIT_V(4); PG8_BAR;
        PG8_STAGE(PG8_SB(1, 0), cB + kstep, voffB); PG8_STAGE(PG8_SA(1, 0), cA + kstep, voffA); PG8_STAGE(PG8_SB(1, 1), cB + hstep + kstep, voffB);
        PG8_WAIT_V(6); PG8_BAR;
    }
    for (;;) {
        const bool has_next = S.next(ui + 1, nxt);
        const char* nA = has_next ? (const char*)g.A + (size_t)nxt.pm * tstep : cA; const char* nB = has_next ? (const char*)g.Bt + (size_t)nxt.pn * tstep : cB;
        for (int t = 0; t < nt; t += 2) {
            const bool last = (t == nt - 2);
            const char* a1 = cA + (size_t)(t + 1) * kstep;
            const char* a2 = last ? nA : cA + (size_t)(t + 2) * kstep; const char* b2 = last ? nB : cB + (size_t)(t + 2) * kstep;
            const char* a3 = a2 + kstep; const char* b3 = b2 + kstep;
            if (last && has_next) S.a_ready(nxt);
            if constexpr (SP2) {
            PG8_LDB(B0, 0, 0); PG8_LDB(B1, 0, 1); PG8_SCHED; PG8_LDA(At, 0, 0); PG8_STAGE(PG8_SA(1, 1), a1 + hstep, voffA);
            PG8_WAIT_V(8); PG8_WAIT_L(0); PG8_BAR; PG8_MMA(0, 0, At, B0); PG8_MMA(0, 1, At, B1); PG8_BAR; PG8_SCHED;
            PG8_LDA(At, 0, 1); PG8_STAGE(PG8_SB(0, 0), b2, voffB); PG8_STAGE(PG8_SB(0, 1), b2 + hstep, voffB); PG8_STAGE(PG8_SA(0, 0), a2, voffA);
            PG8_WAIT_V(8); PG8_WAIT_L(0); PG8_BAR; PG8_MMA(1, 0, At, B0); PG8_MMA(1, 1, At, B1); PG8_BAR; PG8_SCHED;
            PG8_LDB(B0, 1, 0); PG8_LDB(B1, 1, 1); PG8_SCHED; PG8_LDA(At, 1, 0); PG8_STAGE(PG8_SA(0, 1), a2 + hstep, voffA);
            PG8_WAIT_V(8); PG8_WAIT_L(0); PG8_BAR; PG8_MMA(0, 0, At, B0); PG8_MMA(0, 1, At, B1); PG8_BAR; PG8_SCHED;
            PG8_LDA(At, 1, 1); PG8_STAGE(PG8_SB(1, 0), b3, voffB); PG8_STAGE(PG8_SB(1, 1), b3 + hstep, voffB); PG8_STAGE(PG8_SA(1, 0), a3, voffA);
            PG8_WAIT_V(8); PG8_WAIT_L(0); PG8_BAR; PG8_MMA(1, 0, At, B0); PG8_MMA(1, 1, At, B1); PG8_BAR; PG8_SCHED;
            } else {
            PG8_LDB(B0, 0, 0); PG8_SCHED; PG8_LDA(At, 0, 0); PG8_STAGE(PG8_SA(1, 1), a1 + hstep, voffA);
            PG8_WAIT_L(8); PG8_BAR; PG8_WAIT_L(0); PG8_MMA(0, 0, At, B0); PG8_BAR; PG8_SCHED;
            PG8_LDB(B1, 0, 1); PG8_STAGE(PG8_SB(0, 0), b2, voffB);
            PG8_BAR; PG8_WAIT_L(0); PG8_MMA(0, 1, At, B1); PG8_BAR;
            PG8_LDA(At, 0, 1); PG8_STAGE(PG8_SA(0, 0), a2, voffA);
            PG8_BAR; PG8_WAIT_L(0); PG8_MMA(1, 0, At, B0); PG8_BAR; PG8_SCHED;
            PG8_STAGE(PG8_SB(0, 1), b2 + hstep, voffB);
            PG8_WAIT_V(6); PG8_BAR; PG8_MMA(1, 1, At, B1); PG8_BAR;
            PG8_LDB(B0, 1, 0); PG8_SCHED; PG8_LDA(At, 1, 0); PG8_STAGE(PG8_SA(0, 1), a2 + hstep, voffA);
            PG8_WAIT_L(8); PG8_BAR; PG8_WAIT_L(0); PG8_MMA(0, 0, At, B0); PG8_BAR; PG8_SCHED;
            PG8_LDB(B1, 1, 1); PG8_STAGE(PG8_SB(1, 0), b3, voffB);
            PG8_BAR; PG8_WAIT_L(0); PG8_MMA(0, 1, At, B1); PG8_BAR;
            PG8_LDA(At, 1, 1); PG8_STAGE(PG8_SA(1, 0), a3, voffA);
            PG8_BAR; PG8_WAIT_L(0); PG8_MMA(1, 0, At, B0); PG8_BAR; PG8_SCHED;
            PG8_STAGE(PG8_SB(1, 1), b3 + hstep, voffB);
            PG8_WAIT_V(6); PG8_BAR; PG8_MMA(1, 1, At, B1); PG8_BAR;
            }
        }
        if constexpr (ALIGN_EPI) { if (wr == 0) PG8_BAR; }
        if constexpr (!Epi::AFTER_DRAIN) { E(acc, cur, wr, wc, fr, fq); S.done(cur); }
        if (!has_next) break;
#pragma unroll
        for (int a = 0; a < 2; ++a)
#pragma unroll
            for (int b = 0; b < 2; ++b)
#pragma unroll
                for (int m = 0; m < 4; ++m)
#pragma unroll
                    for (int n = 0; n < 2; ++n) acc[a][b][m][n] = (f32x4){0.f, 0.f, 0.f, 0.f};
        cur = nxt; cA = nA; cB = nB; ++ui;
        if constexpr (ALIGN_EPI) { if (wr == 1) PG8_BAR; }
    }
    PG8_WAIT_V(0);
    if constexpr (!ALIGN_EPI) { if (wr == 0) PG8_BAR; }
    PG8_BAR;
    if constexpr (Epi::AFTER_DRAIN) { E.fused(acc, cur, wr, wc, fr, fq, lds, wid, lane); S.done(cur); }
#undef PG8_SA
#undef PG8_SB
#undef PG8_STAGE
#undef PG8_LDA
#undef PG8_LDB
#undef PG8_MMA
#undef PG8_WAIT_V
#undef PG8_WAIT_L
#undef PG8_BAR
#undef PG8_SCHED
}
}

namespace moba {
constexpr float SCALE = 0.08838834764831845f;
constexpr int NW = 8, QBLK = 32, KVBLK = 64, QB = NW * QBLK, D = 128;
struct CfgMoba { static constexpr int LDQ = 7232, LDK = 7232, LDO = 2048; static constexpr bool MOBA = true; };
struct CfgX { static constexpr int LDQ = 512, LDK = 1024, LDO = 512; static constexpr bool MOBA = false; };
constexpr int SHM_V = KVBLK * D * 2, SHM_K = KVBLK * D * 2;
constexpr int OFF_WS = 2 * SHM_V + 2 * SHM_K, OFF_BT = OFF_WS + NW * 64 * 4;
constexpr int OFF_KM = OFF_BT + 1024;
constexpr int OFF_Q = OFF_KM + 8192;
constexpr int LDS_BYTES = OFF_Q + NW * 8192;
constexpr float THR = 8.f;
constexpr float LOG2E = 1.4426950408889634f, QSCALE = LOG2E * SCALE, THR2 = THR * LOG2E;
typedef short bf16x8 __attribute__((ext_vector_type(8)));
typedef short s16x4 __attribute__((ext_vector_type(4)));
typedef float f32x16 __attribute__((ext_vector_type(16)));
typedef float f32x4 __attribute__((ext_vector_type(4)));
typedef unsigned u32x4 __attribute__((ext_vector_type(4)));
typedef unsigned short bf16;

#define KSWZ(row, colB) ((row) * 256 + ((colB) ^ (((row) & 7) << 4)))
#define SBAR() __builtin_amdgcn_sched_barrier(0)
__device__ __forceinline__ int v_st(int k, int c) { const int kk = (k & ~0xC) | ((k & 4) << 1) | ((k & 8) >> 1); return ((kk >> 3) * 4 + (c >> 5)) * 512 + ((kk & 7) * 32 + (c & 31)) * 2; }
__device__ __forceinline__ int v_rd_base(int lane) { return ((lane & 3) << 3) | (((lane >> 2) & 3) << 6) | (((lane >> 4) & 1) << 5) | (((lane >> 5) & 1) << 8); }
constexpr int v_rd_off(int d0, int ks, int half) { return d0 * 512 + ks * 4096 + half * 2048; }
__device__ __forceinline__ int crow(int r, int hi) { return (r & 3) + 8 * (r >> 2) + 4 * hi; }
__device__ __forceinline__ unsigned cvtpk(float lo, float hi) { unsigned r; asm volatile("v_cvt_pk_bf16_f32 %0, %1, %2" : "=v"(r) : "v"(lo), "v"(hi)); return r; }
__device__ __forceinline__ bf16x8 load8(const bf16* p) { return *reinterpret_cast<const bf16x8*>(p); }
__device__ __forceinline__ void mask_tile(f32x16& p0, f32x16& p1, int dq) {
    const float NEG = -__builtin_inff();
#pragma unroll
    for (int r = 0; r < 16; ++r) { const int c = (r & 3) + 8 * (r >> 2); if (dq - c < 0) p0[r] = NEG; if (dq - c - 32 < 0) p1[r] = NEG; }
}
__device__ __forceinline__ void bias_tile(f32x16& p0, f32x16& p1, int dq, const float* bt) {
#pragma unroll
    for (int r = 0; r < 16; ++r) { const int c = (r & 3) + 8 * (r >> 2); int n0 = dq - c, n1 = dq - c - 32; n0 = n0 < 0 ? 0 : n0; n1 = n1 < 0 ? 0 : n1; p0[r] += bt[n0]; p1[r] += bt[n1]; }
}
__device__ __forceinline__ void sel_tile(f32x16& p0, f32x16& p1, bool sel) {
    const float NEG = -__builtin_inff();
#pragma unroll
    for (int r = 0; r < 16; ++r) { p0[r] = sel ? p0[r] : NEG; p1[r] = sel ? p1[r] : NEG; }
}
template <bool FIRST>
__device__ __forceinline__ void partialSM(f32x16& p0, f32x16& p1, float& m_reg, float& alpha) {
    float pmax = p0[0]; for (int r = 1; r < 16; ++r) pmax = fmaxf(pmax, p0[r]); for (int r = 0; r < 16; ++r) pmax = fmaxf(pmax, p1[r]);
    { auto rr = __builtin_amdgcn_permlane32_swap(__float_as_uint(pmax), __float_as_uint(pmax), false, false);
      pmax = fmaxf(__uint_as_float(rr[0]), __uint_as_float(rr[1])); }
    if (!FIRST && __builtin_expect(__all(pmax <= THR2), 1)) { alpha = 1.f; }
    else { const float d = FIRST ? (pmax > -3.0e38f ? pmax : 0.f) : fmaxf(pmax, 0.f);
        alpha = __builtin_amdgcn_exp2f(-d); m_reg += d;
        for (int r = 0; r < 16; ++r) { p0[r] -= d; p1[r] -= d; } }
    for (int r = 0; r < 16; ++r) p0[r] = __builtin_amdgcn_exp2f(p0[r]);
}
__device__ __forceinline__ void finishSM(f32x16& p0, f32x16& p1, float alpha, float& l_reg, bf16x8& pa0, bf16x8& pa1, bf16x8& pa2, bf16x8& pa3) {
    for (int r = 0; r < 16; ++r) p1[r] = __builtin_amdgcn_exp2f(p1[r]);
    float ps;
    { typedef float f32x8_ __attribute__((ext_vector_type(8))); typedef float f32x2_ __attribute__((ext_vector_type(2)));
      const f32x16 t = p0 + p1; const f32x8_ a = __builtin_shufflevector(t, t, 0, 1, 2, 3, 4, 5, 6, 7) + __builtin_shufflevector(t, t, 8, 9, 10, 11, 12, 13, 14, 15);
      const f32x4 b = __builtin_shufflevector(a, a, 0, 1, 2, 3) + __builtin_shufflevector(a, a, 4, 5, 6, 7); const f32x2_ c = __builtin_shufflevector(b, b, 0, 1) + __builtin_shufflevector(b, b, 2, 3); ps = c.x + c.y; }
    { auto rr = __builtin_amdgcn_permlane32_swap(__float_as_uint(ps), __float_as_uint(ps), false, false);
      ps = __uint_as_float(rr[0]) + __uint_as_float(rr[1]); }
    l_reg = l_reg * alpha + ps;
#define PK4(P, B_, OUT) do { unsigned a0 = cvtpk(P[B_+0], P[B_+1]), a1 = cvtpk(P[B_+2], P[B_+3]);                          \
        unsigned b0 = cvtpk(P[B_+4], P[B_+5]), b1 = cvtpk(P[B_+6], P[B_+7]);                                             \
        auto r0 = __builtin_amdgcn_permlane32_swap(a0, b0, false, false); auto r1 = __builtin_amdgcn_permlane32_swap(a1, b1, false, false); \
        u32x4 w = {r0[0], r1[0], r0[1], r1[1]}; OUT = *reinterpret_cast<bf16x8*>(&w); } while (0)
    PK4(p0, 0, pa0); PK4(p0, 8, pa1); PK4(p1, 0, pa2); PK4(p1, 8, pa3);
#undef PK4
}
template <int KB>
__device__ __forceinline__ void qkt(f32x16& p0, f32x16& p1, const char* K_lds, int r32, int hi, const char* qf, float init) {
#pragma unroll
    for (int r = 0; r < 16; ++r) { p0[r] = init; p1[r] = init; }
    const char* kb[4];
#pragma unroll
    for (int dd = 0; dd < 4; ++dd) kb[dd] = K_lds + KB * SHM_K + KSWZ(r32, (dd * 16 + hi * 8) * 2);
#pragma unroll
    for (int d0 = 0; d0 < 8; ++d0) { const char* a = kb[d0 & 3] + (d0 >> 2) * 128;
        bf16x8 b0 = *reinterpret_cast<const bf16x8*>(a);
        bf16x8 b1 = *reinterpret_cast<const bf16x8*>(a + 32 * 256);
        const bf16x8 qv = *reinterpret_cast<const bf16x8*>(qf + d0 * 1024);
        p0 = __builtin_amdgcn_mfma_f32_32x32x16_bf16(b0, qv, p0, 0, 0, 0);
        p1 = __builtin_amdgcn_mfma_f32_32x32x16_bf16(b1, qv, p1, 0, 0, 0); }
}
template <int VB>
__device__ __forceinline__ void pv_tile(f32x16* o, int vb0, bf16x8 pa0, bf16x8 pa1, bf16x8 pa2, bf16x8 pa3) {
#define TRRD(dst, off) asm volatile("ds_read_b64_tr_b16 %0, %1 offset:%2" : "=&v"(dst) : "v"(vb0), "i"(off) : "memory")
#define PV_LD(S, d0) do { constexpr int b_ = VB * SHM_V + v_rd_off(d0, 0, 0); \
        TRRD(S##l0, b_); TRRD(S##h0, b_ + 2048); TRRD(S##l1, b_ + 4096); TRRD(S##h1, b_ + 6144); TRRD(S##l2, b_ + 8192); TRRD(S##h2, b_ + 10240); TRRD(S##l3, b_ + 12288); TRRD(S##h3, b_ + 14336); } while (0)
#define PV_WT(S) do { asm volatile("s_waitcnt lgkmcnt(0)" : "+v"(S##l0), "+v"(S##h0), "+v"(S##l1), "+v"(S##h1), "+v"(S##l2), "+v"(S##h2), "+v"(S##l3), "+v"(S##h3) :: "memory"); SBAR(); } while (0)
#define PV_MM(S, d0) do { \
        o[d0] = __builtin_amdgcn_mfma_f32_32x32x16_bf16(pa0, (bf16x8){S##l0[0], S##l0[1], S##l0[2], S##l0[3], S##h0[0], S##h0[1], S##h0[2], S##h0[3]}, o[d0], 0, 0, 0);   \
        o[d0] = __builtin_amdgcn_mfma_f32_32x32x16_bf16(pa1, (bf16x8){S##l1[0], S##l1[1], S##l1[2], S##l1[3], S##h1[0], S##h1[1], S##h1[2], S##h1[3]}, o[d0], 0, 0, 0);   \
        o[d0] = __builtin_amdgcn_mfma_f32_32x32x16_bf16(pa2, (bf16x8){S##l2[0], S##l2[1], S##l2[2], S##l2[3], S##h2[0], S##h2[1], S##h2[2], S##h2[3]}, o[d0], 0, 0, 0);   \
        o[d0] = __builtin_amdgcn_mfma_f32_32x32x16_bf16(pa3, (bf16x8){S##l3[0], S##l3[1], S##l3[2], S##l3[3], S##h3[0], S##h3[1], S##h3[2], S##h3[3]}, o[d0], 0, 0, 0); } while (0)
    s16x4 al0, al1, al2, al3, ah0, ah1, ah2, ah3, bl0, bl1, bl2, bl3, bh0, bh1, bh2, bh3;
    PV_LD(a, 0); PV_WT(a);
    PV_LD(b, 1); PV_MM(a, 0); PV_WT(b);
    PV_LD(a, 2); PV_MM(b, 1); PV_WT(a);
    PV_LD(b, 3); PV_MM(a, 2); PV_WT(b);
    PV_MM(b, 3);
#undef PV_MM
#undef PV_WT
#undef PV_LD
#undef TRRD
}
struct Head { const bf16* Q0; const bf16* K0; const bf16* V0; bf16* O0; const float* km; };
struct Seam { bf16x8 st_v0, st_v1, st_k0, st_k1; };
#define VMW() asm volatile("s_waitcnt vmcnt(0)" ::: "memory")
#define VMWN(n) asm volatile("s_waitcnt vmcnt(%0)" :: "i"(n) : "memory")
#define SLOAD_H(Kp, Vp, k0) do { const bf16* k_ = (Kp) + (size_t)(k0) * Cfg::LDK; const bf16* v_ = (Vp) + (size_t)(k0) * Cfg::LDK; unsigned vo_ = voff; asm volatile("" : "+v"(vo_));     \
                         S.st_v0 = load8(v_ + vo_); S.st_v1 = load8(v_ + 32 * Cfg::LDK + vo_);                                       \
                         S.st_k0 = load8(k_ + vo_); S.st_k1 = load8(k_ + 32 * Cfg::LDK + vo_); } while (0)
#define SWRITE_HK(bf) do { *(bf16x8*)(K_lds + (bf) * SHM_K + kws) = S.st_k0; *(bf16x8*)(K_lds + (bf) * SHM_K + kws + 32 * 256) = S.st_k1; } while (0)
#define SWRITE_HV(bf) do { *(bf16x8*)(V_lds + (bf) * SHM_V + vst0) = S.st_v0; *(bf16x8*)(V_lds + (bf) * SHM_V + vst1) = S.st_v1; } while (0)
#define SWRITE_H(bf) do { SWRITE_HV(bf); SWRITE_HK(bf); } while (0)
template <class Cfg>
__device__ __forceinline__ void prime(const Head& H, int P0, char* lds, Seam& S, const int tid, const int wid) {
    const int lane = tid & 63, r32 = lane & 31, hi = lane >> 5;
    const int sr = tid >> 4, sc = (tid & 15) * 8, kws = KSWZ(sr, sc * 2); char* K_lds = lds + 2 * SHM_V; const unsigned voff = (unsigned)(sr * Cfg::LDK + sc);
    SLOAD_H(H.K0, H.V0, 0);
    { const bf16* qb = H.Q0 + (size_t)(P0 + wid * QBLK) * Cfg::LDQ; const unsigned qoff = (unsigned)(r32 * Cfg::LDQ + hi * 8); char* qf = lds + OFF_Q + wid * 8192 + lane * 16;
      bf16x8 tq[8];
#pragma unroll
      for (int d0 = 0; d0 < 8; ++d0) tq[d0] = load8(qb + qoff + d0 * 16);
      VMW();
#pragma unroll
      for (int d0 = 0; d0 < 8; ++d0) *(bf16x8*)(qf + d0 * 1024) = tq[d0]; }
    SWRITE_HK(0);
    __syncthreads();
}
template <class Cfg>
__device__ __forceinline__ void block(const Head& H, int P0, int P0n, const float* rel_bias, int h, const float* gn, char* lds, Seam& S, const int tid_in, const int wid) {
    int tid = tid_in; asm volatile("" : "+v"(tid));
    const int lane = tid & 63, r32 = lane & 31, hi = lane >> 5;
    const int own = Cfg::MOBA ? (P0 >> 8) : 0;
    const int NT = Cfg::MOBA ? (P0 + QB) / KVBLK : 4;
    const int qlo = P0 + wid * QBLK, qm = qlo + r32 - 4 * hi;
    char* V_lds = lds; char* K_lds = lds + 2 * SHM_V;
    float* ws = (float*)(lds + OFF_WS) + wid * 64; float* li_l = ws, * al_l = ws + 32;
    float* bt = (float*)(lds + OFF_BT);
    char* qf = lds + OFF_Q + wid * 8192 + lane * 16;
    float m_reg = 0.f, l_reg = 0; f32x16 o[4] = {};
    const int sr = tid >> 4, sc = (tid & 15) * 8, vst0 = v_st(sr, sc), vst1 = v_st(32 + sr, sc), kws = KSWZ(sr, sc * 2); const unsigned voff = (unsigned)(sr * Cfg::LDK + sc);
    const int vb0 = (int)(uintptr_t)V_lds + v_rd_base(lane);
    const bf16* Kh = H.K0; const bf16* Vh = H.V0;
    const float b31 = Cfg::MOBA ? rel_bias[31 * 8 + h] : 0.f; const float cinit = b31 * LOG2E;
    if (Cfg::MOBA && tid < 256) { int bk = 31; if (tid < 16) bk = tid; else if (tid < 128) { const int l = 16 + (int)(logf((float)tid * 0.0625f) * 7.694155931f); bk = l < 31 ? l : 31; }
        bt[tid] = (rel_bias[bk * 8 + h] - b31) * LOG2E; }
    if (own >= 4 && tid < 128) { int t_ = tid; asm volatile("" : "+v"(t_));
        const int n = t_ >> 4, c = t_ & 15; const float* kp = H.km + (unsigned)(n * 1024 + c * 8); const f32x4 k0 = *(const f32x4*)kp, k1 = *(const f32x4*)(kp + 4);
        u32x4 w = {cvtpk(k0[0], k0[1]), cvtpk(k0[2], k0[3]), cvtpk(k1[0], k1[1]), cvtpk(k1[2], k1[3])}; *(u32x4*)(lds + OFF_KM + KSWZ(n, c * 16)) = w; }
    int mask = 0;
#define RESC(a) do { if (__any((a) < 1.f)) { if (hi == 0) al_l[r32] = (a); asm volatile("s_waitcnt lgkmcnt(0)" ::: "memory");              \
                     for (int d_ = 0; d_ < 4; ++d_) for (int r = 0; r < 16; ++r) o[d_][r] *= al_l[crow(r, hi)]; } } while (0)
#define KBASE(t) ((t) * KVBLK)
#define MASKT(P0_, P1_, t, SEL0) do { if (Cfg::MOBA) { const int kb_ = KBASE(t); \
        if (qlo - kb_ < 176) bias_tile(P0_, P1_, qm - kb_, bt); \
        if (SEL0 && own >= 4 && kb_ < P0) sel_tile(P0_, P1_, ((mask >> (kb_ >> 8)) & 1) != 0); \
        if (kb_ + KVBLK - 1 > qlo) mask_tile(P0_, P1_, qm - kb_); } } while (0)
#define AINIT(t) ((Cfg::MOBA && own >= 4 && KBASE(t) < P0 && (((mask >> (KBASE(t) >> 8)) & 1) == 0)) ? -__builtin_inff() : cinit - m_reg)
    constexpr int NQL = 8;
#define SEAM_K0() do { VMWN(NQL); SWRITE_HK(0); SBAR(); } while (0)
    f32x16 pA0, pA1, pB0, pB1; float alA, alB; bf16x8 pa0, pa1, pa2, pa3;
    SWRITE_HV(0); SBAR();
    if (NT > 1) { SLOAD_H(Kh, Vh, KBASE(1)); }
    SBAR(); qkt<0>(pA0, pA1, K_lds, r32, hi, qf, cinit);
    __syncthreads();
    if (own >= 4) {
        f32x16 gacc = {};
        const char* kmb[4];
#pragma unroll
        for (int dd = 0; dd < 4; ++dd) kmb[dd] = lds + OFF_KM + KSWZ(r32, (dd * 16 + hi * 8) * 2);
#pragma unroll
        for (int d0 = 0; d0 < 8; ++d0) { const bf16x8 b0 = *reinterpret_cast<const bf16x8*>(kmb[d0 & 3] + (d0 >> 2) * 128); gacc = __builtin_amdgcn_mfma_f32_32x32x16_bf16(b0, *reinterpret_cast<const bf16x8*>(qf + d0 * 1024), gacc, 0, 0, 0); }
        float g[8];
#pragma unroll
        for (int i = 0; i < 4; ++i) { const float mine = gacc[i], oth = __shfl_xor(mine, 32); g[i] = hi ? oth : mine; g[4 + i] = hi ? mine : oth; }
#pragma unroll
        for (int n = 0; n < 7; ++n) { int cnt = 0;
#pragma unroll
            for (int m = 0; m < 7; ++m) cnt += (m != n && m < own && (g[m] > g[n] || (g[m] == g[n] && m < n))) ? 1 : 0;
            mask |= (n < own && cnt < 3) ? (1 << n) : 0; }
    }
    MASKT(pA0, pA1, 0, true); partialSM<true>(pA0, pA1, m_reg, alA);
    if (NT > 1) { VMW(); SWRITE_HK(1); }
    __syncthreads();
#define HALF_STEP(PX0, PX1, alX, PY0, PY1, alY, t, KB, VB, SB) do {                                                      \
        SWRITE_HV(KB); SBAR();                                                                                                \
        if ((t) + 1 < NT) { SLOAD_H(Kh, Vh, KBASE((t) + 1)); SBAR(); }                                               \
        SBAR(); qkt<KB>(PX0, PX1, K_lds, r32, hi, qf, AINIT(t));                                          \
        finishSM(PY0, PY1, alY, l_reg, pa0, pa1, pa2, pa3); SBAR();                                                           \
        pv_tile<VB>(o, vb0, pa0, pa1, pa2, pa3); MASKT(PX0, PX1, (t), false); partialSM<false>(PX0, PX1, m_reg, alX);                                        \
        if ((t) + 1 < NT) { VMW(); SWRITE_HK(SB); }                                                                         \
        RESC(alX); __syncthreads(); } while (0)
    for (int t = 1; t + 1 < NT; t += 2) {
        HALF_STEP(pB0, pB1, alB, pA0, pA1, alA, t, 1, 0, 0);
        HALF_STEP(pA0, pA1, alA, pB0, pB1, alB, t + 1, 0, 1, 1);
    }
    SWRITE_HV(1); SBAR();
    { SBAR(); qkt<1>(pB0, pB1, K_lds, r32, hi, qf, AINIT(NT - 1)); SBAR(); }
    SLOAD_H(Kh, Vh, 0); SBAR();
    bf16x8 tq[8];
    { const bf16* qb = H.Q0 + (size_t)(P0n + wid * QBLK) * Cfg::LDQ; unsigned qoff = (unsigned)(r32 * Cfg::LDQ + hi * 8); asm volatile("" : "+v"(qoff));
#pragma unroll
      for (int d0 = 0; d0 < 8; ++d0) tq[d0] = load8(qb + qoff + d0 * 16); }
    SBAR();
    finishSM(pA0, pA1, alA, l_reg, pa0, pa1, pa2, pa3); SBAR();
    pv_tile<0>(o, vb0, pa0, pa1, pa2, pa3);
    { MASKT(pB0, pB1, NT - 1, false); partialSM<false>(pB0, pB1, m_reg, alB); __syncthreads(); RESC(alB);
      finishSM(pB0, pB1, alB, l_reg, pa0, pa1, pa2, pa3); SBAR(); pv_tile<1>(o, vb0, pa0, pa1, pa2, pa3); }
    SBAR(); SEAM_K0();
    if (hi == 0) li_l[r32] = l_reg; asm volatile("s_waitcnt lgkmcnt(0)" ::: "memory");
    float gnr[4];
    { unsigned go_ = (unsigned)r32; asm volatile("" : "+v"(go_));
#pragma unroll
      for (int d0 = 0; d0 < 4; ++d0) gnr[d0] = Cfg::MOBA ? (gn + go_)[d0 * 32] : 1.0f; }
    bf16* Ow = H.O0 + (size_t)(P0 + wid * QBLK) * Cfg::LDO;
#pragma unroll
    for (int r = 0; r < 16; ++r) { int orow = crow(r, hi); asm volatile("" : "+v"(orow));
        const float rl = __builtin_amdgcn_rcpf(li_l[orow]);
        float v0 = o[0][r] * rl, v1 = o[1][r] * rl, v2 = o[2][r] * rl, v3 = o[3][r] * rl;
        float ss = (v0 * v0 + v1 * v1) + (v2 * v2 + v3 * v3);
        ss += __shfl_xor(ss, 1); ss += __shfl_xor(ss, 2); ss += __shfl_xor(ss, 4); ss += __shfl_xor(ss, 8); ss += __shfl_xor(ss, 16);
        if (Cfg::MOBA) { const float rs = rsqrtf(ss * (1.0f / 128.0f) + 1e-6f); v0 *= rs * gnr[0]; v1 *= rs * gnr[1]; v2 *= rs * gnr[2]; v3 *= rs * gnr[3]; }
        const float n0 = __shfl_xor(v0, 1), n1 = __shfl_xor(v1, 1), n2 = __shfl_xor(v2, 1), n3 = __shfl_xor(v3, 1);
        if ((r32 & 1) == 0) { bf16* op = Ow + (unsigned)(orow * Cfg::LDO + r32);
            *(unsigned*)(op) = cvtpk(v0, n0); *(unsigned*)(op + 32) = cvtpk(v1, n1); *(unsigned*)(op + 64) = cvtpk(v2, n2); *(unsigned*)(op + 96) = cvtpk(v3, n3); } }
    VMW();
#pragma unroll
    for (int d0 = 0; d0 < 8; ++d0) *(bf16x8*)(qf + d0 * 1024) = tq[d0];
    __syncthreads();
#undef RESC
#undef KBASE
#undef MASKT
#undef AINIT
#undef SEAM_K0
#undef HALF_STEP
}
#undef ROW
#undef VMW
#undef VMWN
#undef SLOAD_H
#undef SWRITE_HK
#undef SWRITE_HV
#undef SWRITE_H
#undef KSWZ
#undef SBAR
}

namespace gdn {
typedef short bf16x8 __attribute__((ext_vector_type(8)));
typedef float f32x16 __attribute__((ext_vector_type(16)));
typedef float f32x4 __attribute__((ext_vector_type(4)));
typedef unsigned u32x4 __attribute__((ext_vector_type(4)));
typedef unsigned u32x2 __attribute__((ext_vector_type(2)));
typedef _Float16 f16x4 __attribute__((ext_vector_type(4)));
typedef _Float16 f16x8 __attribute__((ext_vector_type(8)));
#define GLAS __attribute__((address_space(3)))
constexpr int IMG_BYTES = 75776, IMG_W = 0, IMG_U = 16384, IMG_QD = 32768, IMG_KDT = 49152, IMG_QK = 65536, IMG_GL = 73728;
constexpr int IMG_IN_OUT = 1771;
__device__ __forceinline__ int sw256(int row, int cb) { return row * 256 + (cb ^ ((row & 15) << 4)); }
__device__ __forceinline__ int sw128(int row, int cb) { return row * 128 + (cb ^ (((row >> 1) & 7) << 4)); }
__device__ __forceinline__ unsigned cvtpk(float lo, float hi) { unsigned r; asm volatile("v_cvt_pk_bf16_f32 %0, %1, %2" : "=v"(r) : "v"(lo), "v"(hi)); return r; }
__device__ __forceinline__ float bfl(unsigned w) { return __uint_as_float(w << 16); }
__device__ __forceinline__ float bfh(unsigned w) { return __uint_as_float(w & 0xffff0000u); }
__device__ __forceinline__ unsigned char* img_ptr(unsigned char* out_bytes, unsigned char* ws_img, int chunk) {
    return chunk < IMG_IN_OUT ? out_bytes + (size_t)chunk * IMG_BYTES : ws_img + (size_t)(chunk - IMG_IN_OUT) * IMG_BYTES;
}
#define LBAR() asm volatile("s_waitcnt lgkmcnt(0)\n\ts_barrier" ::: "memory")
#define MFMA32(a, b, c) __builtin_amdgcn_mfma_f32_32x32x16_bf16((a), (b), (c), 0, 0, 0)

constexpr int RAWP = 784;
__device__ __forceinline__ void conv16(float (&a)[16], const GLAS unsigned char* rp, const GLAS float* wl) {
    typedef float f32x2 __attribute__((ext_vector_type(2)));
    f32x2 acc[8];
#pragma unroll
    for (int p = 0; p < 8; ++p) acc[p] = (f32x2){0.f, 0.f};
#pragma unroll
    for (int j = 0; j < 4; ++j) { const u32x4 x0 = *(const GLAS u32x4*)(rp + j * RAWP), x1 = *(const GLAS u32x4*)(rp + j * RAWP + 16);
        const GLAS f32x2* wv = (const GLAS f32x2*)(wl + j * 384);
        const unsigned xw[8] = {x0.x, x0.y, x0.z, x0.w, x1.x, x1.y, x1.z, x1.w};
#pragma unroll
        for (int p = 0; p < 8; ++p) { const f32x2 xv = {bfl(xw[p]), bfh(xw[p])}; acc[p] = __builtin_elementwise_fma(wv[p], xv, acc[p]); }
        __builtin_amdgcn_sched_barrier(0); }
#pragma unroll
    for (int p = 0; p < 8; ++p) { a[2 * p] = acc[p].x; a[2 * p + 1] = acc[p].y; }
#pragma unroll
    for (int e = 0; e < 16; ++e) a[e] = a[e] * __builtin_amdgcn_rcpf(1.0f + __expf(-a[e]));
}
__device__ __forceinline__ void raw_load(u32x4 (&rg)[7], const unsigned short* proj, int b, int h, int n, int tid) {
#pragma unroll
    for (int kq = 0; kq < 7; ++kq) { int p = tid + 512 * kq; p = p < 3216 ? p : 3215; const int r = p / 48, q = p - r * 48, pos = n * 64 - 3 + r, posc = pos < 0 ? 0 : pos;
        const u32x4 v = __builtin_nontemporal_load((const u32x4*)(proj + ((size_t)b * 2048 + posc) * 7232 + (q >> 4) * 1024 + h * 128 + (q & 15) * 8));
        rg[kq] = pos < 0 ? (u32x4){0u, 0u, 0u, 0u} : v; }
}
__device__ __forceinline__ void raw_store(const u32x4 (&rg)[7], GLAS unsigned char* raw, int tid) {
#pragma unroll
    for (int kq = 0; kq < 7; ++kq) { const int p = tid + 512 * kq; const int r = p / 48, q = p - r * 48; if (p < 3216) *(GLAS u32x4*)(raw + r * RAWP + q * 16) = rg[kq]; }
}
typedef _Float16 f16x2 __attribute__((ext_vector_type(2)));
template <int I, int K8> __device__ __forceinline__ void inv_k8(float& acc, float& acc1, const float (&tc)[64], const f16x2 (&tn)[32], const GLAS unsigned char* slot) {
    if constexpr (K8 * 8 < I) { const f16x8 av = *(const GLAS f16x8*)(slot + I * 128 + K8 * 16);
#pragma unroll
        for (int p = 0; p < 4; ++p) { const int k = K8 * 8 + 2 * p;
            if (k + 1 < I) { if (p & 1) acc1 = __builtin_amdgcn_fdot2((f16x2){av[2 * p], av[2 * p + 1]}, tn[k >> 1], acc1, false); else acc = __builtin_amdgcn_fdot2((f16x2){av[2 * p], av[2 * p + 1]}, tn[k >> 1], acc, false); }
            else if (k < I) acc1 -= (float)av[2 * p] * tc[k]; }
        inv_k8<I, K8 + 1>(acc, acc1, tc, tn, slot); }
}
template <int I> __device__ __forceinline__ void inv_row(float (&tc)[64], f16x2 (&tn)[32], const GLAS unsigned char* slot, int lane) {
    if constexpr (I < 64) { float acc = (I == lane) ? 1.0f : 0.0f, acc1 = 0.f; inv_k8<I, 0>(acc, acc1, tc, tn, slot); acc += acc1; tc[I] = acc;
        if constexpr (I & 1) tn[I >> 1] = (f16x2){(_Float16)(-tc[I - 1]), (_Float16)(-acc)};
        __builtin_amdgcn_sched_barrier(0);
        inv_row<I + 1>(tc, tn, slot, lane); }
}
__device__ __forceinline__ void prep(GLAS unsigned char* L, int tid, int lane, int wave, int wg, const unsigned short* proj, const float* beta, const float* gg, const float* conv_w,
                                     unsigned char* out_bytes, unsigned char* ws_img, unsigned char* scr) {
    const int r32 = lane & 31, hi = lane >> 5;
    const int bh = wg >> 2, b = bh >> 3, h = bh & 7, cg0 = (wg & 3) * 8;
    GLAS unsigned char* Kt = L; GLAS unsigned char* Qt = L + 16384; GLAS unsigned char* Vt = L + 32768;
    GLAS unsigned char* raw = L;
    GLAS float* Gs = (GLAS float*)(L + 53248); GLAS float* Bs = Gs + 64; GLAS float* gls = Gs + 128; GLAS float* cwL = Gs + 192;
    GLAS float* eRs = Gs + 192 + 1536; GLAS float* bgs = eRs + 64;
    GLAS unsigned char* As = L + 61440;
    for (int i = tid; i < 1536; i += 512) { const int j = i / 384, rem = i - j * 384; cwL[i] = conv_w[j * 3072 + (rem >> 7) * 1024 + h * 128 + (rem & 127)]; }
    u32x4 rg[7];
    raw_load(rg, proj, b, h, cg0, tid);
    float gpf = gg[((size_t)b * 2048 + cg0 * 64 + lane) * 8 + h], bpf = beta[((size_t)b * 2048 + cg0 * 64 + (tid >> 3)) * 8 + h];
    __syncthreads();
#pragma unroll 1
    for (int c = 0; c < 8; ++c) {
        int tt_ = tid; asm volatile("" : "+v"(tt_));
        const int t = tt_ >> 3, seg = tt_ & 7;
        const int n = cg0 + c, chunk = bh * 32 + n, pos = n * 64 + t; const size_t row = (size_t)b * 2048 + pos;
        unsigned char* img = img_ptr(out_bytes, ws_img, chunk);
        unsigned short* vbt = (unsigned short*)(scr + (size_t)chunk * 32768); unsigned short* kgt = vbt + 8192;
        raw_store(rg, raw, tid);
        if (wave == 0) { float g = gpf;
#pragma unroll
            for (int o = 1; o < 64; o <<= 1) { const float y = __shfl_up(g, o); if (lane >= o) g += y; }
            Gs[lane] = g; if (lane == 63) gls[c] = g; }
        if (seg == 0) Bs[t] = bpf;
        LBAR();
        const float G = Gs[t], GL = Gs[63], eG = __expf(G), eR = __expf(GL - G), bt = Bs[t], bg = bt * eG;
        float xq[16], xk[16], xv[16];
        { const GLAS unsigned char* rp = raw + t * RAWP + seg * 32;
          conv16(xq, rp, cwL + seg * 16); conv16(xk, rp + 256, cwL + 128 + seg * 16); conv16(xv, rp + 512, cwL + 256 + seg * 16); }
        { float sq = 0.f, sk = 0.f;
#pragma unroll
          for (int e = 0; e < 16; ++e) { sq += xq[e] * xq[e]; sk += xk[e] * xk[e]; }
          sq += __shfl_xor(sq, 1); sq += __shfl_xor(sq, 2); sq += __shfl_xor(sq, 4); sk += __shfl_xor(sk, 1); sk += __shfl_xor(sk, 2); sk += __shfl_xor(sk, 4);
          const float nq = rsqrtf(sq + 1e-6f) * 0.08838834764831845f, nk = rsqrtf(sk + 1e-6f);
#pragma unroll
          for (int e = 0; e < 16; ++e) { xq[e] *= nq; xk[e] *= nk; xv[e] *= bt; } }
        LBAR();
        { u32x4 w0, w1;
          w0 = (u32x4){cvtpk(xv[0], xv[1]), cvtpk(xv[2], xv[3]), cvtpk(xv[4], xv[5]), cvtpk(xv[6], xv[7])}; w1 = (u32x4){cvtpk(xv[8], xv[9]), cvtpk(xv[10], xv[11]), cvtpk(xv[12], xv[13]), cvtpk(xv[14], xv[15])};
          *(GLAS u32x4*)(Vt + sw256(t, seg * 32)) = w0; *(GLAS u32x4*)(Vt + sw256(t, seg * 32 + 16)) = w1;
          w0 = (u32x4){cvtpk(xk[0], xk[1]), cvtpk(xk[2], xk[3]), cvtpk(xk[4], xk[5]), cvtpk(xk[6], xk[7])}; w1 = (u32x4){cvtpk(xk[8], xk[9]), cvtpk(xk[10], xk[11]), cvtpk(xk[12], xk[13]), cvtpk(xk[14], xk[15])};
          *(GLAS u32x4*)(Kt + sw256(t, seg * 32)) = w0; *(GLAS u32x4*)(Kt + sw256(t, seg * 32 + 16)) = w1;
          w0 = (u32x4){cvtpk(xq[0], xq[1]), cvtpk(xq[2], xq[3]), cvtpk(xq[4], xq[5]), cvtpk(xq[6], xq[7])}; w1 = (u32x4){cvtpk(xq[8], xq[9]), cvtpk(xq[10], xq[11]), cvtpk(xq[12], xq[13]), cvtpk(xq[14], xq[15])};
          *(GLAS u32x4*)(Qt + sw256(t, seg * 32)) = w0; *(GLAS u32x4*)(Qt + sw256(t, seg * 32 + 16)) = w1;
          w0 = (u32x4){cvtpk(xq[0] * eG, xq[1] * eG), cvtpk(xq[2] * eG, xq[3] * eG), cvtpk(xq[4] * eG, xq[5] * eG), cvtpk(xq[6] * eG, xq[7] * eG)};
          w1 = (u32x4){cvtpk(xq[8] * eG, xq[9] * eG), cvtpk(xq[10] * eG, xq[11] * eG), cvtpk(xq[12] * eG, xq[13] * eG), cvtpk(xq[14] * eG, xq[15] * eG)};
          *(u32x4*)(img + IMG_QD + sw256(t, seg * 32)) = w0; *(u32x4*)(img + IMG_QD + sw256(t, seg * 32 + 16)) = w1; }
        if (seg == 0) { eRs[t] = eR; bgs[t] = bg; }
        raw_load(rg, proj, b, h, n < 31 ? n + 1 : n, tid);
        { const int n1 = n < 31 ? n + 1 : n; gpf = gg[((size_t)b * 2048 + n1 * 64 + (tt_ & 63)) * 8 + h]; bpf = beta[((size_t)b * 2048 + n1 * 64 + t) * 8 + h]; }
        LBAR();
        { const int prod = wave >> 2, mj = (wave >> 1) & 1, ni = wave & 1;
          f32x16 acc = {};
          if (!(mj == 1 && ni == 0)) { GLAS unsigned char* Xb = prod ? Qt : Kt;
#pragma unroll
              for (int s = 0; s < 8; ++s) { const bf16x8 a = *(const GLAS bf16x8*)(Kt + sw256(mj * 32 + r32, (16 * s + 8 * hi) * 2)); const bf16x8 bb = *(const GLAS bf16x8*)(Xb + sw256(ni * 32 + r32, (16 * s + 8 * hi) * 2));
                  acc = MFMA32(a, bb, acc); } }
          const int i = ni * 32 + r32; const float Gi = Gs[i], bi = prod ? 1.0f : Bs[i];
#pragma unroll
          for (int g4 = 0; g4 < 4; ++g4) { const int j0 = mj * 32 + 8 * g4 + 4 * hi; float v[4];
#pragma unroll
              for (int e = 0; e < 4; ++e) { const int j = j0 + e; const bool ok = prod ? (j <= i) : (j < i); const float d = ok ? __expf(Gi - Gs[j]) * bi : 0.f; v[e] = ok ? acc[4 * g4 + e] * d : 0.f; }
              if (prod == 0) { f16x4 hv = {(_Float16)v[0], (_Float16)v[1], (_Float16)v[2], (_Float16)v[3]}; *(GLAS f16x4*)(As + c * 8192 + i * 128 + j0 * 2) = hv; }
              else { u32x2 w = {cvtpk(v[0], v[1]), cvtpk(v[2], v[3])}; *(u32x2*)(img + IMG_QK + sw128(i, j0 * 2)) = w; } } }
        { const int ch = tt_ >> 2, tq = tt_ & 3; float kk[16], vk[16];
#pragma unroll
          for (int e = 0; e < 16; ++e) { const int tk = tq * 16 + e; kk[e] = bfl(*(const GLAS unsigned short*)(Kt + sw256(tk, ch * 2))); vk[e] = bfl(*(const GLAS unsigned short*)(Vt + sw256(tk, ch * 2))); }
          unsigned wa[8], wb[8], wc[8];
#pragma unroll
          for (int p = 0; p < 8; ++p) { const int t0 = tq * 16 + 2 * p; wa[p] = cvtpk(kk[2 * p] * eRs[t0], kk[2 * p + 1] * eRs[t0 + 1]); wb[p] = cvtpk(kk[2 * p] * bgs[t0], kk[2 * p + 1] * bgs[t0 + 1]); wc[p] = cvtpk(vk[2 * p], vk[2 * p + 1]); }
          *(u32x4*)(img + IMG_KDT + sw128(ch, tq * 32)) = (u32x4){wa[0], wa[1], wa[2], wa[3]}; *(u32x4*)(img + IMG_KDT + sw128(ch, tq * 32 + 16)) = (u32x4){wa[4], wa[5], wa[6], wa[7]};
          *(u32x4*)(kgt + ch * 64 + tq * 16) = (u32x4){wb[0], wb[1], wb[2], wb[3]}; *(u32x4*)(kgt + ch * 64 + tq * 16 + 8) = (u32x4){wb[4], wb[5], wb[6], wb[7]};
          *(u32x4*)(vbt + ch * 64 + tq * 16) = (u32x4){wc[0], wc[1], wc[2], wc[3]}; *(u32x4*)(vbt + ch * 64 + tq * 16 + 8) = (u32x4){wc[4], wc[5], wc[6], wc[7]}; }
        LBAR();
    }
    GLAS unsigned char* slot = As + wave * 8192;
    int lane2 = lane; asm volatile("" : "+v"(lane2));
    const int r32b = lane2 & 31, hib = lane2 >> 5;
    { float tc[64]; f16x2 tn[32];
      inv_row<0>(tc, tn, slot, lane2);
      asm volatile("s_waitcnt lgkmcnt(0)" ::: "memory");
#pragma unroll
      for (int i = 0; i < 64; ++i) *(GLAS unsigned short*)(slot + sw128(i, lane2 * 2)) = (unsigned short)(cvtpk(tc[i], 0.f) & 0xffffu); }
    asm volatile("s_waitcnt vmcnt(0) lgkmcnt(0)" ::: "memory");
    __syncthreads();
    { const int chunk = bh * 32 + cg0 + wave; unsigned char* img = img_ptr(out_bytes, ws_img, chunk);
      const unsigned short* vbt = (const unsigned short*)(scr + (size_t)chunk * 32768); const unsigned short* kgt = vbt + 8192;
      bf16x8 gf[4][4], gk[4][4];
#pragma unroll
      for (int dvt = 0; dvt < 4; ++dvt)
#pragma unroll
          for (int s = 0; s < 4; ++s) gf[dvt][s] = *(const bf16x8*)(vbt + (dvt * 32 + r32b) * 64 + 16 * s + 8 * hib);
#pragma unroll
      for (int dkt = 0; dkt < 4; ++dkt)
#pragma unroll
          for (int s = 0; s < 4; ++s) gk[dkt][s] = *(const bf16x8*)(kgt + (dkt * 32 + r32b) * 64 + 16 * s + 8 * hib);
#pragma unroll
      for (int tile = 0; tile < 8; ++tile) { const int ti = tile >> 2, dvt = tile & 3; f32x16 acc = {};
#pragma unroll
          for (int s = 0; s < 4; ++s) { if (s < 2 * (ti + 1)) { const bf16x8 a = *(const GLAS bf16x8*)(slot + sw128(ti * 32 + r32b, (16 * s + 8 * hib) * 2)); acc = MFMA32(a, gf[dvt][s], acc); } }
          u32x4 w0 = {pg8::cvt_pk_bf16_acc(acc[0], acc[1]), pg8::cvt_pk_bf16_acc(acc[2], acc[3]), pg8::cvt_pk_bf16_acc(acc[4], acc[5]), pg8::cvt_pk_bf16_acc(acc[6], acc[7])}, w1 = {pg8::cvt_pk_bf16_acc(acc[8], acc[9]), pg8::cvt_pk_bf16_acc(acc[10], acc[11]), pg8::cvt_pk_bf16_acc(acc[12], acc[13]), pg8::cvt_pk_bf16_acc(acc[14], acc[15])};
          *(u32x4*)(img + IMG_U + tile * 2048 + lane2 * 32) = w0; *(u32x4*)(img + IMG_U + tile * 2048 + lane2 * 32 + 16) = w1; }
#pragma unroll
      for (int tile = 0; tile < 8; ++tile) { const int dkt = tile >> 1, ni = tile & 1; f32x16 acc = {};
#pragma unroll
          for (int s = 0; s < 4; ++s) { if (s < 2 * (ni + 1)) { const bf16x8 bb = *(const GLAS bf16x8*)(slot + sw128(ni * 32 + r32b, (16 * s + 8 * hib) * 2)); acc = MFMA32(gk[dkt][s], bb, acc); } }
          { const unsigned a0 = pg8::cvt_pk_bf16_acc(acc[0], acc[1]), a1 = pg8::cvt_pk_bf16_acc(acc[2], acc[3]), b0 = pg8::cvt_pk_bf16_acc(acc[4], acc[5]), b1 = pg8::cvt_pk_bf16_acc(acc[6], acc[7]);
            const auto r0 = __builtin_amdgcn_permlane32_swap(a0, b0, false, false), r1 = __builtin_amdgcn_permlane32_swap(a1, b1, false, false);
            *(u32x4*)(img + IMG_W + ((ni * 8 + 2 * dkt) * 64 + lane2) * 16) = (u32x4){r0[0], r1[0], r0[1], r1[1]}; }
          { const unsigned a0 = pg8::cvt_pk_bf16_acc(acc[8], acc[9]), a1 = pg8::cvt_pk_bf16_acc(acc[10], acc[11]), b0 = pg8::cvt_pk_bf16_acc(acc[12], acc[13]), b1 = pg8::cvt_pk_bf16_acc(acc[14], acc[15]);
            const auto r0 = __builtin_amdgcn_permlane32_swap(a0, b0, false, false), r1 = __builtin_amdgcn_permlane32_swap(a1, b1, false, false);
            *(u32x4*)(img + IMG_W + ((ni * 8 + 2 * dkt + 1) * 64 + lane2) * 16) = (u32x4){r0[0], r1[0], r0[1], r1[1]}; } }
      if (lane2 == 0) *(float*)(img + IMG_GL) = __expf(gls[wave]); }
}

__device__ __forceinline__ void scan(GLAS unsigned char* L, int tid, int lane, int wave, int bh, unsigned char* out_bytes, unsigned char* ws_img, const unsigned short* proj, const float* gn, unsigned short* ob) {
    const int r32 = lane & 31, hi = lane >> 5, b = bh >> 3, h = bh & 7;
    GLAS unsigned char* ST = L + 75776; GLAS unsigned char* VNT = L + 108544; GLAS float* RED = (GLAS float*)(L + 124928); GLAS float* OT = (GLAS float*)L;
    const int ti = wave >> 2, dvt = wave & 3, dk0t = 2 * (wave >> 2);
    f32x16 s0 = {}, s1 = {};
    for (int i = tid; i < 2048; i += 512) ((GLAS u32x4*)ST)[i] = (u32x4){0u, 0u, 0u, 0u};
    const int tok = tid & 63, part = wave;
    float gnr[16];
#pragma unroll
    for (int e = 0; e < 16; ++e) gnr[e] = gn[part * 16 + e];
    u32x4 pf[10];
    { const u32x4* img0 = (const u32x4*)img_ptr(out_bytes, ws_img, bh * 32);
#pragma unroll
      for (int i = 0; i < 10; ++i) { const int p = tid + 512 * i; pf[i] = img0[p < 4624 ? p : 4623]; } }
#pragma unroll 1
    for (int n = 0; n < 32; ++n) {
#pragma unroll
        for (int i = 0; i < 10; ++i) { const int p = tid + 512 * i; if (p < 4624) ((GLAS u32x4*)L)[p] = pf[i]; }
        LBAR();
        { const u32x4* imgn = (const u32x4*)img_ptr(out_bytes, ws_img, bh * 32 + (n < 31 ? n + 1 : n));
#pragma unroll
          for (int i = 0; i < 10; ++i) { const int p = tid + 512 * i; pf[i] = imgn[p < 4624 ? p : 4623]; } }
        const size_t row = (size_t)b * 2048 + n * 64 + tok;
        const unsigned short* zp = proj + row * 7232 + 3072 + h * 128 + part * 16; const u32x4 z0 = *(const u32x4*)zp, z1 = *(const u32x4*)(zp + 8);
        { f32x16 acc = {};
#pragma unroll
          for (int s = 0; s < 8; ++s) { const bf16x8 a = *(const GLAS bf16x8*)(L + IMG_W + ((ti * 8 + s) * 64 + lane) * 16); const bf16x8 bb = *(const GLAS bf16x8*)(ST + sw256(dvt * 32 + r32, (16 * s + 8 * hi) * 2)); acc = MFMA32(a, bb, acc); }
          const u32x4 u0 = *(const GLAS u32x4*)(L + IMG_U + wave * 2048 + lane * 32), u1 = *(const GLAS u32x4*)(L + IMG_U + wave * 2048 + lane * 32 + 16);
          const unsigned uw[8] = {u0.x, u0.y, u0.z, u0.w, u1.x, u1.y, u1.z, u1.w};
#pragma unroll
          for (int g4 = 0; g4 < 4; ++g4) { const float v0 = bfl(uw[2 * g4]) - acc[4 * g4], v1 = bfh(uw[2 * g4]) - acc[4 * g4 + 1], v2 = bfl(uw[2 * g4 + 1]) - acc[4 * g4 + 2], v3 = bfh(uw[2 * g4 + 1]) - acc[4 * g4 + 3];
              u32x2 w = {cvtpk(v0, v1), cvtpk(v2, v3)}; *(GLAS u32x2*)(VNT + sw128(dvt * 32 + r32, (ti * 32 + 8 * g4 + 4 * hi) * 2)) = w; } }
        LBAR();
        { f32x16 acc = {};
#pragma unroll
          for (int s = 0; s < 8; ++s) { const bf16x8 a = *(const GLAS bf16x8*)(L + IMG_QD + sw256(ti * 32 + r32, (16 * s + 8 * hi) * 2)); const bf16x8 bb = *(const GLAS bf16x8*)(ST + sw256(dvt * 32 + r32, (16 * s + 8 * hi) * 2)); acc = MFMA32(a, bb, acc); }
#pragma unroll
          for (int s = 0; s < 4; ++s) { if (s < 2 * (ti + 1)) { const bf16x8 a = *(const GLAS bf16x8*)(L + IMG_QK + sw128(ti * 32 + r32, (16 * s + 8 * hi) * 2)); const bf16x8 bb = *(const GLAS bf16x8*)(VNT + sw128(dvt * 32 + r32, (16 * s + 8 * hi) * 2)); acc = MFMA32(a, bb, acc); } }
#pragma unroll
          for (int g4 = 0; g4 < 4; ++g4) { const f32x4 w = {acc[4 * g4], acc[4 * g4 + 1], acc[4 * g4 + 2], acc[4 * g4 + 3]}; const int dv = dvt * 32 + r32, chk = ti * 8 + 2 * g4 + hi;
              *(GLAS f32x4*)(OT + dv * 64 + ((chk ^ (dv & 15)) << 2)) = w; } }
        LBAR();
        float ov[16]; float ss = 0.f;
#pragma unroll
        for (int e = 0; e < 16; ++e) { const int dv = part * 16 + e; ov[e] = OT[dv * 64 + ((((tok >> 2) ^ (dv & 15)) << 2) | (tok & 3))]; ss += ov[e] * ov[e]; }
        RED[part * 64 + tok] = ss;
        { const float gl = *(const GLAS float*)(L + IMG_GL);
          s0 = s0 * gl; s1 = s1 * gl;
#pragma unroll
          for (int s = 0; s < 4; ++s) { const bf16x8 bb = *(const GLAS bf16x8*)(VNT + sw128(dvt * 32 + r32, (16 * s + 8 * hi) * 2));
              const bf16x8 a0 = *(const GLAS bf16x8*)(L + IMG_KDT + sw128(dk0t * 32 + r32, (16 * s + 8 * hi) * 2)), a1 = *(const GLAS bf16x8*)(L + IMG_KDT + sw128(dk0t * 32 + 32 + r32, (16 * s + 8 * hi) * 2));
              s0 = MFMA32(a0, bb, s0); s1 = MFMA32(a1, bb, s1); }
#pragma unroll
          for (int g4 = 0; g4 < 4; ++g4) { u32x2 w = {pg8::cvt_pk_bf16_acc(s0[4 * g4], s0[4 * g4 + 1]), pg8::cvt_pk_bf16_acc(s0[4 * g4 + 2], s0[4 * g4 + 3])}; *(GLAS u32x2*)(ST + sw256(dvt * 32 + r32, (dk0t * 32 + 8 * g4 + 4 * hi) * 2)) = w;
              u32x2 w2 = {pg8::cvt_pk_bf16_acc(s1[4 * g4], s1[4 * g4 + 1]), pg8::cvt_pk_bf16_acc(s1[4 * g4 + 2], s1[4 * g4 + 3])}; *(GLAS u32x2*)(ST + sw256(dvt * 32 + r32, (dk0t * 32 + 32 + 8 * g4 + 4 * hi) * 2)) = w2; } }
        LBAR();
        { float tot = 0.f;
#pragma unroll
          for (int p = 0; p < 8; ++p) tot += RED[p * 64 + tok];
          const float rs = rsqrtf(tot * (1.0f / 128.0f) + 1e-6f);
          const unsigned zw[8] = {z0.x, z0.y, z0.z, z0.w, z1.x, z1.y, z1.z, z1.w}; unsigned res[8];
#pragma unroll
          for (int k = 0; k < 8; ++k) res[k] = cvtpk(ov[2 * k] * rs * gnr[2 * k] * bfl(zw[k]), ov[2 * k + 1] * rs * gnr[2 * k + 1] * bfh(zw[k]));
          unsigned short* op = ob + row * 2048 + h * 128 + part * 16;
          *(u32x4*)op = (u32x4){res[0], res[1], res[2], res[3]}; *(u32x4*)(op + 8) = (u32x4){res[4], res[5], res[6], res[7]}; }
    }
}
#undef MFMA32
#undef LBAR
#undef GLAS
}

constexpr int NB = 8, SEQ = 2048, DM = 2048, MTOK = NB * SEQ;
constexpr int HD = 128, NPROJ = 7168, PROJ_LD = 7232;
constexpr int DFF = 5632, MEMLEN = 256, MROWS = NB * MEMLEN, XW = 512;
constexpr float EPS = 1e-6f;
constexpr int NWAVES = 8, NTHREADS = 512;
constexpr int LDS_BYTES = 147456;
constexpr int LDS_MISC = 147200;
constexpr int CW_BAR = 4096;

constexpr size_t MiB = 1u << 20;
constexpr size_t WS_RSQ2 = 768 * 1024, WS_RSQ3 = 832 * 1024, WS_RSQ4 = 896 * 1024;
constexpr size_t WS_KMEAN = 512 * 1024;
constexpr size_t WS_WGU = 1 * MiB, WS_WDOWN = 23 * MiB, WS_X2Q = 34 * MiB, WS_SMALL = 67 * MiB, WS_XB = 70 * MiB;
constexpr float WGU_SCALE = 32.0f, WDOWN_SCALE = 64.0f;
constexpr size_t WS_GATE = 134 * MiB;
constexpr size_t WS_WINB = 142 * MiB;
constexpr size_t WS_WIN = 134 * MiB, WS_PROJ = 162 * MiB, WS_O = 388 * MiB;
constexpr size_t WS_QX = 162 * MiB, WS_OX = 178 * MiB, WS_KVX = 194 * MiB;
constexpr size_t WS_WXQ = 486 * MiB, WS_WXKV = 488 * MiB, WS_WXO = 492 * MiB, WS_WOUT = 494 * MiB, WS_MEMB = 502 * MiB, WS_END = 510 * MiB;
constexpr size_t SM_RSTD1 = 0, SM_RSTD2 = 65536, SM_RSTD3 = 131072, SM_RSTDM = 196608, SM_W16 = 262144, SM_KMEAN = 327680, SM_BETA = 1 * MiB, SM_G = 1 * MiB + 524288;

#define LAS __attribute__((address_space(3)))
typedef unsigned short bf16_t;
typedef float f32x4 __attribute__((ext_vector_type(4)));
typedef unsigned u32x4 __attribute__((ext_vector_type(4)));
typedef unsigned u32x2 __attribute__((ext_vector_type(2)));

__device__ __forceinline__ float bf2f(unsigned v) { return __uint_as_float(v << 16); }
__device__ __forceinline__ unsigned f2bf(float f) { unsigned u = __float_as_uint(f); return (u + 0x7fffu + ((u >> 16) & 1u)) >> 16; }
__device__ __forceinline__ unsigned pk2(float lo, float hi) { return f2bf(lo) | (f2bf(hi) << 16); }
__device__ __forceinline__ float wave_sum(float v) {
#pragma unroll
    for (int o = 1; o < 64; o <<= 1) v += __shfl_xor(v, o);
    return v;
}
__device__ __forceinline__ float silu_acc(float v) { return v * __builtin_amdgcn_rcpf(1.0f + __expf(-v)); }

#define XB_TMO      128
#define XB_XCNT(j)  (256  + 64 * (j))
#define XB_XSUB(j)  (1280 + 64 * (j))
#define XB_XGEN(j)  (2304 + 64 * (j))
#define XB_TOP      3328
#define XB_TOPGEN   3392
#define XCD_BAR_WORDS 3456
#define XB_SPIN_CAP (1u << 18)

__device__ __forceinline__ unsigned xb_ld(unsigned* p)              { return __hip_atomic_load(p, __ATOMIC_RELAXED, __HIP_MEMORY_SCOPE_AGENT); }
__device__ __forceinline__ unsigned xb_add(unsigned* p, unsigned v) { return __hip_atomic_fetch_add(p, v, __ATOMIC_RELAXED, __HIP_MEMORY_SCOPE_AGENT); }
__device__ __forceinline__ unsigned xb_xcc_id() { return (unsigned)__builtin_amdgcn_s_getreg((3 << 11) | 20) & 0xFu; }
#define XB_SPIN(cond, bar) do { unsigned _sp = 0; while (cond) { __builtin_amdgcn_s_sleep(1); \
    if ((++_sp & 255u) == 0u) { if (xb_ld(&(bar)[XB_TMO])) break; if (_sp > XB_SPIN_CAP) { atomicAdd(&(bar)[XB_TMO], 1u); break; } } } } while (0)

struct XcdBarrier {
    unsigned* bar; unsigned x;
    volatile LAS unsigned* st;
};

__device__ __forceinline__ XcdBarrier xcd_barrier_post(unsigned* bar, volatile LAS unsigned* st, int tid) {
    XcdBarrier b; b.bar = bar; b.x = xb_xcc_id(); b.st = st;
    if (tid == 0) (void)xb_add(&bar[XB_XCNT(b.x)], 1u);
    return b;
}
__device__ __forceinline__ void xcd_barrier_complete(unsigned* bar, unsigned x, unsigned& nloc, unsigned& nx) {
    const unsigned G = gridDim.x * gridDim.y * gridDim.z;
    unsigned sum, cnt, mine, sp = 0u;
    for (;;) {
        sum = 0u; cnt = 0u; mine = 0u;
#pragma unroll
        for (unsigned j = 0; j < 16; ++j) { const unsigned c = xb_ld(&bar[XB_XCNT(j)]); sum += c; cnt += (c > 0u) ? 1u : 0u; mine = (j == x) ? c : mine; }
        if (sum == G) break;
        __builtin_amdgcn_s_sleep(1);
        if ((++sp & 255u) == 0u) { if (xb_ld(&bar[XB_TMO])) break; if (sp > XB_SPIN_CAP) { atomicAdd(&bar[XB_TMO], 1u); break; } }
    }
    nloc = mine > 0u ? mine : 1u; nx = cnt > 0u ? cnt : 1u;
}

__device__ __forceinline__ void xcd_barrier(const XcdBarrier& b, int tid) {
    asm volatile("s_waitcnt vmcnt(0)" ::: "memory");
    __syncthreads();
    if (tid == 0) {
        unsigned* bar = b.bar;
        __builtin_amdgcn_s_waitcnt(0);
        unsigned nloc = b.st[0], nx = b.st[1];
        if (nloc == 0u) { xcd_barrier_complete(bar, b.x, nloc, nx); b.st[0] = nloc; b.st[1] = nx; }
        const unsigned seq = b.st[2]; b.st[2] = seq + 1u;
        const unsigned old = xb_add(&bar[XB_XSUB(b.x)], 1u);
        const unsigned gen = old / nloc;
        if (old + 1u == (gen + 1u) * nloc) {
            __builtin_amdgcn_fence(__ATOMIC_RELEASE, "agent");
            asm volatile("s_waitcnt vmcnt(0)" ::: "memory");
            const unsigned og = xb_add(&bar[XB_TOP], 1u);
            const unsigned tg = og / nx;
            if (og + 1u == (tg + 1u) * nx) xb_add(&bar[XB_TOPGEN], 1u);
        }
        XB_SPIN(xb_ld(&bar[XB_TOPGEN]) <= seq, bar);
        __builtin_amdgcn_fence(__ATOMIC_ACQUIRE, "agent");
        asm volatile("s_waitcnt vmcnt(0)" ::: "memory");
    }
    __syncthreads();
}


struct Args { const float* in[23]; float* out; unsigned char* ws; int ph_lo, ph_hi; };
#define ARGP(A, k) ((A).in[k])
#define TABP(F, k) ((const float*)(((const __attribute__((address_space(1))) float* const*)((F).ws + 256))[k]))
struct Frame {
    LAS unsigned char* lds;
    int tid, lane, wave, G, bid;
    float* out; unsigned char* ws;
};

__device__ __forceinline__ void transpose_item(const float* W, int ldw, int col0, int K, const float* gain, bf16_t* WT, int row_off, int nblk, LAS float* scr, int item, int lane) {
    const int kb = item / nblk, nb = item % nblk, k0 = 64 * kb, n0 = 64 * nb;
    const float* src = W + (size_t)(k0 + (lane >> 4)) * ldw + col0 + n0 + (lane & 15) * 4;
    f32x4 v[16];
#pragma unroll
    for (int i = 0; i < 16; ++i) v[i] = __builtin_nontemporal_load((const f32x4*)(src + (size_t)(4 * i) * ldw));
#pragma unroll
    for (int i = 0; i < 16; ++i) { const int kk = 4 * i + (lane >> 4); const float g = gain ? gain[k0 + kk] : 1.0f; LAS float* d = scr + kk * 65 + (lane & 15) * 4;
        d[0] = v[i].x * g; d[1] = v[i].y * g; d[2] = v[i].z * g; d[3] = v[i].w * g; }
    asm volatile("s_waitcnt lgkmcnt(0)" ::: "memory");
    const int c = lane & 7;
#pragma unroll
    for (int j = 0; j < 8; ++j) { const int n = (lane >> 3) + 8 * j; const LAS float* s = scr + (8 * c) * 65 + n;
        u32x4 o; o.x = pk2(s[0 * 65], s[1 * 65]); o.y = pk2(s[2 * 65], s[3 * 65]); o.z = pk2(s[4 * 65], s[5 * 65]); o.w = pk2(s[6 * 65], s[7 * 65]);
        *(u32x4*)(WT + (size_t)(row_off + n0 + n) * K + k0 + 8 * c) = o; }
    asm volatile("s_waitcnt lgkmcnt(0)" ::: "memory");
}
__device__ __forceinline__ void transpose_item8(const float* W, int ldw, int col0, int K, const float* gain, float scale, unsigned char* WT8, int row_off, int nblk, LAS float* scr, int item, int lane) {
    const int kb = item / nblk, nb = item % nblk, k0 = 64 * kb, n0 = 64 * nb;
    const float* src = W + (size_t)(k0 + (lane >> 4)) * ldw + col0 + n0 + (lane & 15) * 4;
    f32x4 v[16];
#pragma unroll
    for (int i = 0; i < 16; ++i) v[i] = __builtin_nontemporal_load((const f32x4*)(src + (size_t)(4 * i) * ldw));
#pragma unroll
    for (int i = 0; i < 16; ++i) { const int kk = 4 * i + (lane >> 4); const float g = (gain ? gain[k0 + kk] : 1.0f) * scale; LAS float* d = scr + kk * 65 + (lane & 15) * 4;
        d[0] = v[i].x * g; d[1] = v[i].y * g; d[2] = v[i].z * g; d[3] = v[i].w * g; }
    asm volatile("s_waitcnt lgkmcnt(0)" ::: "memory");
    const int c = lane & 7;
#pragma unroll
    for (int j = 0; j < 8; ++j) { const int n = (lane >> 3) + 8 * j; const LAS float* s = scr + (8 * c) * 65 + n;
        int w0 = __builtin_amdgcn_cvt_pk_fp8_f32(s[0 * 65], s[1 * 65], 0, false); w0 = __builtin_amdgcn_cvt_pk_fp8_f32(s[2 * 65], s[3 * 65], w0, true);
        int w1 = __builtin_amdgcn_cvt_pk_fp8_f32(s[4 * 65], s[5 * 65], 0, false); w1 = __builtin_amdgcn_cvt_pk_fp8_f32(s[6 * 65], s[7 * 65], w1, true);
        *(u32x2*)(WT8 + (size_t)(row_off + n0 + n) * K + k0 + 8 * c) = (u32x2){(unsigned)w0, (unsigned)w1}; }
    asm volatile("s_waitcnt lgkmcnt(0)" ::: "memory");
}
__device__ __forceinline__ void row_to_bf16(const float* xrow, bf16_t* orow, float* rstd_out, int lane, unsigned char* q8row = nullptr) {
    const f32x4* xr = (const f32x4*)xrow + lane;
    f32x4 v[8]; float s = 0.f;
#pragma unroll
    for (int j = 0; j < 8; ++j) { v[j] = __builtin_nontemporal_load(xr + 64 * j); s += (v[j].x * v[j].x + v[j].y * v[j].y) + (v[j].z * v[j].z + v[j].w * v[j].w); }
    s = wave_sum(s);
    if (lane == 0) *rstd_out = rsqrtf(s * (1.0f / DM) + EPS);
    u32x2* o8 = (u32x2*)orow + lane;
#pragma unroll
    for (int j = 0; j < 8; ++j) { u32x2 w; w.x = pk2(v[j].x, v[j].y); w.y = pk2(v[j].z, v[j].w); o8[64 * j] = w; }
    if (q8row) { unsigned* q4 = (unsigned*)q8row + lane;
#pragma unroll
        for (int j = 0; j < 8; ++j) { int q = __builtin_amdgcn_cvt_pk_fp8_f32(v[j].x, v[j].y, 0, false); q = __builtin_amdgcn_cvt_pk_fp8_f32(v[j].z, v[j].w, q, true); q4[64 * j] = (unsigned)q; } }
}
__device__ __forceinline__ void phase_prologue(const Frame& F, const Args& A) {
    if (F.bid == 0 && F.tid < 23) ((const float**)(F.ws + 256))[F.tid] = A.in[F.tid];
    LAS float* scr = (LAS float*)(F.lds + F.wave * 17408);
    const int gw = F.bid * NWAVES + F.wave, NGW = F.G * NWAVES;
    bf16_t* Win_t = (bf16_t*)(F.ws + WS_WIN); bf16_t* Wout_t = (bf16_t*)(F.ws + WS_WOUT); bf16_t* Wxq_t = (bf16_t*)(F.ws + WS_WXQ); bf16_t* Wxkv_t = (bf16_t*)(F.ws + WS_WXKV);
    bf16_t* Wxo_t = (bf16_t*)(F.ws + WS_WXO); bf16_t* Wgu_t = (bf16_t*)(F.ws + WS_WGU); bf16_t* Wdown_t = (bf16_t*)(F.ws + WS_WDOWN);
    constexpr int I_INA = 32 * 64, I_INB = 32 * 48, I_OUT = 32 * 32, I_XQ = 32 * 8, I_XKV = 32 * 16, I_XO = 8 * 32, I_G = 32 * 88, I_D = 88 * 32;
    constexpr int NITEMS = I_INA + I_INB + I_OUT + I_XQ + I_XKV + I_XO;
    for (int it = gw; it < NITEMS; it += NGW) {
        int r = it;
        if (r < I_INA) { transpose_item8(ARGP(A, 3), 7184, 0, DM, ARGP(A, 2), WGU_SCALE, (unsigned char*)Win_t, 0, 64, scr, r, F.lane); continue; } r -= I_INA;
        if (r < I_INB) { transpose_item(ARGP(A, 3), 7184, 4112, DM, ARGP(A, 2), (bf16_t*)(F.ws + WS_WINB), 0, 48, scr, r, F.lane); continue; } r -= I_INB;
        if (r < I_OUT) { transpose_item(ARGP(A, 10), DM, 0, DM, nullptr, Wout_t, 0, 32, scr, r, F.lane); continue; } r -= I_OUT;
        if (r < I_XQ) { transpose_item(ARGP(A, 13), XW, 0, DM, ARGP(A, 11), Wxq_t, 0, 8, scr, r, F.lane); continue; } r -= I_XQ;
        if (r < I_XKV) { transpose_item(ARGP(A, 14), 2 * XW, 0, DM, ARGP(A, 12), Wxkv_t, 0, 16, scr, r, F.lane); continue; } r -= I_XKV;
        transpose_item(ARGP(A, 15), DM, 0, XW, nullptr, Wxo_t, 0, 32, scr, r, F.lane);
    }
    { bf16_t* W16 = (bf16_t*)(F.ws + WS_SMALL + SM_W16);
      for (int i = F.bid * NTHREADS + F.tid; i < 16 * DM; i += F.G * NTHREADS) { const int j = i >> 11, k = i & 2047; W16[i] = (bf16_t)f2bf(ARGP(A, 3)[(size_t)k * 7184 + 4096 + j] * ARGP(A, 2)[k]); } }
    { bf16_t* xb = (bf16_t*)(F.ws + WS_XB); float* rstd1 = (float*)(F.ws + WS_SMALL + SM_RSTD1);
      for (int m = gw; m < MTOK; m += NGW) row_to_bf16(ARGP(A, 0) + (size_t)m * DM, xb + (size_t)m * DM, rstd1 + m, F.lane, F.ws + WS_X2Q + (size_t)m * DM);
      bf16_t* memb = (bf16_t*)(F.ws + WS_MEMB); float* rstdm = (float*)(F.ws + WS_SMALL + SM_RSTDM);
      for (int m = gw; m < MROWS; m += NGW) row_to_bf16(ARGP(A, 1) + (size_t)m * DM, memb + (size_t)m * DM, rstdm + m, F.lane); }
}
__device__ __forceinline__ void phase_ffn_weights(const Frame& F, int iw, int nwg) {
    LAS float* scr = (LAS float*)(F.lds + F.wave * 17408);
    unsigned char* Wgu8 = F.ws + WS_WGU; unsigned char* Wdown8 = F.ws + WS_WDOWN;
    constexpr int I_G = 32 * 88, I_D = 88 * 32;
    for (int it = iw * NWAVES + F.wave; it < 2 * I_G + I_D; it += nwg * NWAVES) {
        int r = it;
        if (r < I_G) { const int c0 = 64 * (r % 88); transpose_item8(TABP(F, 17), DFF, 0, DM, TABP(F, 16), WGU_SCALE, Wgu8, ((c0 >> 7) << 8) + (c0 & 127) - c0, 88, scr, r, F.lane); continue; } r -= I_G;
        if (r < I_G) { const int c0 = 64 * (r % 88); transpose_item8(TABP(F, 18), DFF, 0, DM, TABP(F, 16), WGU_SCALE, Wgu8, ((c0 >> 7) << 8) + (c0 & 127) - c0 + 128, 88, scr, r, F.lane); continue; } r -= I_G;
        transpose_item8(TABP(F, 21), DM, 0, DFF, nullptr, WDOWN_SCALE, Wdown8, 0, 32, scr, r, F.lane);
    }
}
__device__ __forceinline__ void phase_final_norm(const Frame& F, const Args& A) {
    const int gw = F.bid * NWAVES + F.wave, NGW = F.G * NWAVES; const f32x4* g4 = (const f32x4*)TABP(F, 22) + 2 * F.lane;
    const bf16_t* xb = (const bf16_t*)(F.ws + WS_XB); const float* rsq = (const float*)(F.ws + WS_RSQ4);
    for (int m = gw; m < MTOK; m += NGW) {
        const float r = rsqrtf(rsq[m] * (1.0f / DM) + EPS);
        const u32x4* xr = (const u32x4*)(xb + (size_t)m * DM) + F.lane; f32x4* orow = (f32x4*)(F.out + (size_t)m * DM) + 2 * F.lane;
#pragma unroll
        for (int j = 0; j < 4; ++j) { const u32x4 h = __builtin_nontemporal_load(xr + 64 * j);
            const f32x4 a = {bf2f(h.x & 0xffffu), bf2f(h.x >> 16), bf2f(h.y & 0xffffu), bf2f(h.y >> 16)}, b = {bf2f(h.z & 0xffffu), bf2f(h.z >> 16), bf2f(h.w & 0xffffu), bf2f(h.w >> 16)};
            orow[128 * j] = a * r * g4[128 * j]; orow[128 * j + 1] = b * r * g4[128 * j + 1]; }
    }
}
typedef short mk_bf16x8 __attribute__((ext_vector_type(8)));
__device__ __forceinline__ void ba_item(const Frame& F, int item, int khalf) {
    const int lane = F.lane, r = lane & 15, q = lane >> 4, row0 = item * 16;
    const bf16_t* xa = (const bf16_t*)(F.ws + WS_XB) + (size_t)(row0 + r) * DM + khalf * 1024 + q * 8; const bf16_t* wb = (const bf16_t*)(F.ws + WS_SMALL + SM_W16) + (size_t)r * DM + khalf * 1024 + q * 8;
    f32x4 acc = {0.f, 0.f, 0.f, 0.f};
#pragma unroll 16
    for (int s = 0; s < 32; ++s) { const mk_bf16x8 a = *(const mk_bf16x8*)(xa + 32 * s), b = *(const mk_bf16x8*)(wb + 32 * s); acc = __builtin_amdgcn_mfma_f32_16x16x32_bf16(a, b, acc, 0, 0, 0); }
    LAS f32x4* xch = (LAS f32x4*)F.lds + (F.wave & 3) * 64 + lane;
    if (khalf) *xch = acc;
    __syncthreads();
    if (khalf) return;
    acc += *xch;
    const float* rstd1 = (const float*)(F.ws + WS_SMALL + SM_RSTD1); float* beta = (float*)(F.ws + WS_SMALL + SM_BETA); float* gg = (float*)(F.ws + WS_SMALL + SM_G);
    const int c = lane & 15, h = c & 7; const float alog = TABP(F, 5)[h], dtb = TABP(F, 6)[h];
#pragma unroll
    for (int i = 0; i < 4; ++i) { const int row = row0 + 4 * q + i; const float y = acc[i] * rstd1[row];
        if (c < 8) beta[(size_t)row * 8 + h] = 1.0f / (1.0f + expf(-y));
        else { const float z = y + dtb; const float sp = z > 20.f ? z : log1pf(expf(z)); gg[(size_t)row * 8 + h] = -expf(alog) * sp; } }
}
__device__ __forceinline__ void phase_moba(const Frame& F, const Args& A, char* lds, int cu) {
    const int grp = cu >> 6, bh = cu & 63, b = bh >> 3, h = bh & 7;
    const unsigned list = grp == 0 ? 0x37u : (grp == 1 ? 0x46u : 0x0125u); const int cnt = grp == 2 ? 4 : 2;
    moba::Head H; H.Q0 = (const bf16_t*)(F.ws + WS_PROJ) + (size_t)(b * SEQ) * PROJ_LD + 4096 + h * 128; H.K0 = H.Q0 + 1024; H.V0 = H.Q0 + 2048; H.O0 = (bf16_t*)(F.ws + WS_O) + (size_t)(b * SEQ) * DM + 1024 + h * 128;
    H.km = (const float*)(F.ws + WS_KMEAN) + (size_t)(b * 8) * 1024 + h * 128;
    moba::Seam S; int P0 = (int)(list & 15u) * 256;
    moba::prime<moba::CfgMoba>(H, P0, lds, S, F.tid, F.wave);
    for (int i = 0; i < cnt; ++i) { const int P0n = (i + 1 < cnt) ? (int)((list >> (4 * (i + 1))) & 15u) * 256 : P0; moba::block<moba::CfgMoba>(H, P0, P0n, TABP(F, 9), h, TABP(F, 8), lds, S, F.tid, F.wave); P0 = P0n; }
}
__device__ __forceinline__ void phase_xattn(const Frame& F, char* lds, int item) {
    const int qb = item & 7, h = (item >> 3) & 3, b = item >> 5;
    moba::Head H; H.Q0 = (const bf16_t*)(F.ws + WS_QX) + (size_t)(b * SEQ) * XW + h * 128; H.K0 = (const bf16_t*)(F.ws + WS_KVX) + (size_t)(b * MEMLEN) * (2 * XW) + h * 128; H.V0 = H.K0 + XW;
    H.O0 = (bf16_t*)(F.ws + WS_OX) + (size_t)(b * SEQ) * XW + h * 128; H.km = nullptr;
    moba::Seam S; const int P0 = qb * 256;
    moba::prime<moba::CfgX>(H, P0, lds, S, F.tid, F.wave);
    moba::block<moba::CfgX>(H, P0, P0, nullptr, h, nullptr, lds, S, F.tid, F.wave);
}
static_assert(moba::LDS_BYTES <= LDS_MISC && LDS_MISC + 128 <= LDS_BYTES, "LDS map");

__device__ __forceinline__ void ffn_fixup(const Frame& F, int pm) {
    const bf16_t* halo = (const bf16_t*)(F.ws + WS_GATE); const float* cw = TABP(F, 19); const float* cb = TABP(F, 20); unsigned char* H8 = (unsigned char*)F.out;
    u32x4 a2[3], a1[3], a0[3], au[3];
#pragma unroll
    for (int k = 0; k < 3; ++k) { int idx = F.tid + k * NTHREADS; idx = idx < 2 * 704 ? idx : 2 * 704 - 1; const int R = idx / 704, c = (idx - R * 704) * 8;
        const bf16_t* hp = halo + (size_t)(pm - 1) * 6 * 5632 + c; const bf16_t* hc = halo + (size_t)pm * 6 * 5632 + c;
        a2[k] = *(const u32x4*)(hp + (R == 0 ? 0 : 1) * 5632); a1[k] = *(const u32x4*)(R == 0 ? hp + 5632 : hc + 2 * 5632); a0[k] = *(const u32x4*)(hc + (2 + R) * 5632); au[k] = *(const u32x4*)(hc + (4 + R) * 5632); }
#pragma unroll
    for (int k = 0; k < 3; ++k) { const int idx = F.tid + k * NTHREADS; if (idx >= 2 * 704) break; const int R = idx / 704, c = (idx - R * 704) * 8;
        const unsigned v2[4] = {a2[k].x, a2[k].y, a2[k].z, a2[k].w}, v1[4] = {a1[k].x, a1[k].y, a1[k].z, a1[k].w}, v0[4] = {a0[k].x, a0[k].y, a0[k].z, a0[k].w}, vu[4] = {au[k].x, au[k].y, au[k].z, au[k].w}; float hv[8];
#pragma unroll
        for (int e = 0; e < 8; ++e) { const unsigned sh = (e & 1) ? 16u : 0u; const int kq = e >> 1, chn = c + e;
            const float x2 = bf2f((v2[kq] >> sh) & 0xffffu), x1 = bf2f((v1[kq] >> sh) & 0xffffu), gc = bf2f((v0[kq] >> sh) & 0xffffu), uu = bf2f((vu[kq] >> sh) & 0xffffu);
            const float y = cw[chn] * x2 + cw[DFF + chn] * x1 + cw[2 * DFF + chn] * gc + cb[chn]; hv[e] = y * __builtin_amdgcn_rcpf(1.0f + __expf(-y)) * uu; }
        int q0 = __builtin_amdgcn_cvt_pk_fp8_f32(hv[0], hv[1], 0, false); q0 = __builtin_amdgcn_cvt_pk_fp8_f32(hv[2], hv[3], q0, true);
        int q1 = __builtin_amdgcn_cvt_pk_fp8_f32(hv[4], hv[5], 0, false); q1 = __builtin_amdgcn_cvt_pk_fp8_f32(hv[6], hv[7], q1, true);
        *(u32x2*)(H8 + (size_t)(pm * 256 + R) * DFF + c) = (u32x2){(unsigned)q0, (unsigned)q1}; }
}
constexpr int N_PHASES = 14;

__global__ void __launch_bounds__(NTHREADS, 2) mk_fwd(Args args) {
    const Args& A = args;
    extern __shared__ __attribute__((aligned(16))) unsigned char lds_raw[];
    Frame F;
    F.lds = (LAS unsigned char*)lds_raw;
    F.wave = __builtin_amdgcn_readfirstlane((int)threadIdx.x >> 6); F.lane = 0; F.tid = 0;
#define FRESH_IDS() do { int l_; asm volatile("v_mbcnt_lo_u32_b32 %0, -1, 0\n\tv_mbcnt_hi_u32_b32 %0, -1, %0" : "=v"(l_)); F.lane = l_; F.tid = F.wave * 64 + l_; } while (0)
    F.G = gridDim.x; F.bid = blockIdx.x;
    F.out = args.out; F.ws = args.ws;
    const int lo = args.ph_lo, hi = args.ph_hi;
    unsigned char* ws = args.ws;
    const float* rstd1 = (const float*)(ws + WS_SMALL + SM_RSTD1); float* rstd2 = (float*)(ws + WS_SMALL + SM_RSTD2); float* rstd3 = (float*)(ws + WS_SMALL + SM_RSTD3);
    const float* rstdm = (const float*)(ws + WS_SMALL + SM_RSTDM);
    bf16_t* xb = (bf16_t*)(ws + WS_XB);
#define IN(k) (lo <= (k) && (k) < hi)
    volatile LAS unsigned* MISC = (volatile LAS unsigned*)(F.lds + LDS_MISC);
    XcdBarrier bar; bar.bar = (unsigned*)ws + CW_BAR; bar.x = 0; bar.st = nullptr;
    if (hi - lo > 1) { FRESH_IDS(); if (F.tid < 32) MISC[F.tid] = 0u; __syncthreads(); bar = xcd_barrier_post((unsigned*)ws + CW_BAR, MISC + 8, F.tid); }
#define SEAM(k) do { if (IN(k) && IN((k) + 1)) { FRESH_IDS(); xcd_barrier(bar, F.tid); } } while (0)

    if (IN(0)) { FRESH_IDS(); phase_prologue(F, A); }
    if (lo < 0) cg::this_grid().sync();
    SEAM(0);
    if (IN(1)) { FRESH_IDS();
        if ((F.bid & 1) == 0) { ba_item(F, (F.wave & 3) * 256 + F.bid, F.wave >> 2);
            __syncthreads();
            FRESH_IDS(); }
        { pg8::Gemm g{(const bf16_t*)(ws + WS_X2Q), (const bf16_t*)(ws + WS_WIN), MTOK, 4096, DM / 2}; pg8::StaticOrder S; S.init(MTOK, 4096, F.G, F.bid);
          pg8::EpiScaleBf16 E{(bf16_t*)(ws + WS_PROJ), PROJ_LD, rstd1, 12, 16, 0, 0, nullptr, 0, 0, 0, 1.0f / WGU_SCALE};
          pg8::gemm_phase<pg8::EpiScaleBf16, pg8::StaticOrder, true, true, true>(F.lds, g, S, E, F.tid, F.wave); }
        FRESH_IDS();
        { pg8::Gemm g{xb, (const bf16_t*)(ws + WS_WINB), MTOK, 3072, DM}; pg8::StaticOrder S; S.init(MTOK, 3072, F.G, F.bid);
          pg8::EpiScaleBf16 E{(bf16_t*)(ws + WS_PROJ) + 4096, PROJ_LD, rstd1, 0, 0, 0, 0, (float*)(ws + WS_KMEAN), 4, 8, 0, 1.0f, 0, 4, moba::QSCALE};
          pg8::gemm_phase<pg8::EpiScaleBf16, pg8::StaticOrder, true, true>(F.lds, g, S, E, F.tid, F.wave); }
        if (F.bid & 1) { __syncthreads(); FRESH_IDS(); ba_item(F, (F.wave & 3) * 256 + F.bid, F.wave >> 2); }
    } SEAM(1);
    if (IN(2)) { FRESH_IDS();
        gdn::prep((__attribute__((address_space(3))) unsigned char*)F.lds, F.tid, F.lane, F.wave, F.bid, (const unsigned short*)(ws + WS_PROJ), (const float*)(ws + WS_SMALL + SM_BETA), (const float*)(ws + WS_SMALL + SM_G), TABP(F, 4),
                  (unsigned char*)F.out, ws + WS_WIN, ws + WS_O); } SEAM(2);
    if (IN(3)) { FRESH_IDS();
        if (F.bid < 64) gdn::scan((__attribute__((address_space(3))) unsigned char*)F.lds, F.tid, F.lane, F.wave, F.bid, (unsigned char*)F.out, ws + WS_WIN, (const unsigned short*)(ws + WS_PROJ), TABP(F, 7), (unsigned short*)(ws + WS_O));
        else if (F.bid < 256) phase_moba(F, A, (char*)lds_raw, F.bid - 64);
    } SEAM(3);
    if (IN(4)) { FRESH_IDS();
        pg8::Gemm g{(const bf16_t*)(ws + WS_O), (const bf16_t*)(ws + WS_WOUT), MTOK, DM, DM}; pg8::StaticOrder S; S.init(MTOK, DM, F.G, F.bid);
        pg8::EpiResidBf16 E{xb, xb, DM, (float*)(ws + WS_RSQ2), 1.0f, nullptr};
        pg8::gemm_phase<pg8::EpiResidBf16, pg8::StaticOrder, true, true>(F.lds, g, S, E, F.tid, F.wave);
    } SEAM(4);
    if (IN(6)) { FRESH_IDS();
        { pg8::Gemm g{xb, (const bf16_t*)(ws + WS_WXQ), MTOK, XW, DM}; pg8::StaticOrder S; S.init(MTOK, XW, F.G, F.bid);
          pg8::EpiScaleBf16 E{(bf16_t*)(ws + WS_QX), XW, (const float*)(ws + WS_RSQ2), 0, 0, 0, 0, nullptr, 0, 0, 1, moba::QSCALE};
          pg8::gemm_phase<pg8::EpiScaleBf16, pg8::StaticOrder, true, true>(F.lds, g, S, E, F.tid, F.wave); }
        { pg8::Gemm g{(const bf16_t*)(ws + WS_MEMB), (const bf16_t*)(ws + WS_WXKV), MROWS, 2 * XW, DM}; pg8::StaticOrder S; S.init(MROWS, 2 * XW, F.G, (F.bid + F.G - 128) % F.G);
          pg8::EpiScaleBf16 E{(bf16_t*)(ws + WS_KVX), 2 * XW, rstdm, 0, 0, 0, 0, nullptr, 0, 0, 0, 1.0f};
          pg8::gemm_phase<pg8::EpiScaleBf16, pg8::StaticOrder, true, true>(F.lds, g, S, E, F.tid, F.wave); }
        if (F.bid >= 160 && F.bid < 256) { FRESH_IDS(); phase_ffn_weights(F, F.bid - 160, 96); }
    } SEAM(6);
    if (IN(7)) { FRESH_IDS(); if (F.bid < 256) phase_xattn(F, (char*)lds_raw, F.bid); } SEAM(7);
    if (IN(8)) { FRESH_IDS();
        pg8::Gemm g{(const bf16_t*)(ws + WS_OX), (const bf16_t*)(ws + WS_WXO), MTOK, DM, XW}; pg8::StaticOrder S; S.init(MTOK, DM, F.G, F.bid);
        pg8::EpiResidBf16 E{xb, xb, DM, (float*)(ws + WS_RSQ3), 1.0f, ws + WS_X2Q};
        pg8::gemm_phase<pg8::EpiResidBf16, pg8::StaticOrder, true, true>(F.lds, g, S, E, F.tid, F.wave);
    } SEAM(8);
    if (IN(10)) { FRESH_IDS();
        pg8::Gemm g{(const bf16_t*)(ws + WS_X2Q), (const bf16_t*)(ws + WS_WGU), MTOK, 2 * DFF, DM / 2}; pg8::StaticOrder S; S.init(MTOK, 2 * DFF, F.G, F.bid);
        pg8::EpiFfn E{(unsigned char*)F.out, (const float*)(ws + WS_RSQ3), TABP(F, 19), TABP(F, 20), (bf16_t*)(ws + WS_GATE), (__attribute__((address_space(3))) float*)(F.lds + 131072), 1.0f / WGU_SCALE};
        pg8::gemm_phase<pg8::EpiFfn, pg8::StaticOrder, true, true, true>(F.lds, g, S, E, F.tid, F.wave);
    } SEAM(10);
    if (IN(12)) { FRESH_IDS();
        { pg8::StaticOrder S0; S0.init(MTOK, DM, F.G, F.bid); pg8::Unit u0;
          if (S0.next(0, u0) && (u0.pm & 7)) ffn_fixup(F, u0.pm);
          if (S0.next(1, u0) && (u0.pm & 7)) ffn_fixup(F, u0.pm);
          asm volatile("s_waitcnt vmcnt(0)" ::: "memory"); __syncthreads(); FRESH_IDS(); }
        pg8::Gemm g{(const bf16_t*)F.out, (const bf16_t*)(ws + WS_WDOWN), MTOK, DM, DFF / 2};     pg8::StaticOrder S; S.init(MTOK, DM, F.G, F.bid);
        pg8::EpiResidBf16 E{xb, xb, DM, (float*)(ws + WS_RSQ4), 1.0f / WDOWN_SCALE, nullptr};
        pg8::gemm_phase<pg8::EpiResidBf16, pg8::StaticOrder, true, true, true>(F.lds, g, S, E, F.tid, F.wave);
    } SEAM(12);
    if (IN(13)) { FRESH_IDS(); phase_final_norm(F, A); }
#undef IN
#undef SEAM
}

extern "C" void kernel_launch(void* const* d_in, const int* in_sizes, int n_in, void* d_out, int out_size, void* d_ws, size_t ws_size, hipStream_t stream) {
    static int grid = 0;
    if (grid == 0) {
        if (n_in != 23 || in_sizes[0] != MTOK * DM || out_size != MTOK * DM || ws_size < WS_END) {
            fprintf(stderr, "kernel_launch: unexpected shapes: n_in %d, in0 %d, out %d, ws %zu (need >= %zu); nothing launched\n", n_in, n_in > 0 ? in_sizes[0] : -1, out_size, ws_size, (size_t)WS_END); grid = -1; return; }
        int dev = 0, cus = 0, per_cu = 0;
        if (hipGetDevice(&dev) != hipSuccess || hipDeviceGetAttribute(&cus, hipDeviceAttributeMultiprocessorCount, dev) != hipSuccess) { fprintf(stderr, "kernel_launch: device query failed\n"); grid = -1; return; }
        if (hipFuncSetAttribute((const void*)mk_fwd, hipFuncAttributeMaxDynamicSharedMemorySize, LDS_BYTES) != hipSuccess) { fprintf(stderr, "kernel_launch: hipFuncSetAttribute failed\n"); grid = -1; return; }
        if (hipOccupancyMaxActiveBlocksPerMultiprocessor(&per_cu, (const void*)mk_fwd, NTHREADS, LDS_BYTES) != hipSuccess || per_cu < 1) { fprintf(stderr, "kernel_launch: occupancy query says %d blocks per CU\n", per_cu); per_cu = 1; }
        (void)hipGetLastError();
        if (per_cu > 1) per_cu = 1;
        grid = cus * per_cu;
        if (grid != 256) { fprintf(stderr, "kernel_launch: built for a 256-CU device (grid %d); nothing launched\n", grid); grid = -1; return; }
    }
    if (grid < 0) return;
    if (hipMemsetAsync(d_ws, 0, 1u << 20, stream) != hipSuccess) { fprintf(stderr, "kernel_launch: hipMemsetAsync failed\n"); return; }
    Args a{};
    for (int i = 0; i < 23; ++i) a.in[i] = (const float*)d_in[i];
    a.out = (float*)d_out; a.ws = (unsigned char*)d_ws;
#if MK_MULTI
    for (int p = 0; p < N_PHASES; ++p) { a.ph_lo = p; a.ph_hi = p + 1; hipLaunchKernelGGL(mk_fwd, dim3(grid), dim3(NTHREADS), LDS_BYTES, stream, a); }
#else
    a.ph_lo = 0; a.ph_hi = N_PHASES;
    void* kargs[] = {&a};
    hipError_t e = hipLaunchCooperativeKernel((const void*)mk_fwd, dim3(grid), dim3(NTHREADS), kargs, LDS_BYTES, stream);
    if (e != hipSuccess) fprintf(stderr, "kernel_launch: cooperative launch failed: %s (grid %d)\n", hipGetErrorString(e), grid);
#endif
}
```

```cpp
#include <hip/hip_runtime.h>
#include <hip/hip_cooperative_groups.h>
#include <cstdio>
#include <cstdint>
namespace cg = cooperative_groups;

#ifndef MK_MULTI
#define MK_MULTI 0
#endif

namespace pg8 {
#define PG8_LAS __attribute__((address_space(3)))
typedef unsigned short bf16_t;
typedef short bf16x8 __attribute__((ext_vector_type(8)));
typedef float f32x4 __attribute__((ext_vector_type(4)));
typedef unsigned u32x4 __attribute__((ext_vector_type(4)));
typedef int pg8_v4i __attribute__((ext_vector_type(4)));
typedef int pg8_v8i __attribute__((ext_vector_type(8)));
constexpr int BM = 256, BK = 64, HALF = 128, HTB = HALF * BK * 2  , STAGE_BYTES = 8 * HTB, NXCD = 8, WGM = 8;

__host__ __device__ __forceinline__ int lds_byte(int r, int c) { const int st = (r >> 4) * 2 + (c >> 5), rr = r & 15, cc = c & 31, ob = rr * 64 + cc * 2; return st * 1024 + (ob ^ (((ob >> 9) & 1) << 5)); }
__host__ __device__ __forceinline__ void stage_rc(int b, int& R, int& C) { const int st = b / 1024, sb = b % 1024, swz = sb ^ (((sb >> 9) & 1) << 5); R = (st >> 1) * 16 + swz / 64; C = (st & 1) * 32 + (swz % 64) / 2; }
__host__ __device__ __forceinline__ int perm32(int rho) { const int n = rho >> 4, i = rho & 15; return 8 * (i >> 2) + 4 * n + (i & 3); }

struct Unit { int pm, pn; };
struct Gemm { const bf16_t* A; const bf16_t* Bt; int M, N, K; };

struct StaticOrder {
    int nM, nN, nwg, G, c;
    __host__ __device__ __forceinline__ void init(int M, int N, int G_, int c_) { nM = M / BM; nN = N / BM; nwg = nM * nN; G = G_; c = c_; }
    __host__ __device__ __forceinline__ bool next(int i, Unit& u) const {
        const long L = (long)i * G + c; if (L >= nwg) return false;
        int wgid = (int)L; { const int q = nwg / NXCD, r = nwg % NXCD, xcd = wgid % NXCD, off = wgid / NXCD; wgid = (xcd < r ? xcd * (q + 1) : r * (q + 1) + (xcd - r) * q) + off; }
        const int nig = WGM * nN, gid = wgid / nig, fm = gid * WGM, gsz = (nM - fm) < WGM ? (nM - fm) : WGM;
        u.pm = fm + ((wgid % nig) % gsz); u.pn = (wgid % nig) / gsz; return true;
    }
    __device__ __forceinline__ void a_ready(const Unit&) const {}
    __device__ __forceinline__ void done(const Unit&) const {}
};


__device__ __forceinline__ unsigned cvt_pk_bf16(float lo, float hi) { unsigned r; asm volatile("v_cvt_pk_bf16_f32 %0, %1, %2" : "=v"(r) : "v"(lo), "v"(hi)); return r; }
typedef __bf16 hw_bf16x2 __attribute__((ext_vector_type(2)));
typedef float hw_f32x2 __attribute__((ext_vector_type(2)));
__device__ __forceinline__ unsigned cvt_pk_bf16_acc(float lo, float hi) { const hw_bf16x2 r = __builtin_convertvector((hw_f32x2){lo, hi}, hw_bf16x2); return __builtin_bit_cast(unsigned, r); }
__device__ __forceinline__ float silu_f(float v) { return v * __builtin_amdgcn_rcpf(1.0f + __expf(-v)); }

struct EpiScaleBf16 {
    static constexpr bool PERM = true, AFTER_DRAIN = false;
    bf16_t* O; int ldc; const float* rs; int silu_lo, silu_hi; int split_cols; size_t split_stride; float* km; int km_lo, km_hi; int rs_sumsq; float oscale; int qs_lo, qs_hi; float qscale;
    __device__ __forceinline__ void operator()(const f32x4 (&acc)[2][2][4][2], const Unit& u, int wr, int wc, int fr, int fq) const {
        int colt = u.pn * BM; bf16_t* base = O; if (split_cols && colt >= split_cols) { base += split_stride; colt -= split_cols; }
        const int row0 = u.pm * BM + wr * 64 + fr, col0 = colt + wc * 32 + 8 * fq;
        const bool act = (u.pn >= silu_lo && u.pn < silu_hi); const float tscale = (u.pn >= qs_lo && u.pn < qs_hi) ? oscale * qscale : oscale;
        const bool dokm = km && u.pn >= km_lo && u.pn < km_hi; float cs[2][8];
#pragma unroll
        for (int a_ = 0; a_ < 2; ++a_)
#pragma unroll
            for (int b_ = 0; b_ < 8; ++b_) cs[a_][b_] = 0.f;
        float rsv[2][4];
#pragma unroll
        for (int ai = 0; ai < 2; ++ai)
#pragma unroll
            for (int m = 0; m < 4; ++m) rsv[ai][m] = rs ? rs[row0 + ai * HALF + m * 16] : 1.0f;
#pragma unroll
        for (int ai = 0; ai < 2; ++ai)
#pragma unroll
            for (int m = 0; m < 4; ++m) { const int row = row0 + ai * HALF + m * 16; float r = rsv[ai][m]; if (rs_sumsq) r = rsqrtf(r * (1.0f / 2048.0f) + 1e-6f); r *= tscale; bf16_t* rowp = base + (size_t)row * ldc + col0;
#pragma unroll
                for (int bj = 0; bj < 2; ++bj) { f32x4 v0 = acc[ai][bj][m][0] * r, v1 = acc[ai][bj][m][1] * r;
                    if (act) {
#pragma unroll
                        for (int j = 0; j < 4; ++j) { v0[j] = silu_f(v0[j]); v1[j] = silu_f(v1[j]); } }
                    if (dokm) {
#pragma unroll
                        for (int j = 0; j < 4; ++j) { cs[bj][j] += v0[j]; cs[bj][4 + j] += v1[j]; } }
                    u32x4 w; w.x = cvt_pk_bf16(v0[0], v0[1]); w.y = cvt_pk_bf16(v0[2], v0[3]); w.z = cvt_pk_bf16(v1[0], v1[1]); w.w = cvt_pk_bf16(v1[2], v1[3]);
                    *(u32x4*)(rowp + bj * HALF) = w; } }
        if (dokm) {
#pragma unroll
            for (int bj = 0; bj < 2; ++bj)
#pragma unroll
                for (int c = 0; c < 8; ++c) { float s = cs[bj][c]; s += __shfl_xor(s, 1); s += __shfl_xor(s, 2); s += __shfl_xor(s, 4); s += __shfl_xor(s, 8);
                    if (fr == 0) atomicAdd(km + (size_t)u.pm * 1024 + (u.pn - km_lo) * BM + bj * HALF + wc * 32 + 8 * fq + c, s * (1.0f / 256.0f)); } }
    }
};
struct EpiResidBf16 {
    static constexpr bool PERM = true, AFTER_DRAIN = false;
    const bf16_t* baseh; bf16_t* out; int ldc; float* rowsq; float accscale; unsigned char* q8;
    __device__ __forceinline__ void operator()(const f32x4 (&acc)[2][2][4][2], const Unit& u, int wr, int wc, int fr, int fq) const {
        const int row0 = u.pm * BM + wr * 64 + fr, col0 = u.pn * BM + wc * 32 + 8 * fq;
#pragma unroll
        for (int ai = 0; ai < 2; ++ai) {
            u32x4 hb[4][2];
#pragma unroll
            for (int m = 0; m < 4; ++m)
#pragma unroll
                for (int bj = 0; bj < 2; ++bj) hb[m][bj] = *(const u32x4*)(baseh + (size_t)(row0 + ai * HALF + m * 16) * ldc + col0 + bj * HALF);
#pragma unroll
            for (int m = 0; m < 4; ++m) { const int row = row0 + ai * HALF + m * 16; const size_t off = (size_t)row * ldc + col0; float ss = 0.f;
#pragma unroll
                for (int bj = 0; bj < 2; ++bj) { const u32x4 h = hb[m][bj];
                    const f32x4 b0 = (f32x4){__uint_as_float(h.x << 16), __uint_as_float(h.x & 0xffff0000u), __uint_as_float(h.y << 16), __uint_as_float(h.y & 0xffff0000u)};
                    const f32x4 b1 = (f32x4){__uint_as_float(h.z << 16), __uint_as_float(h.z & 0xffff0000u), __uint_as_float(h.w << 16), __uint_as_float(h.w & 0xffff0000u)};
                    const f32x4 v0 = b0 + acc[ai][bj][m][0] * accscale, v1 = b1 + acc[ai][bj][m][1] * accscale;
                    ss += (v0[0] * v0[0] + v0[1] * v0[1]) + (v0[2] * v0[2] + v0[3] * v0[3]) + (v1[0] * v1[0] + v1[1] * v1[1]) + (v1[2] * v1[2] + v1[3] * v1[3]);
                    u32x4 w; w.x = cvt_pk_bf16(v0[0], v0[1]); w.y = cvt_pk_bf16(v0[2], v0[3]); w.z = cvt_pk_bf16(v1[0], v1[1]); w.w = cvt_pk_bf16(v1[2], v1[3]);
                    *(u32x4*)(out + off + bj * HALF) = w;
                    if (q8) { int q0 = __builtin_amdgcn_cvt_pk_fp8_f32(v0[0], v0[1], 0, false); q0 = __builtin_amdgcn_cvt_pk_fp8_f32(v0[2], v0[3], q0, true);
                        int q1 = __builtin_amdgcn_cvt_pk_fp8_f32(v1[0], v1[1], 0, false); q1 = __builtin_amdgcn_cvt_pk_fp8_f32(v1[2], v1[3], q1, true);
                        typedef unsigned u32x2_ __attribute__((ext_vector_type(2))); *(u32x2_*)(q8 + off + bj * HALF) = (u32x2_){(unsigned)q0, (unsigned)q1}; } }
                ss += __shfl_xor(ss, 16); ss += __shfl_xor(ss, 32);
                if (fq == 0) atomicAdd(rowsq + row, ss); } }
    }
};

struct EpiFfn {
    static constexpr bool PERM = true, AFTER_DRAIN = false;
    unsigned char* H8; const float* rsq; const float* cw; const float* cb; bf16_t* halo; PG8_LAS float* X;
    float oscale;
    __device__ __forceinline__ void operator()(f32x4 (&acc)[2][2][4][2], const Unit& u, int wr, int wc, int fr_in, int fq_in) const {
        int fr = fr_in, fq = fq_in; asm volatile("" : "+v"(fr), "+v"(fq));
        const int wid = wr * 4 + wc, ch = u.pn * 128 + wc * 32 + 8 * fq, lane = fq * 16 + fr;
#pragma unroll
        for (int ai = 0; ai < 2; ++ai)
#pragma unroll
            for (int m = 0; m < 4; ++m) { const int row = u.pm * BM + ai * HALF + wr * 64 + m * 16 + fr; const float r = rsqrtf(rsq[row] * (1.0f / 2048.0f) + 1e-6f) * oscale;
#pragma unroll
                for (int bj = 0; bj < 2; ++bj) { acc[ai][bj][m][0] = acc[ai][bj][m][0] * r; acc[ai][bj][m][1] = acc[ai][bj][m][1] * r; } }
        if (fr >= 14) {
#pragma unroll
            for (int ai = 0; ai < 2; ++ai) { PG8_LAS f32x4* xp = (PG8_LAS f32x4*)(X + ((wid * 2 + ai) * 2 + (fr - 14)) * 64 + fq * 8); xp[0] = acc[ai][0][3][0]; xp[1] = acc[ai][0][3][1]; } }
        { bf16_t* hp = halo + (size_t)u.pm * 6 * 5632 + ch;
          if (wr == 1 && fr >= 14) { u32x4 w = {cvt_pk_bf16(acc[1][0][3][0][0], acc[1][0][3][0][1]), cvt_pk_bf16(acc[1][0][3][0][2], acc[1][0][3][0][3]), cvt_pk_bf16(acc[1][0][3][1][0], acc[1][0][3][1][1]), cvt_pk_bf16(acc[1][0][3][1][2], acc[1][0][3][1][3])};
              *(u32x4*)(hp + (size_t)(fr - 14) * 5632) = w; }
          if (wr == 0 && fr < 2) { u32x4 w = {cvt_pk_bf16(acc[0][0][0][0][0], acc[0][0][0][0][1]), cvt_pk_bf16(acc[0][0][0][0][2], acc[0][0][0][0][3]), cvt_pk_bf16(acc[0][0][0][1][0], acc[0][0][0][1][1]), cvt_pk_bf16(acc[0][0][0][1][2], acc[0][0][0][1][3])};
              *(u32x4*)(hp + (size_t)(2 + fr) * 5632) = w;
              u32x4 w2 = {cvt_pk_bf16(acc[0][1][0][0][0], acc[0][1][0][0][1]), cvt_pk_bf16(acc[0][1][0][0][2], acc[0][1][0][0][3]), cvt_pk_bf16(acc[0][1][0][1][0], acc[0][1][0][1][1]), cvt_pk_bf16(acc[0][1][0][1][2], acc[0][1][0][1][3])};
              *(u32x4*)(hp + (size_t)(4 + fr) * 5632) = w2; } }
        const f32x4 w0a = *(const f32x4*)(cw + ch), w0b = *(const f32x4*)(cw + ch + 4), w1a = *(const f32x4*)(cw + 5632 + ch), w1b = *(const f32x4*)(cw + 5632 + ch + 4);
        const f32x4 w2a = *(const f32x4*)(cw + 2 * 5632 + ch), w2b = *(const f32x4*)(cw + 2 * 5632 + ch + 4), ba = *(const f32x4*)(cb + ch), bb = *(const f32x4*)(cb + ch + 4);
        asm volatile("s_waitcnt lgkmcnt(0)" ::: "memory"); __builtin_amdgcn_s_barrier(); asm volatile("" ::: "memory");
#pragma unroll
        for (int ai = 1; ai >= 0; --ai)
#pragma unroll
            for (int m = 3; m >= 0; --m) {
                f32x4 pv0, pv1;
                if (m > 0) { pv0 = acc[ai][0][m - 1][0]; pv1 = acc[ai][0][m - 1][1]; }
                else { pv0 = (f32x4){0.f, 0.f, 0.f, 0.f}; pv1 = pv0;
                    if (!(wr == 0 && ai == 0) && fr >= 14) { const int pw = (1 - wr) * 4 + wc, pai = (wr == 1) ? ai : 0;
                        const PG8_LAS f32x4* xp = (const PG8_LAS f32x4*)(X + ((pw * 2 + pai) * 2 + (fr - 14)) * 64 + fq * 8); pv0 = xp[0]; pv1 = xp[1]; } }
                const f32x4 g0 = acc[ai][0][m][0], g1 = acc[ai][0][m][1], u0 = acc[ai][1][m][0], u1 = acc[ai][1][m][1];
                float hv[8];
#pragma unroll
                for (int c = 0; c < 8; ++c) { const float gc = c < 4 ? g0[c & 3] : g1[c & 3], pc = c < 4 ? pv0[c & 3] : pv1[c & 3];
                    const float x1 = __int_as_float(__builtin_amdgcn_update_dpp(0, __float_as_int(fr == 15 ? pc : gc), 0x121, 0xf, 0xf, true)), x2 = __int_as_float(__builtin_amdgcn_update_dpp(0, __float_as_int(fr >= 14 ? pc : gc), 0x122, 0xf, 0xf, true));
                    const float y = __builtin_fmaf(c < 4 ? w0a[c & 3] : w0b[c & 3], x2, __builtin_fmaf(c < 4 ? w1a[c & 3] : w1b[c & 3], x1, __builtin_fmaf(c < 4 ? w2a[c & 3] : w2b[c & 3], gc, c < 4 ? ba[c & 3] : bb[c & 3])));
                    hv[c] = y * __builtin_amdgcn_rcpf(1.0f + __expf(-y)) * (c < 4 ? u0[c & 3] : u1[c & 3]); }
                int q0 = __builtin_amdgcn_cvt_pk_fp8_f32(hv[0], hv[1], 0, false); q0 = __builtin_amdgcn_cvt_pk_fp8_f32(hv[2], hv[3], q0, true);
                int q1 = __builtin_amdgcn_cvt_pk_fp8_f32(hv[4], hv[5], 0, false); q1 = __builtin_amdgcn_cvt_pk_fp8_f32(hv[6], hv[7], q1, true);
                typedef unsigned u32x2_ __attribute__((ext_vector_type(2)));
                *(u32x2_*)(H8 + (size_t)(u.pm * BM + ai * HALF + wr * 64 + m * 16 + fr) * 5632 + ch) = (u32x2_){(unsigned)q0, (unsigned)q1}; }
    }
};

template <class Epi, class Sched, bool ALIGN_EPI = false, bool SP2 = false, bool F8 = false>
__device__ __forceinline__ void gemm_phase(PG8_LAS unsigned char* lds, const Gemm g, const Sched& S, const Epi& E, const int tid, const int wid) {
    const int lane = tid & 63, wr = wid >> 2, wc = wid & 3, fr = lane & 15, fq = lane >> 4;
    const int K = g.K, nt = K / BK;
    unsigned voffA[2], voffB[2];
#pragma unroll
    for (int i = 0; i < 2; ++i) { int R, C; stage_rc(tid * 16 + i * 8192, R, C); const int Rb = Epi::PERM ? ((R & ~31) + perm32(R & 31)) : R;
        voffA[i] = (unsigned)(R * K + C) * 2u; voffB[i] = (unsigned)(Rb * K + C) * 2u; }
    const size_t kstep = (size_t)(BK * 2);
    const size_t hstep = (size_t)HALF * K * 2;
    const size_t tstep = 2 * hstep;
    const unsigned ldsw = (unsigned)wid * 1024u;
    const int aoff = lds_byte(wr * 64 + fr, fq * 8), boff = lds_byte(wc * 32 + fr, fq * 8);
#define PG8_SA(b, h) (((b) * 2 + (h)) * HTB)
#define PG8_SB(b, h) ((4 + (b) * 2 + (h)) * HTB)
#define PG8_STAGE(bufoff, gbase, voff) do { _Pragma("unroll") for (int _i = 0; _i < 2; ++_i) { unsigned vo_ = (voff)[_i]; if constexpr (F8) asm volatile("" : "+v"(vo_));     \
        __builtin_amdgcn_global_load_lds((const unsigned*)((const char*)(gbase) + vo_), (PG8_LAS unsigned*)(lds + (bufoff) + ldsw + _i * 8192), 16, 0, 0); } } while (0)
#define PG8_LDA(dst, b, h) do { if constexpr (F8) { _Pragma("unroll") for (int m = 0; m < 4; ++m) { const pg8_v4i l_ = *(const PG8_LAS pg8_v4i*)(lds + PG8_SA(b, h) + aoff + m * 2048), h_ = *(const PG8_LAS pg8_v4i*)(lds + PG8_SA(b, h) + aoff + m * 2048 + 1024); \
            dst##8[m] = __builtin_shufflevector(l_, h_, 0, 1, 2, 3, 4, 5, 6, 7); } } \
        else { _Pragma("unroll") for (int m = 0; m < 4; ++m) _Pragma("unroll") for (int k = 0; k < 2; ++k) dst[m][k] = *(const PG8_LAS bf16x8*)(lds + PG8_SA(b, h) + aoff + m * 2048 + k * 1024); } } while (0)
#define PG8_LDB(dst, b, h) do { if constexpr (F8) { _Pragma("unroll") for (int n = 0; n < 2; ++n) { const pg8_v4i l_ = *(const PG8_LAS pg8_v4i*)(lds + PG8_SB(b, h) + boff + n * 2048), h_ = *(const PG8_LAS pg8_v4i*)(lds + PG8_SB(b, h) + boff + n * 2048 + 1024); \
            dst##8[n] = __builtin_shufflevector(l_, h_, 0, 1, 2, 3, 4, 5, 6, 7); } } \
        else { _Pragma("unroll") for (int n = 0; n < 2; ++n) _Pragma("unroll") for (int k = 0; k < 2; ++k) dst[n][k] = *(const PG8_LAS bf16x8*)(lds + PG8_SB(b, h) + boff + n * 2048 + k * 1024); } } while (0)
#define PG8_MMA(ai, bj, At, Bt) do { __builtin_amdgcn_s_setprio(1); \
        if constexpr (F8) { _Pragma("unroll") for (int m = 0; m < 4; ++m) _Pragma("unroll") for (int n = 0; n < 2; ++n) \
            acc[ai][bj][m][n] = __builtin_amdgcn_mfma_scale_f32_16x16x128_f8f6f4(Bt##8[n], At##8[m], acc[ai][bj][m][n], 0, 0, 0, 0x7f7f7f7f, 0, 0x7f7f7f7f); } \
        else { _Pragma("unroll") for (int m = 0; m < 4; ++m) _Pragma("unroll") for (int n = 0; n < 2; ++n) _Pragma("unroll") for (int k = 0; k < 2; ++k) \
            acc[ai][bj][m][n] = __builtin_amdgcn_mfma_f32_16x16x32_bf16(Bt[n][k], At[m][k], acc[ai][bj][m][n], 0, 0, 0); } \
        __builtin_amdgcn_s_setprio(0); } while (0)
#define PG8_WAIT_V(n) asm volatile("s_waitcnt vmcnt(" #n ")" ::: "memory")
#define PG8_WAIT_L(n) asm volatile("s_waitcnt lgkmcnt(" #n ")" ::: "memory")
#define PG8_BAR __builtin_amdgcn_s_barrier()
#define PG8_SCHED __builtin_amdgcn_sched_barrier(0)
    Unit cur, nxt; int ui = 0;
    if (!S.next(0, cur)) return;
    f32x4 acc[2][2][4][2];
#pragma unroll
    for (int a = 0; a < 2; ++a)
#pragma unroll
        for (int b = 0; b < 2; ++b)
#pragma unroll
            for (int m = 0; m < 4; ++m)
#pragma unroll
                for (int n = 0; n < 2; ++n) acc[a][b][m][n] = (f32x4){0.f, 0.f, 0.f, 0.f};
    bf16x8 At[4][2], B0[2][2], B1[2][2];
    pg8_v8i At8[4], B08[2], B18[2];
    const char* cA = (const char*)g.A + (size_t)cur.pm * tstep; const char* cB = (const char*)g.Bt + (size_t)cur.pn * tstep;
    S.a_ready(cur);
    if constexpr (SP2) {
        PG8_STAGE(PG8_SB(0, 0), cB, voffB); PG8_STAGE(PG8_SB(0, 1), cB + hstep, voffB); PG8_STAGE(PG8_SA(0, 0), cA, voffA); PG8_STAGE(PG8_SA(0, 1), cA + hstep, voffA);
        if (wr == 1) PG8_BAR;
        PG8_WAIT_V(2); PG8_BAR;
        PG8_STAGE(PG8_SB(1, 0), cB + kstep, voffB); PG8_STAGE(PG8_SA(1, 0), cA + kstep, voffA); PG8_STAGE(PG8_SB(1, 1), cB + hstep + kstep, voffB);
        PG8_WAIT_V(6); PG8_BAR;
    } else {
        PG8_STAGE(PG8_SB(0, 0), cB, voffB); PG8_STAGE(PG8_SA(0, 0), cA, voffA); PG8_STAGE(PG8_SB(0, 1), cB + hstep, voffB); PG8_STAGE(PG8_SA(0, 1), cA + hstep, voffA);
        if (wr == 1) PG8_BAR;
        PG8_WAIT_V(4); PG8_BAR;
        PG8_STAGE(PG8_SB(1, 0), cB + kstep, voffB); PG8_STAGE(PG8_SA(1, 0), cA + kstep, voffA); PG8_STAGE(PG8_SB(1, 1), cB + hstep + kstep, voffB);
        PG8_WAIT_V(6); PG8_BAR;
    }
    for (;;) {
        const bool has_next = S.next(ui + 1, nxt);
        const char* nA = has_next ? (const char*)g.A + (size_t)nxt.pm * tstep : cA; const char* nB = has_next ? (const char*)g.Bt + (size_t)nxt.pn * tstep : cB;
        for (int t = 0; t < nt; t += 2) {
            const bool last = (t == nt - 2);
            const char* a1 = cA + (size_t)(t + 1) * kstep;
            const char* a2 = last ? nA : cA + (size_t)(t + 2) * kstep; const char* b2 = last ? nB : cB + (size_t)(t + 2) * kstep;
            const char* a3 = a2 + kstep; const char* b3 = b2 + kstep;
            if (last && has_next) S.a_ready(nxt);
            if constexpr (SP2) {
            PG8_LDB(B0, 0, 0); PG8_LDB(B1, 0, 1); PG8_SCHED; PG8_LDA(At, 0, 0); PG8_STAGE(PG8_SA(1, 1), a1 + hstep, voffA);
            PG8_WAIT_V(8); PG8_WAIT_L(0); PG8_BAR; PG8_MMA(0, 0, At, B0); PG8_MMA(0, 1, At, B1); PG8_BAR; PG8_SCHED;
            PG8_LDA(At, 0, 1); PG8_STAGE(PG8_SB(0, 0), b2, voffB); PG8_STAGE(PG8_SB(0, 1), b2 + hstep, voffB); PG8_STAGE(PG8_SA(0, 0), a2, voffA);
            PG8_WAIT_V(8); PG8_WAIT_L(0); PG8_BAR; PG8_MMA(1, 0, At, B0); PG8_MMA(1, 1, At, B1); PG8_BAR; PG8_SCHED;
            PG8_LDB(B0, 1, 0); PG8_LDB(B1, 1, 1); PG8_SCHED; PG8_LDA(At, 1, 0); PG8_STAGE(PG8_SA(0, 1), a2 + hstep, voffA);
            PG8_WAIT_V(8); PG8_WAIT_L(0); PG8_BAR; PG8_MMA(0, 0, At, B0); PG8_MMA(0, 1, At, B1); PG8_BAR; PG8_SCHED;
            PG8_LDA(At, 1, 1); PG8_STAGE(PG8_SB(1, 0), b3, voffB); PG8_STAGE(PG8_SB(1, 1), b3 + hstep, voffB); PG8_STAGE(PG8_SA(1, 0), a3, voffA);
            PG8_WAIT_V(8); PG8_WAIT_L(0); PG8_BAR; PG8_MMA(1, 0, At, B0); PG8_MMA(1, 1, At, B1); PG8_BAR; PG8_SCHED;
            } else {
            PG8_LDB(B0, 0, 0); PG8_SCHED; PG8_LDA(At, 0, 0); PG8_STAGE(PG8_SA(1, 1), a1 + hstep, voffA);
            PG8_WAIT_L(8); PG8_BAR; PG8_WAIT_L(0); PG8_MMA(0, 0, At, B0); PG8_BAR; PG8_SCHED;
            PG8_LDB(B1, 0, 1); PG8_STAGE(PG8_SB(0, 0), b2, voffB);
            PG8_BAR; PG8_WAIT_L(0); PG8_MMA(0, 1, At, B1); PG8_BAR;
            PG8_LDA(At, 0, 1); PG8_STAGE(PG8_SA(0, 0), a2, voffA);
            PG8_BAR; PG8_WAIT_L(0); PG8_MMA(1, 0, At, B0); PG8_BAR; PG8_SCHED;
            PG8_STAGE(PG8_SB(0, 1), b2 + hstep, voffB);
            PG8_WAIT_V(6); PG8_BAR; PG8_MMA(1, 1, At, B1); PG8_BAR;
            PG8_LDB(B0, 1, 0); PG8_SCHED; PG8_LDA(At, 1, 0); PG8_STAGE(PG8_SA(0, 1), a2 + hstep, voffA);
            PG8_WAIT_L(8); PG8_BAR; PG8_WAIT_L(0); PG8_MMA(0, 0, At, B0); PG8_BAR; PG8_SCHED;
            PG8_LDB(B1, 1, 1); PG8_STAGE(PG8_SB(1, 0), b3, voffB);
            PG8_BAR; PG8_WAIT_L(0); PG8_MMA(0, 1, At, B1); PG8_BAR;
            PG8_LDA(At, 1, 1); PG8_STAGE(PG8_SA(1, 0), a3, voffA);
            PG8_BAR; PG8_WAIT_L(0); PG8_MMA(1, 0, At, B0); PG8_BAR; PG8_SCHED;
            PG8_STAGE(PG8_SB(1, 1), b3 + hstep, voffB);
            PG8_WAIT_V(6); PG8_BAR; PG8_MMA(1, 1, At, B1); PG8_BAR;
            }
        }
        if constexpr (ALIGN_EPI) { if (wr == 0) PG8_BAR; }
        if constexpr (!Epi::AFTER_DRAIN) { E(acc, cur, wr, wc, fr, fq); S.done(cur); }
        if (!has_next) break;
#pragma unroll
        for (int a = 0; a < 2; ++a)
#pragma unroll
            for (int b = 0; b < 2; ++b)
#pragma unroll
                for (int m = 0; m < 4; ++m)
#pragma unroll
                    for (int n = 0; n < 2; ++n) acc[a][b][m][n] = (f32x4){0.f, 0.f, 0.f, 0.f};
        cur = nxt; cA = nA; cB = nB; ++ui;
        if constexpr (ALIGN_EPI) { if (wr == 1) PG8_BAR; }
    }
    PG8_WAIT_V(0);
    if constexpr (!ALIGN_EPI) { if (wr == 0) PG8_BAR; }
    PG8_BAR;
    if constexpr (Epi::AFTER_DRAIN) { E.fused(acc, cur, wr, wc, fr, fq, lds, wid, lane); S.done(cur); }
#undef PG8_SA
#undef PG8_SB
#undef PG8_STAGE
#undef PG8_LDA
#undef PG8_LDB
#undef PG8_MMA
#undef PG8_WAIT_V
#undef PG8_WAIT_L
#undef PG8_BAR
#undef PG8_SCHED
}
}

namespace moba {
constexpr float SCALE = 0.08838834764831845f;
constexpr int NW = 8, QBLK = 32, KVBLK = 64, QB = NW * QBLK, D = 128;
struct CfgMoba { static constexpr int LDQ = 7232, LDK = 7232, LDO = 2048; static constexpr bool MOBA = true; };
struct CfgX { static constexpr int LDQ = 512, LDK = 1024, LDO = 512; static constexpr bool MOBA = false; };
constexpr int SHM_V = KVBLK * D * 2, SHM_K = KVBLK * D * 2;
constexpr int OFF_WS = 2 * SHM_V + 2 * SHM_K, OFF_BT = OFF_WS + NW * 64 * 4;
constexpr int OFF_KM = OFF_BT + 1024;
constexpr int OFF_Q = OFF_KM + 8192;
constexpr int LDS_BYTES = OFF_Q + NW * 8192;
constexpr float THR = 8.f;
constexpr float LOG2E = 1.4426950408889634f, QSCALE = LOG2E * SCALE, THR2 = THR * LOG2E;
typedef short bf16x8 __attribute__((ext_vector_type(8)));
typedef short s16x4 __attribute__((ext_vector_type(4)));
typedef float f32x16 __attribute__((ext_vector_type(16)));
typedef float f32x4 __attribute__((ext_vector_type(4)));
typedef unsigned u32x4 __attribute__((ext_vector_type(4)));
typedef unsigned short bf16;

#define KSWZ(row, colB) ((row) * 256 + ((colB) ^ (((row) & 7) << 4)))
#define SBAR() __builtin_amdgcn_sched_barrier(0)
__device__ __forceinline__ int v_st(int k, int c) { const int kk = (k & ~0xC) | ((k & 4) << 1) | ((k & 8) >> 1); return ((kk >> 3) * 4 + (c >> 5)) * 512 + ((kk & 7) * 32 + (c & 31)) * 2; }
__device__ __forceinline__ int v_rd_base(int lane) { return ((lane & 3) << 3) | (((lane >> 2) & 3) << 6) | (((lane >> 4) & 1) << 5) | (((lane >> 5) & 1) << 8); }
constexpr int v_rd_off(int d0, int ks, int half) { return d0 * 512 + ks * 4096 + half * 2048; }
__device__ __forceinline__ int crow(int r, int hi) { return (r & 3) + 8 * (r >> 2) + 4 * hi; }
__device__ __forceinline__ unsigned cvtpk(float lo, float hi) { unsigned r; asm volatile("v_cvt_pk_bf16_f32 %0, %1, %2" : "=v"(r) : "v"(lo), "v"(hi)); return r; }
__device__ __forceinline__ bf16x8 load8(const bf16* p) { return *reinterpret_cast<const bf16x8*>(p); }
__device__ __forceinline__ void mask_tile(f32x16& p0, f32x16& p1, int dq) {
    const float NEG = -__builtin_inff();
#pragma unroll
    for (int r = 0; r < 16; ++r) { const int c = (r & 3) + 8 * (r >> 2); if (dq - c < 0) p0[r] = NEG; if (dq - c - 32 < 0) p1[r] = NEG; }
}
__device__ __forceinline__ void bias_tile(f32x16& p0, f32x16& p1, int dq, const float* bt) {
#pragma unroll
    for (int r = 0; r < 16; ++r) { const int c = (r & 3) + 8 * (r >> 2); int n0 = dq - c, n1 = dq - c - 32; n0 = n0 < 0 ? 0 : n0; n1 = n1 < 0 ? 0 : n1; p0[r] += bt[n0]; p1[r] += bt[n1]; }
}
__device__ __forceinline__ void sel_tile(f32x16& p0, f32x16& p1, bool sel) {
    const float NEG = -__builtin_inff();
#pragma unroll
    for (int r = 0; r < 16; ++r) { p0[r] = sel ? p0[r] : NEG; p1[r] = sel ? p1[r] : NEG; }
}
template <bool FIRST>
__device__ __forceinline__ void partialSM(f32x16& p0, f32x16& p1, float& m_reg, float& alpha) {
    float pmax = p0[0]; for (int r = 1; r < 16; ++r) pmax = fmaxf(pmax, p0[r]); for (int r = 0; r < 16; ++r) pmax = fmaxf(pmax, p1[r]);
    { auto rr = __builtin_amdgcn_permlane32_swap(__float_as_uint(pmax), __float_as_uint(pmax), false, false);
      pmax = fmaxf(__uint_as_float(rr[0]), __uint_as_float(rr[1])); }
    if (!FIRST && __builtin_expect(__all(pmax <= THR2), 1)) { alpha = 1.f; }
    else { const float d = FIRST ? (pmax > -3.0e38f ? pmax : 0.f) : fmaxf(pmax, 0.f);
        alpha = __builtin_amdgcn_exp2f(-d); m_reg += d;
        for (int r = 0; r < 16; ++r) { p0[r] -= d; p1[r] -= d; } }
    for (int r = 0; r < 16; ++r) p0[r] = __builtin_amdgcn_exp2f(p0[r]);
}
__device__ __forceinline__ void finishSM(f32x16& p0, f32x16& p1, float alpha, float& l_reg, bf16x8& pa0, bf16x8& pa1, bf16x8& pa2, bf16x8& pa3) {
    for (int r = 0; r < 16; ++r) p1[r] = __builtin_amdgcn_exp2f(p1[r]);
    float ps;
    { typedef float f32x8_ __attribute__((ext_vector_type(8))); typedef float f32x2_ __attribute__((ext_vector_type(2)));
      const f32x16 t = p0 + p1; const f32x8_ a = __builtin_shufflevector(t, t, 0, 1, 2, 3, 4, 5, 6, 7) + __builtin_shufflevector(t, t, 8, 9, 10, 11, 12, 13, 14, 15);
      const f32x4 b = __builtin_shufflevector(a, a, 0, 1, 2, 3) + __builtin_shufflevector(a, a, 4, 5, 6, 7); const f32x2_ c = __builtin_shufflevector(b, b, 0, 1) + __builtin_shufflevector(b, b, 2, 3); ps = c.x + c.y; }
    { auto rr = __builtin_amdgcn_permlane32_swap(__float_as_uint(ps), __float_as_uint(ps), false, false);
      ps = __uint_as_float(rr[0]) + __uint_as_float(rr[1]); }
    l_reg = l_reg * alpha + ps;
#define PK4(P, B_, OUT) do { unsigned a0 = cvtpk(P[B_+0], P[B_+1]), a1 = cvtpk(P[B_+2], P[B_+3]);                          \
        unsigned b0 = cvtpk(P[B_+4], P[B_+5]), b1 = cvtpk(P[B_+6], P[B_+7]);                                             \
        auto r0 = __builtin_amdgcn_permlane32_swap(a0, b0, false, false); auto r1 = __builtin_amdgcn_permlane32_swap(a1, b1, false, false); \
        u32x4 w = {r0[0], r1[0], r0[1], r1[1]}; OUT = *reinterpret_cast<bf16x8*>(&w); } while (0)
    PK4(p0, 0, pa0); PK4(p0, 8, pa1); PK4(p1, 0, pa2); PK4(p1, 8, pa3);
#undef PK4
}
template <int KB>
__device__ __forceinline__ void qkt(f32x16& p0, f32x16& p1, const char* K_lds, int r32, int hi, const char* qf, float init) {
#pragma unroll
    for (int r = 0; r < 16; ++r) { p0[r] = init; p1[r] = init; }
    const char* kb[4];
#pragma unroll
    for (int dd = 0; dd < 4; ++dd) kb[dd] = K_lds + KB * SHM_K + KSWZ(r32, (dd * 16 + hi * 8) * 2);
#pragma unroll
    for (int d0 = 0; d0 < 8; ++d0) { const char* a = kb[d0 & 3] + (d0 >> 2) * 128;
        bf16x8 b0 = *reinterpret_cast<const bf16x8*>(a);
        bf16x8 b1 = *reinterpret_cast<const bf16x8*>(a + 32 * 256);
        const bf16x8 qv = *reinterpret_cast<const bf16x8*>(qf + d0 * 1024);
        p0 = __builtin_amdgcn_mfma_f32_32x32x16_bf16(b0, qv, p0, 0, 0, 0);
        p1 = __builtin_amdgcn_mfma_f32_32x32x16_bf16(b1, qv, p1, 0, 0, 0); }
}
template <int VB>
__device__ __forceinline__ void pv_tile(f32x16* o, int vb0, bf16x8 pa0, bf16x8 pa1, bf16x8 pa2, bf16x8 pa3) {
#define TRRD(dst, off) asm volatile("ds_read_b64_tr_b16 %0, %1 offset:%2" : "=&v"(dst) : "v"(vb0), "i"(off) : "memory")
#define PV_D0(d0) do { s16x4 l0, l1, l2, l3, h0, h1, h2, h3; constexpr int b_ = VB * SHM_V + v_rd_off(d0, 0, 0); \
        TRRD(l0, b_); TRRD(h0, b_ + 2048); TRRD(l1, b_ + 4096); TRRD(h1, b_ + 6144); TRRD(l2, b_ + 8192); TRRD(h2, b_ + 10240); TRRD(l3, b_ + 12288); TRRD(h3, b_ + 14336); \
        asm volatile("s_waitcnt lgkmcnt(0)" ::: "memory"); SBAR();   \
        o[d0] = __builtin_amdgcn_mfma_f32_32x32x16_bf16(pa0, (bf16x8){l0[0], l0[1], l0[2], l0[3], h0[0], h0[1], h0[2], h0[3]}, o[d0], 0, 0, 0);   \
        o[d0] = __builtin_amdgcn_mfma_f32_32x32x16_bf16(pa1, (bf16x8){l1[0], l1[1], l1[2], l1[3], h1[0], h1[1], h1[2], h1[3]}, o[d0], 0, 0, 0);   \
        o[d0] = __builtin_amdgcn_mfma_f32_32x32x16_bf16(pa2, (bf16x8){l2[0], l2[1], l2[2], l2[3], h2[0], h2[1], h2[2], h2[3]}, o[d0], 0, 0, 0);   \
        o[d0] = __builtin_amdgcn_mfma_f32_32x32x16_bf16(pa3, (bf16x8){l3[0], l3[1], l3[2], l3[3], h3[0], h3[1], h3[2], h3[3]}, o[d0], 0, 0, 0); } while (0)
    PV_D0(0); PV_D0(1); PV_D0(2); PV_D0(3);
#undef PV_D0
#undef TRRD
}
struct Head { const bf16* Q0; const bf16* K0; const bf16* V0; bf16* O0; const float* km; };
struct Seam { bf16x8 st_v0, st_v1, st_k0, st_k1; };
#define VMW() asm volatile("s_waitcnt vmcnt(0)" ::: "memory")
#define VMWN(n) asm volatile("s_waitcnt vmcnt(%0)" :: "i"(n) : "memory")
#define SLOAD_H(Kp, Vp, k0) do { const bf16* k_ = (Kp) + (size_t)(k0) * Cfg::LDK; const bf16* v_ = (Vp) + (size_t)(k0) * Cfg::LDK; unsigned vo_ = voff; asm volatile("" : "+v"(vo_));     \
                         S.st_v0 = load8(v_ + vo_); S.st_v1 = load8(v_ + 32 * Cfg::LDK + vo_);                                       \
                         S.st_k0 = load8(k_ + vo_); S.st_k1 = load8(k_ + 32 * Cfg::LDK + vo_); } while (0)
#define SWRITE_HK(bf) do { *(bf16x8*)(K_lds + (bf) * SHM_K + kws) = S.st_k0; *(bf16x8*)(K_lds + (bf) * SHM_K + kws + 32 * 256) = S.st_k1; } while (0)
#define SWRITE_HV(bf) do { *(bf16x8*)(V_lds + (bf) * SHM_V + vst0) = S.st_v0; *(bf16x8*)(V_lds + (bf) * SHM_V + vst1) = S.st_v1; } while (0)
#define SWRITE_H(bf) do { SWRITE_HV(bf); SWRITE_HK(bf); } while (0)
template <class Cfg>
__device__ __forceinline__ void prime(const Head& H, int P0, char* lds, Seam& S, const int tid, const int wid) {
    const int lane = tid & 63, r32 = lane & 31, hi = lane >> 5;
    const int sr = tid >> 4, sc = (tid & 15) * 8, kws = KSWZ(sr, sc * 2); char* K_lds = lds + 2 * SHM_V; const unsigned voff = (unsigned)(sr * Cfg::LDK + sc);
    SLOAD_H(H.K0, H.V0, 0);
    { const bf16* qb = H.Q0 + (size_t)(P0 + wid * QBLK) * Cfg::LDQ; const unsigned qoff = (unsigned)(r32 * Cfg::LDQ + hi * 8); char* qf = lds + OFF_Q + wid * 8192 + lane * 16;
      bf16x8 tq[8];
#pragma unroll
      for (int d0 = 0; d0 < 8; ++d0) tq[d0] = load8(qb + qoff + d0 * 16);
      VMW();
#pragma unroll
      for (int d0 = 0; d0 < 8; ++d0) *(bf16x8*)(qf + d0 * 1024) = tq[d0]; }
    SWRITE_HK(0);
    __syncthreads();
}
template <class Cfg>
__device__ __forceinline__ void block(const Head& H, int P0, int P0n, const float* rel_bias, int h, const float* gn, char* lds, Seam& S, const int tid_in, const int wid) {
    int tid = tid_in; asm volatile("" : "+v"(tid));
    const int lane = tid & 63, r32 = lane & 31, hi = lane >> 5;
    const int own = Cfg::MOBA ? (P0 >> 8) : 0;
    const int NT = Cfg::MOBA ? (P0 + QB) / KVBLK : 4;
    const int qlo = P0 + wid * QBLK, qm = qlo + r32 - 4 * hi;
    char* V_lds = lds; char* K_lds = lds + 2 * SHM_V;
    float* ws = (float*)(lds + OFF_WS) + wid * 64; float* li_l = ws, * al_l = ws + 32;
    float* bt = (float*)(lds + OFF_BT);
    char* qf = lds + OFF_Q + wid * 8192 + lane * 16;
    float m_reg = 0.f, l_reg = 0; f32x16 o[4] = {};
    const int sr = tid >> 4, sc = (tid & 15) * 8, vst0 = v_st(sr, sc), vst1 = v_st(32 + sr, sc), kws = KSWZ(sr, sc * 2); const unsigned voff = (unsigned)(sr * Cfg::LDK + sc);
    const int vb0 = (int)(uintptr_t)V_lds + v_rd_base(lane);
    const bf16* Kh = H.K0; const bf16* Vh = H.V0;
    const float b31 = Cfg::MOBA ? rel_bias[31 * 8 + h] : 0.f; const float cinit = b31 * LOG2E;
    if (Cfg::MOBA && tid < 256) { int bk = 31; if (tid < 16) bk = tid; else if (tid < 128) { const int l = 16 + (int)(logf((float)tid * 0.0625f) * 7.694155931f); bk = l < 31 ? l : 31; }
        bt[tid] = (rel_bias[bk * 8 + h] - b31) * LOG2E; }
    if (own >= 4 && tid < 128) { int t_ = tid; asm volatile("" : "+v"(t_));
        const int n = t_ >> 4, c = t_ & 15; const float* kp = H.km + (unsigned)(n * 1024 + c * 8); const f32x4 k0 = *(const f32x4*)kp, k1 = *(const f32x4*)(kp + 4);
        u32x4 w = {cvtpk(k0[0], k0[1]), cvtpk(k0[2], k0[3]), cvtpk(k1[0], k1[1]), cvtpk(k1[2], k1[3])}; *(u32x4*)(lds + OFF_KM + KSWZ(n, c * 16)) = w; }
    int mask = 0;
#define RESC(a) do { if (__any((a) < 1.f)) { if (hi == 0) al_l[r32] = (a); asm volatile("s_waitcnt lgkmcnt(0)" ::: "memory");              \
                     for (int d_ = 0; d_ < 4; ++d_) for (int r = 0; r < 16; ++r) o[d_][r] *= al_l[crow(r, hi)]; } } while (0)
#define KBASE(t) ((t) * KVBLK)
#define MASKT(P0_, P1_, t, SEL0) do { if (Cfg::MOBA) { const int kb_ = KBASE(t); \
        if (qlo - kb_ < 176) bias_tile(P0_, P1_, qm - kb_, bt); \
        if (SEL0 && own >= 4 && kb_ < P0) sel_tile(P0_, P1_, ((mask >> (kb_ >> 8)) & 1) != 0); \
        if (kb_ + KVBLK - 1 > qlo) mask_tile(P0_, P1_, qm - kb_); } } while (0)
#define AINIT(t) ((Cfg::MOBA && own >= 4 && KBASE(t) < P0 && (((mask >> (KBASE(t) >> 8)) & 1) == 0)) ? -__builtin_inff() : cinit - m_reg)
    constexpr int NQL = 8;
#define SEAM_K0() do { VMWN(NQL); SWRITE_HK(0); SBAR(); } while (0)
    f32x16 pA0, pA1, pB0, pB1; float alA, alB; bf16x8 pa0, pa1, pa2, pa3;
    SWRITE_HV(0); SBAR();
    if (NT > 1) { SLOAD_H(Kh, Vh, KBASE(1)); }
    SBAR(); qkt<0>(pA0, pA1, K_lds, r32, hi, qf, cinit);
    __syncthreads();
    if (own >= 4) {
        f32x16 gacc = {};
        const char* kmb[4];
#pragma unroll
        for (int dd = 0; dd < 4; ++dd) kmb[dd] = lds + OFF_KM + KSWZ(r32, (dd * 16 + hi * 8) * 2);
#pragma unroll
        for (int d0 = 0; d0 < 8; ++d0) { const bf16x8 b0 = *reinterpret_cast<const bf16x8*>(kmb[d0 & 3] + (d0 >> 2) * 128); gacc = __builtin_amdgcn_mfma_f32_32x32x16_bf16(b0, *reinterpret_cast<const bf16x8*>(qf + d0 * 1024), gacc, 0, 0, 0); }
        float g[8];
#pragma unroll
        for (int i = 0; i < 4; ++i) { const float mine = gacc[i], oth = __shfl_xor(mine, 32); g[i] = hi ? oth : mine; g[4 + i] = hi ? mine : oth; }
#pragma unroll
        for (int n = 0; n < 7; ++n) { int cnt = 0;
#pragma unroll
            for (int m = 0; m < 7; ++m) cnt += (m != n && m < own && (g[m] > g[n] || (g[m] == g[n] && m < n))) ? 1 : 0;
            mask |= (n < own && cnt < 3) ? (1 << n) : 0; }
    }
    MASKT(pA0, pA1, 0, true); partialSM<true>(pA0, pA1, m_reg, alA);
    if (NT > 1) { VMW(); SWRITE_HK(1); }
    __syncthreads();
#define HALF_STEP(PX0, PX1, alX, PY0, PY1, alY, t, KB, VB, SB) do {                                                      \
        SWRITE_HV(KB); SBAR();                                                                                                \
        if ((t) + 1 < NT) { SLOAD_H(Kh, Vh, KBASE((t) + 1)); SBAR(); }                                               \
        SBAR(); qkt<KB>(PX0, PX1, K_lds, r32, hi, qf, AINIT(t));                                          \
        finishSM(PY0, PY1, alY, l_reg, pa0, pa1, pa2, pa3); SBAR();                                                           \
        pv_tile<VB>(o, vb0, pa0, pa1, pa2, pa3); MASKT(PX0, PX1, (t), false); partialSM<false>(PX0, PX1, m_reg, alX);                                        \
        if ((t) + 1 < NT) { VMW(); SWRITE_HK(SB); }                                                                         \
        RESC(alX); __syncthreads(); } while (0)
    for (int t = 1; t + 1 < NT; t += 2) {
        HALF_STEP(pB0, pB1, alB, pA0, pA1, alA, t, 1, 0, 0);
        HALF_STEP(pA0, pA1, alA, pB0, pB1, alB, t + 1, 0, 1, 1);
    }
    SWRITE_HV(1); SBAR();
    { SBAR(); qkt<1>(pB0, pB1, K_lds, r32, hi, qf, AINIT(NT - 1)); SBAR(); }
    SLOAD_H(Kh, Vh, 0); SBAR();
    bf16x8 tq[8];
    { const bf16* qb = H.Q0 + (size_t)(P0n + wid * QBLK) * Cfg::LDQ; unsigned qoff = (unsigned)(r32 * Cfg::LDQ + hi * 8); asm volatile("" : "+v"(qoff));
#pragma unroll
      for (int d0 = 0; d0 < 8; ++d0) tq[d0] = load8(qb + qoff + d0 * 16); }
    SBAR();
    finishSM(pA0, pA1, alA, l_reg, pa0, pa1, pa2, pa3); SBAR();
    pv_tile<0>(o, vb0, pa0, pa1, pa2, pa3);
    { MASKT(pB0, pB1, NT - 1, false); partialSM<false>(pB0, pB1, m_reg, alB); __syncthreads(); RESC(alB);
      finishSM(pB0, pB1, alB, l_reg, pa0, pa1, pa2, pa3); SBAR(); pv_tile<1>(o, vb0, pa0, pa1, pa2, pa3); }
    SBAR(); SEAM_K0();
    if (hi == 0) li_l[r32] = l_reg; asm volatile("s_waitcnt lgkmcnt(0)" ::: "memory");
    float gnr[4];
    { unsigned go_ = (unsigned)r32; asm volatile("" : "+v"(go_));
#pragma unroll
      for (int d0 = 0; d0 < 4; ++d0) gnr[d0] = Cfg::MOBA ? (gn + go_)[d0 * 32] : 1.0f; }
    bf16* Ow = H.O0 + (size_t)(P0 + wid * QBLK) * Cfg::LDO;
#pragma unroll
    for (int r = 0; r < 16; ++r) { int orow = crow(r, hi); asm volatile("" : "+v"(orow));
        const float rl = __builtin_amdgcn_rcpf(li_l[orow]);
        float v0 = o[0][r] * rl, v1 = o[1][r] * rl, v2 = o[2][r] * rl, v3 = o[3][r] * rl;
        float ss = (v0 * v0 + v1 * v1) + (v2 * v2 + v3 * v3);
        ss += __shfl_xor(ss, 1); ss += __shfl_xor(ss, 2); ss += __shfl_xor(ss, 4); ss += __shfl_xor(ss, 8); ss += __shfl_xor(ss, 16);
        if (Cfg::MOBA) { const float rs = rsqrtf(ss * (1.0f / 128.0f) + 1e-6f); v0 *= rs * gnr[0]; v1 *= rs * gnr[1]; v2 *= rs * gnr[2]; v3 *= rs * gnr[3]; }
        const float n0 = __shfl_xor(v0, 1), n1 = __shfl_xor(v1, 1), n2 = __shfl_xor(v2, 1), n3 = __shfl_xor(v3, 1);
        if ((r32 & 1) == 0) { bf16* op = Ow + (unsigned)(orow * Cfg::LDO + r32);
            *(unsigned*)(op) = cvtpk(v0, n0); *(unsigned*)(op + 32) = cvtpk(v1, n1); *(unsigned*)(op + 64) = cvtpk(v2, n2); *(unsigned*)(op + 96) = cvtpk(v3, n3); } }
    VMW();
#pragma unroll
    for (int d0 = 0; d0 < 8; ++d0) *(bf16x8*)(qf + d0 * 1024) = tq[d0];
    __syncthreads();
#undef RESC
#undef KBASE
#undef MASKT
#undef AINIT
#undef SEAM_K0
#undef HALF_STEP
}
#undef ROW
#undef VMW
#undef VMWN
#undef SLOAD_H
#undef SWRITE_HK
#undef SWRITE_HV
#undef SWRITE_H
#undef KSWZ
#undef SBAR
}

namespace gdn {
typedef short bf16x8 __attribute__((ext_vector_type(8)));
typedef float f32x16 __attribute__((ext_vector_type(16)));
typedef float f32x4 __attribute__((ext_vector_type(4)));
typedef unsigned u32x4 __attribute__((ext_vector_type(4)));
typedef unsigned u32x2 __attribute__((ext_vector_type(2)));
typedef _Float16 f16x4 __attribute__((ext_vector_type(4)));
typedef _Float16 f16x8 __attribute__((ext_vector_type(8)));
#define GLAS __attribute__((address_space(3)))
constexpr int IMG_BYTES = 75776, IMG_W = 0, IMG_U = 16384, IMG_QD = 32768, IMG_KDT = 49152, IMG_QK = 65536, IMG_GL = 73728;
constexpr int IMG_IN_OUT = 1771;
__device__ __forceinline__ int sw256(int row, int cb) { return row * 256 + (cb ^ ((row & 15) << 4)); }
__device__ __forceinline__ int sw128(int row, int cb) { return row * 128 + (cb ^ (((row >> 1) & 7) << 4)); }
__device__ __forceinline__ unsigned cvtpk(float lo, float hi) { unsigned r; asm volatile("v_cvt_pk_bf16_f32 %0, %1, %2" : "=v"(r) : "v"(lo), "v"(hi)); return r; }
__device__ __forceinline__ float bfl(unsigned w) { return __uint_as_float(w << 16); }
__device__ __forceinline__ float bfh(unsigned w) { return __uint_as_float(w & 0xffff0000u); }
__device__ __forceinline__ unsigned char* img_ptr(unsigned char* out_bytes, unsigned char* ws_img, int chunk) {
    return chunk < IMG_IN_OUT ? out_bytes + (size_t)chunk * IMG_BYTES : ws_img + (size_t)(chunk - IMG_IN_OUT) * IMG_BYTES;
}
#define LBAR() asm volatile("s_waitcnt lgkmcnt(0)\n\ts_barrier" ::: "memory")
#define MFMA32(a, b, c) __builtin_amdgcn_mfma_f32_32x32x16_bf16((a), (b), (c), 0, 0, 0)

constexpr int RAWP = 784;
__device__ __forceinline__ void conv16(float (&a)[16], const GLAS unsigned char* rp, const GLAS float* wl) {
    typedef float f32x2 __attribute__((ext_vector_type(2)));
    f32x2 acc[8];
#pragma unroll
    for (int p = 0; p < 8; ++p) acc[p] = (f32x2){0.f, 0.f};
#pragma unroll
    for (int j = 0; j < 4; ++j) { const u32x4 x0 = *(const GLAS u32x4*)(rp + j * RAWP), x1 = *(const GLAS u32x4*)(rp + j * RAWP + 16);
        const GLAS f32x2* wv = (const GLAS f32x2*)(wl + j * 384);
        const unsigned xw[8] = {x0.x, x0.y, x0.z, x0.w, x1.x, x1.y, x1.z, x1.w};
#pragma unroll
        for (int p = 0; p < 8; ++p) { const f32x2 xv = {bfl(xw[p]), bfh(xw[p])}; acc[p] = __builtin_elementwise_fma(wv[p], xv, acc[p]); }
        __builtin_amdgcn_sched_barrier(0); }
#pragma unroll
    for (int p = 0; p < 8; ++p) { a[2 * p] = acc[p].x; a[2 * p + 1] = acc[p].y; }
#pragma unroll
    for (int e = 0; e < 16; ++e) a[e] = a[e] * __builtin_amdgcn_rcpf(1.0f + __expf(-a[e]));
}
__device__ __forceinline__ void raw_load(u32x4 (&rg)[7], const unsigned short* proj, int b, int h, int n, int tid) {
#pragma unroll
    for (int kq = 0; kq < 7; ++kq) { int p = tid + 512 * kq; p = p < 3216 ? p : 3215; const int r = p / 48, q = p - r * 48, pos = n * 64 - 3 + r, posc = pos < 0 ? 0 : pos;
        const u32x4 v = __builtin_nontemporal_load((const u32x4*)(proj + ((size_t)b * 2048 + posc) * 7232 + (q >> 4) * 1024 + h * 128 + (q & 15) * 8));
        rg[kq] = pos < 0 ? (u32x4){0u, 0u, 0u, 0u} : v; }
}
__device__ __forceinline__ void raw_store(const u32x4 (&rg)[7], GLAS unsigned char* raw, int tid) {
#pragma unroll
    for (int kq = 0; kq < 7; ++kq) { const int p = tid + 512 * kq; const int r = p / 48, q = p - r * 48; if (p < 3216) *(GLAS u32x4*)(raw + r * RAWP + q * 16) = rg[kq]; }
}
typedef _Float16 f16x2 __attribute__((ext_vector_type(2)));
template <int I, int K8> __device__ __forceinline__ void inv_k8(float& acc, float& acc1, const float (&tc)[64], const f16x2 (&tn)[32], const GLAS unsigned char* slot) {
    if constexpr (K8 * 8 < I) { const f16x8 av = *(const GLAS f16x8*)(slot + I * 128 + K8 * 16);
#pragma unroll
        for (int p = 0; p < 4; ++p) { const int k = K8 * 8 + 2 * p;
            if (k + 1 < I) { if (p & 1) acc1 = __builtin_amdgcn_fdot2((f16x2){av[2 * p], av[2 * p + 1]}, tn[k >> 1], acc1, false); else acc = __builtin_amdgcn_fdot2((f16x2){av[2 * p], av[2 * p + 1]}, tn[k >> 1], acc, false); }
            else if (k < I) acc1 -= (float)av[2 * p] * tc[k]; }
        inv_k8<I, K8 + 1>(acc, acc1, tc, tn, slot); }
}
template <int I> __device__ __forceinline__ void inv_row(float (&tc)[64], f16x2 (&tn)[32], const GLAS unsigned char* slot, int lane) {
    if constexpr (I < 64) { float acc = (I == lane) ? 1.0f : 0.0f, acc1 = 0.f; inv_k8<I, 0>(acc, acc1, tc, tn, slot); acc += acc1; tc[I] = acc;
        if constexpr (I & 1) tn[I >> 1] = (f16x2){(_Float16)(-tc[I - 1]), (_Float16)(-acc)};
        __builtin_amdgcn_sched_barrier(0);
        inv_row<I + 1>(tc, tn, slot, lane); }
}
__device__ __forceinline__ void prep(GLAS unsigned char* L, int tid, int lane, int wave, int wg, const unsigned short* proj, const float* beta, const float* gg, const float* conv_w,
                                     unsigned char* out_bytes, unsigned char* ws_img, unsigned char* scr) {
    const int r32 = lane & 31, hi = lane >> 5;
    const int bh = wg >> 2, b = bh >> 3, h = bh & 7, cg0 = (wg & 3) * 8;
    GLAS unsigned char* Kt = L; GLAS unsigned char* Qt = L + 16384; GLAS unsigned char* Vt = L + 32768;
    GLAS unsigned char* raw = L;
    GLAS float* Gs = (GLAS float*)(L + 53248); GLAS float* Bs = Gs + 64; GLAS float* gls = Gs + 128; GLAS float* cwL = Gs + 192;
    GLAS float* eRs = Gs + 192 + 1536; GLAS float* bgs = eRs + 64;
    GLAS unsigned char* As = L + 61440;
    for (int i = tid; i < 1536; i += 512) { const int j = i / 384, rem = i - j * 384; cwL[i] = conv_w[j * 3072 + (rem >> 7) * 1024 + h * 128 + (rem & 127)]; }
    u32x4 rg[7];
    raw_load(rg, proj, b, h, cg0, tid);
    float gpf = gg[((size_t)b * 2048 + cg0 * 64 + lane) * 8 + h], bpf = beta[((size_t)b * 2048 + cg0 * 64 + (tid >> 3)) * 8 + h];
    __syncthreads();
#pragma unroll 1
    for (int c = 0; c < 8; ++c) {
        int tt_ = tid; asm volatile("" : "+v"(tt_));
        const int t = tt_ >> 3, seg = tt_ & 7;
        const int n = cg0 + c, chunk = bh * 32 + n, pos = n * 64 + t; const size_t row = (size_t)b * 2048 + pos;
        unsigned char* img = img_ptr(out_bytes, ws_img, chunk);
        unsigned short* vbt = (unsigned short*)(scr + (size_t)chunk * 32768); unsigned short* kgt = vbt + 8192;
        raw_store(rg, raw, tid);
        if (wave == 0) { float g = gpf;
#pragma unroll
            for (int o = 1; o < 64; o <<= 1) { const float y = __shfl_up(g, o); if (lane >= o) g += y; }
            Gs[lane] = g; if (lane == 63) gls[c] = g; }
        if (seg == 0) Bs[t] = bpf;
        LBAR();
        const float G = Gs[t], GL = Gs[63], eG = __expf(G), eR = __expf(GL - G), bt = Bs[t], bg = bt * eG;
        float xq[16], xk[16], xv[16];
        { const GLAS unsigned char* rp = raw + t * RAWP + seg * 32;
          conv16(xq, rp, cwL + seg * 16); conv16(xk, rp + 256, cwL + 128 + seg * 16); conv16(xv, rp + 512, cwL + 256 + seg * 16); }
        { float sq = 0.f, sk = 0.f;
#pragma unroll
          for (int e = 0; e < 16; ++e) { sq += xq[e] * xq[e]; sk += xk[e] * xk[e]; }
          sq += __shfl_xor(sq, 1); sq += __shfl_xor(sq, 2); sq += __shfl_xor(sq, 4); sk += __shfl_xor(sk, 1); sk += __shfl_xor(sk, 2); sk += __shfl_xor(sk, 4);
          const float nq = rsqrtf(sq + 1e-6f) * 0.08838834764831845f, nk = rsqrtf(sk + 1e-6f);
#pragma unroll
          for (int e = 0; e < 16; ++e) { xq[e] *= nq; xk[e] *= nk; xv[e] *= bt; } }
        LBAR();
        { u32x4 w0, w1;
          w0 = (u32x4){cvtpk(xv[0], xv[1]), cvtpk(xv[2], xv[3]), cvtpk(xv[4], xv[5]), cvtpk(xv[6], xv[7])}; w1 = (u32x4){cvtpk(xv[8], xv[9]), cvtpk(xv[10], xv[11]), cvtpk(xv[12], xv[13]), cvtpk(xv[14], xv[15])};
          *(GLAS u32x4*)(Vt + sw256(t, seg * 32)) = w0; *(GLAS u32x4*)(Vt + sw256(t, seg * 32 + 16)) = w1;
          w0 = (u32x4){cvtpk(xk[0], xk[1]), cvtpk(xk[2], xk[3]), cvtpk(xk[4], xk[5]), cvtpk(xk[6], xk[7])}; w1 = (u32x4){cvtpk(xk[8], xk[9]), cvtpk(xk[10], xk[11]), cvtpk(xk[12], xk[13]), cvtpk(xk[14], xk[15])};
          *(GLAS u32x4*)(Kt + sw256(t, seg * 32)) = w0; *(GLAS u32x4*)(Kt + sw256(t, seg * 32 + 16)) = w1;
          w0 = (u32x4){cvtpk(xq[0], xq[1]), cvtpk(xq[2], xq[3]), cvtpk(xq[4], xq[5]), cvtpk(xq[6], xq[7])}; w1 = (u32x4){cvtpk(xq[8], xq[9]), cvtpk(xq[10], xq[11]), cvtpk(xq[12], xq[13]), cvtpk(xq[14], xq[15])};
          *(GLAS u32x4*)(Qt + sw256(t, seg * 32)) = w0; *(GLAS u32x4*)(Qt + sw256(t, seg * 32 + 16)) = w1;
          w0 = (u32x4){cvtpk(xq[0] * eG, xq[1] * eG), cvtpk(xq[2] * eG, xq[3] * eG), cvtpk(xq[4] * eG, xq[5] * eG), cvtpk(xq[6] * eG, xq[7] * eG)};
          w1 = (u32x4){cvtpk(xq[8] * eG, xq[9] * eG), cvtpk(xq[10] * eG, xq[11] * eG), cvtpk(xq[12] * eG, xq[13] * eG), cvtpk(xq[14] * eG, xq[15] * eG)};
          *(u32x4*)(img + IMG_QD + sw256(t, seg * 32)) = w0; *(u32x4*)(img + IMG_QD + sw256(t, seg * 32 + 16)) = w1; }
        if (seg == 0) { eRs[t] = eR; bgs[t] = bg; }
        raw_load(rg, proj, b, h, n < 31 ? n + 1 : n, tid);
        { const int n1 = n < 31 ? n + 1 : n; gpf = gg[((size_t)b * 2048 + n1 * 64 + (tt_ & 63)) * 8 + h]; bpf = beta[((size_t)b * 2048 + n1 * 64 + t) * 8 + h]; }
        LBAR();
        { const int prod = wave >> 2, mj = (wave >> 1) & 1, ni = wave & 1;
          f32x16 acc = {};
          if (!(mj == 1 && ni == 0)) { GLAS unsigned char* Xb = prod ? Qt : Kt;
#pragma unroll
              for (int s = 0; s < 8; ++s) { const bf16x8 a = *(const GLAS bf16x8*)(Kt + sw256(mj * 32 + r32, (16 * s + 8 * hi) * 2)); const bf16x8 bb = *(const GLAS bf16x8*)(Xb + sw256(ni * 32 + r32, (16 * s + 8 * hi) * 2));
                  acc = MFMA32(a, bb, acc); } }
          const int i = ni * 32 + r32; const float Gi = Gs[i], bi = prod ? 1.0f : Bs[i];
#pragma unroll
          for (int g4 = 0; g4 < 4; ++g4) { const int j0 = mj * 32 + 8 * g4 + 4 * hi; float v[4];
#pragma unroll
              for (int e = 0; e < 4; ++e) { const int j = j0 + e; const bool ok = prod ? (j <= i) : (j < i); const float d = ok ? __expf(Gi - Gs[j]) * bi : 0.f; v[e] = ok ? acc[4 * g4 + e] * d : 0.f; }
              if (prod == 0) { f16x4 hv = {(_Float16)v[0], (_Float16)v[1], (_Float16)v[2], (_Float16)v[3]}; *(GLAS f16x4*)(As + c * 8192 + i * 128 + j0 * 2) = hv; }
              else { u32x2 w = {cvtpk(v[0], v[1]), cvtpk(v[2], v[3])}; *(u32x2*)(img + IMG_QK + sw128(i, j0 * 2)) = w; } } }
        { const int ch = tt_ >> 2, tq = tt_ & 3; float kk[16], vk[16];
#pragma unroll
          for (int e = 0; e < 16; ++e) { const int tk = tq * 16 + e; kk[e] = bfl(*(const GLAS unsigned short*)(Kt + sw256(tk, ch * 2))); vk[e] = bfl(*(const GLAS unsigned short*)(Vt + sw256(tk, ch * 2))); }
          unsigned wa[8], wb[8], wc[8];
#pragma unroll
          for (int p = 0; p < 8; ++p) { const int t0 = tq * 16 + 2 * p; wa[p] = cvtpk(kk[2 * p] * eRs[t0], kk[2 * p + 1] * eRs[t0 + 1]); wb[p] = cvtpk(kk[2 * p] * bgs[t0], kk[2 * p + 1] * bgs[t0 + 1]); wc[p] = cvtpk(vk[2 * p], vk[2 * p + 1]); }
          *(u32x4*)(img + IMG_KDT + sw128(ch, tq * 32)) = (u32x4){wa[0], wa[1], wa[2], wa[3]}; *(u32x4*)(img + IMG_KDT + sw128(ch, tq * 32 + 16)) = (u32x4){wa[4], wa[5], wa[6], wa[7]};
          *(u32x4*)(kgt + ch * 64 + tq * 16) = (u32x4){wb[0], wb[1], wb[2], wb[3]}; *(u32x4*)(kgt + ch * 64 + tq * 16 + 8) = (u32x4){wb[4], wb[5], wb[6], wb[7]};
          *(u32x4*)(vbt + ch * 64 + tq * 16) = (u32x4){wc[0], wc[1], wc[2], wc[3]}; *(u32x4*)(vbt + ch * 64 + tq * 16 + 8) = (u32x4){wc[4], wc[5], wc[6], wc[7]}; }
        LBAR();
    }
    GLAS unsigned char* slot = As + wave * 8192;
    int lane2 = lane; asm volatile("" : "+v"(lane2));
    const int r32b = lane2 & 31, hib = lane2 >> 5;
    { float tc[64]; f16x2 tn[32];
      inv_row<0>(tc, tn, slot, lane2);
      asm volatile("s_waitcnt lgkmcnt(0)" ::: "memory");
#pragma unroll
      for (int i = 0; i < 64; ++i) *(GLAS unsigned short*)(slot + sw128(i, lane2 * 2)) = (unsigned short)(cvtpk(tc[i], 0.f) & 0xffffu); }
    asm volatile("s_waitcnt vmcnt(0) lgkmcnt(0)" ::: "memory");
    __syncthreads();
    { const int chunk = bh * 32 + cg0 + wave; unsigned char* img = img_ptr(out_bytes, ws_img, chunk);
      const unsigned short* vbt = (const unsigned short*)(scr + (size_t)chunk * 32768); const unsigned short* kgt = vbt + 8192;
      bf16x8 gf[4][4], gk[4][4];
#pragma unroll
      for (int dvt = 0; dvt < 4; ++dvt)
#pragma unroll
          for (int s = 0; s < 4; ++s) gf[dvt][s] = *(const bf16x8*)(vbt + (dvt * 32 + r32b) * 64 + 16 * s + 8 * hib);
#pragma unroll
      for (int dkt = 0; dkt < 4; ++dkt)
#pragma unroll
          for (int s = 0; s < 4; ++s) gk[dkt][s] = *(const bf16x8*)(kgt + (dkt * 32 + r32b) * 64 + 16 * s + 8 * hib);
#pragma unroll
      for (int tile = 0; tile < 8; ++tile) { const int ti = tile >> 2, dvt = tile & 3; f32x16 acc = {};
#pragma unroll
          for (int s = 0; s < 4; ++s) { if (s < 2 * (ti + 1)) { const bf16x8 a = *(const GLAS bf16x8*)(slot + sw128(ti * 32 + r32b, (16 * s + 8 * hib) * 2)); acc = MFMA32(a, gf[dvt][s], acc); } }
          u32x4 w0 = {pg8::cvt_pk_bf16_acc(acc[0], acc[1]), pg8::cvt_pk_bf16_acc(acc[2], acc[3]), pg8::cvt_pk_bf16_acc(acc[4], acc[5]), pg8::cvt_pk_bf16_acc(acc[6], acc[7])}, w1 = {pg8::cvt_pk_bf16_acc(acc[8], acc[9]), pg8::cvt_pk_bf16_acc(acc[10], acc[11]), pg8::cvt_pk_bf16_acc(acc[12], acc[13]), pg8::cvt_pk_bf16_acc(acc[14], acc[15])};
          *(u32x4*)(img + IMG_U + tile * 2048 + lane2 * 32) = w0; *(u32x4*)(img + IMG_U + tile * 2048 + lane2 * 32 + 16) = w1; }
#pragma unroll
      for (int tile = 0; tile < 8; ++tile) { const int dkt = tile >> 1, ni = tile & 1; f32x16 acc = {};
#pragma unroll
          for (int s = 0; s < 4; ++s) { if (s < 2 * (ni + 1)) { const bf16x8 bb = *(const GLAS bf16x8*)(slot + sw128(ni * 32 + r32b, (16 * s + 8 * hib) * 2)); acc = MFMA32(gk[dkt][s], bb, acc); } }
          { const unsigned a0 = pg8::cvt_pk_bf16_acc(acc[0], acc[1]), a1 = pg8::cvt_pk_bf16_acc(acc[2], acc[3]), b0 = pg8::cvt_pk_bf16_acc(acc[4], acc[5]), b1 = pg8::cvt_pk_bf16_acc(acc[6], acc[7]);
            const auto r0 = __builtin_amdgcn_permlane32_swap(a0, b0, false, false), r1 = __builtin_amdgcn_permlane32_swap(a1, b1, false, false);
            *(u32x4*)(img + IMG_W + ((ni * 8 + 2 * dkt) * 64 + lane2) * 16) = (u32x4){r0[0], r1[0], r0[1], r1[1]}; }
          { const unsigned a0 = pg8::cvt_pk_bf16_acc(acc[8], acc[9]), a1 = pg8::cvt_pk_bf16_acc(acc[10], acc[11]), b0 = pg8::cvt_pk_bf16_acc(acc[12], acc[13]), b1 = pg8::cvt_pk_bf16_acc(acc[14], acc[15]);
            const auto r0 = __builtin_amdgcn_permlane32_swap(a0, b0, false, false), r1 = __builtin_amdgcn_permlane32_swap(a1, b1, false, false);
            *(u32x4*)(img + IMG_W + ((ni * 8 + 2 * dkt + 1) * 64 + lane2) * 16) = (u32x4){r0[0], r1[0], r0[1], r1[1]}; } }
      if (lane2 == 0) *(float*)(img + IMG_GL) = __expf(gls[wave]); }
}

__device__ __forceinline__ void scan(GLAS unsigned char* L, int tid, int lane, int wave, int bh, unsigned char* out_bytes, unsigned char* ws_img, const unsigned short* proj, const float* gn, unsigned short* ob) {
    const int r32 = lane & 31, hi = lane >> 5, b = bh >> 3, h = bh & 7;
    GLAS unsigned char* ST = L + 75776; GLAS unsigned char* VNT = L + 108544; GLAS float* RED = (GLAS float*)(L + 124928); GLAS float* OT = (GLAS float*)L;
    const int ti = wave >> 2, dvt = wave & 3, dk0t = 2 * (wave >> 2);
    f32x16 s0 = {}, s1 = {};
    for (int i = tid; i < 2048; i += 512) ((GLAS u32x4*)ST)[i] = (u32x4){0u, 0u, 0u, 0u};
    const int tok = tid & 63, part = wave;
    float gnr[16];
#pragma unroll
    for (int e = 0; e < 16; ++e) gnr[e] = gn[part * 16 + e];
    u32x4 pf[10];
    { const u32x4* img0 = (const u32x4*)img_ptr(out_bytes, ws_img, bh * 32);
#pragma unroll
      for (int i = 0; i < 10; ++i) { const int p = tid + 512 * i; pf[i] = img0[p < 4624 ? p : 4623]; } }
#pragma unroll 1
    for (int n = 0; n < 32; ++n) {
#pragma unroll
        for (int i = 0; i < 10; ++i) { const int p = tid + 512 * i; if (p < 4624) ((GLAS u32x4*)L)[p] = pf[i]; }
        LBAR();
        { const u32x4* imgn = (const u32x4*)img_ptr(out_bytes, ws_img, bh * 32 + (n < 31 ? n + 1 : n));
#pragma unroll
          for (int i = 0; i < 10; ++i) { const int p = tid + 512 * i; pf[i] = imgn[p < 4624 ? p : 4623]; } }
        const size_t row = (size_t)b * 2048 + n * 64 + tok;
        const unsigned short* zp = proj + row * 7232 + 3072 + h * 128 + part * 16; const u32x4 z0 = *(const u32x4*)zp, z1 = *(const u32x4*)(zp + 8);
        { f32x16 acc = {};
#pragma unroll
          for (int s = 0; s < 8; ++s) { const bf16x8 a = *(const GLAS bf16x8*)(L + IMG_W + ((ti * 8 + s) * 64 + lane) * 16); const bf16x8 bb = *(const GLAS bf16x8*)(ST + sw256(dvt * 32 + r32, (16 * s + 8 * hi) * 2)); acc = MFMA32(a, bb, acc); }
          const u32x4 u0 = *(const GLAS u32x4*)(L + IMG_U + wave * 2048 + lane * 32), u1 = *(const GLAS u32x4*)(L + IMG_U + wave * 2048 + lane * 32 + 16);
          const unsigned uw[8] = {u0.x, u0.y, u0.z, u0.w, u1.x, u1.y, u1.z, u1.w};
#pragma unroll
          for (int g4 = 0; g4 < 4; ++g4) { const float v0 = bfl(uw[2 * g4]) - acc[4 * g4], v1 = bfh(uw[2 * g4]) - acc[4 * g4 + 1], v2 = bfl(uw[2 * g4 + 1]) - acc[4 * g4 + 2], v3 = bfh(uw[2 * g4 + 1]) - acc[4 * g4 + 3];
              u32x2 w = {cvtpk(v0, v1), cvtpk(v2, v3)}; *(GLAS u32x2*)(VNT + sw128(dvt * 32 + r32, (ti * 32 + 8 * g4 + 4 * hi) * 2)) = w; } }
        LBAR();
        { f32x16 acc = {};
#pragma unroll
          for (int s = 0; s < 8; ++s) { const bf16x8 a = *(const GLAS bf16x8*)(L + IMG_QD + sw256(ti * 32 + r32, (16 * s + 8 * hi) * 2)); const bf16x8 bb = *(const GLAS bf16x8*)(ST + sw256(dvt * 32 + r32, (16 * s + 8 * hi) * 2)); acc = MFMA32(a, bb, acc); }
#pragma unroll
          for (int s = 0; s < 4; ++s) { if (s < 2 * (ti + 1)) { const bf16x8 a = *(const GLAS bf16x8*)(L + IMG_QK + sw128(ti * 32 + r32, (16 * s + 8 * hi) * 2)); const bf16x8 bb = *(const GLAS bf16x8*)(VNT + sw128(dvt * 32 + r32, (16 * s + 8 * hi) * 2)); acc = MFMA32(a, bb, acc); } }
#pragma unroll
          for (int g4 = 0; g4 < 4; ++g4) { const f32x4 w = {acc[4 * g4], acc[4 * g4 + 1], acc[4 * g4 + 2], acc[4 * g4 + 3]}; const int dv = dvt * 32 + r32, chk = ti * 8 + 2 * g4 + hi;
              *(GLAS f32x4*)(OT + dv * 64 + ((chk ^ (dv & 15)) << 2)) = w; } }
        LBAR();
        float ov[16]; float ss = 0.f;
#pragma unroll
        for (int e = 0; e < 16; ++e) { const int dv = part * 16 + e; ov[e] = OT[dv * 64 + ((((tok >> 2) ^ (dv & 15)) << 2) | (tok & 3))]; ss += ov[e] * ov[e]; }
        RED[part * 64 + tok] = ss;
        { const float gl = *(const GLAS float*)(L + IMG_GL);
          s0 = s0 * gl; s1 = s1 * gl;
#pragma unroll
          for (int s = 0; s < 4; ++s) { const bf16x8 bb = *(const GLAS bf16x8*)(VNT + sw128(dvt * 32 + r32, (16 * s + 8 * hi) * 2));
              const bf16x8 a0 = *(const GLAS bf16x8*)(L + IMG_KDT + sw128(dk0t * 32 + r32, (16 * s + 8 * hi) * 2)), a1 = *(const GLAS bf16x8*)(L + IMG_KDT + sw128(dk0t * 32 + 32 + r32, (16 * s + 8 * hi) * 2));
              s0 = MFMA32(a0, bb, s0); s1 = MFMA32(a1, bb, s1); }
#pragma unroll
          for (int g4 = 0; g4 < 4; ++g4) { u32x2 w = {pg8::cvt_pk_bf16_acc(s0[4 * g4], s0[4 * g4 + 1]), pg8::cvt_pk_bf16_acc(s0[4 * g4 + 2], s0[4 * g4 + 3])}; *(GLAS u32x2*)(ST + sw256(dvt * 32 + r32, (dk0t * 32 + 8 * g4 + 4 * hi) * 2)) = w;
              u32x2 w2 = {pg8::cvt_pk_bf16_acc(s1[4 * g4], s1[4 * g4 + 1]), pg8::cvt_pk_bf16_acc(s1[4 * g4 + 2], s1[4 * g4 + 3])}; *(GLAS u32x2*)(ST + sw256(dvt * 32 + r32, (dk0t * 32 + 32 + 8 * g4 + 4 * hi) * 2)) = w2; } }
        LBAR();
        { float tot = 0.f;
#pragma unroll
          for (int p = 0; p < 8; ++p) tot += RED[p * 64 + tok];
          const float rs = rsqrtf(tot * (1.0f / 128.0f) + 1e-6f);
          const unsigned zw[8] = {z0.x, z0.y, z0.z, z0.w, z1.x, z1.y, z1.z, z1.w}; unsigned res[8];
#pragma unroll
          for (int k = 0; k < 8; ++k) res[k] = cvtpk(ov[2 * k] * rs * gnr[2 * k] * bfl(zw[k]), ov[2 * k + 1] * rs * gnr[2 * k + 1] * bfh(zw[k]));
          unsigned short* op = ob + row * 2048 + h * 128 + part * 16;
          *(u32x4*)op = (u32x4){res[0], res[1], res[2], res[3]}; *(u32x4*)(op + 8) = (u32x4){res[4], res[5], res[6], res[7]}; }
        LBAR();
    }
}
#undef MFMA32
#undef LBAR
#undef GLAS
}

constexpr int NB = 8, SEQ = 2048, DM = 2048, MTOK = NB * SEQ;
constexpr int HD = 128, NPROJ = 7168, PROJ_LD = 7232;
constexpr int DFF = 5632, MEMLEN = 256, MROWS = NB * MEMLEN, XW = 512;
constexpr float EPS = 1e-6f;
constexpr int NWAVES = 8, NTHREADS = 512;
constexpr int LDS_BYTES = 147456;
constexpr int LDS_MISC = 147200;
constexpr int CW_BAR = 4096;

constexpr size_t MiB = 1u << 20;
constexpr size_t WS_RSQ2 = 768 * 1024, WS_RSQ3 = 832 * 1024, WS_RSQ4 = 896 * 1024;
constexpr size_t WS_KMEAN = 512 * 1024;
constexpr size_t WS_WGU = 1 * MiB, WS_WDOWN = 23 * MiB, WS_X2Q = 34 * MiB, WS_SMALL = 67 * MiB, WS_XB = 70 * MiB;
constexpr float WGU_SCALE = 32.0f, WDOWN_SCALE = 64.0f;
constexpr size_t WS_GATE = 134 * MiB;
constexpr size_t WS_WINB = 142 * MiB;
constexpr size_t WS_WIN = 134 * MiB, WS_PROJ = 162 * MiB, WS_O = 388 * MiB;
constexpr size_t WS_QX = 162 * MiB, WS_OX = 178 * MiB, WS_KVX = 194 * MiB;
constexpr size_t WS_WXQ = 486 * MiB, WS_WXKV = 488 * MiB, WS_WXO = 492 * MiB, WS_WOUT = 494 * MiB, WS_MEMB = 502 * MiB, WS_END = 510 * MiB;
constexpr size_t SM_RSTD1 = 0, SM_RSTD2 = 65536, SM_RSTD3 = 131072, SM_RSTDM = 196608, SM_W16 = 262144, SM_KMEAN = 327680, SM_BETA = 1 * MiB, SM_G = 1 * MiB + 524288;

#define LAS __attribute__((address_space(3)))
typedef unsigned short bf16_t;
typedef float f32x4 __attribute__((ext_vector_type(4)));
typedef unsigned u32x4 __attribute__((ext_vector_type(4)));
typedef unsigned u32x2 __attribute__((ext_vector_type(2)));

__device__ __forceinline__ float bf2f(unsigned v) { return __uint_as_float(v << 16); }
__device__ __forceinline__ unsigned f2bf(float f) { unsigned u = __float_as_uint(f); return (u + 0x7fffu + ((u >> 16) & 1u)) >> 16; }
__device__ __forceinline__ unsigned pk2(float lo, float hi) { return f2bf(lo) | (f2bf(hi) << 16); }
__device__ __forceinline__ float wave_sum(float v) {
#pragma unroll
    for (int o = 1; o < 64; o <<= 1) v += __shfl_xor(v, o);
    return v;
}
__device__ __forceinline__ float silu_acc(float v) { return v * __builtin_amdgcn_rcpf(1.0f + __expf(-v)); }

#define XB_TMO      128
#define XB_XCNT(j)  (256  + 64 * (j))
#define XB_XSUB(j)  (1280 + 64 * (j))
#define XB_XGEN(j)  (2304 + 64 * (j))
#define XB_TOP      3328
#define XB_TOPGEN   3392
#define XCD_BAR_WORDS 3456
#define XB_SPIN_CAP (1u << 18)

__device__ __forceinline__ unsigned xb_ld(unsigned* p)              { return __hip_atomic_load(p, __ATOMIC_RELAXED, __HIP_MEMORY_SCOPE_AGENT); }
__device__ __forceinline__ unsigned xb_add(unsigned* p, unsigned v) { return __hip_atomic_fetch_add(p, v, __ATOMIC_RELAXED, __HIP_MEMORY_SCOPE_AGENT); }
__device__ __forceinline__ unsigned xb_xcc_id() { return (unsigned)__builtin_amdgcn_s_getreg((3 << 11) | 20) & 0xFu; }
#define XB_SPIN(cond, bar) do { unsigned _sp = 0; while (cond) { __builtin_amdgcn_s_sleep(1); \
    if ((++_sp & 255u) == 0u) { if (xb_ld(&(bar)[XB_TMO])) break; if (_sp > XB_SPIN_CAP) { atomicAdd(&(bar)[XB_TMO], 1u); break; } } } } while (0)

struct XcdBarrier {
    unsigned* bar; unsigned x;
    volatile LAS unsigned* st;
};

__device__ __forceinline__ XcdBarrier xcd_barrier_post(unsigned* bar, volatile LAS unsigned* st, int tid) {
    XcdBarrier b; b.bar = bar; b.x = xb_xcc_id(); b.st = st;
    if (tid == 0) (void)xb_add(&bar[XB_XCNT(b.x)], 1u);
    return b;
}
__device__ __forceinline__ void xcd_barrier_complete(unsigned* bar, unsigned x, unsigned& nloc, unsigned& nx) {
    const unsigned G = gridDim.x * gridDim.y * gridDim.z;
    unsigned sum, cnt, mine, sp = 0u;
    for (;;) {
        sum = 0u; cnt = 0u; mine = 0u;
#pragma unroll
        for (unsigned j = 0; j < 16; ++j) { const unsigned c = xb_ld(&bar[XB_XCNT(j)]); sum += c; cnt += (c > 0u) ? 1u : 0u; mine = (j == x) ? c : mine; }
        if (sum == G) break;
        __builtin_amdgcn_s_sleep(1);
        if ((++sp & 255u) == 0u) { if (xb_ld(&bar[XB_TMO])) break; if (sp > XB_SPIN_CAP) { atomicAdd(&bar[XB_TMO], 1u); break; } }
    }
    nloc = mine > 0u ? mine : 1u; nx = cnt > 0u ? cnt : 1u;
}

__device__ __forceinline__ void xcd_barrier(const XcdBarrier& b, int tid) {
    asm volatile("s_waitcnt vmcnt(0)" ::: "memory");
    __syncthreads();
    if (tid == 0) {
        unsigned* bar = b.bar;
        __builtin_amdgcn_s_waitcnt(0);
        unsigned nloc = b.st[0], nx = b.st[1];
        if (nloc == 0u) { xcd_barrier_complete(bar, b.x, nloc, nx); b.st[0] = nloc; b.st[1] = nx; }
        const unsigned seq = b.st[2]; b.st[2] = seq + 1u;
        const unsigned old = xb_add(&bar[XB_XSUB(b.x)], 1u);
        const unsigned gen = old / nloc;
        if (old + 1u == (gen + 1u) * nloc) {
            __builtin_amdgcn_fence(__ATOMIC_RELEASE, "agent");
            asm volatile("s_waitcnt vmcnt(0)" ::: "memory");
            const unsigned og = xb_add(&bar[XB_TOP], 1u);
            const unsigned tg = og / nx;
            if (og + 1u == (tg + 1u) * nx) xb_add(&bar[XB_TOPGEN], 1u);
        }
        XB_SPIN(xb_ld(&bar[XB_TOPGEN]) <= seq, bar);
        __builtin_amdgcn_fence(__ATOMIC_ACQUIRE, "agent");
        asm volatile("s_waitcnt vmcnt(0)" ::: "memory");
    }
    __syncthreads();
}


struct Args { const float* in[23]; float* out; unsigned char* ws; int ph_lo, ph_hi; };
#define ARGP(A, k) ((A).in[k])
#define TABP(F, k) ((const float*)(((const __attribute__((address_space(1))) float* const*)((F).ws + 256))[k]))
struct Frame {
    LAS unsigned char* lds;
    int tid, lane, wave, G, bid;
    float* out; unsigned char* ws;
};

__device__ __forceinline__ void transpose_item(const float* W, int ldw, int col0, int K, const float* gain, bf16_t* WT, int row_off, int nblk, LAS float* scr, int item, int lane) {
    const int kb = item / nblk, nb = item % nblk, k0 = 64 * kb, n0 = 64 * nb;
    const float* src = W + (size_t)(k0 + (lane >> 4)) * ldw + col0 + n0 + (lane & 15) * 4;
    f32x4 v[16];
#pragma unroll
    for (int i = 0; i < 16; ++i) v[i] = __builtin_nontemporal_load((const f32x4*)(src + (size_t)(4 * i) * ldw));
#pragma unroll
    for (int i = 0; i < 16; ++i) { const int kk = 4 * i + (lane >> 4); const float g = gain ? gain[k0 + kk] : 1.0f; LAS float* d = scr + kk * 65 + (lane & 15) * 4;
        d[0] = v[i].x * g; d[1] = v[i].y * g; d[2] = v[i].z * g; d[3] = v[i].w * g; }
    asm volatile("s_waitcnt lgkmcnt(0)" ::: "memory");
    const int c = lane & 7;
#pragma unroll
    for (int j = 0; j < 8; ++j) { const int n = (lane >> 3) + 8 * j; const LAS float* s = scr + (8 * c) * 65 + n;
        u32x4 o; o.x = pk2(s[0 * 65], s[1 * 65]); o.y = pk2(s[2 * 65], s[3 * 65]); o.z = pk2(s[4 * 65], s[5 * 65]); o.w = pk2(s[6 * 65], s[7 * 65]);
        *(u32x4*)(WT + (size_t)(row_off + n0 + n) * K + k0 + 8 * c) = o; }
    asm volatile("s_waitcnt lgkmcnt(0)" ::: "memory");
}
__device__ __forceinline__ void transpose_item8(const float* W, int ldw, int col0, int K, const float* gain, float scale, unsigned char* WT8, int row_off, int nblk, LAS float* scr, int item, int lane) {
    const int kb = item / nblk, nb = item % nblk, k0 = 64 * kb, n0 = 64 * nb;
    const float* src = W + (size_t)(k0 + (lane >> 4)) * ldw + col0 + n0 + (lane & 15) * 4;
    f32x4 v[16];
#pragma unroll
    for (int i = 0; i < 16; ++i) v[i] = __builtin_nontemporal_load((const f32x4*)(src + (size_t)(4 * i) * ldw));
#pragma unroll
    for (int i = 0; i < 16; ++i) { const int kk = 4 * i + (lane >> 4); const float g = (gain ? gain[k0 + kk] : 1.0f) * scale; LAS float* d = scr + kk * 65 + (lane & 15) * 4;
        d[0] = v[i].x * g; d[1] = v[i].y * g; d[2] = v[i].z * g; d[3] = v[i].w * g; }
    asm volatile("s_waitcnt lgkmcnt(0)" ::: "memory");
    const int c = lane & 7;
#pragma unroll
    for (int j = 0; j < 8; ++j) { const int n = (lane >> 3) + 8 * j; const LAS float* s = scr + (8 * c) * 65 + n;
        int w0 = __builtin_amdgcn_cvt_pk_fp8_f32(s[0 * 65], s[1 * 65], 0, false); w0 = __builtin_amdgcn_cvt_pk_fp8_f32(s[2 * 65], s[3 * 65], w0, true);
        int w1 = __builtin_amdgcn_cvt_pk_fp8_f32(s[4 * 65], s[5 * 65], 0, false); w1 = __builtin_amdgcn_cvt_pk_fp8_f32(s[6 * 65], s[7 * 65], w1, true);
        *(u32x2*)(WT8 + (size_t)(row_off + n0 + n) * K + k0 + 8 * c) = (u32x2){(unsigned)w0, (unsigned)w1}; }
    asm volatile("s_waitcnt lgkmcnt(0)" ::: "memory");
}
__device__ __forceinline__ void row_to_bf16(const float* xrow, bf16_t* orow, float* rstd_out, int lane, unsigned char* q8row = nullptr) {
    const f32x4* xr = (const f32x4*)xrow + lane;
    f32x4 v[8]; float s = 0.f;
#pragma unroll
    for (int j = 0; j < 8; ++j) { v[j] = __builtin_nontemporal_load(xr + 64 * j); s += (v[j].x * v[j].x + v[j].y * v[j].y) + (v[j].z * v[j].z + v[j].w * v[j].w); }
    s = wave_sum(s);
    if (lane == 0) *rstd_out = rsqrtf(s * (1.0f / DM) + EPS);
    u32x2* o8 = (u32x2*)orow + lane;
#pragma unroll
    for (int j = 0; j < 8; ++j) { u32x2 w; w.x = pk2(v[j].x, v[j].y); w.y = pk2(v[j].z, v[j].w); o8[64 * j] = w; }
    if (q8row) { unsigned* q4 = (unsigned*)q8row + lane;
#pragma unroll
        for (int j = 0; j < 8; ++j) { int q = __builtin_amdgcn_cvt_pk_fp8_f32(v[j].x, v[j].y, 0, false); q = __builtin_amdgcn_cvt_pk_fp8_f32(v[j].z, v[j].w, q, true); q4[64 * j] = (unsigned)q; } }
}
__device__ __forceinline__ void phase_prologue(const Frame& F, const Args& A) {
    if (F.bid == 0 && F.tid < 23) ((const float**)(F.ws + 256))[F.tid] = A.in[F.tid];
    LAS float* scr = (LAS float*)(F.lds + F.wave * 17408);
    const int gw = F.bid * NWAVES + F.wave, NGW = F.G * NWAVES;
    bf16_t* Win_t = (bf16_t*)(F.ws + WS_WIN); bf16_t* Wout_t = (bf16_t*)(F.ws + WS_WOUT); bf16_t* Wxq_t = (bf16_t*)(F.ws + WS_WXQ); bf16_t* Wxkv_t = (bf16_t*)(F.ws + WS_WXKV);
    bf16_t* Wxo_t = (bf16_t*)(F.ws + WS_WXO); bf16_t* Wgu_t = (bf16_t*)(F.ws + WS_WGU); bf16_t* Wdown_t = (bf16_t*)(F.ws + WS_WDOWN);
    constexpr int I_INA = 32 * 64, I_INB = 32 * 48, I_OUT = 32 * 32, I_XQ = 32 * 8, I_XKV = 32 * 16, I_XO = 8 * 32, I_G = 32 * 88, I_D = 88 * 32;
    constexpr int NITEMS = I_INA + I_INB + I_OUT + I_XQ + I_XKV + I_XO;
    for (int it = gw; it < NITEMS; it += NGW) {
        int r = it;
        if (r < I_INA) { transpose_item8(ARGP(A, 3), 7184, 0, DM, ARGP(A, 2), WGU_SCALE, (unsigned char*)Win_t, 0, 64, scr, r, F.lane); continue; } r -= I_INA;
        if (r < I_INB) { transpose_item(ARGP(A, 3), 7184, 4112, DM, ARGP(A, 2), (bf16_t*)(F.ws + WS_WINB), 0, 48, scr, r, F.lane); continue; } r -= I_INB;
        if (r < I_OUT) { transpose_item(ARGP(A, 10), DM, 0, DM, nullptr, Wout_t, 0, 32, scr, r, F.lane); continue; } r -= I_OUT;
        if (r < I_XQ) { transpose_item(ARGP(A, 13), XW, 0, DM, ARGP(A, 11), Wxq_t, 0, 8, scr, r, F.lane); continue; } r -= I_XQ;
        if (r < I_XKV) { transpose_item(ARGP(A, 14), 2 * XW, 0, DM, ARGP(A, 12), Wxkv_t, 0, 16, scr, r, F.lane); continue; } r -= I_XKV;
        transpose_item(ARGP(A, 15), DM, 0, XW, nullptr, Wxo_t, 0, 32, scr, r, F.lane);
    }
    { bf16_t* W16 = (bf16_t*)(F.ws + WS_SMALL + SM_W16);
      for (int i = F.bid * NTHREADS + F.tid; i < 16 * DM; i += F.G * NTHREADS) { const int j = i >> 11, k = i & 2047; W16[i] = (bf16_t)f2bf(ARGP(A, 3)[(size_t)k * 7184 + 4096 + j] * ARGP(A, 2)[k]); } }
    { bf16_t* xb = (bf16_t*)(F.ws + WS_XB); float* rstd1 = (float*)(F.ws + WS_SMALL + SM_RSTD1);
      for (int m = gw; m < MTOK; m += NGW) row_to_bf16(ARGP(A, 0) + (size_t)m * DM, xb + (size_t)m * DM, rstd1 + m, F.lane, F.ws + WS_X2Q + (size_t)m * DM);
      bf16_t* memb = (bf16_t*)(F.ws + WS_MEMB); float* rstdm = (float*)(F.ws + WS_SMALL + SM_RSTDM);
      for (int m = gw; m < MROWS; m += NGW) row_to_bf16(ARGP(A, 1) + (size_t)m * DM, memb + (size_t)m * DM, rstdm + m, F.lane); }
}
__device__ __forceinline__ void phase_ffn_weights(const Frame& F, int iw, int nwg) {
    LAS float* scr = (LAS float*)(F.lds + F.wave * 17408);
    unsigned char* Wgu8 = F.ws + WS_WGU; unsigned char* Wdown8 = F.ws + WS_WDOWN;
    constexpr int I_G = 32 * 88, I_D = 88 * 32;
    for (int it = iw * NWAVES + F.wave; it < 2 * I_G + I_D; it += nwg * NWAVES) {
        int r = it;
        if (r < I_G) { const int c0 = 64 * (r % 88); transpose_item8(TABP(F, 17), DFF, 0, DM, TABP(F, 16), WGU_SCALE, Wgu8, ((c0 >> 7) << 8) + (c0 & 127) - c0, 88, scr, r, F.lane); continue; } r -= I_G;
        if (r < I_G) { const int c0 = 64 * (r % 88); transpose_item8(TABP(F, 18), DFF, 0, DM, TABP(F, 16), WGU_SCALE, Wgu8, ((c0 >> 7) << 8) + (c0 & 127) - c0 + 128, 88, scr, r, F.lane); continue; } r -= I_G;
        transpose_item8(TABP(F, 21), DM, 0, DFF, nullptr, WDOWN_SCALE, Wdown8, 0, 32, scr, r, F.lane);
    }
}
__device__ __forceinline__ void phase_final_norm(const Frame& F, const Args& A) {
    const int gw = F.bid * NWAVES + F.wave, NGW = F.G * NWAVES; const f32x4* g4 = (const f32x4*)TABP(F, 22) + 2 * F.lane;
    const bf16_t* xb = (const bf16_t*)(F.ws + WS_XB); const float* rsq = (const float*)(F.ws + WS_RSQ4);
    for (int m = gw; m < MTOK; m += NGW) {
        const float r = rsqrtf(rsq[m] * (1.0f / DM) + EPS);
        const u32x4* xr = (const u32x4*)(xb + (size_t)m * DM) + F.lane; f32x4* orow = (f32x4*)(F.out + (size_t)m * DM) + 2 * F.lane;
#pragma unroll
        for (int j = 0; j < 4; ++j) { const u32x4 h = __builtin_nontemporal_load(xr + 64 * j);
            const f32x4 a = {bf2f(h.x & 0xffffu), bf2f(h.x >> 16), bf2f(h.y & 0xffffu), bf2f(h.y >> 16)}, b = {bf2f(h.z & 0xffffu), bf2f(h.z >> 16), bf2f(h.w & 0xffffu), bf2f(h.w >> 16)};
            orow[128 * j] = a * r * g4[128 * j]; orow[128 * j + 1] = b * r * g4[128 * j + 1]; }
    }
}
typedef short mk_bf16x8 __attribute__((ext_vector_type(8)));
__device__ __forceinline__ void ba_item(const Frame& F, int item, int khalf) {
    const int lane = F.lane, r = lane & 15, q = lane >> 4, row0 = item * 16;
    const bf16_t* xa = (const bf16_t*)(F.ws + WS_XB) + (size_t)(row0 + r) * DM + khalf * 1024 + q * 8; const bf16_t* wb = (const bf16_t*)(F.ws + WS_SMALL + SM_W16) + (size_t)r * DM + khalf * 1024 + q * 8;
    f32x4 acc = {0.f, 0.f, 0.f, 0.f};
#pragma unroll 16
    for (int s = 0; s < 32; ++s) { const mk_bf16x8 a = *(const mk_bf16x8*)(xa + 32 * s), b = *(const mk_bf16x8*)(wb + 32 * s); acc = __builtin_amdgcn_mfma_f32_16x16x32_bf16(a, b, acc, 0, 0, 0); }
    LAS f32x4* xch = (LAS f32x4*)F.lds + (F.wave & 3) * 64 + lane;
    if (khalf) *xch = acc;
    __syncthreads();
    if (khalf) return;
    acc += *xch;
    const float* rstd1 = (const float*)(F.ws + WS_SMALL + SM_RSTD1); float* beta = (float*)(F.ws + WS_SMALL + SM_BETA); float* gg = (float*)(F.ws + WS_SMALL + SM_G);
    const int c = lane & 15, h = c & 7; const float alog = TABP(F, 5)[h], dtb = TABP(F, 6)[h];
#pragma unroll
    for (int i = 0; i < 4; ++i) { const int row = row0 + 4 * q + i; const float y = acc[i] * rstd1[row];
        if (c < 8) beta[(size_t)row * 8 + h] = 1.0f / (1.0f + expf(-y));
        else { const float z = y + dtb; const float sp = z > 20.f ? z : log1pf(expf(z)); gg[(size_t)row * 8 + h] = -expf(alog) * sp; } }
}
__device__ __forceinline__ void phase_moba(const Frame& F, const Args& A, char* lds, int cu) {
    const int grp = cu >> 6, bh = cu & 63, b = bh >> 3, h = bh & 7;
    const unsigned list = grp == 0 ? 0x37u : (grp == 1 ? 0x46u : 0x0125u); const int cnt = grp == 2 ? 4 : 2;
    moba::Head H; H.Q0 = (const bf16_t*)(F.ws + WS_PROJ) + (size_t)(b * SEQ) * PROJ_LD + 4096 + h * 128; H.K0 = H.Q0 + 1024; H.V0 = H.Q0 + 2048; H.O0 = (bf16_t*)(F.ws + WS_O) + (size_t)(b * SEQ) * DM + 1024 + h * 128;
    H.km = (const float*)(F.ws + WS_KMEAN) + (size_t)(b * 8) * 1024 + h * 128;
    moba::Seam S; int P0 = (int)(list & 15u) * 256;
    moba::prime<moba::CfgMoba>(H, P0, lds, S, F.tid, F.wave);
    for (int i = 0; i < cnt; ++i) { const int P0n = (i + 1 < cnt) ? (int)((list >> (4 * (i + 1))) & 15u) * 256 : P0; moba::block<moba::CfgMoba>(H, P0, P0n, TABP(F, 9), h, TABP(F, 8), lds, S, F.tid, F.wave); P0 = P0n; }
}
__device__ __forceinline__ void phase_xattn(const Frame& F, char* lds, int item) {
    const int qb = item & 7, h = (item >> 3) & 3, b = item >> 5;
    moba::Head H; H.Q0 = (const bf16_t*)(F.ws + WS_QX) + (size_t)(b * SEQ) * XW + h * 128; H.K0 = (const bf16_t*)(F.ws + WS_KVX) + (size_t)(b * MEMLEN) * (2 * XW) + h * 128; H.V0 = H.K0 + XW;
    H.O0 = (bf16_t*)(F.ws + WS_OX) + (size_t)(b * SEQ) * XW + h * 128; H.km = nullptr;
    moba::Seam S; const int P0 = qb * 256;
    moba::prime<moba::CfgX>(H, P0, lds, S, F.tid, F.wave);
    moba::block<moba::CfgX>(H, P0, P0, nullptr, h, nullptr, lds, S, F.tid, F.wave);
}
static_assert(moba::LDS_BYTES <= LDS_MISC && LDS_MISC + 128 <= LDS_BYTES, "LDS map");

__device__ __forceinline__ void ffn_fixup(const Frame& F, int pm) {
    const bf16_t* halo = (const bf16_t*)(F.ws + WS_GATE); const float* cw = TABP(F, 19); const float* cb = TABP(F, 20); unsigned char* H8 = (unsigned char*)F.out;
    u32x4 a2[3], a1[3], a0[3], au[3];
#pragma unroll
    for (int k = 0; k < 3; ++k) { int idx = F.tid + k * NTHREADS; idx = idx < 2 * 704 ? idx : 2 * 704 - 1; const int R = idx / 704, c = (idx - R * 704) * 8;
        const bf16_t* hp = halo + (size_t)(pm - 1) * 6 * 5632 + c; const bf16_t* hc = halo + (size_t)pm * 6 * 5632 + c;
        a2[k] = *(const u32x4*)(hp + (R == 0 ? 0 : 1) * 5632); a1[k] = *(const u32x4*)(R == 0 ? hp + 5632 : hc + 2 * 5632); a0[k] = *(const u32x4*)(hc + (2 + R) * 5632); au[k] = *(const u32x4*)(hc + (4 + R) * 5632); }
#pragma unroll
    for (int k = 0; k < 3; ++k) { const int idx = F.tid + k * NTHREADS; if (idx >= 2 * 704) break; const int R = idx / 704, c = (idx - R * 704) * 8;
        const unsigned v2[4] = {a2[k].x, a2[k].y, a2[k].z, a2[k].w}, v1[4] = {a1[k].x, a1[k].y, a1[k].z, a1[k].w}, v0[4] = {a0[k].x, a0[k].y, a0[k].z, a0[k].w}, vu[4] = {au[k].x, au[k].y, au[k].z, au[k].w}; float hv[8];
#pragma unroll
        for (int e = 0; e < 8; ++e) { const unsigned sh = (e & 1) ? 16u : 0u; const int kq = e >> 1, chn = c + e;
            const float x2 = bf2f((v2[kq] >> sh) & 0xffffu), x1 = bf2f((v1[kq] >> sh) & 0xffffu), gc = bf2f((v0[kq] >> sh) & 0xffffu), uu = bf2f((vu[kq] >> sh) & 0xffffu);
            const float y = cw[chn] * x2 + cw[DFF + chn] * x1 + cw[2 * DFF + chn] * gc + cb[chn]; hv[e] = y * __builtin_amdgcn_rcpf(1.0f + __expf(-y)) * uu; }
        int q0 = __builtin_amdgcn_cvt_pk_fp8_f32(hv[0], hv[1], 0, false); q0 = __builtin_amdgcn_cvt_pk_fp8_f32(hv[2], hv[3], q0, true);
        int q1 = __builtin_amdgcn_cvt_pk_fp8_f32(hv[4], hv[5], 0, false); q1 = __builtin_amdgcn_cvt_pk_fp8_f32(hv[6], hv[7], q1, true);
        *(u32x2*)(H8 + (size_t)(pm * 256 + R) * DFF + c) = (u32x2){(unsigned)q0, (unsigned)q1}; }
}
constexpr int N_PHASES = 14;

__global__ void __launch_bounds__(NTHREADS, 2) mk_fwd(Args args) {
    const Args& A = args;
    extern __shared__ __attribute__((aligned(16))) unsigned char lds_raw[];
    Frame F;
    F.lds = (LAS unsigned char*)lds_raw;
    F.wave = __builtin_amdgcn_readfirstlane((int)threadIdx.x >> 6); F.lane = 0; F.tid = 0;
#define FRESH_IDS() do { int l_; asm volatile("v_mbcnt_lo_u32_b32 %0, -1, 0\n\tv_mbcnt_hi_u32_b32 %0, -1, %0" : "=v"(l_)); F.lane = l_; F.tid = F.wave * 64 + l_; } while (0)
    F.G = gridDim.x; F.bid = blockIdx.x;
    F.out = args.out; F.ws = args.ws;
    const int lo = args.ph_lo, hi = args.ph_hi;
    unsigned char* ws = args.ws;
    const float* rstd1 = (const float*)(ws + WS_SMALL + SM_RSTD1); float* rstd2 = (float*)(ws + WS_SMALL + SM_RSTD2); float* rstd3 = (float*)(ws + WS_SMALL + SM_RSTD3);
    const float* rstdm = (const float*)(ws + WS_SMALL + SM_RSTDM);
    bf16_t* xb = (bf16_t*)(ws + WS_XB);
#define IN(k) (lo <= (k) && (k) < hi)
    volatile LAS unsigned* MISC = (volatile LAS unsigned*)(F.lds + LDS_MISC);
    XcdBarrier bar; bar.bar = (unsigned*)ws + CW_BAR; bar.x = 0; bar.st = nullptr;
    if (hi - lo > 1) { FRESH_IDS(); if (F.tid < 32) MISC[F.tid] = 0u; __syncthreads(); bar = xcd_barrier_post((unsigned*)ws + CW_BAR, MISC + 8, F.tid); }
#define SEAM(k) do { if (IN(k) && IN((k) + 1)) { FRESH_IDS(); xcd_barrier(bar, F.tid); } } while (0)

    if (IN(0)) { FRESH_IDS(); phase_prologue(F, A); }
    if (lo < 0) cg::this_grid().sync();
    SEAM(0);
    if (IN(1)) { FRESH_IDS();
        if ((F.bid & 1) == 0) { ba_item(F, (F.wave & 3) * 256 + F.bid, F.wave >> 2);
            __syncthreads();
            FRESH_IDS(); }
        { pg8::Gemm g{(const bf16_t*)(ws + WS_X2Q), (const bf16_t*)(ws + WS_WIN), MTOK, 4096, DM / 2}; pg8::StaticOrder S; S.init(MTOK, 4096, F.G, F.bid);
          pg8::EpiScaleBf16 E{(bf16_t*)(ws + WS_PROJ), PROJ_LD, rstd1, 12, 16, 0, 0, nullptr, 0, 0, 0, 1.0f / WGU_SCALE};
          pg8::gemm_phase<pg8::EpiScaleBf16, pg8::StaticOrder, true, true, true>(F.lds, g, S, E, F.tid, F.wave); }
        FRESH_IDS();
        { pg8::Gemm g{xb, (const bf16_t*)(ws + WS_WINB), MTOK, 3072, DM}; pg8::StaticOrder S; S.init(MTOK, 3072, F.G, F.bid);
          pg8::EpiScaleBf16 E{(bf16_t*)(ws + WS_PROJ) + 4096, PROJ_LD, rstd1, 0, 0, 0, 0, (float*)(ws + WS_KMEAN), 4, 8, 0, 1.0f, 0, 4, moba::QSCALE};
          pg8::gemm_phase<pg8::EpiScaleBf16, pg8::StaticOrder, true, true>(F.lds, g, S, E, F.tid, F.wave); }
        if (F.bid & 1) { __syncthreads(); FRESH_IDS(); ba_item(F, (F.wave & 3) * 256 + F.bid, F.wave >> 2); }
    } SEAM(1);
    if (IN(2)) { FRESH_IDS();
        gdn::prep((__attribute__((address_space(3))) unsigned char*)F.lds, F.tid, F.lane, F.wave, F.bid, (const unsigned short*)(ws + WS_PROJ), (const float*)(ws + WS_SMALL + SM_BETA), (const float*)(ws + WS_SMALL + SM_G), TABP(F, 4),
                  (unsigned char*)F.out, ws + WS_WIN, ws + WS_O); } SEAM(2);
    if (IN(3)) { FRESH_IDS();
        if (F.bid < 64) gdn::scan((__attribute__((address_space(3))) unsigned char*)F.lds, F.tid, F.lane, F.wave, F.bid, (unsigned char*)F.out, ws + WS_WIN, (const unsigned short*)(ws + WS_PROJ), TABP(F, 7), (unsigned short*)(ws + WS_O));
        else if (F.bid < 256) phase_moba(F, A, (char*)lds_raw, F.bid - 64);
    } SEAM(3);
    if (IN(4)) { FRESH_IDS();
        pg8::Gemm g{(const bf16_t*)(ws + WS_O), (const bf16_t*)(ws + WS_WOUT), MTOK, DM, DM}; pg8::StaticOrder S; S.init(MTOK, DM, F.G, F.bid);
        pg8::EpiResidBf16 E{xb, xb, DM, (float*)(ws + WS_RSQ2), 1.0f, nullptr};
        pg8::gemm_phase<pg8::EpiResidBf16, pg8::StaticOrder, true, true>(F.lds, g, S, E, F.tid, F.wave);
    } SEAM(4);
    if (IN(6)) { FRESH_IDS();
        { pg8::Gemm g{xb, (const bf16_t*)(ws + WS_WXQ), MTOK, XW, DM}; pg8::StaticOrder S; S.init(MTOK, XW, F.G, F.bid);
          pg8::EpiScaleBf16 E{(bf16_t*)(ws + WS_QX), XW, (const float*)(ws + WS_RSQ2), 0, 0, 0, 0, nullptr, 0, 0, 1, moba::QSCALE};
          pg8::gemm_phase<pg8::EpiScaleBf16, pg8::StaticOrder, true, true>(F.lds, g, S, E, F.tid, F.wave); }
        { pg8::Gemm g{(const bf16_t*)(ws + WS_MEMB), (const bf16_t*)(ws + WS_WXKV), MROWS, 2 * XW, DM}; pg8::StaticOrder S; S.init(MROWS, 2 * XW, F.G, (F.bid + F.G - 128) % F.G);
          pg8::EpiScaleBf16 E{(bf16_t*)(ws + WS_KVX), 2 * XW, rstdm, 0, 0, 0, 0, nullptr, 0, 0, 0, 1.0f};
          pg8::gemm_phase<pg8::EpiScaleBf16, pg8::StaticOrder, true, true>(F.lds, g, S, E, F.tid, F.wave); }
        if (F.bid >= 160 && F.bid < 256) { FRESH_IDS(); phase_ffn_weights(F, F.bid - 160, 96); }
    } SEAM(6);
    if (IN(7)) { FRESH_IDS(); if (F.bid < 256) phase_xattn(F, (char*)lds_raw, F.bid); } SEAM(7);
    if (IN(8)) { FRESH_IDS();
        pg8::Gemm g{(const bf16_t*)(ws + WS_OX), (const bf16_t*)(ws + WS_WXO), MTOK, DM, XW}; pg8::StaticOrder S; S.init(MTOK, DM, F.G, F.bid);
        pg8::EpiResidBf16 E{xb, xb, DM, (float*)(ws + WS_RSQ3), 1.0f, ws + WS_X2Q};
        pg8::gemm_phase<pg8::EpiResidBf16, pg8::StaticOrder, true, true>(F.lds, g, S, E, F.tid, F.wave);
    } SEAM(8);
    if (IN(10)) { FRESH_IDS();
        pg8::Gemm g{(const bf16_t*)(ws + WS_X2Q), (const bf16_t*)(ws + WS_WGU), MTOK, 2 * DFF, DM / 2}; pg8::StaticOrder S; S.init(MTOK, 2 * DFF, F.G, F.bid);
        pg8::EpiFfn E{(unsigned char*)F.out, (const float*)(ws + WS_RSQ3), TABP(F, 19), TABP(F, 20), (bf16_t*)(ws + WS_GATE), (__attribute__((address_space(3))) float*)(F.lds + 131072), 1.0f / WGU_SCALE};
        pg8::gemm_phase<pg8::EpiFfn, pg8::StaticOrder, true, true, true>(F.lds, g, S, E, F.tid, F.wave);
    } SEAM(10);
    if (IN(12)) { FRESH_IDS();
        { pg8::StaticOrder S0; S0.init(MTOK, DM, F.G, F.bid); pg8::Unit u0;
          if (S0.next(0, u0) && (u0.pm & 7)) ffn_fixup(F, u0.pm);
          if (S0.next(1, u0) && (u0.pm & 7)) ffn_fixup(F, u0.pm);
          asm volatile("s_waitcnt vmcnt(0)" ::: "memory"); __syncthreads(); FRESH_IDS(); }
        pg8::Gemm g{(const bf16_t*)F.out, (const bf16_t*)(ws + WS_WDOWN), MTOK, DM, DFF / 2};     pg8::StaticOrder S; S.init(MTOK, DM, F.G, F.bid);
        pg8::EpiResidBf16 E{xb, xb, DM, (float*)(ws + WS_RSQ4), 1.0f / WDOWN_SCALE, nullptr};
        pg8::gemm_phase<pg8::EpiResidBf16, pg8::StaticOrder, true, true, true>(F.lds, g, S, E, F.tid, F.wave);
    } SEAM(12);
    if (IN(13)) { FRESH_IDS(); phase_final_norm(F, A); }
#undef IN
#undef SEAM
}

extern "C" void kernel_launch(void* const* d_in, const int* in_sizes, int n_in, void* d_out, int out_size, void* d_ws, size_t ws_size, hipStream_t stream) {
    static int grid = 0;
    if (grid == 0) {
        if (n_in != 23 || in_sizes[0] != MTOK * DM || out_size != MTOK * DM || ws_size < WS_END) {
            fprintf(stderr, "kernel_launch: unexpected shapes: n_in %d, in0 %d, out %d, ws %zu (need >= %zu); nothing launched\n", n_in, n_in > 0 ? in_sizes[0] : -1, out_size, ws_size, (size_t)WS_END); grid = -1; return; }
        int dev = 0, cus = 0, per_cu = 0;
        if (hipGetDevice(&dev) != hipSuccess || hipDeviceGetAttribute(&cus, hipDeviceAttributeMultiprocessorCount, dev) != hipSuccess) { fprintf(stderr, "kernel_launch: device query failed\n"); grid = -1; return; }
        if (hipFuncSetAttribute((const void*)mk_fwd, hipFuncAttributeMaxDynamicSharedMemorySize, LDS_BYTES) != hipSuccess) { fprintf(stderr, "kernel_launch: hipFuncSetAttribute failed\n"); grid = -1; return; }
        if (hipOccupancyMaxActiveBlocksPerMultiprocessor(&per_cu, (const void*)mk_fwd, NTHREADS, LDS_BYTES) != hipSuccess || per_cu < 1) { fprintf(stderr, "kernel_launch: occupancy query says %d blocks per CU\n", per_cu); per_cu = 1; }
        (void)hipGetLastError();
        if (per_cu > 1) per_cu = 1;
        grid = cus * per_cu;
        if (grid != 256) { fprintf(stderr, "kernel_launch: built for a 256-CU device (grid %d); nothing launched\n", grid); grid = -1; return; }
    }
    if (grid < 0) return;
    if (hipMemsetAsync(d_ws, 0, 1u << 20, stream) != hipSuccess) { fprintf(stderr, "kernel_launch: hipMemsetAsync failed\n"); return; }
    Args a{};
    for (int i = 0; i < 23; ++i) a.in[i] = (const float*)d_in[i];
    a.out = (float*)d_out; a.ws = (unsigned char*)d_ws;
#if MK_MULTI
    for (int p = 0; p < N_PHASES; ++p) { a.ph_lo = p; a.ph_hi = p + 1; hipLaunchKernelGGL(mk_fwd, dim3(grid), dim3(NTHREADS), LDS_BYTES, stream, a); }
#else
    a.ph_lo = 0; a.ph_hi = N_PHASES;
    void* kargs[] = {&a};
    hipError_t e = hipLaunchCooperativeKernel((const void*)mk_fwd, dim3(grid), dim3(NTHREADS), kargs, LDS_BYTES, stream);
    if (e != hipSuccess) fprintf(stderr, "kernel_launch: cooperative launch failed: %s (grid %d)\n", hipGetErrorString(e), grid);
#endif
}
```

```cpp
#include <hip/hip_runtime.h>
#include <hip/hip_cooperative_groups.h>
#include <cstdio>
#include <cstdint>
namespace cg = cooperative_groups;

#ifndef MK_MULTI
#define MK_MULTI 0
#endif

namespace pg8 {
#define PG8_LAS __attribute__((address_space(3)))
typedef unsigned short bf16_t;
typedef short bf16x8 __attribute__((ext_vector_type(8)));
typedef float f32x4 __attribute__((ext_vector_type(4)));
typedef unsigned u32x4 __attribute__((ext_vector_type(4)));
typedef int pg8_v4i __attribute__((ext_vector_type(4)));
typedef int pg8_v8i __attribute__((ext_vector_type(8)));
constexpr int BM = 256, BK = 64, HALF = 128, HTB = HALF * BK * 2  , STAGE_BYTES = 8 * HTB, NXCD = 8;

__host__ __device__ __forceinline__ int lds_byte(int r, int c) { const int st = (r >> 4) * 2 + (c >> 5), rr = r & 15, cc = c & 31, ob = rr * 64 + cc * 2; return st * 1024 + (ob ^ (((ob >> 9) & 1) << 5)); }
__host__ __device__ __forceinline__ void stage_rc(int b, int& R, int& C) { const int st = b / 1024, sb = b % 1024, swz = sb ^ (((sb >> 9) & 1) << 5); R = (st >> 1) * 16 + swz / 64; C = (st & 1) * 32 + (swz % 64) / 2; }
__host__ __device__ __forceinline__ int perm32(int rho) { const int n = rho >> 4, i = rho & 15; return 8 * (i >> 2) + 4 * n + (i & 3); }

struct Unit { int pm, pn; };
struct Gemm { const bf16_t* A; const bf16_t* Bt; int M, N, K; };

struct StaticOrder {
    int nM, nN, nwg, G, c, WGM;
    __host__ __device__ __forceinline__ void init(int M, int N, int G_, int c_, int wgm_ = 8) { nM = M / BM; nN = N / BM; nwg = nM * nN; G = G_; c = c_; WGM = wgm_; }
    __host__ __device__ __forceinline__ bool next(int i, Unit& u) const {
        const long L = (long)i * G + c; if (L >= nwg) return false;
        int wgid = (int)L; { const int q = nwg / NXCD, r = nwg % NXCD, xcd = wgid % NXCD, off = wgid / NXCD; wgid = (xcd < r ? xcd * (q + 1) : r * (q + 1) + (xcd - r) * q) + off; }
        const int nig = WGM * nN, gid = wgid / nig, fm = gid * WGM, gsz = (nM - fm) < WGM ? (nM - fm) : WGM;
        u.pm = fm + ((wgid % nig) % gsz); u.pn = (wgid % nig) / gsz; return true;
    }
    __device__ __forceinline__ void a_ready(const Unit&) const {}
    __device__ __forceinline__ void done(const Unit&) const {}
};


__device__ __forceinline__ unsigned cvt_pk_bf16(float lo, float hi) { unsigned r; asm volatile("v_cvt_pk_bf16_f32 %0, %1, %2" : "=v"(r) : "v"(lo), "v"(hi)); return r; }
typedef __bf16 hw_bf16x2 __attribute__((ext_vector_type(2)));
typedef float hw_f32x2 __attribute__((ext_vector_type(2)));
__device__ __forceinline__ unsigned cvt_pk_bf16_acc(float lo, float hi) { const hw_bf16x2 r = __builtin_convertvector((hw_f32x2){lo, hi}, hw_bf16x2); return __builtin_bit_cast(unsigned, r); }
__device__ __forceinline__ float silu_f(float v) { return v * __builtin_amdgcn_rcpf(1.0f + __expf(-v)); }

struct EpiScaleBf16 {
    static constexpr bool PERM = true, AFTER_DRAIN = false;
    bf16_t* O; int ldc; const float* rs; int silu_lo, silu_hi; int split_cols; size_t split_stride; float* km; int km_lo, km_hi; int rs_sumsq; float oscale; int qs_lo, qs_hi; float qscale;
    __device__ __forceinline__ void operator()(const f32x4 (&acc)[2][2][4][2], const Unit& u, int wr, int wc, int fr, int fq) const {
        int colt = u.pn * BM; bf16_t* base = O; if (split_cols && colt >= split_cols) { base += split_stride; colt -= split_cols; }
        const int row0 = u.pm * BM + wr * 64 + fr, col0 = colt + wc * 32 + 8 * fq;
        const bool act = (u.pn >= silu_lo && u.pn < silu_hi); const float tscale = (u.pn >= qs_lo && u.pn < qs_hi) ? oscale * qscale : oscale;
        const bool dokm = km && u.pn >= km_lo && u.pn < km_hi; float cs[2][8];
#pragma unroll
        for (int a_ = 0; a_ < 2; ++a_)
#pragma unroll
            for (int b_ = 0; b_ < 8; ++b_) cs[a_][b_] = 0.f;
        float rsv[2][4];
#pragma unroll
        for (int ai = 0; ai < 2; ++ai)
#pragma unroll
            for (int m = 0; m < 4; ++m) rsv[ai][m] = rs ? rs[row0 + ai * HALF + m * 16] : 1.0f;
#pragma unroll
        for (int ai = 0; ai < 2; ++ai)
#pragma unroll
            for (int m = 0; m < 4; ++m) { const int row = row0 + ai * HALF + m * 16; float r = rsv[ai][m]; if (rs_sumsq) r = rsqrtf(r * (1.0f / 2048.0f) + 1e-6f); r *= tscale; bf16_t* rowp = base + (size_t)row * ldc + col0;
#pragma unroll
                for (int bj = 0; bj < 2; ++bj) { f32x4 v0 = acc[ai][bj][m][0] * r, v1 = acc[ai][bj][m][1] * r;
                    if (act) {
#pragma unroll
                        for (int j = 0; j < 4; ++j) { v0[j] = silu_f(v0[j]); v1[j] = silu_f(v1[j]); } }
                    if (dokm) {
#pragma unroll
                        for (int j = 0; j < 4; ++j) { cs[bj][j] += v0[j]; cs[bj][4 + j] += v1[j]; } }
                    u32x4 w; w.x = cvt_pk_bf16(v0[0], v0[1]); w.y = cvt_pk_bf16(v0[2], v0[3]); w.z = cvt_pk_bf16(v1[0], v1[1]); w.w = cvt_pk_bf16(v1[2], v1[3]);
                    *(u32x4*)(rowp + bj * HALF) = w; } }
        if (dokm) {
#pragma unroll
            for (int bj = 0; bj < 2; ++bj)
#pragma unroll
                for (int c = 0; c < 8; ++c) { float s = cs[bj][c]; s += __shfl_xor(s, 1); s += __shfl_xor(s, 2); s += __shfl_xor(s, 4); s += __shfl_xor(s, 8);
                    if (fr == 0) atomicAdd(km + (size_t)u.pm * 1024 + (u.pn - km_lo) * BM + bj * HALF + wc * 32 + 8 * fq + c, s * (1.0f / 256.0f)); } }
    }
};
struct EpiResidBf16 {
    static constexpr bool PERM = true, AFTER_DRAIN = false;
    const bf16_t* baseh; bf16_t* out; int ldc; float* rowsq; float accscale; unsigned char* q8;
    __device__ __forceinline__ void operator()(const f32x4 (&acc)[2][2][4][2], const Unit& u, int wr, int wc, int fr, int fq) const {
        const int row0 = u.pm * BM + wr * 64 + fr, col0 = u.pn * BM + wc * 32 + 8 * fq;
#pragma unroll
        for (int ai = 0; ai < 2; ++ai) {
            u32x4 hb[4][2];
#pragma unroll
            for (int m = 0; m < 4; ++m)
#pragma unroll
                for (int bj = 0; bj < 2; ++bj) hb[m][bj] = *(const u32x4*)(baseh + (size_t)(row0 + ai * HALF + m * 16) * ldc + col0 + bj * HALF);
#pragma unroll
            for (int m = 0; m < 4; ++m) { const int row = row0 + ai * HALF + m * 16; const size_t off = (size_t)row * ldc + col0; float ss = 0.f;
#pragma unroll
                for (int bj = 0; bj < 2; ++bj) { const u32x4 h = hb[m][bj];
                    const f32x4 b0 = (f32x4){__uint_as_float(h.x << 16), __uint_as_float(h.x & 0xffff0000u), __uint_as_float(h.y << 16), __uint_as_float(h.y & 0xffff0000u)};
                    const f32x4 b1 = (f32x4){__uint_as_float(h.z << 16), __uint_as_float(h.z & 0xffff0000u), __uint_as_float(h.w << 16), __uint_as_float(h.w & 0xffff0000u)};
                    const f32x4 v0 = b0 + acc[ai][bj][m][0] * accscale, v1 = b1 + acc[ai][bj][m][1] * accscale;
                    ss += (v0[0] * v0[0] + v0[1] * v0[1]) + (v0[2] * v0[2] + v0[3] * v0[3]) + (v1[0] * v1[0] + v1[1] * v1[1]) + (v1[2] * v1[2] + v1[3] * v1[3]);
                    u32x4 w; w.x = cvt_pk_bf16(v0[0], v0[1]); w.y = cvt_pk_bf16(v0[2], v0[3]); w.z = cvt_pk_bf16(v1[0], v1[1]); w.w = cvt_pk_bf16(v1[2], v1[3]);
                    *(u32x4*)(out + off + bj * HALF) = w;
                    if (q8) { int q0 = __builtin_amdgcn_cvt_pk_fp8_f32(v0[0], v0[1], 0, false); q0 = __builtin_amdgcn_cvt_pk_fp8_f32(v0[2], v0[3], q0, true);
                        int q1 = __builtin_amdgcn_cvt_pk_fp8_f32(v1[0], v1[1], 0, false); q1 = __builtin_amdgcn_cvt_pk_fp8_f32(v1[2], v1[3], q1, true);
                        typedef unsigned u32x2_ __attribute__((ext_vector_type(2))); *(u32x2_*)(q8 + off + bj * HALF) = (u32x2_){(unsigned)q0, (unsigned)q1}; } }
                ss += __shfl_xor(ss, 16); ss += __shfl_xor(ss, 32);
                if (fq == 0) atomicAdd(rowsq + row, ss); } }
    }
};

struct EpiFfn {
    static constexpr bool PERM = true, AFTER_DRAIN = false;
    unsigned char* H8; const float* rsq; const float* cw; const float* cb; bf16_t* halo; PG8_LAS float* X;
    float oscale;
    __device__ __forceinline__ void operator()(f32x4 (&acc)[2][2][4][2], const Unit& u, int wr, int wc, int fr_in, int fq_in) const {
        int fr = fr_in, fq = fq_in; asm volatile("" : "+v"(fr), "+v"(fq));
        const int wid = wr * 4 + wc, ch = u.pn * 128 + wc * 32 + 8 * fq, lane = fq * 16 + fr;
#pragma unroll
        for (int ai = 0; ai < 2; ++ai)
#pragma unroll
            for (int m = 0; m < 4; ++m) { const int row = u.pm * BM + ai * HALF + wr * 64 + m * 16 + fr; const float r = rsqrtf(rsq[row] * (1.0f / 2048.0f) + 1e-6f) * oscale;
#pragma unroll
                for (int bj = 0; bj < 2; ++bj) { acc[ai][bj][m][0] = acc[ai][bj][m][0] * r; acc[ai][bj][m][1] = acc[ai][bj][m][1] * r; } }
        if (fr >= 14) {
#pragma unroll
            for (int ai = 0; ai < 2; ++ai) { PG8_LAS f32x4* xp = (PG8_LAS f32x4*)(X + ((wid * 2 + ai) * 2 + (fr - 14)) * 64 + fq * 8); xp[0] = acc[ai][0][3][0]; xp[1] = acc[ai][0][3][1]; } }
        { bf16_t* hp = halo + (size_t)u.pm * 6 * 5632 + ch;
          if (wr == 1 && fr >= 14) { u32x4 w = {cvt_pk_bf16(acc[1][0][3][0][0], acc[1][0][3][0][1]), cvt_pk_bf16(acc[1][0][3][0][2], acc[1][0][3][0][3]), cvt_pk_bf16(acc[1][0][3][1][0], acc[1][0][3][1][1]), cvt_pk_bf16(acc[1][0][3][1][2], acc[1][0][3][1][3])};
              *(u32x4*)(hp + (size_t)(fr - 14) * 5632) = w; }
          if (wr == 0 && fr < 2) { u32x4 w = {cvt_pk_bf16(acc[0][0][0][0][0], acc[0][0][0][0][1]), cvt_pk_bf16(acc[0][0][0][0][2], acc[0][0][0][0][3]), cvt_pk_bf16(acc[0][0][0][1][0], acc[0][0][0][1][1]), cvt_pk_bf16(acc[0][0][0][1][2], acc[0][0][0][1][3])};
              *(u32x4*)(hp + (size_t)(2 + fr) * 5632) = w;
              u32x4 w2 = {cvt_pk_bf16(acc[0][1][0][0][0], acc[0][1][0][0][1]), cvt_pk_bf16(acc[0][1][0][0][2], acc[0][1][0][0][3]), cvt_pk_bf16(acc[0][1][0][1][0], acc[0][1][0][1][1]), cvt_pk_bf16(acc[0][1][0][1][2], acc[0][1][0][1][3])};
              *(u32x4*)(hp + (size_t)(4 + fr) * 5632) = w2; } }
        const f32x4 w0a = *(const f32x4*)(cw + ch), w0b = *(const f32x4*)(cw + ch + 4), w1a = *(const f32x4*)(cw + 5632 + ch), w1b = *(const f32x4*)(cw + 5632 + ch + 4);
        const f32x4 w2a = *(const f32x4*)(cw + 2 * 5632 + ch), w2b = *(const f32x4*)(cw + 2 * 5632 + ch + 4), ba = *(const f32x4*)(cb + ch), bb = *(const f32x4*)(cb + ch + 4);
        asm volatile("s_waitcnt lgkmcnt(0)" ::: "memory"); __builtin_amdgcn_s_barrier(); asm volatile("" ::: "memory");
#pragma unroll
        for (int ai = 1; ai >= 0; --ai)
#pragma unroll
            for (int m = 3; m >= 0; --m) {
                f32x4 pv0, pv1;
                if (m > 0) { pv0 = acc[ai][0][m - 1][0]; pv1 = acc[ai][0][m - 1][1]; }
                else { pv0 = (f32x4){0.f, 0.f, 0.f, 0.f}; pv1 = pv0;
                    if (!(wr == 0 && ai == 0) && fr >= 14) { const int pw = (1 - wr) * 4 + wc, pai = (wr == 1) ? ai : 0;
                        const PG8_LAS f32x4* xp = (const PG8_LAS f32x4*)(X + ((pw * 2 + pai) * 2 + (fr - 14)) * 64 + fq * 8); pv0 = xp[0]; pv1 = xp[1]; } }
                const f32x4 g0 = acc[ai][0][m][0], g1 = acc[ai][0][m][1], u0 = acc[ai][1][m][0], u1 = acc[ai][1][m][1];
                float hv[8];
#pragma unroll
                for (int c = 0; c < 8; ++c) { const float gc = c < 4 ? g0[c & 3] : g1[c & 3], pc = c < 4 ? pv0[c & 3] : pv1[c & 3];
                    const float x1 = __int_as_float(__builtin_amdgcn_update_dpp(0, __float_as_int(fr == 15 ? pc : gc), 0x121, 0xf, 0xf, true)), x2 = __int_as_float(__builtin_amdgcn_update_dpp(0, __float_as_int(fr >= 14 ? pc : gc), 0x122, 0xf, 0xf, true));
                    const float y = __builtin_fmaf(c < 4 ? w0a[c & 3] : w0b[c & 3], x2, __builtin_fmaf(c < 4 ? w1a[c & 3] : w1b[c & 3], x1, __builtin_fmaf(c < 4 ? w2a[c & 3] : w2b[c & 3], gc, c < 4 ? ba[c & 3] : bb[c & 3])));
                    hv[c] = y * __builtin_amdgcn_rcpf(1.0f + __expf(-y)) * (c < 4 ? u0[c & 3] : u1[c & 3]); }
                int q0 = __builtin_amdgcn_cvt_pk_fp8_f32(hv[0], hv[1], 0, false); q0 = __builtin_amdgcn_cvt_pk_fp8_f32(hv[2], hv[3], q0, true);
                int q1 = __builtin_amdgcn_cvt_pk_fp8_f32(hv[4], hv[5], 0, false); q1 = __builtin_amdgcn_cvt_pk_fp8_f32(hv[6], hv[7], q1, true);
                typedef unsigned u32x2_ __attribute__((ext_vector_type(2)));
                *(u32x2_*)(H8 + (size_t)(u.pm * BM + ai * HALF + wr * 64 + m * 16 + fr) * 5632 + ch) = (u32x2_){(unsigned)q0, (unsigned)q1}; }
    }
};

template <class Epi, class Sched, bool ALIGN_EPI = false, bool SP2 = false, bool F8 = false>
__device__ __forceinline__ void gemm_phase(PG8_LAS unsigned char* lds, const Gemm g, const Sched& S, const Epi& E, const int tid, const int wid) {
    const int lane = tid & 63, wr = wid >> 2, wc = wid & 3, fr = lane & 15, fq = lane >> 4;
    const int K = g.K, nt = K / BK;
    unsigned voffA[2], voffB[2];
#pragma unroll
    for (int i = 0; i < 2; ++i) { int R, C; stage_rc(tid * 16 + i * 8192, R, C); const int Rb = Epi::PERM ? ((R & ~31) + perm32(R & 31)) : R;
        voffA[i] = (unsigned)(R * K + C) * 2u; voffB[i] = (unsigned)(Rb * K + C) * 2u; }
    const size_t kstep = (size_t)(BK * 2);
    const size_t hstep = (size_t)HALF * K * 2;
    const size_t tstep = 2 * hstep;
    const unsigned ldsw = (unsigned)wid * 1024u;
    const int aoff = lds_byte(wr * 64 + fr, fq * 8), boff = lds_byte(wc * 32 + fr, fq * 8);
#define PG8_SA(b, h) (((b) * 2 + (h)) * HTB)
#define PG8_SB(b, h) ((4 + (b) * 2 + (h)) * HTB)
#define PG8_STAGE(bufoff, gbase, voff) do { _Pragma("unroll") for (int _i = 0; _i < 2; ++_i) { unsigned vo_ = (voff)[_i]; if constexpr (F8) asm volatile("" : "+v"(vo_));     \
        __builtin_amdgcn_global_load_lds((const unsigned*)((const char*)(gbase) + vo_), (PG8_LAS unsigned*)(lds + (bufoff) + ldsw + _i * 8192), 16, 0, 0); } } while (0)
#define PG8_LDA(dst, b, h) do { if constexpr (F8) { _Pragma("unroll") for (int m = 0; m < 4; ++m) { const pg8_v4i l_ = *(const PG8_LAS pg8_v4i*)(lds + PG8_SA(b, h) + aoff + m * 2048), h_ = *(const PG8_LAS pg8_v4i*)(lds + PG8_SA(b, h) + aoff + m * 2048 + 1024); \
            dst##8[m] = __builtin_shufflevector(l_, h_, 0, 1, 2, 3, 4, 5, 6, 7); } } \
        else { _Pragma("unroll") for (int m = 0; m < 4; ++m) _Pragma("unroll") for (int k = 0; k < 2; ++k) dst[m][k] = *(const PG8_LAS bf16x8*)(lds + PG8_SA(b, h) + aoff + m * 2048 + k * 1024); } } while (0)
#define PG8_LDB(dst, b, h) do { if constexpr (F8) { _Pragma("unroll") for (int n = 0; n < 2; ++n) { const pg8_v4i l_ = *(const PG8_LAS pg8_v4i*)(lds + PG8_SB(b, h) + boff + n * 2048), h_ = *(const PG8_LAS pg8_v4i*)(lds + PG8_SB(b, h) + boff + n * 2048 + 1024); \
            dst##8[n] = __builtin_shufflevector(l_, h_, 0, 1, 2, 3, 4, 5, 6, 7); } } \
        else { _Pragma("unroll") for (int n = 0; n < 2; ++n) _Pragma("unroll") for (int k = 0; k < 2; ++k) dst[n][k] = *(const PG8_LAS bf16x8*)(lds + PG8_SB(b, h) + boff + n * 2048 + k * 1024); } } while (0)
#define PG8_MMA(ai, bj, At, Bt) do { __builtin_amdgcn_s_setprio(1); \
        if constexpr (F8) { _Pragma("unroll") for (int m = 0; m < 4; ++m) _Pragma("unroll") for (int n = 0; n < 2; ++n) \
            acc[ai][bj][m][n] = __builtin_amdgcn_mfma_scale_f32_16x16x128_f8f6f4(Bt##8[n], At##8[m], acc[ai][bj][m][n], 0, 0, 0, 0x7f7f7f7f, 0, 0x7f7f7f7f); } \
        else { _Pragma("unroll") for (int m = 0; m < 4; ++m) _Pragma("unroll") for (int n = 0; n < 2; ++n) _Pragma("unroll") for (int k = 0; k < 2; ++k) \
            acc[ai][bj][m][n] = __builtin_amdgcn_mfma_f32_16x16x32_bf16(Bt[n][k], At[m][k], acc[ai][bj][m][n], 0, 0, 0); } \
        __builtin_amdgcn_s_setprio(0); } while (0)
#define PG8_WAIT_V(n) asm volatile("s_waitcnt vmcnt(" #n ")" ::: "memory")
#define PG8_WAIT_L(n) asm volatile("s_waitcnt lgkmcnt(" #n ")" ::: "memory")
#define PG8_BAR __builtin_amdgcn_s_barrier()
#define PG8_SCHED __builtin_amdgcn_sched_barrier(0)
    Unit cur, nxt; int ui = 0;
    if (!S.next(0, cur)) return;
    f32x4 acc[2][2][4][2];
#pragma unroll
    for (int a = 0; a < 2; ++a)
#pragma unroll
        for (int b = 0; b < 2; ++b)
#pragma unroll
            for (int m = 0; m < 4; ++m)
#pragma unroll
                for (int n = 0; n < 2; ++n) acc[a][b][m][n] = (f32x4){0.f, 0.f, 0.f, 0.f};
    bf16x8 At[4][2], B0[2][2], B1[2][2];
    pg8_v8i At8[4], B08[2], B18[2];
    const char* cA = (const char*)g.A + (size_t)cur.pm * tstep; const char* cB = (const char*)g.Bt + (size_t)cur.pn * tstep;
    S.a_ready(cur);
    if constexpr (SP2) {
        PG8_STAGE(PG8_SB(0, 0), cB, voffB); PG8_STAGE(PG8_SB(0, 1), cB + hstep, voffB); PG8_STAGE(PG8_SA(0, 0), cA, voffA); PG8_STAGE(PG8_SA(0, 1), cA + hstep, voffA);
        if (wr == 1) PG8_BAR;
        PG8_WAIT_V(2); PG8_BAR;
        PG8_STAGE(PG8_SB(1, 0), cB + kstep, voffB); PG8_STAGE(PG8_SA(1, 0), cA + kstep, voffA); PG8_STAGE(PG8_SB(1, 1), cB + hstep + kstep, voffB);
        PG8_WAIT_V(6); PG8_BAR;
    } else {
        PG8_STAGE(PG8_SB(0, 0), cB, voffB); PG8_STAGE(PG8_SA(0, 0), cA, voffA); PG8_STAGE(PG8_SB(0, 1), cB + hstep, voffB); PG8_STAGE(PG8_SA(0, 1), cA + hstep, voffA);
        if (wr == 1) PG8_BAR;
        PG8_WAIT_V(4); PG8_BAR;
        PG8_STAGE(PG8_SB(1, 0), cB + kstep, voffB); PG8_STAGE(PG8_SA(1, 0), cA + kstep, voffA); PG8_STAGE(PG8_SB(1, 1), cB + hstep + kstep, voffB);
        PG8_WAIT_V(6); PG8_BAR;
    }
    for (;;) {
        const bool has_next = S.next(ui + 1, nxt);
        const char* nA = has_next ? (const char*)g.A + (size_t)nxt.pm * tstep : cA; const char* nB = has_next ? (const char*)g.Bt + (size_t)nxt.pn * tstep : cB;
        for (int t = 0; t < nt; t += 2) {
            const bool last = (t == nt - 2);
            const char* a1 = cA + (size_t)(t + 1) * kstep;
            const char* a2 = last ? nA : cA + (size_t)(t + 2) * kstep; const char* b2 = last ? nB : cB + (size_t)(t + 2) * kstep;
            const char* a3 = a2 + kstep; const char* b3 = b2 + kstep;
            if (last && has_next) S.a_ready(nxt);
            if constexpr (SP2) {
            PG8_LDB(B0, 0, 0); PG8_LDB(B1, 0, 1); PG8_SCHED; PG8_LDA(At, 0, 0); PG8_STAGE(PG8_SA(1, 1), a1 + hstep, voffA);
            PG8_WAIT_V(8); PG8_WAIT_L(0); PG8_BAR; PG8_MMA(0, 0, At, B0); PG8_MMA(0, 1, At, B1); PG8_BAR; PG8_SCHED;
            PG8_LDA(At, 0, 1); PG8_STAGE(PG8_SB(0, 0), b2, voffB); PG8_STAGE(PG8_SB(0, 1), b2 + hstep, voffB); PG8_STAGE(PG8_SA(0, 0), a2, voffA);
            PG8_WAIT_V(8); PG8_WAIT_L(0); PG8_BAR; PG8_MMA(1, 0, At, B0); PG8_MMA(1, 1, At, B1); PG8_BAR; PG8_SCHED;
            PG8_LDB(B0, 1, 0); PG8_LDB(B1, 1, 1); PG8_SCHED; PG8_LDA(At, 1, 0); PG8_STAGE(PG8_SA(0, 1), a2 + hstep, voffA);
            PG8_WAIT_V(8); PG8_WAIT_L(0); PG8_BAR; PG8_MMA(0, 0, At, B0); PG8_MMA(0, 1, At, B1); PG8_BAR; PG8_SCHED;
            PG8_LDA(At, 1, 1); PG8_STAGE(PG8_SB(1, 0), b3, voffB); PG8_STAGE(PG8_SB(1, 1), b3 + hstep, voffB); PG8_STAGE(PG8_SA(1, 0), a3, voffA);
            PG8_WAIT_V(8); PG8_WAIT_L(0); PG8_BAR; PG8_MMA(1, 0, At, B0); PG8_MMA(1, 1, At, B1); PG8_BAR; PG8_SCHED;
            } else {
            PG8_LDB(B0, 0, 0); PG8_SCHED; PG8_LDA(At, 0, 0); PG8_STAGE(PG8_SA(1, 1), a1 + hstep, voffA);
            PG8_WAIT_L(8); PG8_BAR; PG8_WAIT_L(0); PG8_MMA(0, 0, At, B0); PG8_BAR; PG8_SCHED;
            PG8_LDB(B1, 0, 1); PG8_STAGE(PG8_SB(0, 0), b2, voffB);
            PG8_BAR; PG8_WAIT_L(0); PG8_MMA(0, 1, At, B1); PG8_BAR;
            PG8_LDA(At, 0, 1); PG8_STAGE(PG8_SA(0, 0), a2, voffA);
            PG8_BAR; PG8_WAIT_L(0); PG8_MMA(1, 0, At, B0); PG8_BAR; PG8_SCHED;
            PG8_STAGE(PG8_SB(0, 1), b2 + hstep, voffB);
            PG8_WAIT_V(6); PG8_BAR; PG8_MMA(1, 1, At, B1); PG8_BAR;
            PG8_LDB(B0, 1, 0); PG8_SCHED; PG8_LDA(At, 1, 0); PG8_STAGE(PG8_SA(0, 1), a2 + hstep, voffA);
            PG8_WAIT_L(8); PG8_BAR; PG8_WAIT_L(0); PG8_MMA(0, 0, At, B0); PG8_BAR; PG8_SCHED;
            PG8_LDB(B1, 1, 1); PG8_STAGE(PG8_SB(1, 0), b3, voffB);
            PG8_BAR; PG8_WAIT_L(0); PG8_MMA(0, 1, At, B1); PG8_BAR;
            PG8_LDA(At, 1, 1); PG8_STAGE(PG8_SA(1, 0), a3, voffA);
            PG8_BAR; PG8_WAIT_L(0); PG8_MMA(1, 0, At, B0); PG8_BAR; PG8_SCHED;
            PG8_STAGE(PG8_SB(1, 1), b3 + hstep, voffB);
            PG8_WAIT_V(6); PG8_BAR; PG8_MMA(1, 1, At, B1); PG8_BAR;
            }
        }
        if constexpr (ALIGN_EPI) { if (wr == 0) PG8_BAR; }
        if constexpr (!Epi::AFTER_DRAIN) { E(acc, cur, wr, wc, fr, fq); S.done(cur); }
        if (!has_next) break;
#pragma unroll
        for (int a = 0; a < 2; ++a)
#pragma unroll
            for (int b = 0; b < 2; ++b)
#pragma unroll
                for (int m = 0; m < 4; ++m)
#pragma unroll
                    for (int n = 0; n < 2; ++n) acc[a][b][m][n] = (f32x4){0.f, 0.f, 0.f, 0.f};
        cur = nxt; cA = nA; cB = nB; ++ui;
        if constexpr (ALIGN_EPI) { if (wr == 1) PG8_BAR; }
    }
    PG8_WAIT_V(0);
    if constexpr (!ALIGN_EPI) { if (wr == 0) PG8_BAR; }
    PG8_BAR;
    if constexpr (Epi::AFTER_DRAIN) { E.fused(acc, cur, wr, wc, fr, fq, lds, wid, lane); S.done(cur); }
#undef PG8_SA
#undef PG8_SB
#undef PG8_STAGE
#undef PG8_LDA
#undef PG8_LDB
#undef PG8_MMA
#undef PG8_WAIT_V
#undef PG8_WAIT_L
#undef PG8_BAR
#undef PG8_SCHED
}
}

namespace moba {
constexpr float SCALE = 0.08838834764831845f;
constexpr int NW = 8, QBLK = 32, KVBLK = 64, QB = NW * QBLK, D = 128;
struct CfgMoba { static constexpr int LDQ = 7232, LDK = 7232, LDO = 2048; static constexpr bool MOBA = true; };
struct CfgX { static constexpr int LDQ = 512, LDK = 1024, LDO = 512; static constexpr bool MOBA = false; };
constexpr int SHM_V = KVBLK * D * 2, SHM_K = KVBLK * D * 2;
constexpr int OFF_WS = 2 * SHM_V + 2 * SHM_K, OFF_BT = OFF_WS + NW * 64 * 4;
constexpr int OFF_KM = OFF_BT + 1024;
constexpr int OFF_Q = OFF_KM + 8192;
constexpr int LDS_BYTES = OFF_Q + NW * 8192;
constexpr float THR = 8.f;
constexpr float LOG2E = 1.4426950408889634f, QSCALE = LOG2E * SCALE, THR2 = THR * LOG2E;
typedef short bf16x8 __attribute__((ext_vector_type(8)));
typedef short s16x4 __attribute__((ext_vector_type(4)));
typedef float f32x16 __attribute__((ext_vector_type(16)));
typedef float f32x4 __attribute__((ext_vector_type(4)));
typedef unsigned u32x4 __attribute__((ext_vector_type(4)));
typedef unsigned short bf16;

#define KSWZ(row, colB) ((row) * 256 + ((colB) ^ (((row) & 7) << 4)))
#define SBAR() __builtin_amdgcn_sched_barrier(0)
__device__ __forceinline__ int v_st(int k, int c) { const int kk = (k & ~0xC) | ((k & 4) << 1) | ((k & 8) >> 1); return ((kk >> 3) * 4 + (c >> 5)) * 512 + ((kk & 7) * 32 + (c & 31)) * 2; }
__device__ __forceinline__ int v_rd_base(int lane) { return ((lane & 3) << 3) | (((lane >> 2) & 3) << 6) | (((lane >> 4) & 1) << 5) | (((lane >> 5) & 1) << 8); }
constexpr int v_rd_off(int d0, int ks, int half) { return d0 * 512 + ks * 4096 + half * 2048; }
__device__ __forceinline__ int crow(int r, int hi) { return (r & 3) + 8 * (r >> 2) + 4 * hi; }
__device__ __forceinline__ unsigned cvtpk(float lo, float hi) { unsigned r; asm volatile("v_cvt_pk_bf16_f32 %0, %1, %2" : "=v"(r) : "v"(lo), "v"(hi)); return r; }
__device__ __forceinline__ bf16x8 load8(const bf16* p) { return *reinterpret_cast<const bf16x8*>(p); }
__device__ __forceinline__ void mask_tile(f32x16& p0, f32x16& p1, int dq) {
    const float NEG = -__builtin_inff();
#pragma unroll
    for (int r = 0; r < 16; ++r) { const int c = (r & 3) + 8 * (r >> 2); if (dq - c < 0) p0[r] = NEG; if (dq - c - 32 < 0) p1[r] = NEG; }
}
__device__ __forceinline__ void bias_tile(f32x16& p0, f32x16& p1, int dq, const float* bt) {
#pragma unroll
    for (int r = 0; r < 16; ++r) { const int c = (r & 3) + 8 * (r >> 2); int n0 = dq - c, n1 = dq - c - 32; n0 = n0 < 0 ? 0 : n0; n1 = n1 < 0 ? 0 : n1; p0[r] += bt[n0]; p1[r] += bt[n1]; }
}
__device__ __forceinline__ void sel_tile(f32x16& p0, f32x16& p1, bool sel) {
    const float NEG = -__builtin_inff();
#pragma unroll
    for (int r = 0; r < 16; ++r) { p0[r] = sel ? p0[r] : NEG; p1[r] = sel ? p1[r] : NEG; }
}
template <bool FIRST>
__device__ __forceinline__ void partialSM(f32x16& p0, f32x16& p1, float& m_reg, float& alpha) {
    float pmax = p0[0]; for (int r = 1; r < 16; ++r) pmax = fmaxf(pmax, p0[r]); for (int r = 0; r < 16; ++r) pmax = fmaxf(pmax, p1[r]);
    { auto rr = __builtin_amdgcn_permlane32_swap(__float_as_uint(pmax), __float_as_uint(pmax), false, false);
      pmax = fmaxf(__uint_as_float(rr[0]), __uint_as_float(rr[1])); }
    if (!FIRST && __builtin_expect(__all(pmax <= THR2), 1)) { alpha = 1.f; }
    else { const float d = FIRST ? (pmax > -3.0e38f ? pmax : 0.f) : fmaxf(pmax, 0.f);
        alpha = __builtin_amdgcn_exp2f(-d); m_reg += d;
        for (int r = 0; r < 16; ++r) { p0[r] -= d; p1[r] -= d; } }
    for (int r = 0; r < 16; ++r) p0[r] = __builtin_amdgcn_exp2f(p0[r]);
}
__device__ __forceinline__ void finishSM(f32x16& p0, f32x16& p1, float alpha, float& l_reg, bf16x8& pa0, bf16x8& pa1, bf16x8& pa2, bf16x8& pa3) {
    for (int r = 0; r < 16; ++r) p1[r] = __builtin_amdgcn_exp2f(p1[r]);
    float ps;
    { typedef float f32x8_ __attribute__((ext_vector_type(8))); typedef float f32x2_ __attribute__((ext_vector_type(2)));
      const f32x16 t = p0 + p1; const f32x8_ a = __builtin_shufflevector(t, t, 0, 1, 2, 3, 4, 5, 6, 7) + __builtin_shufflevector(t, t, 8, 9, 10, 11, 12, 13, 14, 15);
      const f32x4 b = __builtin_shufflevector(a, a, 0, 1, 2, 3) + __builtin_shufflevector(a, a, 4, 5, 6, 7); const f32x2_ c = __builtin_shufflevector(b, b, 0, 1) + __builtin_shufflevector(b, b, 2, 3); ps = c.x + c.y; }
    { auto rr = __builtin_amdgcn_permlane32_swap(__float_as_uint(ps), __float_as_uint(ps), false, false);
      ps = __uint_as_float(rr[0]) + __uint_as_float(rr[1]); }
    l_reg = l_reg * alpha + ps;
#define PK4(P, B_, OUT) do { unsigned a0 = cvtpk(P[B_+0], P[B_+1]), a1 = cvtpk(P[B_+2], P[B_+3]);                          \
        unsigned b0 = cvtpk(P[B_+4], P[B_+5]), b1 = cvtpk(P[B_+6], P[B_+7]);                                             \
        auto r0 = __builtin_amdgcn_permlane32_swap(a0, b0, false, false); auto r1 = __builtin_amdgcn_permlane32_swap(a1, b1, false, false); \
        u32x4 w = {r0[0], r1[0], r0[1], r1[1]}; OUT = *reinterpret_cast<bf16x8*>(&w); } while (0)
    PK4(p0, 0, pa0); PK4(p0, 8, pa1); PK4(p1, 0, pa2); PK4(p1, 8, pa3);
#undef PK4
}
template <int KB>
__device__ __forceinline__ void qkt(f32x16& p0, f32x16& p1, const char* K_lds, int r32, int hi, const char* qf, float init) {
#pragma unroll
    for (int r = 0; r < 16; ++r) { p0[r] = init; p1[r] = init; }
    const char* kb[4];
#pragma unroll
    for (int dd = 0; dd < 4; ++dd) kb[dd] = K_lds + KB * SHM_K + KSWZ(r32, (dd * 16 + hi * 8) * 2);
#pragma unroll
    for (int d0 = 0; d0 < 8; ++d0) { const char* a = kb[d0 & 3] + (d0 >> 2) * 128;
        bf16x8 b0 = *reinterpret_cast<const bf16x8*>(a);
        bf16x8 b1 = *reinterpret_cast<const bf16x8*>(a + 32 * 256);
        const bf16x8 qv = *reinterpret_cast<const bf16x8*>(qf + d0 * 1024);
        p0 = __builtin_amdgcn_mfma_f32_32x32x16_bf16(b0, qv, p0, 0, 0, 0);
        p1 = __builtin_amdgcn_mfma_f32_32x32x16_bf16(b1, qv, p1, 0, 0, 0); }
}
template <int VB>
__device__ __forceinline__ void pv_tile(f32x16* o, int vb0, bf16x8 pa0, bf16x8 pa1, bf16x8 pa2, bf16x8 pa3) {
#define TRRD(dst, off) asm volatile("ds_read_b64_tr_b16 %0, %1 offset:%2" : "=&v"(dst) : "v"(vb0), "i"(off) : "memory")
#define PV_D0(d0) do { s16x4 l0, l1, l2, l3, h0, h1, h2, h3; constexpr int b_ = VB * SHM_V + v_rd_off(d0, 0, 0); \
        TRRD(l0, b_); TRRD(h0, b_ + 2048); TRRD(l1, b_ + 4096); TRRD(h1, b_ + 6144); TRRD(l2, b_ + 8192); TRRD(h2, b_ + 10240); TRRD(l3, b_ + 12288); TRRD(h3, b_ + 14336); \
        asm volatile("s_waitcnt lgkmcnt(0)" ::: "memory"); SBAR();   \
        o[d0] = __builtin_amdgcn_mfma_f32_32x32x16_bf16(pa0, (bf16x8){l0[0], l0[1], l0[2], l0[3], h0[0], h0[1], h0[2], h0[3]}, o[d0], 0, 0, 0);   \
        o[d0] = __builtin_amdgcn_mfma_f32_32x32x16_bf16(pa1, (bf16x8){l1[0], l1[1], l1[2], l1[3], h1[0], h1[1], h1[2], h1[3]}, o[d0], 0, 0, 0);   \
        o[d0] = __builtin_amdgcn_mfma_f32_32x32x16_bf16(pa2, (bf16x8){l2[0], l2[1], l2[2], l2[3], h2[0], h2[1], h2[2], h2[3]}, o[d0], 0, 0, 0);   \
        o[d0] = __builtin_amdgcn_mfma_f32_32x32x16_bf16(pa3, (bf16x8){l3[0], l3[1], l3[2], l3[3], h3[0], h3[1], h3[2], h3[3]}, o[d0], 0, 0, 0); } while (0)
    PV_D0(0); PV_D0(1); PV_D0(2); PV_D0(3);
#undef PV_D0
#undef TRRD
}
struct Head { const bf16* Q0; const bf16* K0; const bf16* V0; bf16* O0; const float* km; };
struct Seam { bf16x8 st_v0, st_v1, st_k0, st_k1; };
#define VMW() asm volatile("s_waitcnt vmcnt(0)" ::: "memory")
#define VMWN(n) asm volatile("s_waitcnt vmcnt(%0)" :: "i"(n) : "memory")
#define SLOAD_H(Kp, Vp, k0) do { const bf16* k_ = (Kp) + (size_t)(k0) * Cfg::LDK; const bf16* v_ = (Vp) + (size_t)(k0) * Cfg::LDK; unsigned vo_ = voff; asm volatile("" : "+v"(vo_));     \
                         S.st_v0 = load8(v_ + vo_); S.st_v1 = load8(v_ + 32 * Cfg::LDK + vo_);                                       \
                         S.st_k0 = load8(k_ + vo_); S.st_k1 = load8(k_ + 32 * Cfg::LDK + vo_); } while (0)
#define SWRITE_HK(bf) do { *(bf16x8*)(K_lds + (bf) * SHM_K + kws) = S.st_k0; *(bf16x8*)(K_lds + (bf) * SHM_K + kws + 32 * 256) = S.st_k1; } while (0)
#define SWRITE_HV(bf) do { *(bf16x8*)(V_lds + (bf) * SHM_V + vst0) = S.st_v0; *(bf16x8*)(V_lds + (bf) * SHM_V + vst1) = S.st_v1; } while (0)
#define SWRITE_H(bf) do { SWRITE_HV(bf); SWRITE_HK(bf); } while (0)
template <class Cfg>
__device__ __forceinline__ void prime(const Head& H, int P0, char* lds, Seam& S, const int tid, const int wid) {
    const int lane = tid & 63, r32 = lane & 31, hi = lane >> 5;
    const int sr = tid >> 4, sc = (tid & 15) * 8, kws = KSWZ(sr, sc * 2); char* K_lds = lds + 2 * SHM_V; const unsigned voff = (unsigned)(sr * Cfg::LDK + sc);
    SLOAD_H(H.K0, H.V0, 0);
    { const bf16* qb = H.Q0 + (size_t)(P0 + wid * QBLK) * Cfg::LDQ; const unsigned qoff = (unsigned)(r32 * Cfg::LDQ + hi * 8); char* qf = lds + OFF_Q + wid * 8192 + lane * 16;
      bf16x8 tq[8];
#pragma unroll
      for (int d0 = 0; d0 < 8; ++d0) tq[d0] = load8(qb + qoff + d0 * 16);
      VMW();
#pragma unroll
      for (int d0 = 0; d0 < 8; ++d0) *(bf16x8*)(qf + d0 * 1024) = tq[d0]; }
    SWRITE_HK(0);
    __syncthreads();
}
template <class Cfg>
__device__ __forceinline__ void block(const Head& H, int P0, int P0n, const float* rel_bias, int h, const float* gn, char* lds, Seam& S, const int tid_in, const int wid) {
    int tid = tid_in; asm volatile("" : "+v"(tid));
    const int lane = tid & 63, r32 = lane & 31, hi = lane >> 5;
    const int own = Cfg::MOBA ? (P0 >> 8) : 0;
    const int NT = Cfg::MOBA ? (P0 + QB) / KVBLK : 4;
    const int qlo = P0 + wid * QBLK, qm = qlo + r32 - 4 * hi;
    char* V_lds = lds; char* K_lds = lds + 2 * SHM_V;
    float* ws = (float*)(lds + OFF_WS) + wid * 64; float* li_l = ws, * al_l = ws + 32;
    float* bt = (float*)(lds + OFF_BT);
    char* qf = lds + OFF_Q + wid * 8192 + lane * 16;
    float m_reg = 0.f, l_reg = 0; f32x16 o[4] = {};
    const int sr = tid >> 4, sc = (tid & 15) * 8, vst0 = v_st(sr, sc), vst1 = v_st(32 + sr, sc), kws = KSWZ(sr, sc * 2); const unsigned voff = (unsigned)(sr * Cfg::LDK + sc);
    const int vb0 = (int)(uintptr_t)V_lds + v_rd_base(lane);
    const bf16* Kh = H.K0; const bf16* Vh = H.V0;
    const float b31 = Cfg::MOBA ? rel_bias[31 * 8 + h] : 0.f; const float cinit = b31 * LOG2E;
    if (Cfg::MOBA && tid < 256) { int bk = 31; if (tid < 16) bk = tid; else if (tid < 128) { const int l = 16 + (int)(logf((float)tid * 0.0625f) * 7.694155931f); bk = l < 31 ? l : 31; }
        bt[tid] = (rel_bias[bk * 8 + h] - b31) * LOG2E; }
    if (own >= 4 && tid < 128) { int t_ = tid; asm volatile("" : "+v"(t_));
        const int n = t_ >> 4, c = t_ & 15; const float* kp = H.km + (unsigned)(n * 1024 + c * 8); const f32x4 k0 = *(const f32x4*)kp, k1 = *(const f32x4*)(kp + 4);
        u32x4 w = {cvtpk(k0[0], k0[1]), cvtpk(k0[2], k0[3]), cvtpk(k1[0], k1[1]), cvtpk(k1[2], k1[3])}; *(u32x4*)(lds + OFF_KM + KSWZ(n, c * 16)) = w; }
    int mask = 0;
#define RESC(a) do { if (__any((a) < 1.f)) { if (hi == 0) al_l[r32] = (a); asm volatile("s_waitcnt lgkmcnt(0)" ::: "memory");              \
                     for (int d_ = 0; d_ < 4; ++d_) for (int r = 0; r < 16; ++r) o[d_][r] *= al_l[crow(r, hi)]; } } while (0)
#define KBASE(t) ((t) * KVBLK)
#define MASKT(P0_, P1_, t, SEL0) do { if (Cfg::MOBA) { const int kb_ = KBASE(t); \
        if (qlo - kb_ < 176) bias_tile(P0_, P1_, qm - kb_, bt); \
        if (SEL0 && own >= 4 && kb_ < P0) sel_tile(P0_, P1_, ((mask >> (kb_ >> 8)) & 1) != 0); \
        if (kb_ + KVBLK - 1 > qlo) mask_tile(P0_, P1_, qm - kb_); } } while (0)
#define AINIT(t) ((Cfg::MOBA && own >= 4 && KBASE(t) < P0 && (((mask >> (KBASE(t) >> 8)) & 1) == 0)) ? -__builtin_inff() : cinit - m_reg)
    constexpr int NQL = 8;
#define SEAM_K0() do { VMWN(NQL); SWRITE_HK(0); SBAR(); } while (0)
    f32x16 pA0, pA1, pB0, pB1; float alA, alB; bf16x8 pa0, pa1, pa2, pa3;
    SWRITE_HV(0); SBAR();
    if (NT > 1) { SLOAD_H(Kh, Vh, KBASE(1)); }
    SBAR(); qkt<0>(pA0, pA1, K_lds, r32, hi, qf, cinit);
    __syncthreads();
    if (own >= 4) {
        f32x16 gacc = {};
        const char* kmb[4];
#pragma unroll
        for (int dd = 0; dd < 4; ++dd) kmb[dd] = lds + OFF_KM + KSWZ(r32, (dd * 16 + hi * 8) * 2);
#pragma unroll
        for (int d0 = 0; d0 < 8; ++d0) { const bf16x8 b0 = *reinterpret_cast<const bf16x8*>(kmb[d0 & 3] + (d0 >> 2) * 128); gacc = __builtin_amdgcn_mfma_f32_32x32x16_bf16(b0, *reinterpret_cast<const bf16x8*>(qf + d0 * 1024), gacc, 0, 0, 0); }
        float g[8];
#pragma unroll
        for (int i = 0; i < 4; ++i) { const float mine = gacc[i], oth = __shfl_xor(mine, 32); g[i] = hi ? oth : mine; g[4 + i] = hi ? mine : oth; }
#pragma unroll
        for (int n = 0; n < 7; ++n) { int cnt = 0;
#pragma unroll
            for (int m = 0; m < 7; ++m) cnt += (m != n && m < own && (g[m] > g[n] || (g[m] == g[n] && m < n))) ? 1 : 0;
            mask |= (n < own && cnt < 3) ? (1 << n) : 0; }
    }
    MASKT(pA0, pA1, 0, true); partialSM<true>(pA0, pA1, m_reg, alA);
    if (NT > 1) { VMW(); SWRITE_HK(1); }
    __syncthreads();
#define HALF_STEP(PX0, PX1, alX, PY0, PY1, alY, t, KB, VB, SB) do {                                                      \
        SWRITE_HV(KB); SBAR();                                                                                                \
        if ((t) + 1 < NT) { SLOAD_H(Kh, Vh, KBASE((t) + 1)); SBAR(); }                                               \
        SBAR(); qkt<KB>(PX0, PX1, K_lds, r32, hi, qf, AINIT(t));                                          \
        finishSM(PY0, PY1, alY, l_reg, pa0, pa1, pa2, pa3); SBAR();                                                           \
        pv_tile<VB>(o, vb0, pa0, pa1, pa2, pa3); MASKT(PX0, PX1, (t), false); partialSM<false>(PX0, PX1, m_reg, alX);                                        \
        if ((t) + 1 < NT) { VMW(); SWRITE_HK(SB); }                                                                         \
        RESC(alX); __syncthreads(); } while (0)
    for (int t = 1; t + 1 < NT; t += 2) {
        HALF_STEP(pB0, pB1, alB, pA0, pA1, alA, t, 1, 0, 0);
        HALF_STEP(pA0, pA1, alA, pB0, pB1, alB, t + 1, 0, 1, 1);
    }
    SWRITE_HV(1); SBAR();
    { SBAR(); qkt<1>(pB0, pB1, K_lds, r32, hi, qf, AINIT(NT - 1)); SBAR(); }
    SLOAD_H(Kh, Vh, 0); SBAR();
    bf16x8 tq[8];
    { const bf16* qb = H.Q0 + (size_t)(P0n + wid * QBLK) * Cfg::LDQ; unsigned qoff = (unsigned)(r32 * Cfg::LDQ + hi * 8); asm volatile("" : "+v"(qoff));
#pragma unroll
      for (int d0 = 0; d0 < 8; ++d0) tq[d0] = load8(qb + qoff + d0 * 16); }
    SBAR();
    finishSM(pA0, pA1, alA, l_reg, pa0, pa1, pa2, pa3); SBAR();
    pv_tile<0>(o, vb0, pa0, pa1, pa2, pa3);
    { MASKT(pB0, pB1, NT - 1, false); partialSM<false>(pB0, pB1, m_reg, alB); __syncthreads(); RESC(alB);
      finishSM(pB0, pB1, alB, l_reg, pa0, pa1, pa2, pa3); SBAR(); pv_tile<1>(o, vb0, pa0, pa1, pa2, pa3); }
    SBAR(); SEAM_K0();
    if (hi == 0) li_l[r32] = l_reg; asm volatile("s_waitcnt lgkmcnt(0)" ::: "memory");
    float gnr[4];
    { unsigned go_ = (unsigned)r32; asm volatile("" : "+v"(go_));
#pragma unroll
      for (int d0 = 0; d0 < 4; ++d0) gnr[d0] = Cfg::MOBA ? (gn + go_)[d0 * 32] : 1.0f; }
    bf16* Ow = H.O0 + (size_t)(P0 + wid * QBLK) * Cfg::LDO;
#pragma unroll
    for (int r = 0; r < 16; ++r) { int orow = crow(r, hi); asm volatile("" : "+v"(orow));
        const float rl = __builtin_amdgcn_rcpf(li_l[orow]);
        float v0 = o[0][r] * rl, v1 = o[1][r] * rl, v2 = o[2][r] * rl, v3 = o[3][r] * rl;
        float ss = (v0 * v0 + v1 * v1) + (v2 * v2 + v3 * v3);
        ss += __shfl_xor(ss, 1); ss += __shfl_xor(ss, 2); ss += __shfl_xor(ss, 4); ss += __shfl_xor(ss, 8); ss += __shfl_xor(ss, 16);
        if (Cfg::MOBA) { const float rs = rsqrtf(ss * (1.0f / 128.0f) + 1e-6f); v0 *= rs * gnr[0]; v1 *= rs * gnr[1]; v2 *= rs * gnr[2]; v3 *= rs * gnr[3]; }
        const float n0 = __shfl_xor(v0, 1), n1 = __shfl_xor(v1, 1), n2 = __shfl_xor(v2, 1), n3 = __shfl_xor(v3, 1);
        if ((r32 & 1) == 0) { bf16* op = Ow + (unsigned)(orow * Cfg::LDO + r32);
            *(unsigned*)(op) = cvtpk(v0, n0); *(unsigned*)(op + 32) = cvtpk(v1, n1); *(unsigned*)(op + 64) = cvtpk(v2, n2); *(unsigned*)(op + 96) = cvtpk(v3, n3); } }
    VMW();
#pragma unroll
    for (int d0 = 0; d0 < 8; ++d0) *(bf16x8*)(qf + d0 * 1024) = tq[d0];
    __syncthreads();
#undef RESC
#undef KBASE
#undef MASKT
#undef AINIT
#undef SEAM_K0
#undef HALF_STEP
}
#undef ROW
#undef VMW
#undef VMWN
#undef SLOAD_H
#undef SWRITE_HK
#undef SWRITE_HV
#undef SWRITE_H
#undef KSWZ
#undef SBAR
}

namespace gdn {
typedef short bf16x8 __attribute__((ext_vector_type(8)));
typedef float f32x16 __attribute__((ext_vector_type(16)));
typedef float f32x4 __attribute__((ext_vector_type(4)));
typedef unsigned u32x4 __attribute__((ext_vector_type(4)));
typedef unsigned u32x2 __attribute__((ext_vector_type(2)));
typedef _Float16 f16x4 __attribute__((ext_vector_type(4)));
typedef _Float16 f16x8 __attribute__((ext_vector_type(8)));
#define GLAS __attribute__((address_space(3)))
constexpr int IMG_BYTES = 75776, IMG_W = 0, IMG_U = 16384, IMG_QD = 32768, IMG_KDT = 49152, IMG_QK = 65536, IMG_GL = 73728;
constexpr int IMG_IN_OUT = 1771;
__device__ __forceinline__ int sw256(int row, int cb) { return row * 256 + (cb ^ ((row & 15) << 4)); }
__device__ __forceinline__ int sw128(int row, int cb) { return row * 128 + (cb ^ (((row >> 1) & 7) << 4)); }
__device__ __forceinline__ unsigned cvtpk(float lo, float hi) { unsigned r; asm volatile("v_cvt_pk_bf16_f32 %0, %1, %2" : "=v"(r) : "v"(lo), "v"(hi)); return r; }
__device__ __forceinline__ float bfl(unsigned w) { return __uint_as_float(w << 16); }
__device__ __forceinline__ float bfh(unsigned w) { return __uint_as_float(w & 0xffff0000u); }
__device__ __forceinline__ unsigned char* img_ptr(unsigned char* out_bytes, unsigned char* ws_img, int chunk) {
    return chunk < IMG_IN_OUT ? out_bytes + (size_t)chunk * IMG_BYTES : ws_img + (size_t)(chunk - IMG_IN_OUT) * IMG_BYTES;
}
#define LBAR() asm volatile("s_waitcnt lgkmcnt(0)\n\ts_barrier" ::: "memory")
#define MFMA32(a, b, c) __builtin_amdgcn_mfma_f32_32x32x16_bf16((a), (b), (c), 0, 0, 0)

constexpr int RAWP = 784;
__device__ __forceinline__ void conv16(float (&a)[16], const GLAS unsigned char* rp, const GLAS float* wl) {
    typedef float f32x2 __attribute__((ext_vector_type(2)));
    f32x2 acc[8];
#pragma unroll
    for (int p = 0; p < 8; ++p) acc[p] = (f32x2){0.f, 0.f};
#pragma unroll
    for (int j = 0; j < 4; ++j) { const u32x4 x0 = *(const GLAS u32x4*)(rp + j * RAWP), x1 = *(const GLAS u32x4*)(rp + j * RAWP + 16);
        const GLAS f32x2* wv = (const GLAS f32x2*)(wl + j * 384);
        const unsigned xw[8] = {x0.x, x0.y, x0.z, x0.w, x1.x, x1.y, x1.z, x1.w};
#pragma unroll
        for (int p = 0; p < 8; ++p) { const f32x2 xv = {bfl(xw[p]), bfh(xw[p])}; acc[p] = __builtin_elementwise_fma(wv[p], xv, acc[p]); }
        __builtin_amdgcn_sched_barrier(0); }
#pragma unroll
    for (int p = 0; p < 8; ++p) { a[2 * p] = acc[p].x; a[2 * p + 1] = acc[p].y; }
#pragma unroll
    for (int e = 0; e < 16; ++e) a[e] = a[e] * __builtin_amdgcn_rcpf(1.0f + __expf(-a[e]));
}
__device__ __forceinline__ void raw_load(u32x4 (&rg)[7], const unsigned short* proj, int b, int h, int n, int tid) {
#pragma unroll
    for (int kq = 0; kq < 7; ++kq) { int p = tid + 512 * kq; p = p < 3216 ? p : 3215; const int r = p / 48, q = p - r * 48, pos = n * 64 - 3 + r, posc = pos < 0 ? 0 : pos;
        const u32x4 v = __builtin_nontemporal_load((const u32x4*)(proj + ((size_t)b * 2048 + posc) * 7232 + (q >> 4) * 1024 + h * 128 + (q & 15) * 8));
        rg[kq] = pos < 0 ? (u32x4){0u, 0u, 0u, 0u} : v; }
}
__device__ __forceinline__ void raw_store(const u32x4 (&rg)[7], GLAS unsigned char* raw, int tid) {
#pragma unroll
    for (int kq = 0; kq < 7; ++kq) { const int p = tid + 512 * kq; const int r = p / 48, q = p - r * 48; if (p < 3216) *(GLAS u32x4*)(raw + r * RAWP + q * 16) = rg[kq]; }
}
typedef _Float16 f16x2 __attribute__((ext_vector_type(2)));
template <int I, int K8> __device__ __forceinline__ void inv_k8(float& acc, float& acc1, const float (&tc)[64], const f16x2 (&tn)[32], const GLAS unsigned char* slot) {
    if constexpr (K8 * 8 < I) { const f16x8 av = *(const GLAS f16x8*)(slot + I * 128 + K8 * 16);
#pragma unroll
        for (int p = 0; p < 4; ++p) { const int k = K8 * 8 + 2 * p;
            if (k + 1 < I) { if (p & 1) acc1 = __builtin_amdgcn_fdot2((f16x2){av[2 * p], av[2 * p + 1]}, tn[k >> 1], acc1, false); else acc = __builtin_amdgcn_fdot2((f16x2){av[2 * p], av[2 * p + 1]}, tn[k >> 1], acc, false); }
            else if (k < I) acc1 -= (float)av[2 * p] * tc[k]; }
        inv_k8<I, K8 + 1>(acc, acc1, tc, tn, slot); }
}
template <int I> __device__ __forceinline__ void inv_row(float (&tc)[64], f16x2 (&tn)[32], const GLAS unsigned char* slot, int lane) {
    if constexpr (I < 64) { float acc = (I == lane) ? 1.0f : 0.0f, acc1 = 0.f; inv_k8<I, 0>(acc, acc1, tc, tn, slot); acc += acc1; tc[I] = acc;
        if constexpr (I & 1) tn[I >> 1] = (f16x2){(_Float16)(-tc[I - 1]), (_Float16)(-acc)};
        __builtin_amdgcn_sched_barrier(0);
        inv_row<I + 1>(tc, tn, slot, lane); }
}
__device__ __forceinline__ void prep(GLAS unsigned char* L, int tid, int lane, int wave, int wg, const unsigned short* proj, const float* beta, const float* gg, const float* conv_w,
                                     unsigned char* out_bytes, unsigned char* ws_img, unsigned char* scr) {
    const int r32 = lane & 31, hi = lane >> 5;
    const int bh = wg >> 2, b = bh >> 3, h = bh & 7, cg0 = (wg & 3) * 8;
    GLAS unsigned char* Kt = L; GLAS unsigned char* Qt = L + 16384; GLAS unsigned char* Vt = L + 32768;
    GLAS unsigned char* raw = L;
    GLAS float* Gs = (GLAS float*)(L + 53248); GLAS float* Bs = Gs + 64; GLAS float* gls = Gs + 128; GLAS float* cwL = Gs + 192;
    GLAS float* eRs = Gs + 192 + 1536; GLAS float* bgs = eRs + 64;
    GLAS unsigned char* As = L + 61440;
    for (int i = tid; i < 1536; i += 512) { const int j = i / 384, rem = i - j * 384; cwL[i] = conv_w[j * 3072 + (rem >> 7) * 1024 + h * 128 + (rem & 127)]; }
    u32x4 rg[7];
    raw_load(rg, proj, b, h, cg0, tid);
    float gpf = gg[((size_t)b * 2048 + cg0 * 64 + lane) * 8 + h], bpf = beta[((size_t)b * 2048 + cg0 * 64 + (tid >> 3)) * 8 + h];
    __syncthreads();
#pragma unroll 1
    for (int c = 0; c < 8; ++c) {
        int tt_ = tid; asm volatile("" : "+v"(tt_));
        const int t = tt_ >> 3, seg = tt_ & 7;
        const int n = cg0 + c, chunk = bh * 32 + n, pos = n * 64 + t; const size_t row = (size_t)b * 2048 + pos;
        unsigned char* img = img_ptr(out_bytes, ws_img, chunk);
        unsigned short* vbt = (unsigned short*)(scr + (size_t)chunk * 32768); unsigned short* kgt = vbt + 8192;
        raw_store(rg, raw, tid);
        if (wave == 0) { float g = gpf;
#pragma unroll
            for (int o = 1; o < 64; o <<= 1) { const float y = __shfl_up(g, o); if (lane >= o) g += y; }
            Gs[lane] = g; if (lane == 63) gls[c] = g; }
        if (seg == 0) Bs[t] = bpf;
        LBAR();
        const float G = Gs[t], GL = Gs[63], eG = __expf(G), eR = __expf(GL - G), bt = Bs[t], bg = bt * eG;
        float xq[16], xk[16], xv[16];
        { const GLAS unsigned char* rp = raw + t * RAWP + seg * 32;
          conv16(xq, rp, cwL + seg * 16); conv16(xk, rp + 256, cwL + 128 + seg * 16); conv16(xv, rp + 512, cwL + 256 + seg * 16); }
        { float sq = 0.f, sk = 0.f;
#pragma unroll
          for (int e = 0; e < 16; ++e) { sq += xq[e] * xq[e]; sk += xk[e] * xk[e]; }
          sq += __shfl_xor(sq, 1); sq += __shfl_xor(sq, 2); sq += __shfl_xor(sq, 4); sk += __shfl_xor(sk, 1); sk += __shfl_xor(sk, 2); sk += __shfl_xor(sk, 4);
          const float nq = rsqrtf(sq + 1e-6f) * 0.08838834764831845f, nk = rsqrtf(sk + 1e-6f);
#pragma unroll
          for (int e = 0; e < 16; ++e) { xq[e] *= nq; xk[e] *= nk; xv[e] *= bt; } }
        LBAR();
        { u32x4 w0, w1;
          w0 = (u32x4){cvtpk(xv[0], xv[1]), cvtpk(xv[2], xv[3]), cvtpk(xv[4], xv[5]), cvtpk(xv[6], xv[7])}; w1 = (u32x4){cvtpk(xv[8], xv[9]), cvtpk(xv[10], xv[11]), cvtpk(xv[12], xv[13]), cvtpk(xv[14], xv[15])};
          *(GLAS u32x4*)(Vt + sw256(t, seg * 32)) = w0; *(GLAS u32x4*)(Vt + sw256(t, seg * 32 + 16)) = w1;
          w0 = (u32x4){cvtpk(xk[0], xk[1]), cvtpk(xk[2], xk[3]), cvtpk(xk[4], xk[5]), cvtpk(xk[6], xk[7])}; w1 = (u32x4){cvtpk(xk[8], xk[9]), cvtpk(xk[10], xk[11]), cvtpk(xk[12], xk[13]), cvtpk(xk[14], xk[15])};
          *(GLAS u32x4*)(Kt + sw256(t, seg * 32)) = w0; *(GLAS u32x4*)(Kt + sw256(t, seg * 32 + 16)) = w1;
          w0 = (u32x4){cvtpk(xq[0], xq[1]), cvtpk(xq[2], xq[3]), cvtpk(xq[4], xq[5]), cvtpk(xq[6], xq[7])}; w1 = (u32x4){cvtpk(xq[8], xq[9]), cvtpk(xq[10], xq[11]), cvtpk(xq[12], xq[13]), cvtpk(xq[14], xq[15])};
          *(GLAS u32x4*)(Qt + sw256(t, seg * 32)) = w0; *(GLAS u32x4*)(Qt + sw256(t, seg * 32 + 16)) = w1;
          w0 = (u32x4){cvtpk(xq[0] * eG, xq[1] * eG), cvtpk(xq[2] * eG, xq[3] * eG), cvtpk(xq[4] * eG, xq[5] * eG), cvtpk(xq[6] * eG, xq[7] * eG)};
          w1 = (u32x4){cvtpk(xq[8] * eG, xq[9] * eG), cvtpk(xq[10] * eG, xq[11] * eG), cvtpk(xq[12] * eG, xq[13] * eG), cvtpk(xq[14] * eG, xq[15] * eG)};
          *(u32x4*)(img + IMG_QD + sw256(t, seg * 32)) = w0; *(u32x4*)(img + IMG_QD + sw256(t, seg * 32 + 16)) = w1; }
        if (seg == 0) { eRs[t] = eR; bgs[t] = bg; }
        raw_load(rg, proj, b, h, n < 31 ? n + 1 : n, tid);
        { const int n1 = n < 31 ? n + 1 : n; gpf = gg[((size_t)b * 2048 + n1 * 64 + (tt_ & 63)) * 8 + h]; bpf = beta[((size_t)b * 2048 + n1 * 64 + t) * 8 + h]; }
        LBAR();
        { const int prod = wave >> 2, mj = (wave >> 1) & 1, ni = wave & 1;
          f32x16 acc = {};
          if (!(mj == 1 && ni == 0)) { GLAS unsigned char* Xb = prod ? Qt : Kt;
#pragma unroll
              for (int s = 0; s < 8; ++s) { const bf16x8 a = *(const GLAS bf16x8*)(Kt + sw256(mj * 32 + r32, (16 * s + 8 * hi) * 2)); const bf16x8 bb = *(const GLAS bf16x8*)(Xb + sw256(ni * 32 + r32, (16 * s + 8 * hi) * 2));
                  acc = MFMA32(a, bb, acc); } }
          const int i = ni * 32 + r32; const float Gi = Gs[i], bi = prod ? 1.0f : Bs[i];
#pragma unroll
          for (int g4 = 0; g4 < 4; ++g4) { const int j0 = mj * 32 + 8 * g4 + 4 * hi; float v[4];
#pragma unroll
              for (int e = 0; e < 4; ++e) { const int j = j0 + e; const bool ok = prod ? (j <= i) : (j < i); const float d = ok ? __expf(Gi - Gs[j]) * bi : 0.f; v[e] = ok ? acc[4 * g4 + e] * d : 0.f; }
              if (prod == 0) { f16x4 hv = {(_Float16)v[0], (_Float16)v[1], (_Float16)v[2], (_Float16)v[3]}; *(GLAS f16x4*)(As + c * 8192 + i * 128 + j0 * 2) = hv; }
              else { u32x2 w = {cvtpk(v[0], v[1]), cvtpk(v[2], v[3])}; *(u32x2*)(img + IMG_QK + sw128(i, j0 * 2)) = w; } } }
        { const int ch = tt_ >> 2, tq = tt_ & 3; float kk[16], vk[16];
#pragma unroll
          for (int e = 0; e < 16; ++e) { const int tk = tq * 16 + e; kk[e] = bfl(*(const GLAS unsigned short*)(Kt + sw256(tk, ch * 2))); vk[e] = bfl(*(const GLAS unsigned short*)(Vt + sw256(tk, ch * 2))); }
          unsigned wa[8], wb[8], wc[8];
#pragma unroll
          for (int p = 0; p < 8; ++p) { const int t0 = tq * 16 + 2 * p; wa[p] = cvtpk(kk[2 * p] * eRs[t0], kk[2 * p + 1] * eRs[t0 + 1]); wb[p] = cvtpk(kk[2 * p] * bgs[t0], kk[2 * p + 1] * bgs[t0 + 1]); wc[p] = cvtpk(vk[2 * p], vk[2 * p + 1]); }
          *(u32x4*)(img + IMG_KDT + sw128(ch, tq * 32)) = (u32x4){wa[0], wa[1], wa[2], wa[3]}; *(u32x4*)(img + IMG_KDT + sw128(ch, tq * 32 + 16)) = (u32x4){wa[4], wa[5], wa[6], wa[7]};
          *(u32x4*)(kgt + ch * 64 + tq * 16) = (u32x4){wb[0], wb[1], wb[2], wb[3]}; *(u32x4*)(kgt + ch * 64 + tq * 16 + 8) = (u32x4){wb[4], wb[5], wb[6], wb[7]};
          *(u32x4*)(vbt + ch * 64 + tq * 16) = (u32x4){wc[0], wc[1], wc[2], wc[3]}; *(u32x4*)(vbt + ch * 64 + tq * 16 + 8) = (u32x4){wc[4], wc[5], wc[6], wc[7]}; }
        LBAR();
    }
    GLAS unsigned char* slot = As + wave * 8192;
    int lane2 = lane; asm volatile("" : "+v"(lane2));
    const int r32b = lane2 & 31, hib = lane2 >> 5;
    { float tc[64]; f16x2 tn[32];
      inv_row<0>(tc, tn, slot, lane2);
      asm volatile("s_waitcnt lgkmcnt(0)" ::: "memory");
#pragma unroll
      for (int i = 0; i < 64; ++i) *(GLAS unsigned short*)(slot + sw128(i, lane2 * 2)) = (unsigned short)(cvtpk(tc[i], 0.f) & 0xffffu); }
    asm volatile("s_waitcnt vmcnt(0) lgkmcnt(0)" ::: "memory");
    __syncthreads();
    { const int chunk = bh * 32 + cg0 + wave; unsigned char* img = img_ptr(out_bytes, ws_img, chunk);
      const unsigned short* vbt = (const unsigned short*)(scr + (size_t)chunk * 32768); const unsigned short* kgt = vbt + 8192;
      bf16x8 gf[4][4], gk[4][4];
#pragma unroll
      for (int dvt = 0; dvt < 4; ++dvt)
#pragma unroll
          for (int s = 0; s < 4; ++s) gf[dvt][s] = *(const bf16x8*)(vbt + (dvt * 32 + r32b) * 64 + 16 * s + 8 * hib);
#pragma unroll
      for (int dkt = 0; dkt < 4; ++dkt)
#pragma unroll
          for (int s = 0; s < 4; ++s) gk[dkt][s] = *(const bf16x8*)(kgt + (dkt * 32 + r32b) * 64 + 16 * s + 8 * hib);
#pragma unroll
      for (int tile = 0; tile < 8; ++tile) { const int ti = tile >> 2, dvt = tile & 3; f32x16 acc = {};
#pragma unroll
          for (int s = 0; s < 4; ++s) { if (s < 2 * (ti + 1)) { const bf16x8 a = *(const GLAS bf16x8*)(slot + sw128(ti * 32 + r32b, (16 * s + 8 * hib) * 2)); acc = MFMA32(a, gf[dvt][s], acc); } }
          u32x4 w0 = {pg8::cvt_pk_bf16_acc(acc[0], acc[1]), pg8::cvt_pk_bf16_acc(acc[2], acc[3]), pg8::cvt_pk_bf16_acc(acc[4], acc[5]), pg8::cvt_pk_bf16_acc(acc[6], acc[7])}, w1 = {pg8::cvt_pk_bf16_acc(acc[8], acc[9]), pg8::cvt_pk_bf16_acc(acc[10], acc[11]), pg8::cvt_pk_bf16_acc(acc[12], acc[13]), pg8::cvt_pk_bf16_acc(acc[14], acc[15])};
          *(u32x4*)(img + IMG_U + tile * 2048 + lane2 * 32) = w0; *(u32x4*)(img + IMG_U + tile * 2048 + lane2 * 32 + 16) = w1; }
#pragma unroll
      for (int tile = 0; tile < 8; ++tile) { const int dkt = tile >> 1, ni = tile & 1; f32x16 acc = {};
#pragma unroll
          for (int s = 0; s < 4; ++s) { if (s < 2 * (ni + 1)) { const bf16x8 bb = *(const GLAS bf16x8*)(slot + sw128(ni * 32 + r32b, (16 * s + 8 * hib) * 2)); acc = MFMA32(gk[dkt][s], bb, acc); } }
          { const unsigned a0 = pg8::cvt_pk_bf16_acc(acc[0], acc[1]), a1 = pg8::cvt_pk_bf16_acc(acc[2], acc[3]), b0 = pg8::cvt_pk_bf16_acc(acc[4], acc[5]), b1 = pg8::cvt_pk_bf16_acc(acc[6], acc[7]);
            const auto r0 = __builtin_amdgcn_permlane32_swap(a0, b0, false, false), r1 = __builtin_amdgcn_permlane32_swap(a1, b1, false, false);
            *(u32x4*)(img + IMG_W + ((ni * 8 + 2 * dkt) * 64 + lane2) * 16) = (u32x4){r0[0], r1[0], r0[1], r1[1]}; }
          { const unsigned a0 = pg8::cvt_pk_bf16_acc(acc[8], acc[9]), a1 = pg8::cvt_pk_bf16_acc(acc[10], acc[11]), b0 = pg8::cvt_pk_bf16_acc(acc[12], acc[13]), b1 = pg8::cvt_pk_bf16_acc(acc[14], acc[15]);
            const auto r0 = __builtin_amdgcn_permlane32_swap(a0, b0, false, false), r1 = __builtin_amdgcn_permlane32_swap(a1, b1, false, false);
            *(u32x4*)(img + IMG_W + ((ni * 8 + 2 * dkt + 1) * 64 + lane2) * 16) = (u32x4){r0[0], r1[0], r0[1], r1[1]}; } }
      if (lane2 == 0) *(float*)(img + IMG_GL) = __expf(gls[wave]); }
}

__device__ __forceinline__ void scan(GLAS unsigned char* L, int tid, int lane, int wave, int bh, unsigned char* out_bytes, unsigned char* ws_img, const unsigned short* proj, const float* gn, unsigned short* ob) {
    const int r32 = lane & 31, hi = lane >> 5, b = bh >> 3, h = bh & 7;
    GLAS unsigned char* ST = L + 75776; GLAS unsigned char* VNT = L + 108544; GLAS float* RED = (GLAS float*)(L + 124928); GLAS float* OT = (GLAS float*)L;
    const int ti = wave >> 2, dvt = wave & 3, dk0t = 2 * (wave >> 2);
    f32x16 s0 = {}, s1 = {};
    for (int i = tid; i < 2048; i += 512) ((GLAS u32x4*)ST)[i] = (u32x4){0u, 0u, 0u, 0u};
    const int tok = tid & 63, part = wave;
    float gnr[16];
#pragma unroll
    for (int e = 0; e < 16; ++e) gnr[e] = gn[part * 16 + e];
    u32x4 pf[10];
    { const u32x4* img0 = (const u32x4*)img_ptr(out_bytes, ws_img, bh * 32);
#pragma unroll
      for (int i = 0; i < 10; ++i) { const int p = tid + 512 * i; pf[i] = img0[p < 4624 ? p : 4623]; } }
#pragma unroll 1
    for (int n = 0; n < 32; ++n) {
#pragma unroll
        for (int i = 0; i < 10; ++i) { const int p = tid + 512 * i; if (p < 4624) ((GLAS u32x4*)L)[p] = pf[i]; }
        LBAR();
        { const u32x4* imgn = (const u32x4*)img_ptr(out_bytes, ws_img, bh * 32 + (n < 31 ? n + 1 : n));
#pragma unroll
          for (int i = 0; i < 10; ++i) { const int p = tid + 512 * i; pf[i] = imgn[p < 4624 ? p : 4623]; } }
        const size_t row = (size_t)b * 2048 + n * 64 + tok;
        const unsigned short* zp = proj + row * 7232 + 3072 + h * 128 + part * 16; const u32x4 z0 = *(const u32x4*)zp, z1 = *(const u32x4*)(zp + 8);
        { f32x16 acc = {};
#pragma unroll
          for (int s = 0; s < 8; ++s) { const bf16x8 a = *(const GLAS bf16x8*)(L + IMG_W + ((ti * 8 + s) * 64 + lane) * 16); const bf16x8 bb = *(const GLAS bf16x8*)(ST + sw256(dvt * 32 + r32, (16 * s + 8 * hi) * 2)); acc = MFMA32(a, bb, acc); }
          const u32x4 u0 = *(const GLAS u32x4*)(L + IMG_U + wave * 2048 + lane * 32), u1 = *(const GLAS u32x4*)(L + IMG_U + wave * 2048 + lane * 32 + 16);
          const unsigned uw[8] = {u0.x, u0.y, u0.z, u0.w, u1.x, u1.y, u1.z, u1.w};
#pragma unroll
          for (int g4 = 0; g4 < 4; ++g4) { const float v0 = bfl(uw[2 * g4]) - acc[4 * g4], v1 = bfh(uw[2 * g4]) - acc[4 * g4 + 1], v2 = bfl(uw[2 * g4 + 1]) - acc[4 * g4 + 2], v3 = bfh(uw[2 * g4 + 1]) - acc[4 * g4 + 3];
              u32x2 w = {cvtpk(v0, v1), cvtpk(v2, v3)}; *(GLAS u32x2*)(VNT + sw128(dvt * 32 + r32, (ti * 32 + 8 * g4 + 4 * hi) * 2)) = w; } }
        LBAR();
        { f32x16 acc = {};
#pragma unroll
          for (int s = 0; s < 8; ++s) { const bf16x8 a = *(const GLAS bf16x8*)(L + IMG_QD + sw256(ti * 32 + r32, (16 * s + 8 * hi) * 2)); const bf16x8 bb = *(const GLAS bf16x8*)(ST + sw256(dvt * 32 + r32, (16 * s + 8 * hi) * 2)); acc = MFMA32(a, bb, acc); }
#pragma unroll
          for (int s = 0; s < 4; ++s) { if (s < 2 * (ti + 1)) { const bf16x8 a = *(const GLAS bf16x8*)(L + IMG_QK + sw128(ti * 32 + r32, (16 * s + 8 * hi) * 2)); const bf16x8 bb = *(const GLAS bf16x8*)(VNT + sw128(dvt * 32 + r32, (16 * s + 8 * hi) * 2)); acc = MFMA32(a, bb, acc); } }
#pragma unroll
          for (int g4 = 0; g4 < 4; ++g4) { const f32x4 w = {acc[4 * g4], acc[4 * g4 + 1], acc[4 * g4 + 2], acc[4 * g4 + 3]}; const int dv = dvt * 32 + r32, chk = ti * 8 + 2 * g4 + hi;
              *(GLAS f32x4*)(OT + dv * 64 + ((chk ^ (dv & 15)) << 2)) = w; } }
        LBAR();
        float ov[16]; float ss = 0.f;
#pragma unroll
        for (int e = 0; e < 16; ++e) { const int dv = part * 16 + e; ov[e] = OT[dv * 64 + ((((tok >> 2) ^ (dv & 15)) << 2) | (tok & 3))]; ss += ov[e] * ov[e]; }
        RED[part * 64 + tok] = ss;
        { const float gl = *(const GLAS float*)(L + IMG_GL);
          s0 = s0 * gl; s1 = s1 * gl;
#pragma unroll
          for (int s = 0; s < 4; ++s) { const bf16x8 bb = *(const GLAS bf16x8*)(VNT + sw128(dvt * 32 + r32, (16 * s + 8 * hi) * 2));
              const bf16x8 a0 = *(const GLAS bf16x8*)(L + IMG_KDT + sw128(dk0t * 32 + r32, (16 * s + 8 * hi) * 2)), a1 = *(const GLAS bf16x8*)(L + IMG_KDT + sw128(dk0t * 32 + 32 + r32, (16 * s + 8 * hi) * 2));
              s0 = MFMA32(a0, bb, s0); s1 = MFMA32(a1, bb, s1); }
#pragma unroll
          for (int g4 = 0; g4 < 4; ++g4) { u32x2 w = {pg8::cvt_pk_bf16_acc(s0[4 * g4], s0[4 * g4 + 1]), pg8::cvt_pk_bf16_acc(s0[4 * g4 + 2], s0[4 * g4 + 3])}; *(GLAS u32x2*)(ST + sw256(dvt * 32 + r32, (dk0t * 32 + 8 * g4 + 4 * hi) * 2)) = w;
              u32x2 w2 = {pg8::cvt_pk_bf16_acc(s1[4 * g4], s1[4 * g4 + 1]), pg8::cvt_pk_bf16_acc(s1[4 * g4 + 2], s1[4 * g4 + 3])}; *(GLAS u32x2*)(ST + sw256(dvt * 32 + r32, (dk0t * 32 + 32 + 8 * g4 + 4 * hi) * 2)) = w2; } }
        LBAR();
        { float tot = 0.f;
#pragma unroll
          for (int p = 0; p < 8; ++p) tot += RED[p * 64 + tok];
          const float rs = rsqrtf(tot * (1.0f / 128.0f) + 1e-6f);
          const unsigned zw[8] = {z0.x, z0.y, z0.z, z0.w, z1.x, z1.y, z1.z, z1.w}; unsigned res[8];
#pragma unroll
          for (int k = 0; k < 8; ++k) res[k] = cvtpk(ov[2 * k] * rs * gnr[2 * k] * bfl(zw[k]), ov[2 * k + 1] * rs * gnr[2 * k + 1] * bfh(zw[k]));
          unsigned short* op = ob + row * 2048 + h * 128 + part * 16;
          *(u32x4*)op = (u32x4){res[0], res[1], res[2], res[3]}; *(u32x4*)(op + 8) = (u32x4){res[4], res[5], res[6], res[7]}; }
        LBAR();
    }
}
#undef MFMA32
#undef LBAR
#undef GLAS
}

constexpr int NB = 8, SEQ = 2048, DM = 2048, MTOK = NB * SEQ;
constexpr int HD = 128, NPROJ = 7168, PROJ_LD = 7232;
constexpr int DFF = 5632, MEMLEN = 256, MROWS = NB * MEMLEN, XW = 512;
constexpr float EPS = 1e-6f;
constexpr int NWAVES = 8, NTHREADS = 512;
constexpr int LDS_BYTES = 147456;
constexpr int LDS_MISC = 147200;
constexpr int CW_BAR = 4096;

constexpr size_t MiB = 1u << 20;
constexpr size_t WS_RSQ2 = 768 * 1024, WS_RSQ3 = 832 * 1024, WS_RSQ4 = 896 * 1024;
constexpr size_t WS_KMEAN = 512 * 1024;
constexpr size_t WS_WGU = 1 * MiB, WS_WDOWN = 23 * MiB, WS_X2Q = 34 * MiB, WS_SMALL = 67 * MiB, WS_XB = 70 * MiB;
constexpr float WGU_SCALE = 32.0f, WDOWN_SCALE = 64.0f;
constexpr size_t WS_GATE = 134 * MiB;
constexpr size_t WS_WINB = 142 * MiB;
constexpr size_t WS_WIN = 134 * MiB, WS_PROJ = 162 * MiB, WS_O = 388 * MiB;
constexpr size_t WS_QX = 162 * MiB, WS_OX = 178 * MiB, WS_KVX = 194 * MiB;
constexpr size_t WS_WXQ = 486 * MiB, WS_WXKV = 488 * MiB, WS_WXO = 492 * MiB, WS_WOUT = 494 * MiB, WS_MEMB = 502 * MiB, WS_END = 510 * MiB;
constexpr size_t SM_RSTD1 = 0, SM_RSTD2 = 65536, SM_RSTD3 = 131072, SM_RSTDM = 196608, SM_W16 = 262144, SM_KMEAN = 327680, SM_BETA = 1 * MiB, SM_G = 1 * MiB + 524288;

#define LAS __attribute__((address_space(3)))
typedef unsigned short bf16_t;
typedef float f32x4 __attribute__((ext_vector_type(4)));
typedef unsigned u32x4 __attribute__((ext_vector_type(4)));
typedef unsigned u32x2 __attribute__((ext_vector_type(2)));

__device__ __forceinline__ float bf2f(unsigned v) { return __uint_as_float(v << 16); }
__device__ __forceinline__ unsigned f2bf(float f) { unsigned u = __float_as_uint(f); return (u + 0x7fffu + ((u >> 16) & 1u)) >> 16; }
__device__ __forceinline__ unsigned pk2(float lo, float hi) { return f2bf(lo) | (f2bf(hi) << 16); }
__device__ __forceinline__ float wave_sum(float v) {
#pragma unroll
    for (int o = 1; o < 64; o <<= 1) v += __shfl_xor(v, o);
    return v;
}
__device__ __forceinline__ float silu_acc(float v) { return v * __builtin_amdgcn_rcpf(1.0f + __expf(-v)); }

#define XB_TMO      128
#define XB_XCNT(j)  (256  + 64 * (j))
#define XB_XSUB(j)  (1280 + 64 * (j))
#define XB_XGEN(j)  (2304 + 64 * (j))
#define XB_TOP      3328
#define XB_TOPGEN   3392
#define XCD_BAR_WORDS 3456
#define XB_SPIN_CAP (1u << 18)

__device__ __forceinline__ unsigned xb_ld(unsigned* p)              { return __hip_atomic_load(p, __ATOMIC_RELAXED, __HIP_MEMORY_SCOPE_AGENT); }
__device__ __forceinline__ unsigned xb_add(unsigned* p, unsigned v) { return __hip_atomic_fetch_add(p, v, __ATOMIC_RELAXED, __HIP_MEMORY_SCOPE_AGENT); }
__device__ __forceinline__ unsigned xb_xcc_id() { return (unsigned)__builtin_amdgcn_s_getreg((3 << 11) | 20) & 0xFu; }
#define XB_SPIN(cond, bar) do { unsigned _sp = 0; while (cond) { __builtin_amdgcn_s_sleep(1); \
    if ((++_sp & 255u) == 0u) { if (xb_ld(&(bar)[XB_TMO])) break; if (_sp > XB_SPIN_CAP) { atomicAdd(&(bar)[XB_TMO], 1u); break; } } } } while (0)

struct XcdBarrier {
    unsigned* bar; unsigned x;
    volatile LAS unsigned* st;
};

__device__ __forceinline__ XcdBarrier xcd_barrier_post(unsigned* bar, volatile LAS unsigned* st, int tid) {
    XcdBarrier b; b.bar = bar; b.x = xb_xcc_id(); b.st = st;
    if (tid == 0) (void)xb_add(&bar[XB_XCNT(b.x)], 1u);
    return b;
}
__device__ __forceinline__ void xcd_barrier_complete(unsigned* bar, unsigned x, unsigned& nloc, unsigned& nx) {
    const unsigned G = gridDim.x * gridDim.y * gridDim.z;
    unsigned sum, cnt, mine, sp = 0u;
    for (;;) {
        sum = 0u; cnt = 0u; mine = 0u;
#pragma unroll
        for (unsigned j = 0; j < 16; ++j) { const unsigned c = xb_ld(&bar[XB_XCNT(j)]); sum += c; cnt += (c > 0u) ? 1u : 0u; mine = (j == x) ? c : mine; }
        if (sum == G) break;
        __builtin_amdgcn_s_sleep(1);
        if ((++sp & 255u) == 0u) { if (xb_ld(&bar[XB_TMO])) break; if (sp > XB_SPIN_CAP) { atomicAdd(&bar[XB_TMO], 1u); break; } }
    }
    nloc = mine > 0u ? mine : 1u; nx = cnt > 0u ? cnt : 1u;
}

__device__ __forceinline__ void xcd_barrier(const XcdBarrier& b, int tid) {
    asm volatile("s_waitcnt vmcnt(0)" ::: "memory");
    __syncthreads();
    if (tid == 0) {
        unsigned* bar = b.bar;
        __builtin_amdgcn_s_waitcnt(0);
        unsigned nloc = b.st[0], nx = b.st[1];
        if (nloc == 0u) { xcd_barrier_complete(bar, b.x, nloc, nx); b.st[0] = nloc; b.st[1] = nx; }
        const unsigned seq = b.st[2]; b.st[2] = seq + 1u;
        const unsigned old = xb_add(&bar[XB_XSUB(b.x)], 1u);
        const unsigned gen = old / nloc;
        if (old + 1u == (gen + 1u) * nloc) {
            __builtin_amdgcn_fence(__ATOMIC_RELEASE, "agent");
            asm volatile("s_waitcnt vmcnt(0)" ::: "memory");
            const unsigned og = xb_add(&bar[XB_TOP], 1u);
            const unsigned tg = og / nx;
            if (og + 1u == (tg + 1u) * nx) xb_add(&bar[XB_TOPGEN], 1u);
        }
        XB_SPIN(xb_ld(&bar[XB_TOPGEN]) <= seq, bar);
        __builtin_amdgcn_fence(__ATOMIC_ACQUIRE, "agent");
        asm volatile("s_waitcnt vmcnt(0)" ::: "memory");
    }
    __syncthreads();
}


struct Args { const float* in[23]; float* out; unsigned char* ws; int ph_lo, ph_hi; };
#define ARGP(A, k) ((A).in[k])
#define TABP(F, k) ((const float*)(((const __attribute__((address_space(1))) float* const*)((F).ws + 256))[k]))
struct Frame {
    LAS unsigned char* lds;
    int tid, lane, wave, G, bid;
    float* out; unsigned char* ws;
};

__device__ __forceinline__ void transpose_item(const float* W, int ldw, int col0, int K, const float* gain, bf16_t* WT, int row_off, int nblk, LAS float* scr, int item, int lane) {
    const int kb = item / nblk, nb = item % nblk, k0 = 64 * kb, n0 = 64 * nb;
    const float* src = W + (size_t)(k0 + (lane >> 4)) * ldw + col0 + n0 + (lane & 15) * 4;
    f32x4 v[16];
#pragma unroll
    for (int i = 0; i < 16; ++i) v[i] = __builtin_nontemporal_load((const f32x4*)(src + (size_t)(4 * i) * ldw));
#pragma unroll
    for (int i = 0; i < 16; ++i) { const int kk = 4 * i + (lane >> 4); const float g = gain ? gain[k0 + kk] : 1.0f; LAS float* d = scr + kk * 65 + (lane & 15) * 4;
        d[0] = v[i].x * g; d[1] = v[i].y * g; d[2] = v[i].z * g; d[3] = v[i].w * g; }
    asm volatile("s_waitcnt lgkmcnt(0)" ::: "memory");
    const int c = lane & 7;
#pragma unroll
    for (int j = 0; j < 8; ++j) { const int n = (lane >> 3) + 8 * j; const LAS float* s = scr + (8 * c) * 65 + n;
        u32x4 o; o.x = pk2(s[0 * 65], s[1 * 65]); o.y = pk2(s[2 * 65], s[3 * 65]); o.z = pk2(s[4 * 65], s[5 * 65]); o.w = pk2(s[6 * 65], s[7 * 65]);
        *(u32x4*)(WT + (size_t)(row_off + n0 + n) * K + k0 + 8 * c) = o; }
    asm volatile("s_waitcnt lgkmcnt(0)" ::: "memory");
}
__device__ __forceinline__ void transpose_item8(const float* W, int ldw, int col0, int K, const float* gain, float scale, unsigned char* WT8, int row_off, int nblk, LAS float* scr, int item, int lane) {
    const int kb = item / nblk, nb = item % nblk, k0 = 64 * kb, n0 = 64 * nb;
    const float* src = W + (size_t)(k0 + (lane >> 4)) * ldw + col0 + n0 + (lane & 15) * 4;
    f32x4 v[16];
#pragma unroll
    for (int i = 0; i < 16; ++i) v[i] = __builtin_nontemporal_load((const f32x4*)(src + (size_t)(4 * i) * ldw));
#pragma unroll
    for (int i = 0; i < 16; ++i) { const int kk = 4 * i + (lane >> 4); const float g = (gain ? gain[k0 + kk] : 1.0f) * scale; LAS float* d = scr + kk * 65 + (lane & 15) * 4;
        d[0] = v[i].x * g; d[1] = v[i].y * g; d[2] = v[i].z * g; d[3] = v[i].w * g; }
    asm volatile("s_waitcnt lgkmcnt(0)" ::: "memory");
    const int c = lane & 7;
#pragma unroll
    for (int j = 0; j < 8; ++j) { const int n = (lane >> 3) + 8 * j; const LAS float* s = scr + (8 * c) * 65 + n;
        int w0 = __builtin_amdgcn_cvt_pk_fp8_f32(s[0 * 65], s[1 * 65], 0, false); w0 = __builtin_amdgcn_cvt_pk_fp8_f32(s[2 * 65], s[3 * 65], w0, true);
        int w1 = __builtin_amdgcn_cvt_pk_fp8_f32(s[4 * 65], s[5 * 65], 0, false); w1 = __builtin_amdgcn_cvt_pk_fp8_f32(s[6 * 65], s[7 * 65], w1, true);
        *(u32x2*)(WT8 + (size_t)(row_off + n0 + n) * K + k0 + 8 * c) = (u32x2){(unsigned)w0, (unsigned)w1}; }
    asm volatile("s_waitcnt lgkmcnt(0)" ::: "memory");
}
__device__ __forceinline__ void row_to_bf16(const float* xrow, bf16_t* orow, float* rstd_out, int lane, unsigned char* q8row = nullptr) {
    const f32x4* xr = (const f32x4*)xrow + lane;
    f32x4 v[8]; float s = 0.f;
#pragma unroll
    for (int j = 0; j < 8; ++j) { v[j] = __builtin_nontemporal_load(xr + 64 * j); s += (v[j].x * v[j].x + v[j].y * v[j].y) + (v[j].z * v[j].z + v[j].w * v[j].w); }
    s = wave_sum(s);
    if (lane == 0) *rstd_out = rsqrtf(s * (1.0f / DM) + EPS);
    u32x2* o8 = (u32x2*)orow + lane;
#pragma unroll
    for (int j = 0; j < 8; ++j) { u32x2 w; w.x = pk2(v[j].x, v[j].y); w.y = pk2(v[j].z, v[j].w); o8[64 * j] = w; }
    if (q8row) { unsigned* q4 = (unsigned*)q8row + lane;
#pragma unroll
        for (int j = 0; j < 8; ++j) { int q = __builtin_amdgcn_cvt_pk_fp8_f32(v[j].x, v[j].y, 0, false); q = __builtin_amdgcn_cvt_pk_fp8_f32(v[j].z, v[j].w, q, true); q4[64 * j] = (unsigned)q; } }
}
__device__ __forceinline__ void phase_prologue(const Frame& F, const Args& A) {
    if (F.bid == 0 && F.tid < 23) ((const float**)(F.ws + 256))[F.tid] = A.in[F.tid];
    LAS float* scr = (LAS float*)(F.lds + F.wave * 17408);
    const int gw = F.bid * NWAVES + F.wave, NGW = F.G * NWAVES;
    bf16_t* Win_t = (bf16_t*)(F.ws + WS_WIN); bf16_t* Wout_t = (bf16_t*)(F.ws + WS_WOUT); bf16_t* Wxq_t = (bf16_t*)(F.ws + WS_WXQ); bf16_t* Wxkv_t = (bf16_t*)(F.ws + WS_WXKV);
    bf16_t* Wxo_t = (bf16_t*)(F.ws + WS_WXO); bf16_t* Wgu_t = (bf16_t*)(F.ws + WS_WGU); bf16_t* Wdown_t = (bf16_t*)(F.ws + WS_WDOWN);
    constexpr int I_INA = 32 * 64, I_INB = 32 * 48, I_OUT = 32 * 32, I_XQ = 32 * 8, I_XKV = 32 * 16, I_XO = 8 * 32, I_G = 32 * 88, I_D = 88 * 32;
    constexpr int NITEMS = I_INA + I_INB + I_OUT + I_XQ + I_XKV + I_XO;
    for (int it = gw; it < NITEMS; it += NGW) {
        int r = it;
        if (r < I_INA) { transpose_item8(ARGP(A, 3), 7184, 0, DM, ARGP(A, 2), WGU_SCALE, (unsigned char*)Win_t, 0, 64, scr, r, F.lane); continue; } r -= I_INA;
        if (r < I_INB) { transpose_item(ARGP(A, 3), 7184, 4112, DM, ARGP(A, 2), (bf16_t*)(F.ws + WS_WINB), 0, 48, scr, r, F.lane); continue; } r -= I_INB;
        if (r < I_OUT) { transpose_item(ARGP(A, 10), DM, 0, DM, nullptr, Wout_t, 0, 32, scr, r, F.lane); continue; } r -= I_OUT;
        if (r < I_XQ) { transpose_item(ARGP(A, 13), XW, 0, DM, ARGP(A, 11), Wxq_t, 0, 8, scr, r, F.lane); continue; } r -= I_XQ;
        if (r < I_XKV) { transpose_item(ARGP(A, 14), 2 * XW, 0, DM, ARGP(A, 12), Wxkv_t, 0, 16, scr, r, F.lane); continue; } r -= I_XKV;
        transpose_item(ARGP(A, 15), DM, 0, XW, nullptr, Wxo_t, 0, 32, scr, r, F.lane);
    }
    { bf16_t* W16 = (bf16_t*)(F.ws + WS_SMALL + SM_W16);
      for (int i = F.bid * NTHREADS + F.tid; i < 16 * DM; i += F.G * NTHREADS) { const int j = i >> 11, k = i & 2047; W16[i] = (bf16_t)f2bf(ARGP(A, 3)[(size_t)k * 7184 + 4096 + j] * ARGP(A, 2)[k]); } }
    { bf16_t* xb = (bf16_t*)(F.ws + WS_XB); float* rstd1 = (float*)(F.ws + WS_SMALL + SM_RSTD1);
      for (int m = gw; m < MTOK; m += NGW) row_to_bf16(ARGP(A, 0) + (size_t)m * DM, xb + (size_t)m * DM, rstd1 + m, F.lane, F.ws + WS_X2Q + (size_t)m * DM);
      bf16_t* memb = (bf16_t*)(F.ws + WS_MEMB); float* rstdm = (float*)(F.ws + WS_SMALL + SM_RSTDM);
      for (int m = gw; m < MROWS; m += NGW) row_to_bf16(ARGP(A, 1) + (size_t)m * DM, memb + (size_t)m * DM, rstdm + m, F.lane); }
}
__device__ __forceinline__ void phase_ffn_weights(const Frame& F, int iw, int nwg) {
    LAS float* scr = (LAS float*)(F.lds + F.wave * 17408);
    unsigned char* Wgu8 = F.ws + WS_WGU; unsigned char* Wdown8 = F.ws + WS_WDOWN;
    constexpr int I_G = 32 * 88, I_D = 88 * 32;
    for (int it = iw * NWAVES + F.wave; it < 2 * I_G + I_D; it += nwg * NWAVES) {
        int r = it;
        if (r < I_G) { const int c0 = 64 * (r % 88); transpose_item8(TABP(F, 17), DFF, 0, DM, TABP(F, 16), WGU_SCALE, Wgu8, ((c0 >> 7) << 8) + (c0 & 127) - c0, 88, scr, r, F.lane); continue; } r -= I_G;
        if (r < I_G) { const int c0 = 64 * (r % 88); transpose_item8(TABP(F, 18), DFF, 0, DM, TABP(F, 16), WGU_SCALE, Wgu8, ((c0 >> 7) << 8) + (c0 & 127) - c0 + 128, 88, scr, r, F.lane); continue; } r -= I_G;
        transpose_item8(TABP(F, 21), DM, 0, DFF, nullptr, WDOWN_SCALE, Wdown8, 0, 32, scr, r, F.lane);
    }
}
__device__ __forceinline__ void phase_final_norm(const Frame& F, const Args& A) {
    const int gw = F.bid * NWAVES + F.wave, NGW = F.G * NWAVES; const f32x4* g4 = (const f32x4*)TABP(F, 22) + 2 * F.lane;
    const bf16_t* xb = (const bf16_t*)(F.ws + WS_XB); const float* rsq = (const float*)(F.ws + WS_RSQ4);
    for (int m = gw; m < MTOK; m += NGW) {
        const float r = rsqrtf(rsq[m] * (1.0f / DM) + EPS);
        const u32x4* xr = (const u32x4*)(xb + (size_t)m * DM) + F.lane; f32x4* orow = (f32x4*)(F.out + (size_t)m * DM) + 2 * F.lane;
#pragma unroll
        for (int j = 0; j < 4; ++j) { const u32x4 h = __builtin_nontemporal_load(xr + 64 * j);
            const f32x4 a = {bf2f(h.x & 0xffffu), bf2f(h.x >> 16), bf2f(h.y & 0xffffu), bf2f(h.y >> 16)}, b = {bf2f(h.z & 0xffffu), bf2f(h.z >> 16), bf2f(h.w & 0xffffu), bf2f(h.w >> 16)};
            orow[128 * j] = a * r * g4[128 * j]; orow[128 * j + 1] = b * r * g4[128 * j + 1]; }
    }
}
typedef short mk_bf16x8 __attribute__((ext_vector_type(8)));
__device__ __forceinline__ void ba_item(const Frame& F, int item, int khalf) {
    const int lane = F.lane, r = lane & 15, q = lane >> 4, row0 = item * 16;
    const bf16_t* xa = (const bf16_t*)(F.ws + WS_XB) + (size_t)(row0 + r) * DM + khalf * 1024 + q * 8; const bf16_t* wb = (const bf16_t*)(F.ws + WS_SMALL + SM_W16) + (size_t)r * DM + khalf * 1024 + q * 8;
    f32x4 acc = {0.f, 0.f, 0.f, 0.f};
#pragma unroll 16
    for (int s = 0; s < 32; ++s) { const mk_bf16x8 a = *(const mk_bf16x8*)(xa + 32 * s), b = *(const mk_bf16x8*)(wb + 32 * s); acc = __builtin_amdgcn_mfma_f32_16x16x32_bf16(a, b, acc, 0, 0, 0); }
    LAS f32x4* xch = (LAS f32x4*)F.lds + (F.wave & 3) * 64 + lane;
    if (khalf) *xch = acc;
    __syncthreads();
    if (khalf) return;
    acc += *xch;
    const float* rstd1 = (const float*)(F.ws + WS_SMALL + SM_RSTD1); float* beta = (float*)(F.ws + WS_SMALL + SM_BETA); float* gg = (float*)(F.ws + WS_SMALL + SM_G);
    const int c = lane & 15, h = c & 7; const float alog = TABP(F, 5)[h], dtb = TABP(F, 6)[h];
#pragma unroll
    for (int i = 0; i < 4; ++i) { const int row = row0 + 4 * q + i; const float y = acc[i] * rstd1[row];
        if (c < 8) beta[(size_t)row * 8 + h] = 1.0f / (1.0f + expf(-y));
        else { const float z = y + dtb; const float sp = z > 20.f ? z : log1pf(expf(z)); gg[(size_t)row * 8 + h] = -expf(alog) * sp; } }
}
__device__ __forceinline__ void phase_moba(const Frame& F, const Args& A, char* lds, int cu) {
    const int grp = cu >> 6, bh = cu & 63, b = bh >> 3, h = bh & 7;
    const unsigned list = grp == 0 ? 0x37u : (grp == 1 ? 0x46u : 0x0125u); const int cnt = grp == 2 ? 4 : 2;
    moba::Head H; H.Q0 = (const bf16_t*)(F.ws + WS_PROJ) + (size_t)(b * SEQ) * PROJ_LD + 4096 + h * 128; H.K0 = H.Q0 + 1024; H.V0 = H.Q0 + 2048; H.O0 = (bf16_t*)(F.ws + WS_O) + (size_t)(b * SEQ) * DM + 1024 + h * 128;
    H.km = (const float*)(F.ws + WS_KMEAN) + (size_t)(b * 8) * 1024 + h * 128;
    moba::Seam S; int P0 = (int)(list & 15u) * 256;
    moba::prime<moba::CfgMoba>(H, P0, lds, S, F.tid, F.wave);
    for (int i = 0; i < cnt; ++i) { const int P0n = (i + 1 < cnt) ? (int)((list >> (4 * (i + 1))) & 15u) * 256 : P0; moba::block<moba::CfgMoba>(H, P0, P0n, TABP(F, 9), h, TABP(F, 8), lds, S, F.tid, F.wave); P0 = P0n; }
}
__device__ __forceinline__ void phase_xattn(const Frame& F, char* lds, int item) {
    const int qb = item & 7, h = (item >> 3) & 3, b = item >> 5;
    moba::Head H; H.Q0 = (const bf16_t*)(F.ws + WS_QX) + (size_t)(b * SEQ) * XW + h * 128; H.K0 = (const bf16_t*)(F.ws + WS_KVX) + (size_t)(b * MEMLEN) * (2 * XW) + h * 128; H.V0 = H.K0 + XW;
    H.O0 = (bf16_t*)(F.ws + WS_OX) + (size_t)(b * SEQ) * XW + h * 128; H.km = nullptr;
    moba::Seam S; const int P0 = qb * 256;
    moba::prime<moba::CfgX>(H, P0, lds, S, F.tid, F.wave);
    moba::block<moba::CfgX>(H, P0, P0, nullptr, h, nullptr, lds, S, F.tid, F.wave);
}
static_assert(moba::LDS_BYTES <= LDS_MISC && LDS_MISC + 128 <= LDS_BYTES, "LDS map");

__device__ __forceinline__ void ffn_fixup(const Frame& F, int pm) {
    const bf16_t* halo = (const bf16_t*)(F.ws + WS_GATE); const float* cw = TABP(F, 19); const float* cb = TABP(F, 20); unsigned char* H8 = (unsigned char*)F.out;
    u32x4 a2[3], a1[3], a0[3], au[3];
#pragma unroll
    for (int k = 0; k < 3; ++k) { int idx = F.tid + k * NTHREADS; idx = idx < 2 * 704 ? idx : 2 * 704 - 1; const int R = idx / 704, c = (idx - R * 704) * 8;
        const bf16_t* hp = halo + (size_t)(pm - 1) * 6 * 5632 + c; const bf16_t* hc = halo + (size_t)pm * 6 * 5632 + c;
        a2[k] = *(const u32x4*)(hp + (R == 0 ? 0 : 1) * 5632); a1[k] = *(const u32x4*)(R == 0 ? hp + 5632 : hc + 2 * 5632); a0[k] = *(const u32x4*)(hc + (2 + R) * 5632); au[k] = *(const u32x4*)(hc + (4 + R) * 5632); }
#pragma unroll
    for (int k = 0; k < 3; ++k) { const int idx = F.tid + k * NTHREADS; if (idx >= 2 * 704) break; const int R = idx / 704, c = (idx - R * 704) * 8;
        const unsigned v2[4] = {a2[k].x, a2[k].y, a2[k].z, a2[k].w}, v1[4] = {a1[k].x, a1[k].y, a1[k].z, a1[k].w}, v0[4] = {a0[k].x, a0[k].y, a0[k].z, a0[k].w}, vu[4] = {au[k].x, au[k].y, au[k].z, au[k].w}; float hv[8];
#pragma unroll
        for (int e = 0; e < 8; ++e) { const unsigned sh = (e & 1) ? 16u : 0u; const int kq = e >> 1, chn = c + e;
            const float x2 = bf2f((v2[kq] >> sh) & 0xffffu), x1 = bf2f((v1[kq] >> sh) & 0xffffu), gc = bf2f((v0[kq] >> sh) & 0xffffu), uu = bf2f((vu[kq] >> sh) & 0xffffu);
            const float y = cw[chn] * x2 + cw[DFF + chn] * x1 + cw[2 * DFF + chn] * gc + cb[chn]; hv[e] = y * __builtin_amdgcn_rcpf(1.0f + __expf(-y)) * uu; }
        int q0 = __builtin_amdgcn_cvt_pk_fp8_f32(hv[0], hv[1], 0, false); q0 = __builtin_amdgcn_cvt_pk_fp8_f32(hv[2], hv[3], q0, true);
        int q1 = __builtin_amdgcn_cvt_pk_fp8_f32(hv[4], hv[5], 0, false); q1 = __builtin_amdgcn_cvt_pk_fp8_f32(hv[6], hv[7], q1, true);
        *(u32x2*)(H8 + (size_t)(pm * 256 + R) * DFF + c) = (u32x2){(unsigned)q0, (unsigned)q1}; }
}
constexpr int N_PHASES = 14;
constexpr int WGM_IN1 = 8, WGM_IN2 = 8, WGM_OUT = 4, WGM_XQ = 4, WGM_XO = 4, WGM_GU = 4, WGM_DOWN = 4;

__global__ void __launch_bounds__(NTHREADS, 2) mk_fwd(Args args) {
    const Args& A = args;
    extern __shared__ __attribute__((aligned(16))) unsigned char lds_raw[];
    Frame F;
    F.lds = (LAS unsigned char*)lds_raw;
    F.wave = __builtin_amdgcn_readfirstlane((int)threadIdx.x >> 6); F.lane = 0; F.tid = 0;
#define FRESH_IDS() do { int l_; asm volatile("v_mbcnt_lo_u32_b32 %0, -1, 0\n\tv_mbcnt_hi_u32_b32 %0, -1, %0" : "=v"(l_)); F.lane = l_; F.tid = F.wave * 64 + l_; } while (0)
    F.G = gridDim.x; F.bid = blockIdx.x;
    F.out = args.out; F.ws = args.ws;
    const int lo = args.ph_lo, hi = args.ph_hi;
    unsigned char* ws = args.ws;
    const float* rstd1 = (const float*)(ws + WS_SMALL + SM_RSTD1); float* rstd2 = (float*)(ws + WS_SMALL + SM_RSTD2); float* rstd3 = (float*)(ws + WS_SMALL + SM_RSTD3);
    const float* rstdm = (const float*)(ws + WS_SMALL + SM_RSTDM);
    bf16_t* xb = (bf16_t*)(ws + WS_XB);
#define IN(k) (lo <= (k) && (k) < hi)
    volatile LAS unsigned* MISC = (volatile LAS unsigned*)(F.lds + LDS_MISC);
    XcdBarrier bar; bar.bar = (unsigned*)ws + CW_BAR; bar.x = 0; bar.st = nullptr;
    if (hi - lo > 1) { FRESH_IDS(); if (F.tid < 32) MISC[F.tid] = 0u; __syncthreads(); bar = xcd_barrier_post((unsigned*)ws + CW_BAR, MISC + 8, F.tid); }
#define SEAM(k) do { if (IN(k) && IN((k) + 1)) { FRESH_IDS(); xcd_barrier(bar, F.tid); } } while (0)

    if (IN(0)) { FRESH_IDS(); phase_prologue(F, A); }
    if (lo < 0) cg::this_grid().sync();
    SEAM(0);
    if (IN(1)) { FRESH_IDS();
        if ((F.bid & 1) == 0) { ba_item(F, (F.wave & 3) * 256 + F.bid, F.wave >> 2);
            __syncthreads();
            FRESH_IDS(); }
        { pg8::Gemm g{(const bf16_t*)(ws + WS_X2Q), (const bf16_t*)(ws + WS_WIN), MTOK, 4096, DM / 2}; pg8::StaticOrder S; S.init(MTOK, 4096, F.G, F.bid, WGM_IN1);
          pg8::EpiScaleBf16 E{(bf16_t*)(ws + WS_PROJ), PROJ_LD, rstd1, 12, 16, 0, 0, nullptr, 0, 0, 0, 1.0f / WGU_SCALE};
          pg8::gemm_phase<pg8::EpiScaleBf16, pg8::StaticOrder, true, true, true>(F.lds, g, S, E, F.tid, F.wave); }
        FRESH_IDS();
        { pg8::Gemm g{xb, (const bf16_t*)(ws + WS_WINB), MTOK, 3072, DM}; pg8::StaticOrder S; S.init(MTOK, 3072, F.G, F.bid, WGM_IN2);
          pg8::EpiScaleBf16 E{(bf16_t*)(ws + WS_PROJ) + 4096, PROJ_LD, rstd1, 0, 0, 0, 0, (float*)(ws + WS_KMEAN), 4, 8, 0, 1.0f, 0, 4, moba::QSCALE};
          pg8::gemm_phase<pg8::EpiScaleBf16, pg8::StaticOrder, true, true>(F.lds, g, S, E, F.tid, F.wave); }
        if (F.bid & 1) { __syncthreads(); FRESH_IDS(); ba_item(F, (F.wave & 3) * 256 + F.bid, F.wave >> 2); }
    } SEAM(1);
    if (IN(2)) { FRESH_IDS();
        gdn::prep((__attribute__((address_space(3))) unsigned char*)F.lds, F.tid, F.lane, F.wave, F.bid, (const unsigned short*)(ws + WS_PROJ), (const float*)(ws + WS_SMALL + SM_BETA), (const float*)(ws + WS_SMALL + SM_G), TABP(F, 4),
                  (unsigned char*)F.out, ws + WS_WIN, ws + WS_O); } SEAM(2);
    if (IN(3)) { FRESH_IDS();
        if (F.bid < 64) gdn::scan((__attribute__((address_space(3))) unsigned char*)F.lds, F.tid, F.lane, F.wave, F.bid, (unsigned char*)F.out, ws + WS_WIN, (const unsigned short*)(ws + WS_PROJ), TABP(F, 7), (unsigned short*)(ws + WS_O));
        else if (F.bid < 256) phase_moba(F, A, (char*)lds_raw, F.bid - 64);
    } SEAM(3);
    if (IN(4)) { FRESH_IDS();
        pg8::Gemm g{(const bf16_t*)(ws + WS_O), (const bf16_t*)(ws + WS_WOUT), MTOK, DM, DM}; pg8::StaticOrder S; S.init(MTOK, DM, F.G, F.bid, WGM_OUT);
        pg8::EpiResidBf16 E{xb, xb, DM, (float*)(ws + WS_RSQ2), 1.0f, nullptr};
        pg8::gemm_phase<pg8::EpiResidBf16, pg8::StaticOrder, true, true>(F.lds, g, S, E, F.tid, F.wave);
    } SEAM(4);
    if (IN(6)) { FRESH_IDS();
        { pg8::Gemm g{xb, (const bf16_t*)(ws + WS_WXQ), MTOK, XW, DM}; pg8::StaticOrder S; S.init(MTOK, XW, F.G, F.bid, WGM_XQ);
          pg8::EpiScaleBf16 E{(bf16_t*)(ws + WS_QX), XW, (const float*)(ws + WS_RSQ2), 0, 0, 0, 0, nullptr, 0, 0, 1, moba::QSCALE};
          pg8::gemm_phase<pg8::EpiScaleBf16, pg8::StaticOrder, true, true>(F.lds, g, S, E, F.tid, F.wave); }
        { pg8::Gemm g{(const bf16_t*)(ws + WS_MEMB), (const bf16_t*)(ws + WS_WXKV), MROWS, 2 * XW, DM}; pg8::StaticOrder S; S.init(MROWS, 2 * XW, F.G, (F.bid + F.G - 128) % F.G);
          pg8::EpiScaleBf16 E{(bf16_t*)(ws + WS_KVX), 2 * XW, rstdm, 0, 0, 0, 0, nullptr, 0, 0, 0, 1.0f};
          pg8::gemm_phase<pg8::EpiScaleBf16, pg8::StaticOrder, true, true>(F.lds, g, S, E, F.tid, F.wave); }
        if (F.bid >= 160 && F.bid < 256) { FRESH_IDS(); phase_ffn_weights(F, F.bid - 160, 96); }
    } SEAM(6);
    if (IN(7)) { FRESH_IDS(); if (F.bid < 256) phase_xattn(F, (char*)lds_raw, F.bid); } SEAM(7);
    if (IN(8)) { FRESH_IDS();
        pg8::Gemm g{(const bf16_t*)(ws + WS_OX), (const bf16_t*)(ws + WS_WXO), MTOK, DM, XW}; pg8::StaticOrder S; S.init(MTOK, DM, F.G, F.bid, WGM_XO);
        pg8::EpiResidBf16 E{xb, xb, DM, (float*)(ws + WS_RSQ3), 1.0f, ws + WS_X2Q};
        pg8::gemm_phase<pg8::EpiResidBf16, pg8::StaticOrder, true, true>(F.lds, g, S, E, F.tid, F.wave);
    } SEAM(8);
    if (IN(10)) { FRESH_IDS();
        pg8::Gemm g{(const bf16_t*)(ws + WS_X2Q), (const bf16_t*)(ws + WS_WGU), MTOK, 2 * DFF, DM / 2}; pg8::StaticOrder S; S.init(MTOK, 2 * DFF, F.G, F.bid, WGM_GU);
        pg8::EpiFfn E{(unsigned char*)F.out, (const float*)(ws + WS_RSQ3), TABP(F, 19), TABP(F, 20), (bf16_t*)(ws + WS_GATE), (__attribute__((address_space(3))) float*)(F.lds + 131072), 1.0f / WGU_SCALE};
        pg8::gemm_phase<pg8::EpiFfn, pg8::StaticOrder, true, true, true>(F.lds, g, S, E, F.tid, F.wave);
    } SEAM(10);
    if (IN(12)) { FRESH_IDS();
        { pg8::StaticOrder S0; S0.init(MTOK, DM, F.G, F.bid, WGM_DOWN); pg8::Unit u0;
          if (S0.next(0, u0) && (u0.pm & 7)) ffn_fixup(F, u0.pm);
          if (S0.next(1, u0) && (u0.pm & 7)) ffn_fixup(F, u0.pm);
          asm volatile("s_waitcnt vmcnt(0)" ::: "memory"); __syncthreads(); FRESH_IDS(); }
        pg8::Gemm g{(const bf16_t*)F.out, (const bf16_t*)(ws + WS_WDOWN), MTOK, DM, DFF / 2};     pg8::StaticOrder S; S.init(MTOK, DM, F.G, F.bid, WGM_DOWN);
        pg8::EpiResidBf16 E{xb, xb, DM, (float*)(ws + WS_RSQ4), 1.0f / WDOWN_SCALE, nullptr};
        pg8::gemm_phase<pg8::EpiResidBf16, pg8::StaticOrder, true, true, true>(F.lds, g, S, E, F.tid, F.wave);
    } SEAM(12);
    if (IN(13)) { FRESH_IDS(); phase_final_norm(F, A); }
#undef IN
#undef SEAM
}

extern "C" void kernel_launch(void* const* d_in, const int* in_sizes, int n_in, void* d_out, int out_size, void* d_ws, size_t ws_size, hipStream_t stream) {
    static int grid = 0;
    if (grid == 0) {
        if (n_in != 23 || in_sizes[0] != MTOK * DM || out_size != MTOK * DM || ws_size < WS_END) {
            fprintf(stderr, "kernel_launch: unexpected shapes: n_in %d, in0 %d, out %d, ws %zu (need >= %zu); nothing launched\n", n_in, n_in > 0 ? in_sizes[0] : -1, out_size, ws_size, (size_t)WS_END); grid = -1; return; }
        int dev = 0, cus = 0, per_cu = 0;
        if (hipGetDevice(&dev) != hipSuccess || hipDeviceGetAttribute(&cus, hipDeviceAttributeMultiprocessorCount, dev) != hipSuccess) { fprintf(stderr, "kernel_launch: device query failed\n"); grid = -1; return; }
        if (hipFuncSetAttribute((const void*)mk_fwd, hipFuncAttributeMaxDynamicSharedMemorySize, LDS_BYTES) != hipSuccess) { fprintf(stderr, "kernel_launch: hipFuncSetAttribute failed\n"); grid = -1; return; }
        if (hipOccupancyMaxActiveBlocksPerMultiprocessor(&per_cu, (const void*)mk_fwd, NTHREADS, LDS_BYTES) != hipSuccess || per_cu < 1) { fprintf(stderr, "kernel_launch: occupancy query says %d blocks per CU\n", per_cu); per_cu = 1; }
        (void)hipGetLastError();
        if (per_cu > 1) per_cu = 1;
        grid = cus * per_cu;
        if (grid != 256) { fprintf(stderr, "kernel_launch: built for a 256-CU device (grid %d); nothing launched\n", grid); grid = -1; return; }
    }
    if (grid < 0) return;
    if (hipMemsetAsync(d_ws, 0, 1u << 20, stream) != hipSuccess) { fprintf(stderr, "kernel_launch: hipMemsetAsync failed\n"); return; }
    Args a{};
    for (int i = 0; i < 23; ++i) a.in[i] = (const float*)d_in[i];
    a.out = (float*)d_out; a.ws = (unsigned char*)d_ws;
#if MK_MULTI
    for (int p = 0; p < N_PHASES; ++p) { a.ph_lo = p; a.ph_hi = p + 1; hipLaunchKernelGGL(mk_fwd, dim3(grid), dim3(NTHREADS), LDS_BYTES, stream, a); }
#else
    a.ph_lo = 0; a.ph_hi = N_PHASES;
    void* kargs[] = {&a};
    hipError_t e = hipLaunchCooperativeKernel((const void*)mk_fwd, dim3(grid), dim3(NTHREADS), kargs, LDS_BYTES, stream);
    if (e != hipSuccess) fprintf(stderr, "kernel_launch: cooperative launch failed: %s (grid %d)\n", hipGetErrorString(e), grid);
#endif
}
```

```cpp
#include <hip/hip_runtime.h>
#include <hip/hip_cooperative_groups.h>
#include <cstdio>
#include <cstdint>
namespace cg = cooperative_groups;

#ifndef MK_MULTI
#define MK_MULTI 0
#endif

namespace pg8 {
#define PG8_LAS __attribute__((address_space(3)))
typedef unsigned short bf16_t;
typedef short bf16x8 __attribute__((ext_vector_type(8)));
typedef float f32x4 __attribute__((ext_vector_type(4)));
typedef unsigned u32x4 __attribute__((ext_vector_type(4)));
typedef int pg8_v4i __attribute__((ext_vector_type(4)));
typedef int pg8_v8i __attribute__((ext_vector_type(8)));
constexpr int BM = 256, BK = 64, HALF = 128, HTB = HALF * BK * 2  , STAGE_BYTES = 8 * HTB, NXCD = 8;

__host__ __device__ __forceinline__ int lds_byte(int r, int c) { const int st = (r >> 4) * 2 + (c >> 5), rr = r & 15, cc = c & 31, ob = rr * 64 + cc * 2; return st * 1024 + (ob ^ (((ob >> 9) & 1) << 5)); }
__host__ __device__ __forceinline__ void stage_rc(int b, int& R, int& C) { const int st = b / 1024, sb = b % 1024, swz = sb ^ (((sb >> 9) & 1) << 5); R = (st >> 1) * 16 + swz / 64; C = (st & 1) * 32 + (swz % 64) / 2; }
__host__ __device__ __forceinline__ int perm32(int rho) { const int n = rho >> 4, i = rho & 15; return 8 * (i >> 2) + 4 * n + (i & 3); }

struct Unit { int pm, pn; };
struct Gemm { const bf16_t* A; const bf16_t* Bt; int M, N, K; };

struct StaticOrder {
    int nM, nN, nwg, G, c, WGM;
    __host__ __device__ __forceinline__ void init(int M, int N, int G_, int c_, int wgm_ = 8) { nM = M / BM; nN = N / BM; nwg = nM * nN; G = G_; c = c_; WGM = wgm_; }
    __host__ __device__ __forceinline__ bool next(int i, Unit& u) const {
        const long L = (long)i * G + c; if (L >= nwg) return false;
        int wgid = (int)L; { const int q = nwg / NXCD, r = nwg % NXCD, xcd = wgid % NXCD, off = wgid / NXCD; wgid = (xcd < r ? xcd * (q + 1) : r * (q + 1) + (xcd - r) * q) + off; }
        const int nig = WGM * nN, gid = wgid / nig, fm = gid * WGM, gsz = (nM - fm) < WGM ? (nM - fm) : WGM;
        u.pm = fm + ((wgid % nig) % gsz); u.pn = (wgid % nig) / gsz; return true;
    }
    __device__ __forceinline__ void a_ready(const Unit&) const {}
    __device__ __forceinline__ void done(const Unit&) const {}
};


__device__ __forceinline__ unsigned cvt_pk_bf16(float lo, float hi) { unsigned r; asm volatile("v_cvt_pk_bf16_f32 %0, %1, %2" : "=v"(r) : "v"(lo), "v"(hi)); return r; }
typedef __bf16 hw_bf16x2 __attribute__((ext_vector_type(2)));
typedef float hw_f32x2 __attribute__((ext_vector_type(2)));
__device__ __forceinline__ unsigned cvt_pk_bf16_acc(float lo, float hi) { const hw_bf16x2 r = __builtin_convertvector((hw_f32x2){lo, hi}, hw_bf16x2); return __builtin_bit_cast(unsigned, r); }
__device__ __forceinline__ float silu_f(float v) { return v * __builtin_amdgcn_rcpf(1.0f + __expf(-v)); }

struct EpiScaleBf16 {
    static constexpr bool PERM = true, AFTER_DRAIN = false;
    bf16_t* O; int ldc; const float* rs; int silu_lo, silu_hi; int split_cols; size_t split_stride; float* km; int km_lo, km_hi; int rs_sumsq; float oscale; int qs_lo, qs_hi; float qscale;
    __device__ __forceinline__ void operator()(const f32x4 (&acc)[2][2][4][2], const Unit& u, int wr, int wc, int fr, int fq) const {
        int colt = u.pn * BM; bf16_t* base = O; if (split_cols && colt >= split_cols) { base += split_stride; colt -= split_cols; }
        const int row0 = u.pm * BM + wr * 64 + fr, col0 = colt + wc * 32 + 8 * fq;
        const bool act = (u.pn >= silu_lo && u.pn < silu_hi); const float tscale = (u.pn >= qs_lo && u.pn < qs_hi) ? oscale * qscale : oscale;
        const bool dokm = km && u.pn >= km_lo && u.pn < km_hi; float cs[2][8];
#pragma unroll
        for (int a_ = 0; a_ < 2; ++a_)
#pragma unroll
            for (int b_ = 0; b_ < 8; ++b_) cs[a_][b_] = 0.f;
        float rsv[2][4];
#pragma unroll
        for (int ai = 0; ai < 2; ++ai)
#pragma unroll
            for (int m = 0; m < 4; ++m) rsv[ai][m] = rs ? rs[row0 + ai * HALF + m * 16] : 1.0f;
#pragma unroll
        for (int ai = 0; ai < 2; ++ai)
#pragma unroll
            for (int m = 0; m < 4; ++m) { const int row = row0 + ai * HALF + m * 16; float r = rsv[ai][m]; if (rs_sumsq) r = rsqrtf(r * (1.0f / 2048.0f) + 1e-6f); r *= tscale; bf16_t* rowp = base + (size_t)row * ldc + col0;
#pragma unroll
                for (int bj = 0; bj < 2; ++bj) { f32x4 v0 = acc[ai][bj][m][0] * r, v1 = acc[ai][bj][m][1] * r;
                    if (act) {
#pragma unroll
                        for (int j = 0; j < 4; ++j) { v0[j] = silu_f(v0[j]); v1[j] = silu_f(v1[j]); } }
                    if (dokm) {
#pragma unroll
                        for (int j = 0; j < 4; ++j) { cs[bj][j] += v0[j]; cs[bj][4 + j] += v1[j]; } }
                    u32x4 w; w.x = cvt_pk_bf16(v0[0], v0[1]); w.y = cvt_pk_bf16(v0[2], v0[3]); w.z = cvt_pk_bf16(v1[0], v1[1]); w.w = cvt_pk_bf16(v1[2], v1[3]);
                    *(u32x4*)(rowp + bj * HALF) = w; } }
        if (dokm) {
#pragma unroll
            for (int bj = 0; bj < 2; ++bj)
#pragma unroll
                for (int c = 0; c < 8; ++c) { float s = cs[bj][c]; s += __shfl_xor(s, 1); s += __shfl_xor(s, 2); s += __shfl_xor(s, 4); s += __shfl_xor(s, 8);
                    if (fr == 0) atomicAdd(km + (size_t)u.pm * 1024 + (u.pn - km_lo) * BM + bj * HALF + wc * 32 + 8 * fq + c, s * (1.0f / 256.0f)); } }
    }
};
struct EpiResidBf16 {
    static constexpr bool PERM = true, AFTER_DRAIN = false;
    const bf16_t* baseh; bf16_t* out; int ldc; float* rowsq; float accscale; unsigned char* q8;
    __device__ __forceinline__ void operator()(const f32x4 (&acc)[2][2][4][2], const Unit& u, int wr, int wc, int fr, int fq) const {
        const int row0 = u.pm * BM + wr * 64 + fr, col0 = u.pn * BM + wc * 32 + 8 * fq;
#pragma unroll
        for (int ai = 0; ai < 2; ++ai) {
            u32x4 hb[4][2];
#pragma unroll
            for (int m = 0; m < 4; ++m)
#pragma unroll
                for (int bj = 0; bj < 2; ++bj) hb[m][bj] = *(const u32x4*)(baseh + (size_t)(row0 + ai * HALF + m * 16) * ldc + col0 + bj * HALF);
#pragma unroll
            for (int m = 0; m < 4; ++m) { const int row = row0 + ai * HALF + m * 16; const size_t off = (size_t)row * ldc + col0; float ss = 0.f;
#pragma unroll
                for (int bj = 0; bj < 2; ++bj) { const u32x4 h = hb[m][bj];
                    const f32x4 b0 = (f32x4){__uint_as_float(h.x << 16), __uint_as_float(h.x & 0xffff0000u), __uint_as_float(h.y << 16), __uint_as_float(h.y & 0xffff0000u)};
                    const f32x4 b1 = (f32x4){__uint_as_float(h.z << 16), __uint_as_float(h.z & 0xffff0000u), __uint_as_float(h.w << 16), __uint_as_float(h.w & 0xffff0000u)};
                    const f32x4 v0 = b0 + acc[ai][bj][m][0] * accscale, v1 = b1 + acc[ai][bj][m][1] * accscale;
                    ss += (v0[0] * v0[0] + v0[1] * v0[1]) + (v0[2] * v0[2] + v0[3] * v0[3]) + (v1[0] * v1[0] + v1[1] * v1[1]) + (v1[2] * v1[2] + v1[3] * v1[3]);
                    u32x4 w; w.x = cvt_pk_bf16(v0[0], v0[1]); w.y = cvt_pk_bf16(v0[2], v0[3]); w.z = cvt_pk_bf16(v1[0], v1[1]); w.w = cvt_pk_bf16(v1[2], v1[3]);
                    *(u32x4*)(out + off + bj * HALF) = w;
                    if (q8) { int q0 = __builtin_amdgcn_cvt_pk_fp8_f32(v0[0], v0[1], 0, false); q0 = __builtin_amdgcn_cvt_pk_fp8_f32(v0[2], v0[3], q0, true);
                        int q1 = __builtin_amdgcn_cvt_pk_fp8_f32(v1[0], v1[1], 0, false); q1 = __builtin_amdgcn_cvt_pk_fp8_f32(v1[2], v1[3], q1, true);
                        typedef unsigned u32x2_ __attribute__((ext_vector_type(2))); *(u32x2_*)(q8 + off + bj * HALF) = (u32x2_){(unsigned)q0, (unsigned)q1}; } }
                ss += __shfl_xor(ss, 16); ss += __shfl_xor(ss, 32);
                if (fq == 0) atomicAdd(rowsq + row, ss); } }
    }
};

struct EpiFfn {
    static constexpr bool PERM = true, AFTER_DRAIN = false;
    unsigned char* H8; const float* rsq; const float* cw; const float* cb; bf16_t* halo; PG8_LAS float* X;
    float oscale;
    __device__ __forceinline__ void operator()(f32x4 (&acc)[2][2][4][2], const Unit& u, int wr, int wc, int fr_in, int fq_in) const {
        int fr = fr_in, fq = fq_in; asm volatile("" : "+v"(fr), "+v"(fq));
        const int wid = wr * 4 + wc, ch = u.pn * 128 + wc * 32 + 8 * fq, lane = fq * 16 + fr;
#pragma unroll
        for (int ai = 0; ai < 2; ++ai)
#pragma unroll
            for (int m = 0; m < 4; ++m) { const int row = u.pm * BM + ai * HALF + wr * 64 + m * 16 + fr; const float r = rsqrtf(rsq[row] * (1.0f / 2048.0f) + 1e-6f) * oscale;
#pragma unroll
                for (int bj = 0; bj < 2; ++bj) { acc[ai][bj][m][0] = acc[ai][bj][m][0] * r; acc[ai][bj][m][1] = acc[ai][bj][m][1] * r; } }
        if (fr >= 14) {
#pragma unroll
            for (int ai = 0; ai < 2; ++ai) { PG8_LAS f32x4* xp = (PG8_LAS f32x4*)(X + ((wid * 2 + ai) * 2 + (fr - 14)) * 64 + fq * 8); xp[0] = acc[ai][0][3][0]; xp[1] = acc[ai][0][3][1]; } }
        { bf16_t* hp = halo + (size_t)u.pm * 6 * 5632 + ch;
          if (wr == 1 && fr >= 14) { u32x4 w = {cvt_pk_bf16(acc[1][0][3][0][0], acc[1][0][3][0][1]), cvt_pk_bf16(acc[1][0][3][0][2], acc[1][0][3][0][3]), cvt_pk_bf16(acc[1][0][3][1][0], acc[1][0][3][1][1]), cvt_pk_bf16(acc[1][0][3][1][2], acc[1][0][3][1][3])};
              *(u32x4*)(hp + (size_t)(fr - 14) * 5632) = w; }
          if (wr == 0 && fr < 2) { u32x4 w = {cvt_pk_bf16(acc[0][0][0][0][0], acc[0][0][0][0][1]), cvt_pk_bf16(acc[0][0][0][0][2], acc[0][0][0][0][3]), cvt_pk_bf16(acc[0][0][0][1][0], acc[0][0][0][1][1]), cvt_pk_bf16(acc[0][0][0][1][2], acc[0][0][0][1][3])};
              *(u32x4*)(hp + (size_t)(2 + fr) * 5632) = w;
              u32x4 w2 = {cvt_pk_bf16(acc[0][1][0][0][0], acc[0][1][0][0][1]), cvt_pk_bf16(acc[0][1][0][0][2], acc[0][1][0][0][3]), cvt_pk_bf16(acc[0][1][0][1][0], acc[0][1][0][1][1]), cvt_pk_bf16(acc[0][1][0][1][2], acc[0][1][0][1][3])};
              *(u32x4*)(hp + (size_t)(4 + fr) * 5632) = w2; } }
        const f32x4 w0a = *(const f32x4*)(cw + ch), w0b = *(const f32x4*)(cw + ch + 4), w1a = *(const f32x4*)(cw + 5632 + ch), w1b = *(const f32x4*)(cw + 5632 + ch + 4);
        const f32x4 w2a = *(const f32x4*)(cw + 2 * 5632 + ch), w2b = *(const f32x4*)(cw + 2 * 5632 + ch + 4), ba = *(const f32x4*)(cb + ch), bb = *(const f32x4*)(cb + ch + 4);
        asm volatile("s_waitcnt lgkmcnt(0)" ::: "memory"); __builtin_amdgcn_s_barrier(); asm volatile("" ::: "memory");
#pragma unroll
        for (int ai = 1; ai >= 0; --ai)
#pragma unroll
            for (int m = 3; m >= 0; --m) {
                f32x4 pv0, pv1;
                if (m > 0) { pv0 = acc[ai][0][m - 1][0]; pv1 = acc[ai][0][m - 1][1]; }
                else { pv0 = (f32x4){0.f, 0.f, 0.f, 0.f}; pv1 = pv0;
                    if (!(wr == 0 && ai == 0) && fr >= 14) { const int pw = (1 - wr) * 4 + wc, pai = (wr == 1) ? ai : 0;
                        const PG8_LAS f32x4* xp = (const PG8_LAS f32x4*)(X + ((pw * 2 + pai) * 2 + (fr - 14)) * 64 + fq * 8); pv0 = xp[0]; pv1 = xp[1]; } }
                const f32x4 g0 = acc[ai][0][m][0], g1 = acc[ai][0][m][1], u0 = acc[ai][1][m][0], u1 = acc[ai][1][m][1];
                float hv[8];
#pragma unroll
                for (int c = 0; c < 8; ++c) { const float gc = c < 4 ? g0[c & 3] : g1[c & 3], pc = c < 4 ? pv0[c & 3] : pv1[c & 3];
                    const float x1 = __int_as_float(__builtin_amdgcn_update_dpp(0, __float_as_int(fr == 15 ? pc : gc), 0x121, 0xf, 0xf, true)), x2 = __int_as_float(__builtin_amdgcn_update_dpp(0, __float_as_int(fr >= 14 ? pc : gc), 0x122, 0xf, 0xf, true));
                    const float y = __builtin_fmaf(c < 4 ? w0a[c & 3] : w0b[c & 3], x2, __builtin_fmaf(c < 4 ? w1a[c & 3] : w1b[c & 3], x1, __builtin_fmaf(c < 4 ? w2a[c & 3] : w2b[c & 3], gc, c < 4 ? ba[c & 3] : bb[c & 3])));
                    hv[c] = y * __builtin_amdgcn_rcpf(1.0f + __expf(-y)) * (c < 4 ? u0[c & 3] : u1[c & 3]); }
                int q0 = __builtin_amdgcn_cvt_pk_fp8_f32(hv[0], hv[1], 0, false); q0 = __builtin_amdgcn_cvt_pk_fp8_f32(hv[2], hv[3], q0, true);
                int q1 = __builtin_amdgcn_cvt_pk_fp8_f32(hv[4], hv[5], 0, false); q1 = __builtin_amdgcn_cvt_pk_fp8_f32(hv[6], hv[7], q1, true);
                typedef unsigned u32x2_ __attribute__((ext_vector_type(2)));
                *(u32x2_*)(H8 + (size_t)(u.pm * BM + ai * HALF + wr * 64 + m * 16 + fr) * 5632 + ch) = (u32x2_){(unsigned)q0, (unsigned)q1}; }
    }
};

template <class Epi, class Sched, bool ALIGN_EPI = false, bool SP2 = false, bool F8 = false>
__device__ __forceinline__ void gemm_phase(PG8_LAS unsigned char* lds, const Gemm g, const Sched& S, const Epi& E, const int tid, const int wid) {
    const int lane = tid & 63, wr = wid >> 2, wc = wid & 3, fr = lane & 15, fq = lane >> 4;
    const int K = g.K, nt = K / BK;
    unsigned voffA[2], voffB[2];
#pragma unroll
    for (int i = 0; i < 2; ++i) { int R, C; stage_rc(tid * 16 + i * 8192, R, C); const int Rb = Epi::PERM ? ((R & ~31) + perm32(R & 31)) : R;
        voffA[i] = (unsigned)(R * K + C) * 2u; voffB[i] = (unsigned)(Rb * K + C) * 2u; }
    const size_t kstep = (size_t)(BK * 2);
    const size_t hstep = (size_t)HALF * K * 2;
    const size_t tstep = 2 * hstep;
    const unsigned ldsw = (unsigned)wid * 1024u;
    const int aoff = lds_byte(wr * 64 + fr, fq * 8), boff = lds_byte(wc * 32 + fr, fq * 8);
#define PG8_SA(b, h) (((b) * 2 + (h)) * HTB)
#define PG8_SB(b, h) ((4 + (b) * 2 + (h)) * HTB)
#define PG8_STAGE(bufoff, gbase, voff) do { _Pragma("unroll") for (int _i = 0; _i < 2; ++_i) { unsigned vo_ = (voff)[_i]; if constexpr (F8) asm volatile("" : "+v"(vo_));     \
        __builtin_amdgcn_global_load_lds((const unsigned*)((const char*)(gbase) + vo_), (PG8_LAS unsigned*)(lds + (bufoff) + ldsw + _i * 8192), 16, 0, 0); } } while (0)
#define PG8_LDA(dst, b, h) do { if constexpr (F8) { _Pragma("unroll") for (int m = 0; m < 4; ++m) { const pg8_v4i l_ = *(const PG8_LAS pg8_v4i*)(lds + PG8_SA(b, h) + aoff + m * 2048), h_ = *(const PG8_LAS pg8_v4i*)(lds + PG8_SA(b, h) + aoff + m * 2048 + 1024); \
            dst##8[m] = __builtin_shufflevector(l_, h_, 0, 1, 2, 3, 4, 5, 6, 7); } } \
        else { _Pragma("unroll") for (int m = 0; m < 4; ++m) _Pragma("unroll") for (int k = 0; k < 2; ++k) dst[m][k] = *(const PG8_LAS bf16x8*)(lds + PG8_SA(b, h) + aoff + m * 2048 + k * 1024); } } while (0)
#define PG8_LDB(dst, b, h) do { if constexpr (F8) { _Pragma("unroll") for (int n = 0; n < 2; ++n) { const pg8_v4i l_ = *(const PG8_LAS pg8_v4i*)(lds + PG8_SB(b, h) + boff + n * 2048), h_ = *(const PG8_LAS pg8_v4i*)(lds + PG8_SB(b, h) + boff + n * 2048 + 1024); \
            dst##8[n] = __builtin_shufflevector(l_, h_, 0, 1, 2, 3, 4, 5, 6, 7); } } \
        else { _Pragma("unroll") for (int n = 0; n < 2; ++n) _Pragma("unroll") for (int k = 0; k < 2; ++k) dst[n][k] = *(const PG8_LAS bf16x8*)(lds + PG8_SB(b, h) + boff + n * 2048 + k * 1024); } } while (0)
#define PG8_MMA(ai, bj, At, Bt) do { __builtin_amdgcn_s_setprio(1); \
        if constexpr (F8) { _Pragma("unroll") for (int m = 0; m < 4; ++m) _Pragma("unroll") for (int n = 0; n < 2; ++n) \
            acc[ai][bj][m][n] = __builtin_amdgcn_mfma_scale_f32_16x16x128_f8f6f4(Bt##8[n], At##8[m], acc[ai][bj][m][n], 0, 0, 0, 0x7f7f7f7f, 0, 0x7f7f7f7f); } \
        else { _Pragma("unroll") for (int m = 0; m < 4; ++m) _Pragma("unroll") for (int n = 0; n < 2; ++n) _Pragma("unroll") for (int k = 0; k < 2; ++k) \
            acc[ai][bj][m][n] = __builtin_amdgcn_mfma_f32_16x16x32_bf16(Bt[n][k], At[m][k], acc[ai][bj][m][n], 0, 0, 0); } \
        __builtin_amdgcn_s_setprio(0); } while (0)
#define PG8_WAIT_V(n) asm volatile("s_waitcnt vmcnt(" #n ")" ::: "memory")
#define PG8_WAIT_L(n) asm volatile("s_waitcnt lgkmcnt(" #n ")" ::: "memory")
#define PG8_BAR __builtin_amdgcn_s_barrier()
#define PG8_SCHED __builtin_amdgcn_sched_barrier(0)
    Unit cur, nxt; int ui = 0;
    if (!S.next(0, cur)) return;
    f32x4 acc[2][2][4][2];
#pragma unroll
    for (int a = 0; a < 2; ++a)
#pragma unroll
        for (int b = 0; b < 2; ++b)
#pragma unroll
            for (int m = 0; m < 4; ++m)
#pragma unroll
                for (int n = 0; n < 2; ++n) acc[a][b][m][n] = (f32x4){0.f, 0.f, 0.f, 0.f};
    bf16x8 At[4][2], B0[2][2], B1[2][2];
    pg8_v8i At8[4], B08[2], B18[2];
    const char* cA = (const char*)g.A + (size_t)cur.pm * tstep; const char* cB = (const char*)g.Bt + (size_t)cur.pn * tstep;
    S.a_ready(cur);
    if constexpr (SP2) {
        PG8_STAGE(PG8_SB(0, 0), cB, voffB); PG8_STAGE(PG8_SB(0, 1), cB + hstep, voffB); PG8_STAGE(PG8_SA(0, 0), cA, voffA); PG8_STAGE(PG8_SA(0, 1), cA + hstep, voffA);
        if (wr == 1) PG8_BAR;
        PG8_WAIT_V(2); PG8_BAR;
        PG8_STAGE(PG8_SB(1, 0), cB + kstep, voffB); PG8_STAGE(PG8_SA(1, 0), cA + kstep, voffA); PG8_STAGE(PG8_SB(1, 1), cB + hstep + kstep, voffB);
        PG8_WAIT_V(6); PG8_BAR;
    } else {
        PG8_STAGE(PG8_SB(0, 0), cB, voffB); PG8_STAGE(PG8_SA(0, 0), cA, voffA); PG8_STAGE(PG8_SB(0, 1), cB + hstep, voffB); PG8_STAGE(PG8_SA(0, 1), cA + hstep, voffA);
        if (wr == 1) PG8_BAR;
        PG8_WAIT_V(4); PG8_BAR;
        PG8_STAGE(PG8_SB(1, 0), cB + kstep, voffB); PG8_STAGE(PG8_SA(1, 0), cA + kstep, voffA); PG8_STAGE(PG8_SB(1, 1), cB + hstep + kstep, voffB);
        PG8_WAIT_V(6); PG8_BAR;
    }
    for (;;) {
        const bool has_next = S.next(ui + 1, nxt);
        const char* nA = has_next ? (const char*)g.A + (size_t)nxt.pm * tstep : cA; const char* nB = has_next ? (const char*)g.Bt + (size_t)nxt.pn * tstep : cB;
        for (int t = 0; t < nt; t += 2) {
            const bool last = (t == nt - 2);
            const char* a1 = cA + (size_t)(t + 1) * kstep;
            const char* a2 = last ? nA : cA + (size_t)(t + 2) * kstep; const char* b2 = last ? nB : cB + (size_t)(t + 2) * kstep;
            const char* a3 = a2 + kstep; const char* b3 = b2 + kstep;
            if (last && has_next) S.a_ready(nxt);
            if constexpr (SP2) {
            PG8_LDB(B0, 0, 0); PG8_LDB(B1, 0, 1); PG8_SCHED; PG8_LDA(At, 0, 0); PG8_STAGE(PG8_SA(1, 1), a1 + hstep, voffA);
            PG8_WAIT_V(8); PG8_WAIT_L(0); PG8_BAR; PG8_MMA(0, 0, At, B0); PG8_MMA(0, 1, At, B1); PG8_BAR; PG8_SCHED;
            PG8_LDA(At, 0, 1); PG8_STAGE(PG8_SB(0, 0), b2, voffB); PG8_STAGE(PG8_SB(0, 1), b2 + hstep, voffB); PG8_STAGE(PG8_SA(0, 0), a2, voffA);
            PG8_WAIT_V(8); PG8_WAIT_L(0); PG8_BAR; PG8_MMA(1, 0, At, B0); PG8_MMA(1, 1, At, B1); PG8_BAR; PG8_SCHED;
            PG8_LDB(B0, 1, 0); PG8_LDB(B1, 1, 1); PG8_SCHED; PG8_LDA(At, 1, 0); PG8_STAGE(PG8_SA(0, 1), a2 + hstep, voffA);
            PG8_WAIT_V(8); PG8_WAIT_L(0); PG8_BAR; PG8_MMA(0, 0, At, B0); PG8_MMA(0, 1, At, B1); PG8_BAR; PG8_SCHED;
            PG8_LDA(At, 1, 1); PG8_STAGE(PG8_SB(1, 0), b3, voffB); PG8_STAGE(PG8_SB(1, 1), b3 + hstep, voffB); PG8_STAGE(PG8_SA(1, 0), a3, voffA);
            PG8_WAIT_V(8); PG8_WAIT_L(0); PG8_BAR; PG8_MMA(1, 0, At, B0); PG8_MMA(1, 1, At, B1); PG8_BAR; PG8_SCHED;
            } else {
            PG8_LDB(B0, 0, 0); PG8_SCHED; PG8_LDA(At, 0, 0); PG8_STAGE(PG8_SA(1, 1), a1 + hstep, voffA);
            PG8_WAIT_L(8); PG8_BAR; PG8_WAIT_L(0); PG8_MMA(0, 0, At, B0); PG8_BAR; PG8_SCHED;
            PG8_LDB(B1, 0, 1); PG8_STAGE(PG8_SB(0, 0), b2, voffB);
            PG8_BAR; PG8_WAIT_L(0); PG8_MMA(0, 1, At, B1); PG8_BAR;
            PG8_LDA(At, 0, 1); PG8_STAGE(PG8_SA(0, 0), a2, voffA);
            PG8_BAR; PG8_WAIT_L(0); PG8_MMA(1, 0, At, B0); PG8_BAR; PG8_SCHED;
            PG8_STAGE(PG8_SB(0, 1), b2 + hstep, voffB);
            PG8_WAIT_V(6); PG8_BAR; PG8_MMA(1, 1, At, B1); PG8_BAR;
            PG8_LDB(B0, 1, 0); PG8_SCHED; PG8_LDA(At, 1, 0); PG8_STAGE(PG8_SA(0, 1), a2 + hstep, voffA);
            PG8_WAIT_L(8); PG8_BAR; PG8_WAIT_L(0); PG8_MMA(0, 0, At, B0); PG8_BAR; PG8_SCHED;
            PG8_LDB(B1, 1, 1); PG8_STAGE(PG8_SB(1, 0), b3, voffB);
            PG8_BAR; PG8_WAIT_L(0); PG8_MMA(0, 1, At, B1); PG8_BAR;
            PG8_LDA(At, 1, 1); PG8_STAGE(PG8_SA(1, 0), a3, voffA);
            PG8_BAR; PG8_WAIT_L(0); PG8_MMA(1, 0, At, B0); PG8_BAR; PG8_SCHED;
            PG8_STAGE(PG8_SB(1, 1), b3 + hstep, voffB);
            PG8_WAIT_V(6); PG8_BAR; PG8_MMA(1, 1, At, B1); PG8_BAR;
            }
        }
        if constexpr (ALIGN_EPI) { if (wr == 0) PG8_BAR; }
        if constexpr (!Epi::AFTER_DRAIN) { E(acc, cur, wr, wc, fr, fq); S.done(cur); }
        if (!has_next) break;
#pragma unroll
        for (int a = 0; a < 2; ++a)
#pragma unroll
            for (int b = 0; b < 2; ++b)
#pragma unroll
                for (int m = 0; m < 4; ++m)
#pragma unroll
                    for (int n = 0; n < 2; ++n) acc[a][b][m][n] = (f32x4){0.f, 0.f, 0.f, 0.f};
        cur = nxt; cA = nA; cB = nB; ++ui;
        if constexpr (ALIGN_EPI) { if (wr == 1) PG8_BAR; }
    }
    PG8_WAIT_V(0);
    if constexpr (!ALIGN_EPI) { if (wr == 0) PG8_BAR; }
    PG8_BAR;
    if constexpr (Epi::AFTER_DRAIN) { E.fused(acc, cur, wr, wc, fr, fq, lds, wid, lane); S.done(cur); }
#undef PG8_SA
#undef PG8_SB
#undef PG8_STAGE
#undef PG8_LDA
#undef PG8_LDB
#undef PG8_MMA
#undef PG8_WAIT_V
#undef PG8_WAIT_L
#undef PG8_BAR
#undef PG8_SCHED
}
}

namespace moba {
constexpr float SCALE = 0.08838834764831845f;
constexpr int NW = 8, QBLK = 32, KVBLK = 64, QB = NW * QBLK, D = 128;
struct CfgMoba { static constexpr int LDQ = 7232, LDK = 7232, LDO = 2048; static constexpr bool MOBA = true; };
struct CfgX { static constexpr int LDQ = 512, LDK = 1024, LDO = 512; static constexpr bool MOBA = false; };
constexpr int SHM_V = KVBLK * D * 2, SHM_K = KVBLK * D * 2;
constexpr int OFF_WS = 2 * SHM_V + 2 * SHM_K, OFF_BT = OFF_WS + NW * 64 * 4;
constexpr int OFF_KM = OFF_BT + 1024;
constexpr int OFF_Q = OFF_KM + 8192;
constexpr int LDS_BYTES = OFF_Q + NW * 8192;
constexpr float THR = 8.f;
constexpr float LOG2E = 1.4426950408889634f, QSCALE = LOG2E * SCALE, THR2 = THR * LOG2E;
typedef short bf16x8 __attribute__((ext_vector_type(8)));
typedef short s16x4 __attribute__((ext_vector_type(4)));
typedef float f32x16 __attribute__((ext_vector_type(16)));
typedef float f32x4 __attribute__((ext_vector_type(4)));
typedef unsigned u32x4 __attribute__((ext_vector_type(4)));
typedef unsigned short bf16;

#define KSWZ(row, colB) ((row) * 256 + ((colB) ^ (((row) & 7) << 4)))
#define SBAR() __builtin_amdgcn_sched_barrier(0)
__device__ __forceinline__ int v_st(int k, int c) { const int kk = (k & ~0xC) | ((k & 4) << 1) | ((k & 8) >> 1); return ((kk >> 3) * 4 + (c >> 5)) * 512 + ((kk & 7) * 32 + (c & 31)) * 2; }
__device__ __forceinline__ int v_rd_base(int lane) { return ((lane & 3) << 3) | (((lane >> 2) & 3) << 6) | (((lane >> 4) & 1) << 5) | (((lane >> 5) & 1) << 8); }
constexpr int v_rd_off(int d0, int ks, int half) { return d0 * 512 + ks * 4096 + half * 2048; }
__device__ __forceinline__ int crow(int r, int hi) { return (r & 3) + 8 * (r >> 2) + 4 * hi; }
__device__ __forceinline__ unsigned cvtpk(float lo, float hi) { unsigned r; asm volatile("v_cvt_pk_bf16_f32 %0, %1, %2" : "=v"(r) : "v"(lo), "v"(hi)); return r; }
__device__ __forceinline__ bf16x8 load8(const bf16* p) { return *reinterpret_cast<const bf16x8*>(p); }
__device__ __forceinline__ void mask_tile(f32x16& p0, f32x16& p1, int dq) {
    const float NEG = -__builtin_inff();
#pragma unroll
    for (int r = 0; r < 16; ++r) { const int c = (r & 3) + 8 * (r >> 2); if (dq - c < 0) p0[r] = NEG; if (dq - c - 32 < 0) p1[r] = NEG; }
}
__device__ __forceinline__ void bias_tile(f32x16& p0, f32x16& p1, int dq, const float* bt) {
#pragma unroll
    for (int r = 0; r < 16; ++r) { const int c = (r & 3) + 8 * (r >> 2); int n0 = dq - c, n1 = dq - c - 32; n0 = n0 < 0 ? 0 : n0; n1 = n1 < 0 ? 0 : n1; p0[r] += bt[n0]; p1[r] += bt[n1]; }
}
__device__ __forceinline__ void sel_tile(f32x16& p0, f32x16& p1, bool sel) {
    const float NEG = -__builtin_inff();
#pragma unroll
    for (int r = 0; r < 16; ++r) { p0[r] = sel ? p0[r] : NEG; p1[r] = sel ? p1[r] : NEG; }
}
template <bool FIRST>
__device__ __forceinline__ void partialSM(f32x16& p0, f32x16& p1, float& m_reg, float& alpha) {
    float pmax = p0[0]; for (int r = 1; r < 16; ++r) pmax = fmaxf(pmax, p0[r]); for (int r = 0; r < 16; ++r) pmax = fmaxf(pmax, p1[r]);
    { auto rr = __builtin_amdgcn_permlane32_swap(__float_as_uint(pmax), __float_as_uint(pmax), false, false);
      pmax = fmaxf(__uint_as_float(rr[0]), __uint_as_float(rr[1])); }
    if (!FIRST && __builtin_expect(__all(pmax <= THR2), 1)) { alpha = 1.f; }
    else { const float d = FIRST ? (pmax > -3.0e38f ? pmax : 0.f) : fmaxf(pmax, 0.f);
        alpha = __builtin_amdgcn_exp2f(-d); m_reg += d;
        for (int r = 0; r < 16; ++r) { p0[r] -= d; p1[r] -= d; } }
    for (int r = 0; r < 16; ++r) p0[r] = __builtin_amdgcn_exp2f(p0[r]);
}
__device__ __forceinline__ void finishSM(f32x16& p0, f32x16& p1, float alpha, float& l_reg, bf16x8& pa0, bf16x8& pa1, bf16x8& pa2, bf16x8& pa3) {
    for (int r = 0; r < 16; ++r) p1[r] = __builtin_amdgcn_exp2f(p1[r]);
    float ps;
    { typedef float f32x8_ __attribute__((ext_vector_type(8))); typedef float f32x2_ __attribute__((ext_vector_type(2)));
      const f32x16 t = p0 + p1; const f32x8_ a = __builtin_shufflevector(t, t, 0, 1, 2, 3, 4, 5, 6, 7) + __builtin_shufflevector(t, t, 8, 9, 10, 11, 12, 13, 14, 15);
      const f32x4 b = __builtin_shufflevector(a, a, 0, 1, 2, 3) + __builtin_shufflevector(a, a, 4, 5, 6, 7); const f32x2_ c = __builtin_shufflevector(b, b, 0, 1) + __builtin_shufflevector(b, b, 2, 3); ps = c.x + c.y; }
    { auto rr = __builtin_amdgcn_permlane32_swap(__float_as_uint(ps), __float_as_uint(ps), false, false);
      ps = __uint_as_float(rr[0]) + __uint_as_float(rr[1]); }
    l_reg = l_reg * alpha + ps;
#define PK4(P, B_, OUT) do { unsigned a0 = cvtpk(P[B_+0], P[B_+1]), a1 = cvtpk(P[B_+2], P[B_+3]);                          \
        unsigned b0 = cvtpk(P[B_+4], P[B_+5]), b1 = cvtpk(P[B_+6], P[B_+7]);                                             \
        auto r0 = __builtin_amdgcn_permlane32_swap(a0, b0, false, false); auto r1 = __builtin_amdgcn_permlane32_swap(a1, b1, false, false); \
        u32x4 w = {r0[0], r1[0], r0[1], r1[1]}; OUT = *reinterpret_cast<bf16x8*>(&w); } while (0)
    PK4(p0, 0, pa0); PK4(p0, 8, pa1); PK4(p1, 0, pa2); PK4(p1, 8, pa3);
#undef PK4
}
template <int KB>
__device__ __forceinline__ void qkt(f32x16& p0, f32x16& p1, const char* K_lds, int r32, int hi, const char* qf, float init) {
#pragma unroll
    for (int r = 0; r < 16; ++r) { p0[r] = init; p1[r] = init; }
    const char* kb[4];
#pragma unroll
    for (int dd = 0; dd < 4; ++dd) kb[dd] = K_lds + KB * SHM_K + KSWZ(r32, (dd * 16 + hi * 8) * 2);
#pragma unroll
    for (int d0 = 0; d0 < 8; ++d0) { const char* a = kb[d0 & 3] + (d0 >> 2) * 128;
        bf16x8 b0 = *reinterpret_cast<const bf16x8*>(a);
        bf16x8 b1 = *reinterpret_cast<const bf16x8*>(a + 32 * 256);
        const bf16x8 qv = *reinterpret_cast<const bf16x8*>(qf + d0 * 1024);
        p0 = __builtin_amdgcn_mfma_f32_32x32x16_bf16(b0, qv, p0, 0, 0, 0);
        p1 = __builtin_amdgcn_mfma_f32_32x32x16_bf16(b1, qv, p1, 0, 0, 0); }
}
template <int VB>
__device__ __forceinline__ void pv_tile(f32x16* o, int vb0, bf16x8 pa0, bf16x8 pa1, bf16x8 pa2, bf16x8 pa3) {
#define TRRD(dst, off) asm volatile("ds_read_b64_tr_b16 %0, %1 offset:%2" : "=&v"(dst) : "v"(vb0), "i"(off) : "memory")
#define PV_D0(d0) do { s16x4 l0, l1, l2, l3, h0, h1, h2, h3; constexpr int b_ = VB * SHM_V + v_rd_off(d0, 0, 0); \
        TRRD(l0, b_); TRRD(h0, b_ + 2048); TRRD(l1, b_ + 4096); TRRD(h1, b_ + 6144); TRRD(l2, b_ + 8192); TRRD(h2, b_ + 10240); TRRD(l3, b_ + 12288); TRRD(h3, b_ + 14336); \
        asm volatile("s_waitcnt lgkmcnt(0)" ::: "memory"); SBAR();   \
        o[d0] = __builtin_amdgcn_mfma_f32_32x32x16_bf16(pa0, (bf16x8){l0[0], l0[1], l0[2], l0[3], h0[0], h0[1], h0[2], h0[3]}, o[d0], 0, 0, 0);   \
        o[d0] = __builtin_amdgcn_mfma_f32_32x32x16_bf16(pa1, (bf16x8){l1[0], l1[1], l1[2], l1[3], h1[0], h1[1], h1[2], h1[3]}, o[d0], 0, 0, 0);   \
        o[d0] = __builtin_amdgcn_mfma_f32_32x32x16_bf16(pa2, (bf16x8){l2[0], l2[1], l2[2], l2[3], h2[0], h2[1], h2[2], h2[3]}, o[d0], 0, 0, 0);   \
        o[d0] = __builtin_amdgcn_mfma_f32_32x32x16_bf16(pa3, (bf16x8){l3[0], l3[1], l3[2], l3[3], h3[0], h3[1], h3[2], h3[3]}, o[d0], 0, 0, 0); } while (0)
    PV_D0(0); PV_D0(1); PV_D0(2); PV_D0(3);
#undef PV_D0
#undef TRRD
}
struct Head { const bf16* Q0; const bf16* K0; const bf16* V0; bf16* O0; const float* km; };
struct Seam { bf16x8 st_v0, st_v1, st_k0, st_k1; };
#define VMW() asm volatile("s_waitcnt vmcnt(0)" ::: "memory")
#define VMWN(n) asm volatile("s_waitcnt vmcnt(%0)" :: "i"(n) : "memory")
#define SLOAD_H(Kp, Vp, k0) do { const bf16* k_ = (Kp) + (size_t)(k0) * Cfg::LDK; const bf16* v_ = (Vp) + (size_t)(k0) * Cfg::LDK; unsigned vo_ = voff; asm volatile("" : "+v"(vo_));     \
                         S.st_v0 = load8(v_ + vo_); S.st_v1 = load8(v_ + 32 * Cfg::LDK + vo_);                                       \
                         S.st_k0 = load8(k_ + vo_); S.st_k1 = load8(k_ + 32 * Cfg::LDK + vo_); } while (0)
#define SWRITE_HK(bf) do { *(bf16x8*)(K_lds + (bf) * SHM_K + kws) = S.st_k0; *(bf16x8*)(K_lds + (bf) * SHM_K + kws + 32 * 256) = S.st_k1; } while (0)
#define SWRITE_HV(bf) do { *(bf16x8*)(V_lds + (bf) * SHM_V + vst0) = S.st_v0; *(bf16x8*)(V_lds + (bf) * SHM_V + vst1) = S.st_v1; } while (0)
#define SWRITE_H(bf) do { SWRITE_HV(bf); SWRITE_HK(bf); } while (0)
template <class Cfg>
__device__ __forceinline__ void prime(const Head& H, int P0, char* lds, Seam& S, const int tid, const int wid) {
    const int lane = tid & 63, r32 = lane & 31, hi = lane >> 5;
    const int sr = tid >> 4, sc = (tid & 15) * 8, kws = KSWZ(sr, sc * 2); char* K_lds = lds + 2 * SHM_V; const unsigned voff = (unsigned)(sr * Cfg::LDK + sc);
    SLOAD_H(H.K0, H.V0, 0);
    { const bf16* qb = H.Q0 + (size_t)(P0 + wid * QBLK) * Cfg::LDQ; const unsigned qoff = (unsigned)(r32 * Cfg::LDQ + hi * 8); char* qf = lds + OFF_Q + wid * 8192 + lane * 16;
      bf16x8 tq[8];
#pragma unroll
      for (int d0 = 0; d0 < 8; ++d0) tq[d0] = load8(qb + qoff + d0 * 16);
      VMW();
#pragma unroll
      for (int d0 = 0; d0 < 8; ++d0) *(bf16x8*)(qf + d0 * 1024) = tq[d0]; }
    SWRITE_HK(0);
    __syncthreads();
}
template <class Cfg>
__device__ __forceinline__ void block(const Head& H, int P0, int P0n, const float* rel_bias, int h, const float* gn, char* lds, Seam& S, const int tid_in, const int wid) {
    int tid = tid_in; asm volatile("" : "+v"(tid));
    const int lane = tid & 63, r32 = lane & 31, hi = lane >> 5;
    const int own = Cfg::MOBA ? (P0 >> 8) : 0;
    const int NT = Cfg::MOBA ? (P0 + QB) / KVBLK : 4;
    const int qlo = P0 + wid * QBLK, qm = qlo + r32 - 4 * hi;
    char* V_lds = lds; char* K_lds = lds + 2 * SHM_V;
    float* ws = (float*)(lds + OFF_WS) + wid * 64; float* li_l = ws, * al_l = ws + 32;
    float* bt = (float*)(lds + OFF_BT);
    char* qf = lds + OFF_Q + wid * 8192 + lane * 16;
    float m_reg = 0.f, l_reg = 0; f32x16 o[4] = {};
    const int sr = tid >> 4, sc = (tid & 15) * 8, vst0 = v_st(sr, sc), vst1 = v_st(32 + sr, sc), kws = KSWZ(sr, sc * 2); const unsigned voff = (unsigned)(sr * Cfg::LDK + sc);
    const int vb0 = (int)(uintptr_t)V_lds + v_rd_base(lane);
    const bf16* Kh = H.K0; const bf16* Vh = H.V0;
    const float b31 = Cfg::MOBA ? rel_bias[31 * 8 + h] : 0.f; const float cinit = b31 * LOG2E;
    if (Cfg::MOBA && tid < 256) { int bk = 31; if (tid < 16) bk = tid; else if (tid < 128) { const int l = 16 + (int)(logf((float)tid * 0.0625f) * 7.694155931f); bk = l < 31 ? l : 31; }
        bt[tid] = (rel_bias[bk * 8 + h] - b31) * LOG2E; }
    if (own >= 4 && tid < 128) { int t_ = tid; asm volatile("" : "+v"(t_));
        const int n = t_ >> 4, c = t_ & 15; const float* kp = H.km + (unsigned)(n * 1024 + c * 8); const f32x4 k0 = *(const f32x4*)kp, k1 = *(const f32x4*)(kp + 4);
        u32x4 w = {cvtpk(k0[0], k0[1]), cvtpk(k0[2], k0[3]), cvtpk(k1[0], k1[1]), cvtpk(k1[2], k1[3])}; *(u32x4*)(lds + OFF_KM + KSWZ(n, c * 16)) = w; }
    int mask = 0;
#define RESC(a) do { if (__any((a) < 1.f)) { if (hi == 0) al_l[r32] = (a); asm volatile("s_waitcnt lgkmcnt(0)" ::: "memory");              \
                     for (int d_ = 0; d_ < 4; ++d_) for (int r = 0; r < 16; ++r) o[d_][r] *= al_l[crow(r, hi)]; } } while (0)
#define KBASE(t) ((t) * KVBLK)
#define MASKT(P0_, P1_, t, SEL0) do { if (Cfg::MOBA) { const int kb_ = KBASE(t); \
        if (qlo - kb_ < 176) bias_tile(P0_, P1_, qm - kb_, bt); \
        if (SEL0 && own >= 4 && kb_ < P0) sel_tile(P0_, P1_, ((mask >> (kb_ >> 8)) & 1) != 0); \
        if (kb_ + KVBLK - 1 > qlo) mask_tile(P0_, P1_, qm - kb_); } } while (0)
#define AINIT(t) ((Cfg::MOBA && own >= 4 && KBASE(t) < P0 && (((mask >> (KBASE(t) >> 8)) & 1) == 0)) ? -__builtin_inff() : cinit - m_reg)
    constexpr int NQL = 8;
#define SEAM_K0() do { VMWN(NQL); SWRITE_HK(0); SBAR(); } while (0)
    f32x16 pA0, pA1, pB0, pB1; float alA, alB; bf16x8 pa0, pa1, pa2, pa3;
    SWRITE_HV(0); SBAR();
    if (NT > 1) { SLOAD_H(Kh, Vh, KBASE(1)); }
    SBAR(); qkt<0>(pA0, pA1, K_lds, r32, hi, qf, cinit);
    __syncthreads();
    if (own >= 4) {
        f32x16 gacc = {};
        const char* kmb[4];
#pragma unroll
        for (int dd = 0; dd < 4; ++dd) kmb[dd] = lds + OFF_KM + KSWZ(r32, (dd * 16 + hi * 8) * 2);
#pragma unroll
        for (int d0 = 0; d0 < 8; ++d0) { const bf16x8 b0 = *reinterpret_cast<const bf16x8*>(kmb[d0 & 3] + (d0 >> 2) * 128); gacc = __builtin_amdgcn_mfma_f32_32x32x16_bf16(b0, *reinterpret_cast<const bf16x8*>(qf + d0 * 1024), gacc, 0, 0, 0); }
        float g[8];
#pragma unroll
        for (int i = 0; i < 4; ++i) { const float mine = gacc[i], oth = __shfl_xor(mine, 32); g[i] = hi ? oth : mine; g[4 + i] = hi ? mine : oth; }
#pragma unroll
        for (int n = 0; n < 7; ++n) { int cnt = 0;
#pragma unroll
            for (int m = 0; m < 7; ++m) cnt += (m != n && m < own && (g[m] > g[n] || (g[m] == g[n] && m < n))) ? 1 : 0;
            mask |= (n < own && cnt < 3) ? (1 << n) : 0; }
    }
    MASKT(pA0, pA1, 0, true); partialSM<true>(pA0, pA1, m_reg, alA);
    if (NT > 1) { VMW(); SWRITE_HK(1); }
    __syncthreads();
#define HALF_STEP(PX0, PX1, alX, PY0, PY1, alY, t, KB, VB, SB) do {                                                      \
        SWRITE_HV(KB); SBAR();                                                                                                \
        if ((t) + 1 < NT) { SLOAD_H(Kh, Vh, KBASE((t) + 1)); SBAR(); }                                               \
        SBAR(); qkt<KB>(PX0, PX1, K_lds, r32, hi, qf, AINIT(t));                                          \
        finishSM(PY0, PY1, alY, l_reg, pa0, pa1, pa2, pa3); SBAR();                                                           \
        pv_tile<VB>(o, vb0, pa0, pa1, pa2, pa3); MASKT(PX0, PX1, (t), false); partialSM<false>(PX0, PX1, m_reg, alX);                                        \
        if ((t) + 1 < NT) { VMW(); SWRITE_HK(SB); }                                                                         \
        RESC(alX); __syncthreads(); } while (0)
    for (int t = 1; t + 1 < NT; t += 2) {
        HALF_STEP(pB0, pB1, alB, pA0, pA1, alA, t, 1, 0, 0);
        HALF_STEP(pA0, pA1, alA, pB0, pB1, alB, t + 1, 0, 1, 1);
    }
    SWRITE_HV(1); SBAR();
    { SBAR(); qkt<1>(pB0, pB1, K_lds, r32, hi, qf, AINIT(NT - 1)); SBAR(); }
    SLOAD_H(Kh, Vh, 0); SBAR();
    bf16x8 tq[8];
    { const bf16* qb = H.Q0 + (size_t)(P0n + wid * QBLK) * Cfg::LDQ; unsigned qoff = (unsigned)(r32 * Cfg::LDQ + hi * 8); asm volatile("" : "+v"(qoff));
#pragma unroll
      for (int d0 = 0; d0 < 8; ++d0) tq[d0] = load8(qb + qoff + d0 * 16); }
    SBAR();
    finishSM(pA0, pA1, alA, l_reg, pa0, pa1, pa2, pa3); SBAR();
    pv_tile<0>(o, vb0, pa0, pa1, pa2, pa3);
    { MASKT(pB0, pB1, NT - 1, false); partialSM<false>(pB0, pB1, m_reg, alB); __syncthreads(); RESC(alB);
      finishSM(pB0, pB1, alB, l_reg, pa0, pa1, pa2, pa3); SBAR(); pv_tile<1>(o, vb0, pa0, pa1, pa2, pa3); }
    SBAR(); SEAM_K0();
    if (hi == 0) li_l[r32] = l_reg; asm volatile("s_waitcnt lgkmcnt(0)" ::: "memory");
    float gnr[4];
    { unsigned go_ = (unsigned)r32; asm volatile("" : "+v"(go_));
#pragma unroll
      for (int d0 = 0; d0 < 4; ++d0) gnr[d0] = Cfg::MOBA ? (gn + go_)[d0 * 32] : 1.0f; }
    bf16* Ow = H.O0 + (size_t)(P0 + wid * QBLK) * Cfg::LDO;
#pragma unroll
    for (int r = 0; r < 16; ++r) { int orow = crow(r, hi); asm volatile("" : "+v"(orow));
        const float rl = __builtin_amdgcn_rcpf(li_l[orow]);
        float v0 = o[0][r] * rl, v1 = o[1][r] * rl, v2 = o[2][r] * rl, v3 = o[3][r] * rl;
        float ss = (v0 * v0 + v1 * v1) + (v2 * v2 + v3 * v3);
        ss += __shfl_xor(ss, 1); ss += __shfl_xor(ss, 2); ss += __shfl_xor(ss, 4); ss += __shfl_xor(ss, 8); ss += __shfl_xor(ss, 16);
        if (Cfg::MOBA) { const float rs = rsqrtf(ss * (1.0f / 128.0f) + 1e-6f); v0 *= rs * gnr[0]; v1 *= rs * gnr[1]; v2 *= rs * gnr[2]; v3 *= rs * gnr[3]; }
        const float n0 = __shfl_xor(v0, 1), n1 = __shfl_xor(v1, 1), n2 = __shfl_xor(v2, 1), n3 = __shfl_xor(v3, 1);
        if ((r32 & 1) == 0) { bf16* op = Ow + (unsigned)(orow * Cfg::LDO + r32);
            *(unsigned*)(op) = cvtpk(v0, n0); *(unsigned*)(op + 32) = cvtpk(v1, n1); *(unsigned*)(op + 64) = cvtpk(v2, n2); *(unsigned*)(op + 96) = cvtpk(v3, n3); } }
    VMW();
#pragma unroll
    for (int d0 = 0; d0 < 8; ++d0) *(bf16x8*)(qf + d0 * 1024) = tq[d0];
    __syncthreads();
#undef RESC
#undef KBASE
#undef MASKT
#undef AINIT
#undef SEAM_K0
#undef HALF_STEP
}
#undef ROW
#undef VMW
#undef VMWN
#undef SLOAD_H
#undef SWRITE_HK
#undef SWRITE_HV
#undef SWRITE_H
#undef KSWZ
#undef SBAR
}

namespace gdn {
typedef short bf16x8 __attribute__((ext_vector_type(8)));
typedef float f32x16 __attribute__((ext_vector_type(16)));
typedef float f32x4 __attribute__((ext_vector_type(4)));
typedef unsigned u32x4 __attribute__((ext_vector_type(4)));
typedef unsigned u32x2 __attribute__((ext_vector_type(2)));
typedef _Float16 f16x4 __attribute__((ext_vector_type(4)));
typedef _Float16 f16x8 __attribute__((ext_vector_type(8)));
#define GLAS __attribute__((address_space(3)))
constexpr int IMG_BYTES = 75776, IMG_W = 0, IMG_U = 16384, IMG_QD = 32768, IMG_KDT = 49152, IMG_QK = 65536, IMG_GL = 73728;
constexpr int IMG_IN_OUT = 1771;
__device__ __forceinline__ int sw256(int row, int cb) { return row * 256 + (cb ^ ((row & 15) << 4)); }
__device__ __forceinline__ int sw128(int row, int cb) { return row * 128 + (cb ^ (((row >> 1) & 7) << 4)); }
__device__ __forceinline__ unsigned cvtpk(float lo, float hi) { unsigned r; asm volatile("v_cvt_pk_bf16_f32 %0, %1, %2" : "=v"(r) : "v"(lo), "v"(hi)); return r; }
__device__ __forceinline__ float bfl(unsigned w) { return __uint_as_float(w << 16); }
__device__ __forceinline__ float bfh(unsigned w) { return __uint_as_float(w & 0xffff0000u); }
__device__ __forceinline__ unsigned char* img_ptr(unsigned char* out_bytes, unsigned char* ws_img, int chunk) {
    return chunk < IMG_IN_OUT ? out_bytes + (size_t)chunk * IMG_BYTES : ws_img + (size_t)(chunk - IMG_IN_OUT) * IMG_BYTES;
}
#define LBAR() asm volatile("s_waitcnt lgkmcnt(0)\n\ts_barrier" ::: "memory")
#define MFMA32(a, b, c) __builtin_amdgcn_mfma_f32_32x32x16_bf16((a), (b), (c), 0, 0, 0)

constexpr int RAWP = 784;
__device__ __forceinline__ void conv16(float (&a)[16], const GLAS unsigned char* rp, const GLAS float* wl) {
    typedef float f32x2 __attribute__((ext_vector_type(2)));
    f32x2 acc[8];
#pragma unroll
    for (int p = 0; p < 8; ++p) acc[p] = (f32x2){0.f, 0.f};
#pragma unroll
    for (int j = 0; j < 4; ++j) { const u32x4 x0 = *(const GLAS u32x4*)(rp + j * RAWP), x1 = *(const GLAS u32x4*)(rp + j * RAWP + 16);
        const GLAS f32x2* wv = (const GLAS f32x2*)(wl + j * 384);
        const unsigned xw[8] = {x0.x, x0.y, x0.z, x0.w, x1.x, x1.y, x1.z, x1.w};
#pragma unroll
        for (int p = 0; p < 8; ++p) { const f32x2 xv = {bfl(xw[p]), bfh(xw[p])}; acc[p] = __builtin_elementwise_fma(wv[p], xv, acc[p]); }
        __builtin_amdgcn_sched_barrier(0); }
#pragma unroll
    for (int p = 0; p < 8; ++p) { a[2 * p] = acc[p].x; a[2 * p + 1] = acc[p].y; }
#pragma unroll
    for (int e = 0; e < 16; ++e) a[e] = a[e] * __builtin_amdgcn_rcpf(1.0f + __expf(-a[e]));
}
__device__ __forceinline__ void raw_load(u32x4 (&rg)[7], const unsigned short* proj, int b, int h, int n, int tid) {
#pragma unroll
    for (int kq = 0; kq < 7; ++kq) { int p = tid + 512 * kq; p = p < 3216 ? p : 3215; const int r = p / 48, q = p - r * 48, pos = n * 64 - 3 + r, posc = pos < 0 ? 0 : pos;
        const u32x4 v = __builtin_nontemporal_load((const u32x4*)(proj + ((size_t)b * 2048 + posc) * 7232 + (q >> 4) * 1024 + h * 128 + (q & 15) * 8));
        rg[kq] = pos < 0 ? (u32x4){0u, 0u, 0u, 0u} : v; }
}
__device__ __forceinline__ void raw_store(const u32x4 (&rg)[7], GLAS unsigned char* raw, int tid) {
#pragma unroll
    for (int kq = 0; kq < 7; ++kq) { const int p = tid + 512 * kq; const int r = p / 48, q = p - r * 48; if (p < 3216) *(GLAS u32x4*)(raw + r * RAWP + q * 16) = rg[kq]; }
}
typedef _Float16 f16x2 __attribute__((ext_vector_type(2)));
template <int I, int K8> __device__ __forceinline__ void inv_k8(float& acc, float& acc1, const float (&tc)[64], const f16x2 (&tn)[32], const GLAS unsigned char* slot) {
    if constexpr (K8 * 8 < I) { const f16x8 av = *(const GLAS f16x8*)(slot + I * 128 + K8 * 16);
#pragma unroll
        for (int p = 0; p < 4; ++p) { const int k = K8 * 8 + 2 * p;
            if (k + 1 < I) { if (p & 1) acc1 = __builtin_amdgcn_fdot2((f16x2){av[2 * p], av[2 * p + 1]}, tn[k >> 1], acc1, false); else acc = __builtin_amdgcn_fdot2((f16x2){av[2 * p], av[2 * p + 1]}, tn[k >> 1], acc, false); }
            else if (k < I) acc1 -= (float)av[2 * p] * tc[k]; }
        inv_k8<I, K8 + 1>(acc, acc1, tc, tn, slot); }
}
template <int I> __device__ __forceinline__ void inv_row(float (&tc)[64], f16x2 (&tn)[32], const GLAS unsigned char* slot, int lane) {
    if constexpr (I < 64) { float acc = (I == lane) ? 1.0f : 0.0f, acc1 = 0.f; inv_k8<I, 0>(acc, acc1, tc, tn, slot); acc += acc1; tc[I] = acc;
        if constexpr (I & 1) tn[I >> 1] = (f16x2){(_Float16)(-tc[I - 1]), (_Float16)(-acc)};
        __builtin_amdgcn_sched_barrier(0);
        inv_row<I + 1>(tc, tn, slot, lane); }
}
__device__ __forceinline__ void prep(GLAS unsigned char* L, int tid, int lane, int wave, int wg, const unsigned short* proj, const float* beta, const float* gg, const float* conv_w,
                                     unsigned char* out_bytes, unsigned char* ws_img, unsigned char* scr) {
    const int r32 = lane & 31, hi = lane >> 5;
    const int bh = wg & 63, b = bh >> 3, h = bh & 7, cg0 = (wg >> 6) * 8;
    GLAS unsigned char* Kt = L; GLAS unsigned char* Qt = L + 16384; GLAS unsigned char* Vt = L + 32768;
    GLAS unsigned char* raw = L;
    GLAS float* Gs = (GLAS float*)(L + 53248); GLAS float* Bs = Gs + 64; GLAS float* gls = Gs + 128; GLAS float* cwL = Gs + 192;
    GLAS float* eRs = Gs + 192 + 1536; GLAS float* bgs = eRs + 64;
    GLAS unsigned char* As = L + 61440;
    for (int i = tid; i < 1536; i += 512) { const int j = i / 384, rem = i - j * 384; cwL[i] = conv_w[j * 3072 + (rem >> 7) * 1024 + h * 128 + (rem & 127)]; }
    u32x4 rg[7];
    raw_load(rg, proj, b, h, cg0, tid);
    float gpf = gg[((size_t)b * 2048 + cg0 * 64 + lane) * 8 + h], bpf = beta[((size_t)b * 2048 + cg0 * 64 + (tid >> 3)) * 8 + h];
    __syncthreads();
#pragma unroll 1
    for (int c = 0; c < 8; ++c) {
        int tt_ = tid; asm volatile("" : "+v"(tt_));
        const int t = tt_ >> 3, seg = tt_ & 7;
        const int n = cg0 + c, chunk = bh * 32 + n, pos = n * 64 + t; const size_t row = (size_t)b * 2048 + pos;
        unsigned char* img = img_ptr(out_bytes, ws_img, chunk);
        unsigned short* vbt = (unsigned short*)(scr + (size_t)chunk * 32768); unsigned short* kgt = vbt + 8192;
        raw_store(rg, raw, tid);
        if (wave == 0) { float g = gpf;
#pragma unroll
            for (int o = 1; o < 64; o <<= 1) { const float y = __shfl_up(g, o); if (lane >= o) g += y; }
            Gs[lane] = g; if (lane == 63) gls[c] = g; }
        if (seg == 0) Bs[t] = bpf;
        LBAR();
        const float G = Gs[t], GL = Gs[63], eG = __expf(G), eR = __expf(GL - G), bt = Bs[t], bg = bt * eG;
        float xq[16], xk[16], xv[16];
        { const GLAS unsigned char* rp = raw + t * RAWP + seg * 32;
          conv16(xq, rp, cwL + seg * 16); conv16(xk, rp + 256, cwL + 128 + seg * 16); conv16(xv, rp + 512, cwL + 256 + seg * 16); }
        { float sq = 0.f, sk = 0.f;
#pragma unroll
          for (int e = 0; e < 16; ++e) { sq += xq[e] * xq[e]; sk += xk[e] * xk[e]; }
          sq += __shfl_xor(sq, 1); sq += __shfl_xor(sq, 2); sq += __shfl_xor(sq, 4); sk += __shfl_xor(sk, 1); sk += __shfl_xor(sk, 2); sk += __shfl_xor(sk, 4);
          const float nq = rsqrtf(sq + 1e-6f) * 0.08838834764831845f, nk = rsqrtf(sk + 1e-6f);
#pragma unroll
          for (int e = 0; e < 16; ++e) { xq[e] *= nq; xk[e] *= nk; xv[e] *= bt; } }
        LBAR();
        { u32x4 w0, w1;
          w0 = (u32x4){cvtpk(xv[0], xv[1]), cvtpk(xv[2], xv[3]), cvtpk(xv[4], xv[5]), cvtpk(xv[6], xv[7])}; w1 = (u32x4){cvtpk(xv[8], xv[9]), cvtpk(xv[10], xv[11]), cvtpk(xv[12], xv[13]), cvtpk(xv[14], xv[15])};
          *(GLAS u32x4*)(Vt + sw256(t, seg * 32)) = w0; *(GLAS u32x4*)(Vt + sw256(t, seg * 32 + 16)) = w1;
          w0 = (u32x4){cvtpk(xk[0], xk[1]), cvtpk(xk[2], xk[3]), cvtpk(xk[4], xk[5]), cvtpk(xk[6], xk[7])}; w1 = (u32x4){cvtpk(xk[8], xk[9]), cvtpk(xk[10], xk[11]), cvtpk(xk[12], xk[13]), cvtpk(xk[14], xk[15])};
          *(GLAS u32x4*)(Kt + sw256(t, seg * 32)) = w0; *(GLAS u32x4*)(Kt + sw256(t, seg * 32 + 16)) = w1;
          w0 = (u32x4){cvtpk(xq[0], xq[1]), cvtpk(xq[2], xq[3]), cvtpk(xq[4], xq[5]), cvtpk(xq[6], xq[7])}; w1 = (u32x4){cvtpk(xq[8], xq[9]), cvtpk(xq[10], xq[11]), cvtpk(xq[12], xq[13]), cvtpk(xq[14], xq[15])};
          *(GLAS u32x4*)(Qt + sw256(t, seg * 32)) = w0; *(GLAS u32x4*)(Qt + sw256(t, seg * 32 + 16)) = w1;
          w0 = (u32x4){cvtpk(xq[0] * eG, xq[1] * eG), cvtpk(xq[2] * eG, xq[3] * eG), cvtpk(xq[4] * eG, xq[5] * eG), cvtpk(xq[6] * eG, xq[7] * eG)};
          w1 = (u32x4){cvtpk(xq[8] * eG, xq[9] * eG), cvtpk(xq[10] * eG, xq[11] * eG), cvtpk(xq[12] * eG, xq[13] * eG), cvtpk(xq[14] * eG, xq[15] * eG)};
          *(u32x4*)(img + IMG_QD + sw256(t, seg * 32)) = w0; *(u32x4*)(img + IMG_QD + sw256(t, seg * 32 + 16)) = w1; }
        if (seg == 0) { eRs[t] = eR; bgs[t] = bg; }
        raw_load(rg, proj, b, h, n < 31 ? n + 1 : n, tid);
        { const int n1 = n < 31 ? n + 1 : n; gpf = gg[((size_t)b * 2048 + n1 * 64 + (tt_ & 63)) * 8 + h]; bpf = beta[((size_t)b * 2048 + n1 * 64 + t) * 8 + h]; }
        LBAR();
        { const int prod = wave >> 2, mj = (wave >> 1) & 1, ni = wave & 1;
          f32x16 acc = {};
          if (!(mj == 1 && ni == 0)) { GLAS unsigned char* Xb = prod ? Qt : Kt;
#pragma unroll
              for (int s = 0; s < 8; ++s) { const bf16x8 a = *(const GLAS bf16x8*)(Kt + sw256(mj * 32 + r32, (16 * s + 8 * hi) * 2)); const bf16x8 bb = *(const GLAS bf16x8*)(Xb + sw256(ni * 32 + r32, (16 * s + 8 * hi) * 2));
                  acc = MFMA32(a, bb, acc); } }
          const int i = ni * 32 + r32; const float Gi = Gs[i], bi = prod ? 1.0f : Bs[i];
#pragma unroll
          for (int g4 = 0; g4 < 4; ++g4) { const int j0 = mj * 32 + 8 * g4 + 4 * hi; float v[4];
#pragma unroll
              for (int e = 0; e < 4; ++e) { const int j = j0 + e; const bool ok = prod ? (j <= i) : (j < i); const float d = ok ? __expf(Gi - Gs[j]) * bi : 0.f; v[e] = ok ? acc[4 * g4 + e] * d : 0.f; }
              if (prod == 0) { f16x4 hv = {(_Float16)v[0], (_Float16)v[1], (_Float16)v[2], (_Float16)v[3]}; *(GLAS f16x4*)(As + c * 8192 + i * 128 + j0 * 2) = hv; }
              else { u32x2 w = {cvtpk(v[0], v[1]), cvtpk(v[2], v[3])}; *(u32x2*)(img + IMG_QK + sw128(i, j0 * 2)) = w; } } }
        { const int ch = tt_ >> 2, tq = tt_ & 3; float kk[16], vk[16];
#pragma unroll
          for (int e = 0; e < 16; ++e) { const int tk = tq * 16 + e; kk[e] = bfl(*(const GLAS unsigned short*)(Kt + sw256(tk, ch * 2))); vk[e] = bfl(*(const GLAS unsigned short*)(Vt + sw256(tk, ch * 2))); }
          unsigned wa[8], wb[8], wc[8];
#pragma unroll
          for (int p = 0; p < 8; ++p) { const int t0 = tq * 16 + 2 * p; wa[p] = cvtpk(kk[2 * p] * eRs[t0], kk[2 * p + 1] * eRs[t0 + 1]); wb[p] = cvtpk(kk[2 * p] * bgs[t0], kk[2 * p + 1] * bgs[t0 + 1]); wc[p] = cvtpk(vk[2 * p], vk[2 * p + 1]); }
          *(u32x4*)(img + IMG_KDT + sw128(ch, tq * 32)) = (u32x4){wa[0], wa[1], wa[2], wa[3]}; *(u32x4*)(img + IMG_KDT + sw128(ch, tq * 32 + 16)) = (u32x4){wa[4], wa[5], wa[6], wa[7]};
          *(u32x4*)(kgt + ch * 64 + tq * 16) = (u32x4){wb[0], wb[1], wb[2], wb[3]}; *(u32x4*)(kgt + ch * 64 + tq * 16 + 8) = (u32x4){wb[4], wb[5], wb[6], wb[7]};
          *(u32x4*)(vbt + ch * 64 + tq * 16) = (u32x4){wc[0], wc[1], wc[2], wc[3]}; *(u32x4*)(vbt + ch * 64 + tq * 16 + 8) = (u32x4){wc[4], wc[5], wc[6], wc[7]}; }
        LBAR();
    }
    GLAS unsigned char* slot = As + wave * 8192;
    int lane2 = lane; asm volatile("" : "+v"(lane2));
    const int r32b = lane2 & 31, hib = lane2 >> 5;
    { float tc[64]; f16x2 tn[32];
      inv_row<0>(tc, tn, slot, lane2);
      asm volatile("s_waitcnt lgkmcnt(0)" ::: "memory");
#pragma unroll
      for (int i = 0; i < 64; ++i) *(GLAS unsigned short*)(slot + sw128(i, lane2 * 2)) = (unsigned short)(cvtpk(tc[i], 0.f) & 0xffffu); }
    asm volatile("s_waitcnt vmcnt(0) lgkmcnt(0)" ::: "memory");
    __syncthreads();
    { const int chunk = bh * 32 + cg0 + wave; unsigned char* img = img_ptr(out_bytes, ws_img, chunk);
      const unsigned short* vbt = (const unsigned short*)(scr + (size_t)chunk * 32768); const unsigned short* kgt = vbt + 8192;
      bf16x8 gf[4][4], gk[4][4];
#pragma unroll
      for (int dvt = 0; dvt < 4; ++dvt)
#pragma unroll
          for (int s = 0; s < 4; ++s) gf[dvt][s] = *(const bf16x8*)(vbt + (dvt * 32 + r32b) * 64 + 16 * s + 8 * hib);
#pragma unroll
      for (int dkt = 0; dkt < 4; ++dkt)
#pragma unroll
          for (int s = 0; s < 4; ++s) gk[dkt][s] = *(const bf16x8*)(kgt + (dkt * 32 + r32b) * 64 + 16 * s + 8 * hib);
#pragma unroll
      for (int tile = 0; tile < 8; ++tile) { const int ti = tile >> 2, dvt = tile & 3; f32x16 acc = {};
#pragma unroll
          for (int s = 0; s < 4; ++s) { if (s < 2 * (ti + 1)) { const bf16x8 a = *(const GLAS bf16x8*)(slot + sw128(ti * 32 + r32b, (16 * s + 8 * hib) * 2)); acc = MFMA32(a, gf[dvt][s], acc); } }
          u32x4 w0 = {pg8::cvt_pk_bf16_acc(acc[0], acc[1]), pg8::cvt_pk_bf16_acc(acc[2], acc[3]), pg8::cvt_pk_bf16_acc(acc[4], acc[5]), pg8::cvt_pk_bf16_acc(acc[6], acc[7])}, w1 = {pg8::cvt_pk_bf16_acc(acc[8], acc[9]), pg8::cvt_pk_bf16_acc(acc[10], acc[11]), pg8::cvt_pk_bf16_acc(acc[12], acc[13]), pg8::cvt_pk_bf16_acc(acc[14], acc[15])};
          *(u32x4*)(img + IMG_U + tile * 2048 + lane2 * 32) = w0; *(u32x4*)(img + IMG_U + tile * 2048 + lane2 * 32 + 16) = w1; }
#pragma unroll
      for (int tile = 0; tile < 8; ++tile) { const int dkt = tile >> 1, ni = tile & 1; f32x16 acc = {};
#pragma unroll
          for (int s = 0; s < 4; ++s) { if (s < 2 * (ni + 1)) { const bf16x8 bb = *(const GLAS bf16x8*)(slot + sw128(ni * 32 + r32b, (16 * s + 8 * hib) * 2)); acc = MFMA32(gk[dkt][s], bb, acc); } }
          { const unsigned a0 = pg8::cvt_pk_bf16_acc(acc[0], acc[1]), a1 = pg8::cvt_pk_bf16_acc(acc[2], acc[3]), b0 = pg8::cvt_pk_bf16_acc(acc[4], acc[5]), b1 = pg8::cvt_pk_bf16_acc(acc[6], acc[7]);
            const auto r0 = __builtin_amdgcn_permlane32_swap(a0, b0, false, false), r1 = __builtin_amdgcn_permlane32_swap(a1, b1, false, false);
            *(u32x4*)(img + IMG_W + ((ni * 8 + 2 * dkt) * 64 + lane2) * 16) = (u32x4){r0[0], r1[0], r0[1], r1[1]}; }
          { const unsigned a0 = pg8::cvt_pk_bf16_acc(acc[8], acc[9]), a1 = pg8::cvt_pk_bf16_acc(acc[10], acc[11]), b0 = pg8::cvt_pk_bf16_acc(acc[12], acc[13]), b1 = pg8::cvt_pk_bf16_acc(acc[14], acc[15]);
            const auto r0 = __builtin_amdgcn_permlane32_swap(a0, b0, false, false), r1 = __builtin_amdgcn_permlane32_swap(a1, b1, false, false);
            *(u32x4*)(img + IMG_W + ((ni * 8 + 2 * dkt + 1) * 64 + lane2) * 16) = (u32x4){r0[0], r1[0], r0[1], r1[1]}; } }
      if (lane2 == 0) *(float*)(img + IMG_GL) = __expf(gls[wave]); }
}

__device__ __forceinline__ void scan(GLAS unsigned char* L, int tid, int lane, int wave, int bh, unsigned char* out_bytes, unsigned char* ws_img, const unsigned short* proj, const float* gn, unsigned short* ob) {
    const int r32 = lane & 31, hi = lane >> 5, b = bh >> 3, h = bh & 7;
    GLAS unsigned char* ST = L + 75776; GLAS unsigned char* VNT = L + 108544; GLAS float* RED = (GLAS float*)(L + 124928); GLAS float* OT = (GLAS float*)L;
    const int ti = wave >> 2, dvt = wave & 3, dk0t = 2 * (wave >> 2);
    f32x16 s0 = {}, s1 = {};
    for (int i = tid; i < 2048; i += 512) ((GLAS u32x4*)ST)[i] = (u32x4){0u, 0u, 0u, 0u};
    const int tok = tid & 63, part = wave;
    float gnr[16];
#pragma unroll
    for (int e = 0; e < 16; ++e) gnr[e] = gn[part * 16 + e];
    u32x4 pf[10];
    { const u32x4* img0 = (const u32x4*)img_ptr(out_bytes, ws_img, bh * 32);
#pragma unroll
      for (int i = 0; i < 10; ++i) { const int p = tid + 512 * i; pf[i] = img0[p < 4624 ? p : 4623]; } }
#pragma unroll 1
    for (int n = 0; n < 32; ++n) {
#pragma unroll
        for (int i = 0; i < 10; ++i) { const int p = tid + 512 * i; if (p < 4624) ((GLAS u32x4*)L)[p] = pf[i]; }
        LBAR();
        { const u32x4* imgn = (const u32x4*)img_ptr(out_bytes, ws_img, bh * 32 + (n < 31 ? n + 1 : n));
#pragma unroll
          for (int i = 0; i < 10; ++i) { const int p = tid + 512 * i; pf[i] = imgn[p < 4624 ? p : 4623]; } }
        const size_t row = (size_t)b * 2048 + n * 64 + tok;
        const unsigned short* zp = proj + row * 7232 + 3072 + h * 128 + part * 16; const u32x4 z0 = *(const u32x4*)zp, z1 = *(const u32x4*)(zp + 8);
        { f32x16 acc = {};
#pragma unroll
          for (int s = 0; s < 8; ++s) { const bf16x8 a = *(const GLAS bf16x8*)(L + IMG_W + ((ti * 8 + s) * 64 + lane) * 16); const bf16x8 bb = *(const GLAS bf16x8*)(ST + sw256(dvt * 32 + r32, (16 * s + 8 * hi) * 2)); acc = MFMA32(a, bb, acc); }
          const u32x4 u0 = *(const GLAS u32x4*)(L + IMG_U + wave * 2048 + lane * 32), u1 = *(const GLAS u32x4*)(L + IMG_U + wave * 2048 + lane * 32 + 16);
          const unsigned uw[8] = {u0.x, u0.y, u0.z, u0.w, u1.x, u1.y, u1.z, u1.w};
#pragma unroll
          for (int g4 = 0; g4 < 4; ++g4) { const float v0 = bfl(uw[2 * g4]) - acc[4 * g4], v1 = bfh(uw[2 * g4]) - acc[4 * g4 + 1], v2 = bfl(uw[2 * g4 + 1]) - acc[4 * g4 + 2], v3 = bfh(uw[2 * g4 + 1]) - acc[4 * g4 + 3];
              u32x2 w = {cvtpk(v0, v1), cvtpk(v2, v3)}; *(GLAS u32x2*)(VNT + sw128(dvt * 32 + r32, (ti * 32 + 8 * g4 + 4 * hi) * 2)) = w; } }
        LBAR();
        { f32x16 acc = {};
#pragma unroll
          for (int s = 0; s < 8; ++s) { const bf16x8 a = *(const GLAS bf16x8*)(L + IMG_QD + sw256(ti * 32 + r32, (16 * s + 8 * hi) * 2)); const bf16x8 bb = *(const GLAS bf16x8*)(ST + sw256(dvt * 32 + r32, (16 * s + 8 * hi) * 2)); acc = MFMA32(a, bb, acc); }
#pragma unroll
          for (int s = 0; s < 4; ++s) { if (s < 2 * (ti + 1)) { const bf16x8 a = *(const GLAS bf16x8*)(L + IMG_QK + sw128(ti * 32 + r32, (16 * s + 8 * hi) * 2)); const bf16x8 bb = *(const GLAS bf16x8*)(VNT + sw128(dvt * 32 + r32, (16 * s + 8 * hi) * 2)); acc = MFMA32(a, bb, acc); } }
#pragma unroll
          for (int g4 = 0; g4 < 4; ++g4) { const f32x4 w = {acc[4 * g4], acc[4 * g4 + 1], acc[4 * g4 + 2], acc[4 * g4 + 3]}; const int dv = dvt * 32 + r32, chk = ti * 8 + 2 * g4 + hi;
              *(GLAS f32x4*)(OT + dv * 64 + ((chk ^ (dv & 15)) << 2)) = w; } }
        LBAR();
        float ov[16]; float ss = 0.f;
#pragma unroll
        for (int e = 0; e < 16; ++e) { const int dv = part * 16 + e; ov[e] = OT[dv * 64 + ((((tok >> 2) ^ (dv & 15)) << 2) | (tok & 3))]; ss += ov[e] * ov[e]; }
        RED[part * 64 + tok] = ss;
        { const float gl = *(const GLAS float*)(L + IMG_GL);
          s0 = s0 * gl; s1 = s1 * gl;
#pragma unroll
          for (int s = 0; s < 4; ++s) { const bf16x8 bb = *(const GLAS bf16x8*)(VNT + sw128(dvt * 32 + r32, (16 * s + 8 * hi) * 2));
              const bf16x8 a0 = *(const GLAS bf16x8*)(L + IMG_KDT + sw128(dk0t * 32 + r32, (16 * s + 8 * hi) * 2)), a1 = *(const GLAS bf16x8*)(L + IMG_KDT + sw128(dk0t * 32 + 32 + r32, (16 * s + 8 * hi) * 2));
              s0 = MFMA32(a0, bb, s0); s1 = MFMA32(a1, bb, s1); }
#pragma unroll
          for (int g4 = 0; g4 < 4; ++g4) { u32x2 w = {pg8::cvt_pk_bf16_acc(s0[4 * g4], s0[4 * g4 + 1]), pg8::cvt_pk_bf16_acc(s0[4 * g4 + 2], s0[4 * g4 + 3])}; *(GLAS u32x2*)(ST + sw256(dvt * 32 + r32, (dk0t * 32 + 8 * g4 + 4 * hi) * 2)) = w;
              u32x2 w2 = {pg8::cvt_pk_bf16_acc(s1[4 * g4], s1[4 * g4 + 1]), pg8::cvt_pk_bf16_acc(s1[4 * g4 + 2], s1[4 * g4 + 3])}; *(GLAS u32x2*)(ST + sw256(dvt * 32 + r32, (dk0t * 32 + 32 + 8 * g4 + 4 * hi) * 2)) = w2; } }
        LBAR();
        { float tot = 0.f;
#pragma unroll
          for (int p = 0; p < 8; ++p) tot += RED[p * 64 + tok];
          const float rs = rsqrtf(tot * (1.0f / 128.0f) + 1e-6f);
          const unsigned zw[8] = {z0.x, z0.y, z0.z, z0.w, z1.x, z1.y, z1.z, z1.w}; unsigned res[8];
#pragma unroll
          for (int k = 0; k < 8; ++k) res[k] = cvtpk(ov[2 * k] * rs * gnr[2 * k] * bfl(zw[k]), ov[2 * k + 1] * rs * gnr[2 * k + 1] * bfh(zw[k]));
          unsigned short* op = ob + row * 2048 + h * 128 + part * 16;
          *(u32x4*)op = (u32x4){res[0], res[1], res[2], res[3]}; *(u32x4*)(op + 8) = (u32x4){res[4], res[5], res[6], res[7]}; }
        LBAR();
    }
}
#undef MFMA32
#undef LBAR
#undef GLAS
}

constexpr int NB = 8, SEQ = 2048, DM = 2048, MTOK = NB * SEQ;
constexpr int HD = 128, NPROJ = 7168, PROJ_LD = 7232;
constexpr int DFF = 5632, MEMLEN = 256, MROWS = NB * MEMLEN, XW = 512;
constexpr float EPS = 1e-6f;
constexpr int NWAVES = 8, NTHREADS = 512;
constexpr int LDS_BYTES = 147456;
constexpr int LDS_MISC = 147200;
constexpr int CW_BAR = 4096;

constexpr size_t MiB = 1u << 20;
constexpr size_t WS_RSQ2 = 768 * 1024, WS_RSQ3 = 832 * 1024, WS_RSQ4 = 896 * 1024;
constexpr size_t WS_KMEAN = 512 * 1024;
constexpr size_t WS_WGU = 1 * MiB, WS_WDOWN = 23 * MiB, WS_X2Q = 34 * MiB, WS_SMALL = 67 * MiB, WS_XB = 70 * MiB;
constexpr float WGU_SCALE = 32.0f, WDOWN_SCALE = 64.0f;
constexpr size_t WS_GATE = 134 * MiB;
constexpr size_t WS_WINB = 142 * MiB;
constexpr size_t WS_WIN = 134 * MiB, WS_PROJ = 162 * MiB, WS_O = 388 * MiB;
constexpr size_t WS_QX = 162 * MiB, WS_OX = 178 * MiB, WS_KVX = 194 * MiB;
constexpr size_t WS_WXQ = 486 * MiB, WS_WXKV = 488 * MiB, WS_WXO = 492 * MiB, WS_WOUT = 494 * MiB, WS_MEMB = 502 * MiB, WS_END = 510 * MiB;
constexpr size_t SM_RSTD1 = 0, SM_RSTD2 = 65536, SM_RSTD3 = 131072, SM_RSTDM = 196608, SM_W16 = 262144, SM_KMEAN = 327680, SM_BETA = 1 * MiB, SM_G = 1 * MiB + 524288;

#define LAS __attribute__((address_space(3)))
typedef unsigned short bf16_t;
typedef float f32x4 __attribute__((ext_vector_type(4)));
typedef unsigned u32x4 __attribute__((ext_vector_type(4)));
typedef unsigned u32x2 __attribute__((ext_vector_type(2)));

__device__ __forceinline__ float bf2f(unsigned v) { return __uint_as_float(v << 16); }
__device__ __forceinline__ unsigned f2bf(float f) { unsigned u = __float_as_uint(f); return (u + 0x7fffu + ((u >> 16) & 1u)) >> 16; }
__device__ __forceinline__ unsigned pk2(float lo, float hi) { return f2bf(lo) | (f2bf(hi) << 16); }
__device__ __forceinline__ float wave_sum(float v) {
#pragma unroll
    for (int o = 1; o < 64; o <<= 1) v += __shfl_xor(v, o);
    return v;
}
__device__ __forceinline__ float silu_acc(float v) { return v * __builtin_amdgcn_rcpf(1.0f + __expf(-v)); }

#define XB_TMO      128
#define XB_XCNT(j)  (256  + 64 * (j))
#define XB_XSUB(j)  (1280 + 64 * (j))
#define XB_XGEN(j)  (2304 + 64 * (j))
#define XB_TOP      3328
#define XB_TOPGEN   3392
#define XCD_BAR_WORDS 3456
#define XB_SPIN_CAP (1u << 18)

__device__ __forceinline__ unsigned xb_ld(unsigned* p)              { return __hip_atomic_load(p, __ATOMIC_RELAXED, __HIP_MEMORY_SCOPE_AGENT); }
__device__ __forceinline__ unsigned xb_add(unsigned* p, unsigned v) { return __hip_atomic_fetch_add(p, v, __ATOMIC_RELAXED, __HIP_MEMORY_SCOPE_AGENT); }
__device__ __forceinline__ unsigned xb_xcc_id() { return (unsigned)__builtin_amdgcn_s_getreg((3 << 11) | 20) & 0xFu; }
#define XB_SPIN(cond, bar) do { unsigned _sp = 0; while (cond) { __builtin_amdgcn_s_sleep(1); \
    if ((++_sp & 255u) == 0u) { if (xb_ld(&(bar)[XB_TMO])) break; if (_sp > XB_SPIN_CAP) { atomicAdd(&(bar)[XB_TMO], 1u); break; } } } } while (0)

struct XcdBarrier {
    unsigned* bar; unsigned x;
    volatile LAS unsigned* st;
};

__device__ __forceinline__ XcdBarrier xcd_barrier_post(unsigned* bar, volatile LAS unsigned* st, int tid) {
    XcdBarrier b; b.bar = bar; b.x = xb_xcc_id(); b.st = st;
    if (tid == 0) (void)xb_add(&bar[XB_XCNT(b.x)], 1u);
    return b;
}
__device__ __forceinline__ void xcd_barrier_complete(unsigned* bar, unsigned x, unsigned& nloc, unsigned& nx) {
    const unsigned G = gridDim.x * gridDim.y * gridDim.z;
    unsigned sum, cnt, mine, sp = 0u;
    for (;;) {
        sum = 0u; cnt = 0u; mine = 0u;
#pragma unroll
        for (unsigned j = 0; j < 16; ++j) { const unsigned c = xb_ld(&bar[XB_XCNT(j)]); sum += c; cnt += (c > 0u) ? 1u : 0u; mine = (j == x) ? c : mine; }
        if (sum == G) break;
        __builtin_amdgcn_s_sleep(1);
        if ((++sp & 255u) == 0u) { if (xb_ld(&bar[XB_TMO])) break; if (sp > XB_SPIN_CAP) { atomicAdd(&bar[XB_TMO], 1u); break; } }
    }
    nloc = mine > 0u ? mine : 1u; nx = cnt > 0u ? cnt : 1u;
}

__device__ __forceinline__ void xcd_barrier(const XcdBarrier& b, int tid) {
    asm volatile("s_waitcnt vmcnt(0)" ::: "memory");
    __syncthreads();
    if (tid == 0) {
        unsigned* bar = b.bar;
        __builtin_amdgcn_s_waitcnt(0);
        unsigned nloc = b.st[0], nx = b.st[1];
        if (nloc == 0u) { xcd_barrier_complete(bar, b.x, nloc, nx); b.st[0] = nloc; b.st[1] = nx; }
        const unsigned seq = b.st[2]; b.st[2] = seq + 1u;
        const unsigned old = xb_add(&bar[XB_XSUB(b.x)], 1u);
        const unsigned gen = old / nloc;
        if (old + 1u == (gen + 1u) * nloc) {
            __builtin_amdgcn_fence(__ATOMIC_RELEASE, "agent");
            asm volatile("s_waitcnt vmcnt(0)" ::: "memory");
            const unsigned og = xb_add(&bar[XB_TOP], 1u);
            const unsigned tg = og / nx;
            if (og + 1u == (tg + 1u) * nx) xb_add(&bar[XB_TOPGEN], 1u);
        }
        XB_SPIN(xb_ld(&bar[XB_TOPGEN]) <= seq, bar);
        __builtin_amdgcn_fence(__ATOMIC_ACQUIRE, "agent");
        asm volatile("s_waitcnt vmcnt(0)" ::: "memory");
    }
    __syncthreads();
}


struct Args { const float* in[23]; float* out; unsigned char* ws; int ph_lo, ph_hi; };
#define ARGP(A, k) ((A).in[k])
#define TABP(F, k) ((const float*)(((const __attribute__((address_space(1))) float* const*)((F).ws + 256))[k]))
struct Frame {
    LAS unsigned char* lds;
    int tid, lane, wave, G, bid;
    float* out; unsigned char* ws;
};

__device__ __forceinline__ void transpose_item(const float* W, int ldw, int col0, int K, const float* gain, bf16_t* WT, int row_off, int nblk, LAS float* scr, int item, int lane) {
    const int kb = item / nblk, nb = item % nblk, k0 = 64 * kb, n0 = 64 * nb;
    const float* src = W + (size_t)(k0 + (lane >> 4)) * ldw + col0 + n0 + (lane & 15) * 4;
    f32x4 v[16];
#pragma unroll
    for (int i = 0; i < 16; ++i) v[i] = __builtin_nontemporal_load((const f32x4*)(src + (size_t)(4 * i) * ldw));
#pragma unroll
    for (int i = 0; i < 16; ++i) { const int kk = 4 * i + (lane >> 4); const float g = gain ? gain[k0 + kk] : 1.0f; LAS float* d = scr + kk * 65 + (lane & 15) * 4;
        d[0] = v[i].x * g; d[1] = v[i].y * g; d[2] = v[i].z * g; d[3] = v[i].w * g; }
    asm volatile("s_waitcnt lgkmcnt(0)" ::: "memory");
    const int c = lane & 7;
#pragma unroll
    for (int j = 0; j < 8; ++j) { const int n = (lane >> 3) + 8 * j; const LAS float* s = scr + (8 * c) * 65 + n;
        u32x4 o; o.x = pk2(s[0 * 65], s[1 * 65]); o.y = pk2(s[2 * 65], s[3 * 65]); o.z = pk2(s[4 * 65], s[5 * 65]); o.w = pk2(s[6 * 65], s[7 * 65]);
        *(u32x4*)(WT + (size_t)(row_off + n0 + n) * K + k0 + 8 * c) = o; }
    asm volatile("s_waitcnt lgkmcnt(0)" ::: "memory");
}
__device__ __forceinline__ void transpose_item8(const float* W, int ldw, int col0, int K, const float* gain, float scale, unsigned char* WT8, int row_off, int nblk, LAS float* scr, int item, int lane) {
    const int kb = item / nblk, nb = item % nblk, k0 = 64 * kb, n0 = 64 * nb;
    const float* src = W + (size_t)(k0 + (lane >> 4)) * ldw + col0 + n0 + (lane & 15) * 4;
    f32x4 v[16];
#pragma unroll
    for (int i = 0; i < 16; ++i) v[i] = __builtin_nontemporal_load((const f32x4*)(src + (size_t)(4 * i) * ldw));
#pragma unroll
    for (int i = 0; i < 16; ++i) { const int kk = 4 * i + (lane >> 4); const float g = (gain ? gain[k0 + kk] : 1.0f) * scale; LAS float* d = scr + kk * 65 + (lane & 15) * 4;
        d[0] = v[i].x * g; d[1] = v[i].y * g; d[2] = v[i].z * g; d[3] = v[i].w * g; }
    asm volatile("s_waitcnt lgkmcnt(0)" ::: "memory");
    const int c = lane & 7;
#pragma unroll
    for (int j = 0; j < 8; ++j) { const int n = (lane >> 3) + 8 * j; const LAS float* s = scr + (8 * c) * 65 + n;
        int w0 = __builtin_amdgcn_cvt_pk_fp8_f32(s[0 * 65], s[1 * 65], 0, false); w0 = __builtin_amdgcn_cvt_pk_fp8_f32(s[2 * 65], s[3 * 65], w0, true);
        int w1 = __builtin_amdgcn_cvt_pk_fp8_f32(s[4 * 65], s[5 * 65], 0, false); w1 = __builtin_amdgcn_cvt_pk_fp8_f32(s[6 * 65], s[7 * 65], w1, true);
        *(u32x2*)(WT8 + (size_t)(row_off + n0 + n) * K + k0 + 8 * c) = (u32x2){(unsigned)w0, (unsigned)w1}; }
    asm volatile("s_waitcnt lgkmcnt(0)" ::: "memory");
}
__device__ __forceinline__ void row_to_bf16(const float* xrow, bf16_t* orow, float* rstd_out, int lane, unsigned char* q8row = nullptr) {
    const f32x4* xr = (const f32x4*)xrow + lane;
    f32x4 v[8]; float s = 0.f;
#pragma unroll
    for (int j = 0; j < 8; ++j) { v[j] = __builtin_nontemporal_load(xr + 64 * j); s += (v[j].x * v[j].x + v[j].y * v[j].y) + (v[j].z * v[j].z + v[j].w * v[j].w); }
    s = wave_sum(s);
    if (lane == 0) *rstd_out = rsqrtf(s * (1.0f / DM) + EPS);
    u32x2* o8 = (u32x2*)orow + lane;
#pragma unroll
    for (int j = 0; j < 8; ++j) { u32x2 w; w.x = pk2(v[j].x, v[j].y); w.y = pk2(v[j].z, v[j].w); o8[64 * j] = w; }
    if (q8row) { unsigned* q4 = (unsigned*)q8row + lane;
#pragma unroll
        for (int j = 0; j < 8; ++j) { int q = __builtin_amdgcn_cvt_pk_fp8_f32(v[j].x, v[j].y, 0, false); q = __builtin_amdgcn_cvt_pk_fp8_f32(v[j].z, v[j].w, q, true); q4[64 * j] = (unsigned)q; } }
}
__device__ __forceinline__ void phase_prologue(const Frame& F, const Args& A) {
    if (F.bid == 0 && F.tid < 23) ((const float**)(F.ws + 256))[F.tid] = A.in[F.tid];
    LAS float* scr = (LAS float*)(F.lds + F.wave * 17408);
    const int gw = F.bid * NWAVES + F.wave, NGW = F.G * NWAVES;
    bf16_t* Win_t = (bf16_t*)(F.ws + WS_WIN); bf16_t* Wout_t = (bf16_t*)(F.ws + WS_WOUT); bf16_t* Wxq_t = (bf16_t*)(F.ws + WS_WXQ); bf16_t* Wxkv_t = (bf16_t*)(F.ws + WS_WXKV);
    bf16_t* Wxo_t = (bf16_t*)(F.ws + WS_WXO); bf16_t* Wgu_t = (bf16_t*)(F.ws + WS_WGU); bf16_t* Wdown_t = (bf16_t*)(F.ws + WS_WDOWN);
    constexpr int I_INA = 32 * 64, I_INB = 32 * 48, I_OUT = 32 * 32, I_XQ = 32 * 8, I_XKV = 32 * 16, I_XO = 8 * 32, I_G = 32 * 88, I_D = 88 * 32;
    constexpr int NITEMS = I_INA + I_INB + I_OUT + I_XQ + I_XKV + I_XO;
    for (int it = gw; it < NITEMS; it += NGW) {
        int r = it;
        if (r < I_INA) { transpose_item8(ARGP(A, 3), 7184, 0, DM, ARGP(A, 2), WGU_SCALE, (unsigned char*)Win_t, 0, 64, scr, r, F.lane); continue; } r -= I_INA;
        if (r < I_INB) { transpose_item(ARGP(A, 3), 7184, 4112, DM, ARGP(A, 2), (bf16_t*)(F.ws + WS_WINB), 0, 48, scr, r, F.lane); continue; } r -= I_INB;
        if (r < I_OUT) { transpose_item(ARGP(A, 10), DM, 0, DM, nullptr, Wout_t, 0, 32, scr, r, F.lane); continue; } r -= I_OUT;
        if (r < I_XQ) { transpose_item(ARGP(A, 13), XW, 0, DM, ARGP(A, 11), Wxq_t, 0, 8, scr, r, F.lane); continue; } r -= I_XQ;
        if (r < I_XKV) { transpose_item(ARGP(A, 14), 2 * XW, 0, DM, ARGP(A, 12), Wxkv_t, 0, 16, scr, r, F.lane); continue; } r -= I_XKV;
        transpose_item(ARGP(A, 15), DM, 0, XW, nullptr, Wxo_t, 0, 32, scr, r, F.lane);
    }
    { bf16_t* W16 = (bf16_t*)(F.ws + WS_SMALL + SM_W16);
      for (int i = F.bid * NTHREADS + F.tid; i < 16 * DM; i += F.G * NTHREADS) { const int j = i >> 11, k = i & 2047; W16[i] = (bf16_t)f2bf(ARGP(A, 3)[(size_t)k * 7184 + 4096 + j] * ARGP(A, 2)[k]); } }
    { bf16_t* xb = (bf16_t*)(F.ws + WS_XB); float* rstd1 = (float*)(F.ws + WS_SMALL + SM_RSTD1);
      for (int m = gw; m < MTOK; m += NGW) row_to_bf16(ARGP(A, 0) + (size_t)m * DM, xb + (size_t)m * DM, rstd1 + m, F.lane, F.ws + WS_X2Q + (size_t)m * DM);
      bf16_t* memb = (bf16_t*)(F.ws + WS_MEMB); float* rstdm = (float*)(F.ws + WS_SMALL + SM_RSTDM);
      for (int m = gw; m < MROWS; m += NGW) row_to_bf16(ARGP(A, 1) + (size_t)m * DM, memb + (size_t)m * DM, rstdm + m, F.lane); }
}
__device__ __forceinline__ void phase_ffn_weights(const Frame& F, int iw, int nwg) {
    LAS float* scr = (LAS float*)(F.lds + F.wave * 17408);
    unsigned char* Wgu8 = F.ws + WS_WGU; unsigned char* Wdown8 = F.ws + WS_WDOWN;
    constexpr int I_G = 32 * 88, I_D = 88 * 32;
    for (int it = iw * NWAVES + F.wave; it < 2 * I_G + I_D; it += nwg * NWAVES) {
        int r = it;
        if (r < I_G) { const int c0 = 64 * (r % 88); transpose_item8(TABP(F, 17), DFF, 0, DM, TABP(F, 16), WGU_SCALE, Wgu8, ((c0 >> 7) << 8) + (c0 & 127) - c0, 88, scr, r, F.lane); continue; } r -= I_G;
        if (r < I_G) { const int c0 = 64 * (r % 88); transpose_item8(TABP(F, 18), DFF, 0, DM, TABP(F, 16), WGU_SCALE, Wgu8, ((c0 >> 7) << 8) + (c0 & 127) - c0 + 128, 88, scr, r, F.lane); continue; } r -= I_G;
        transpose_item8(TABP(F, 21), DM, 0, DFF, nullptr, WDOWN_SCALE, Wdown8, 0, 32, scr, r, F.lane);
    }
}
__device__ __forceinline__ void phase_final_norm(const Frame& F, const Args& A) {
    const int gw = F.bid * NWAVES + F.wave, NGW = F.G * NWAVES; const f32x4* g4 = (const f32x4*)TABP(F, 22) + 2 * F.lane;
    const bf16_t* xb = (const bf16_t*)(F.ws + WS_XB); const float* rsq = (const float*)(F.ws + WS_RSQ4);
    for (int m = gw; m < MTOK; m += NGW) {
        const float r = rsqrtf(rsq[m] * (1.0f / DM) + EPS);
        const u32x4* xr = (const u32x4*)(xb + (size_t)m * DM) + F.lane; f32x4* orow = (f32x4*)(F.out + (size_t)m * DM) + 2 * F.lane;
#pragma unroll
        for (int j = 0; j < 4; ++j) { const u32x4 h = __builtin_nontemporal_load(xr + 64 * j);
            const f32x4 a = {bf2f(h.x & 0xffffu), bf2f(h.x >> 16), bf2f(h.y & 0xffffu), bf2f(h.y >> 16)}, b = {bf2f(h.z & 0xffffu), bf2f(h.z >> 16), bf2f(h.w & 0xffffu), bf2f(h.w >> 16)};
            orow[128 * j] = a * r * g4[128 * j]; orow[128 * j + 1] = b * r * g4[128 * j + 1]; }
    }
}
typedef short mk_bf16x8 __attribute__((ext_vector_type(8)));
__device__ __forceinline__ void ba_item(const Frame& F, int item, int khalf) {
    const int lane = F.lane, r = lane & 15, q = lane >> 4, row0 = item * 16;
    const bf16_t* xa = (const bf16_t*)(F.ws + WS_XB) + (size_t)(row0 + r) * DM + khalf * 1024 + q * 8; const bf16_t* wb = (const bf16_t*)(F.ws + WS_SMALL + SM_W16) + (size_t)r * DM + khalf * 1024 + q * 8;
    f32x4 acc = {0.f, 0.f, 0.f, 0.f};
#pragma unroll 16
    for (int s = 0; s < 32; ++s) { const mk_bf16x8 a = *(const mk_bf16x8*)(xa + 32 * s), b = *(const mk_bf16x8*)(wb + 32 * s); acc = __builtin_amdgcn_mfma_f32_16x16x32_bf16(a, b, acc, 0, 0, 0); }
    LAS f32x4* xch = (LAS f32x4*)F.lds + (F.wave & 3) * 64 + lane;
    if (khalf) *xch = acc;
    __syncthreads();
    if (khalf) return;
    acc += *xch;
    const float* rstd1 = (const float*)(F.ws + WS_SMALL + SM_RSTD1); float* beta = (float*)(F.ws + WS_SMALL + SM_BETA); float* gg = (float*)(F.ws + WS_SMALL + SM_G);
    const int c = lane & 15, h = c & 7; const float alog = TABP(F, 5)[h], dtb = TABP(F, 6)[h];
#pragma unroll
    for (int i = 0; i < 4; ++i) { const int row = row0 + 4 * q + i; const float y = acc[i] * rstd1[row];
        if (c < 8) beta[(size_t)row * 8 + h] = 1.0f / (1.0f + expf(-y));
        else { const float z = y + dtb; const float sp = z > 20.f ? z : log1pf(expf(z)); gg[(size_t)row * 8 + h] = -expf(alog) * sp; } }
}
__device__ __forceinline__ void phase_moba(const Frame& F, const Args& A, char* lds, int cu) {
    const int grp = cu >> 6, bh = cu & 63, b = bh >> 3, h = bh & 7;
    const unsigned list = grp == 0 ? 0x37u : (grp == 1 ? 0x46u : 0x0125u); const int cnt = grp == 2 ? 4 : 2;
    moba::Head H; H.Q0 = (const bf16_t*)(F.ws + WS_PROJ) + (size_t)(b * SEQ) * PROJ_LD + 4096 + h * 128; H.K0 = H.Q0 + 1024; H.V0 = H.Q0 + 2048; H.O0 = (bf16_t*)(F.ws + WS_O) + (size_t)(b * SEQ) * DM + 1024 + h * 128;
    H.km = (const float*)(F.ws + WS_KMEAN) + (size_t)(b * 8) * 1024 + h * 128;
    moba::Seam S; int P0 = (int)(list & 15u) * 256;
    moba::prime<moba::CfgMoba>(H, P0, lds, S, F.tid, F.wave);
    for (int i = 0; i < cnt; ++i) { const int P0n = (i + 1 < cnt) ? (int)((list >> (4 * (i + 1))) & 15u) * 256 : P0; moba::block<moba::CfgMoba>(H, P0, P0n, TABP(F, 9), h, TABP(F, 8), lds, S, F.tid, F.wave); P0 = P0n; }
}
__device__ __forceinline__ void phase_xattn(const Frame& F, char* lds, int item) {
    const int qb = item & 7, h = (item >> 3) & 3, b = item >> 5;
    moba::Head H; H.Q0 = (const bf16_t*)(F.ws + WS_QX) + (size_t)(b * SEQ) * XW + h * 128; H.K0 = (const bf16_t*)(F.ws + WS_KVX) + (size_t)(b * MEMLEN) * (2 * XW) + h * 128; H.V0 = H.K0 + XW;
    H.O0 = (bf16_t*)(F.ws + WS_OX) + (size_t)(b * SEQ) * XW + h * 128; H.km = nullptr;
    moba::Seam S; const int P0 = qb * 256;
    moba::prime<moba::CfgX>(H, P0, lds, S, F.tid, F.wave);
    moba::block<moba::CfgX>(H, P0, P0, nullptr, h, nullptr, lds, S, F.tid, F.wave);
}
static_assert(moba::LDS_BYTES <= LDS_MISC && LDS_MISC + 128 <= LDS_BYTES, "LDS map");

__device__ __forceinline__ void ffn_fixup(const Frame& F, int pm) {
    const bf16_t* halo = (const bf16_t*)(F.ws + WS_GATE); const float* cw = TABP(F, 19); const float* cb = TABP(F, 20); unsigned char* H8 = (unsigned char*)F.out;
    u32x4 a2[3], a1[3], a0[3], au[3];
#pragma unroll
    for (int k = 0; k < 3; ++k) { int idx = F.tid + k * NTHREADS; idx = idx < 2 * 704 ? idx : 2 * 704 - 1; const int R = idx / 704, c = (idx - R * 704) * 8;
        const bf16_t* hp = halo + (size_t)(pm - 1) * 6 * 5632 + c; const bf16_t* hc = halo + (size_t)pm * 6 * 5632 + c;
        a2[k] = *(const u32x4*)(hp + (R == 0 ? 0 : 1) * 5632); a1[k] = *(const u32x4*)(R == 0 ? hp + 5632 : hc + 2 * 5632); a0[k] = *(const u32x4*)(hc + (2 + R) * 5632); au[k] = *(const u32x4*)(hc + (4 + R) * 5632); }
#pragma unroll
    for (int k = 0; k < 3; ++k) { const int idx = F.tid + k * NTHREADS; if (idx >= 2 * 704) break; const int R = idx / 704, c = (idx - R * 704) * 8;
        const unsigned v2[4] = {a2[k].x, a2[k].y, a2[k].z, a2[k].w}, v1[4] = {a1[k].x, a1[k].y, a1[k].z, a1[k].w}, v0[4] = {a0[k].x, a0[k].y, a0[k].z, a0[k].w}, vu[4] = {au[k].x, au[k].y, au[k].z, au[k].w}; float hv[8];
#pragma unroll
        for (int e = 0; e < 8; ++e) { const unsigned sh = (e & 1) ? 16u : 0u; const int kq = e >> 1, chn = c + e;
            const float x2 = bf2f((v2[kq] >> sh) & 0xffffu), x1 = bf2f((v1[kq] >> sh) & 0xffffu), gc = bf2f((v0[kq] >> sh) & 0xffffu), uu = bf2f((vu[kq] >> sh) & 0xffffu);
            const float y = cw[chn] * x2 + cw[DFF + chn] * x1 + cw[2 * DFF + chn] * gc + cb[chn]; hv[e] = y * __builtin_amdgcn_rcpf(1.0f + __expf(-y)) * uu; }
        int q0 = __builtin_amdgcn_cvt_pk_fp8_f32(hv[0], hv[1], 0, false); q0 = __builtin_amdgcn_cvt_pk_fp8_f32(hv[2], hv[3], q0, true);
        int q1 = __builtin_amdgcn_cvt_pk_fp8_f32(hv[4], hv[5], 0, false); q1 = __builtin_amdgcn_cvt_pk_fp8_f32(hv[6], hv[7], q1, true);
        *(u32x2*)(H8 + (size_t)(pm * 256 + R) * DFF + c) = (u32x2){(unsigned)q0, (unsigned)q1}; }
}
constexpr int N_PHASES = 14;
constexpr int WGM_IN1 = 8, WGM_IN2 = 8, WGM_OUT = 4, WGM_XQ = 4, WGM_XO = 4, WGM_GU = 4, WGM_DOWN = 4;

__global__ void __launch_bounds__(NTHREADS, 2) mk_fwd(Args args) {
    const Args& A = args;
    extern __shared__ __attribute__((aligned(16))) unsigned char lds_raw[];
    Frame F;
    F.lds = (LAS unsigned char*)lds_raw;
    F.wave = __builtin_amdgcn_readfirstlane((int)threadIdx.x >> 6); F.lane = 0; F.tid = 0;
#define FRESH_IDS() do { int l_; asm volatile("v_mbcnt_lo_u32_b32 %0, -1, 0\n\tv_mbcnt_hi_u32_b32 %0, -1, %0" : "=v"(l_)); F.lane = l_; F.tid = F.wave * 64 + l_; } while (0)
    F.G = gridDim.x; F.bid = blockIdx.x;
    F.out = args.out; F.ws = args.ws;
    const int lo = args.ph_lo, hi = args.ph_hi;
    unsigned char* ws = args.ws;
    const float* rstd1 = (const float*)(ws + WS_SMALL + SM_RSTD1); float* rstd2 = (float*)(ws + WS_SMALL + SM_RSTD2); float* rstd3 = (float*)(ws + WS_SMALL + SM_RSTD3);
    const float* rstdm = (const float*)(ws + WS_SMALL + SM_RSTDM);
    bf16_t* xb = (bf16_t*)(ws + WS_XB);
#define IN(k) (lo <= (k) && (k) < hi)
    volatile LAS unsigned* MISC = (volatile LAS unsigned*)(F.lds + LDS_MISC);
    XcdBarrier bar; bar.bar = (unsigned*)ws + CW_BAR; bar.x = 0; bar.st = nullptr;
    if (hi - lo > 1) { FRESH_IDS(); if (F.tid < 32) MISC[F.tid] = 0u; __syncthreads(); bar = xcd_barrier_post((unsigned*)ws + CW_BAR, MISC + 8, F.tid); }
#define SEAM(k) do { if (IN(k) && IN((k) + 1)) { FRESH_IDS(); xcd_barrier(bar, F.tid); } } while (0)

    if (IN(0)) { FRESH_IDS(); phase_prologue(F, A); }
    if (lo < 0) cg::this_grid().sync();
    SEAM(0);
    if (IN(1)) { FRESH_IDS();
        if ((F.bid & 1) == 0) { ba_item(F, (F.wave & 3) * 256 + F.bid, F.wave >> 2);
            __syncthreads();
            FRESH_IDS(); }
        { pg8::Gemm g{(const bf16_t*)(ws + WS_X2Q), (const bf16_t*)(ws + WS_WIN), MTOK, 4096, DM / 2}; pg8::StaticOrder S; S.init(MTOK, 4096, F.G, F.bid, WGM_IN1);
          pg8::EpiScaleBf16 E{(bf16_t*)(ws + WS_PROJ), PROJ_LD, rstd1, 12, 16, 0, 0, nullptr, 0, 0, 0, 1.0f / WGU_SCALE};
          pg8::gemm_phase<pg8::EpiScaleBf16, pg8::StaticOrder, true, true, true>(F.lds, g, S, E, F.tid, F.wave); }
        FRESH_IDS();
        { pg8::Gemm g{xb, (const bf16_t*)(ws + WS_WINB), MTOK, 3072, DM}; pg8::StaticOrder S; S.init(MTOK, 3072, F.G, F.bid, WGM_IN2);
          pg8::EpiScaleBf16 E{(bf16_t*)(ws + WS_PROJ) + 4096, PROJ_LD, rstd1, 0, 0, 0, 0, (float*)(ws + WS_KMEAN), 4, 8, 0, 1.0f, 0, 4, moba::QSCALE};
          pg8::gemm_phase<pg8::EpiScaleBf16, pg8::StaticOrder, true, true>(F.lds, g, S, E, F.tid, F.wave); }
        if (F.bid & 1) { __syncthreads(); FRESH_IDS(); ba_item(F, (F.wave & 3) * 256 + F.bid, F.wave >> 2); }
    } SEAM(1);
    if (IN(2)) { FRESH_IDS();
        gdn::prep((__attribute__((address_space(3))) unsigned char*)F.lds, F.tid, F.lane, F.wave, F.bid, (const unsigned short*)(ws + WS_PROJ), (const float*)(ws + WS_SMALL + SM_BETA), (const float*)(ws + WS_SMALL + SM_G), TABP(F, 4),
                  (unsigned char*)F.out, ws + WS_WIN, ws + WS_O); } SEAM(2);
    if (IN(3)) { FRESH_IDS();
        if (F.bid < 64) gdn::scan((__attribute__((address_space(3))) unsigned char*)F.lds, F.tid, F.lane, F.wave, F.bid, (unsigned char*)F.out, ws + WS_WIN, (const unsigned short*)(ws + WS_PROJ), TABP(F, 7), (unsigned short*)(ws + WS_O));
        else if (F.bid < 256) phase_moba(F, A, (char*)lds_raw, F.bid - 64);
    } SEAM(3);
    if (IN(4)) { FRESH_IDS();
        pg8::Gemm g{(const bf16_t*)(ws + WS_O), (const bf16_t*)(ws + WS_WOUT), MTOK, DM, DM}; pg8::StaticOrder S; S.init(MTOK, DM, F.G, F.bid, WGM_OUT);
        pg8::EpiResidBf16 E{xb, xb, DM, (float*)(ws + WS_RSQ2), 1.0f, nullptr};
        pg8::gemm_phase<pg8::EpiResidBf16, pg8::StaticOrder, true, true>(F.lds, g, S, E, F.tid, F.wave);
    } SEAM(4);
    if (IN(6)) { FRESH_IDS();
        { pg8::Gemm g{xb, (const bf16_t*)(ws + WS_WXQ), MTOK, XW, DM}; pg8::StaticOrder S; S.init(MTOK, XW, F.G, F.bid, WGM_XQ);
          pg8::EpiScaleBf16 E{(bf16_t*)(ws + WS_QX), XW, (const float*)(ws + WS_RSQ2), 0, 0, 0, 0, nullptr, 0, 0, 1, moba::QSCALE};
          pg8::gemm_phase<pg8::EpiScaleBf16, pg8::StaticOrder, true, true>(F.lds, g, S, E, F.tid, F.wave); }
        { pg8::Gemm g{(const bf16_t*)(ws + WS_MEMB), (const bf16_t*)(ws + WS_WXKV), MROWS, 2 * XW, DM}; pg8::StaticOrder S; S.init(MROWS, 2 * XW, F.G, (F.bid + F.G - 128) % F.G);
          pg8::EpiScaleBf16 E{(bf16_t*)(ws + WS_KVX), 2 * XW, rstdm, 0, 0, 0, 0, nullptr, 0, 0, 0, 1.0f};
          pg8::gemm_phase<pg8::EpiScaleBf16, pg8::StaticOrder, true, true>(F.lds, g, S, E, F.tid, F.wave); }
        if (F.bid >= 160 && F.bid < 256) { FRESH_IDS(); phase_ffn_weights(F, F.bid - 160, 96); }
    } SEAM(6);
    if (IN(7)) { FRESH_IDS(); if (F.bid < 256) phase_xattn(F, (char*)lds_raw, F.bid); } SEAM(7);
    if (IN(8)) { FRESH_IDS();
        pg8::Gemm g{(const bf16_t*)(ws + WS_OX), (const bf16_t*)(ws + WS_WXO), MTOK, DM, XW}; pg8::StaticOrder S; S.init(MTOK, DM, F.G, F.bid, WGM_XO);
        pg8::EpiResidBf16 E{xb, xb, DM, (float*)(ws + WS_RSQ3), 1.0f, ws + WS_X2Q};
        pg8::gemm_phase<pg8::EpiResidBf16, pg8::StaticOrder, true, true>(F.lds, g, S, E, F.tid, F.wave);
    } SEAM(8);
    if (IN(10)) { FRESH_IDS();
        pg8::Gemm g{(const bf16_t*)(ws + WS_X2Q), (const bf16_t*)(ws + WS_WGU), MTOK, 2 * DFF, DM / 2}; pg8::StaticOrder S; S.init(MTOK, 2 * DFF, F.G, F.bid, WGM_GU);
        pg8::EpiFfn E{(unsigned char*)F.out, (const float*)(ws + WS_RSQ3), TABP(F, 19), TABP(F, 20), (bf16_t*)(ws + WS_GATE), (__attribute__((address_space(3))) float*)(F.lds + 131072), 1.0f / WGU_SCALE};
        pg8::gemm_phase<pg8::EpiFfn, pg8::StaticOrder, true, true, true>(F.lds, g, S, E, F.tid, F.wave);
    } SEAM(10);
    if (IN(12)) { FRESH_IDS();
        { pg8::StaticOrder S0; S0.init(MTOK, DM, F.G, F.bid, WGM_DOWN); pg8::Unit u0;
          if (S0.next(0, u0) && (u0.pm & 7)) ffn_fixup(F, u0.pm);
          if (S0.next(1, u0) && (u0.pm & 7)) ffn_fixup(F, u0.pm);
          asm volatile("s_waitcnt vmcnt(0)" ::: "memory"); __syncthreads(); FRESH_IDS(); }
        pg8::Gemm g{(const bf16_t*)F.out, (const bf16_t*)(ws + WS_WDOWN), MTOK, DM, DFF / 2};     pg8::StaticOrder S; S.init(MTOK, DM, F.G, F.bid, WGM_DOWN);
        pg8::EpiResidBf16 E{xb, xb, DM, (float*)(ws + WS_RSQ4), 1.0f / WDOWN_SCALE, nullptr};
        pg8::gemm_phase<pg8::EpiResidBf16, pg8::StaticOrder, true, true, true>(F.lds, g, S, E, F.tid, F.wave);
    } SEAM(12);
    if (IN(13)) { FRESH_IDS(); phase_final_norm(F, A); }
#undef IN
#undef SEAM
}

extern "C" void kernel_launch(void* const* d_in, const int* in_sizes, int n_in, void* d_out, int out_size, void* d_ws, size_t ws_size, hipStream_t stream) {
    static int grid = 0;
    if (grid == 0) {
        if (n_in != 23 || in_sizes[0] != MTOK * DM || out_size != MTOK * DM || ws_size < WS_END) {
            fprintf(stderr, "kernel_launch: unexpected shapes: n_in %d, in0 %d, out %d, ws %zu (need >= %zu); nothing launched\n", n_in, n_in > 0 ? in_sizes[0] : -1, out_size, ws_size, (size_t)WS_END); grid = -1; return; }
        int dev = 0, cus = 0, per_cu = 0;
        if (hipGetDevice(&dev) != hipSuccess || hipDeviceGetAttribute(&cus, hipDeviceAttributeMultiprocessorCount, dev) != hipSuccess) { fprintf(stderr, "kernel_launch: device query failed\n"); grid = -1; return; }
        if (hipFuncSetAttribute((const void*)mk_fwd, hipFuncAttributeMaxDynamicSharedMemorySize, LDS_BYTES) != hipSuccess) { fprintf(stderr, "kernel_launch: hipFuncSetAttribute failed\n"); grid = -1; return; }
        if (hipOccupancyMaxActiveBlocksPerMultiprocessor(&per_cu, (const void*)mk_fwd, NTHREADS, LDS_BYTES) != hipSuccess || per_cu < 1) { fprintf(stderr, "kernel_launch: occupancy query says %d blocks per CU\n", per_cu); per_cu = 1; }
        (void)hipGetLastError();
        if (per_cu > 1) per_cu = 1;
        grid = cus * per_cu;
        if (grid != 256) { fprintf(stderr, "kernel_launch: built for a 256-CU device (grid %d); nothing launched\n", grid); grid = -1; return; }
    }
    if (grid < 0) return;
    if (hipMemsetAsync(d_ws, 0, 1u << 20, stream) != hipSuccess) { fprintf(stderr, "kernel_launch: hipMemsetAsync failed\n"); return; }
    Args a{};
    for (int i = 0; i < 23; ++i) a.in[i] = (const float*)d_in[i];
    a.out = (float*)d_out; a.ws = (unsigned char*)d_ws;
#if MK_MULTI
    for (int p = 0; p < N_PHASES; ++p) { a.ph_lo = p; a.ph_hi = p + 1; hipLaunchKernelGGL(mk_fwd, dim3(grid), dim3(NTHREADS), LDS_BYTES, stream, a); }
#else
    a.ph_lo = 0; a.ph_hi = N_PHASES;
    void* kargs[] = {&a};
    hipError_t e = hipLaunchCooperativeKernel((const void*)mk_fwd, dim3(grid), dim3(NTHREADS), kargs, LDS_BYTES, stream);
    if (e != hipSuccess) fprintf(stderr, "kernel_launch: cooperative launch failed: %s (grid %d)\n", hipGetErrorString(e), grid);
#endif
}
```

```cpp
#include <hip/hip_runtime.h>
#include <hip/hip_cooperative_groups.h>
#include <cstdio>
#include <cstdint>
namespace cg = cooperative_groups;

#ifndef MK_MULTI
#define MK_MULTI 0
#endif

namespace pg8 {
#define PG8_LAS __attribute__((address_space(3)))
typedef unsigned short bf16_t;
typedef short bf16x8 __attribute__((ext_vector_type(8)));
typedef float f32x4 __attribute__((ext_vector_type(4)));
typedef unsigned u32x4 __attribute__((ext_vector_type(4)));
typedef int pg8_v4i __attribute__((ext_vector_type(4)));
typedef int pg8_v8i __attribute__((ext_vector_type(8)));
constexpr int BM = 256, BK = 64, HALF = 128, HTB = HALF * BK * 2  , STAGE_BYTES = 8 * HTB, NXCD = 8;

__host__ __device__ __forceinline__ int lds_byte(int r, int c) { const int st = (r >> 4) * 2 + (c >> 5), rr = r & 15, cc = c & 31, ob = rr * 64 + cc * 2; return st * 1024 + (ob ^ (((ob >> 9) & 1) << 5)); }
__host__ __device__ __forceinline__ void stage_rc(int b, int& R, int& C) { const int st = b / 1024, sb = b % 1024, swz = sb ^ (((sb >> 9) & 1) << 5); R = (st >> 1) * 16 + swz / 64; C = (st & 1) * 32 + (swz % 64) / 2; }
__host__ __device__ __forceinline__ int perm32(int rho) { const int n = rho >> 4, i = rho & 15; return 8 * (i >> 2) + 4 * n + (i & 3); }

struct Unit { int pm, pn; };
struct Gemm { const bf16_t* A; const bf16_t* Bt; int M, N, K; };

struct StaticOrder {
    int nM, nN, nwg, G, c, WGM;
    __host__ __device__ __forceinline__ void init(int M, int N, int G_, int c_, int wgm_ = 8) { nM = M / BM; nN = N / BM; nwg = nM * nN; G = G_; c = c_; WGM = wgm_; }
    __host__ __device__ __forceinline__ bool next(int i, Unit& u) const {
        const long L = (long)i * G + c; if (L >= nwg) return false;
        int wgid = (int)L; { const int q = nwg / NXCD, r = nwg % NXCD, xcd = wgid % NXCD, off = wgid / NXCD; wgid = (xcd < r ? xcd * (q + 1) : r * (q + 1) + (xcd - r) * q) + off; }
        const int nig = WGM * nN, gid = wgid / nig, fm = gid * WGM, gsz = (nM - fm) < WGM ? (nM - fm) : WGM;
        u.pm = fm + ((wgid % nig) % gsz); u.pn = (wgid % nig) / gsz; return true;
    }
    __device__ __forceinline__ void a_ready(const Unit&) const {}
    __device__ __forceinline__ void done(const Unit&) const {}
};


__device__ __forceinline__ unsigned cvt_pk_bf16(float lo, float hi) { unsigned r; asm volatile("v_cvt_pk_bf16_f32 %0, %1, %2" : "=v"(r) : "v"(lo), "v"(hi)); return r; }
typedef __bf16 hw_bf16x2 __attribute__((ext_vector_type(2)));
typedef float hw_f32x2 __attribute__((ext_vector_type(2)));
__device__ __forceinline__ unsigned cvt_pk_bf16_acc(float lo, float hi) { const hw_bf16x2 r = __builtin_convertvector((hw_f32x2){lo, hi}, hw_bf16x2); return __builtin_bit_cast(unsigned, r); }
__device__ __forceinline__ float silu_f(float v) { return v * __builtin_amdgcn_rcpf(1.0f + __expf(-v)); }

struct EpiScaleBf16 {
    static constexpr bool PERM = true, AFTER_DRAIN = false;
    bf16_t* O; int ldc; const float* rs; int silu_lo, silu_hi; int split_cols; size_t split_stride; float* km; int km_lo, km_hi; int rs_sumsq; float oscale; int qs_lo, qs_hi; float qscale;
    __device__ __forceinline__ void operator()(const f32x4 (&acc)[2][2][4][2], const Unit& u, int wr, int wc, int fr, int fq) const {
        int colt = u.pn * BM; bf16_t* base = O; if (split_cols && colt >= split_cols) { base += split_stride; colt -= split_cols; }
        const int row0 = u.pm * BM + wr * 64 + fr, col0 = colt + wc * 32 + 8 * fq;
        const bool act = (u.pn >= silu_lo && u.pn < silu_hi); const float tscale = (u.pn >= qs_lo && u.pn < qs_hi) ? oscale * qscale : oscale;
        const bool dokm = km && u.pn >= km_lo && u.pn < km_hi; float cs[2][8];
#pragma unroll
        for (int a_ = 0; a_ < 2; ++a_)
#pragma unroll
            for (int b_ = 0; b_ < 8; ++b_) cs[a_][b_] = 0.f;
        float rsv[2][4];
#pragma unroll
        for (int ai = 0; ai < 2; ++ai)
#pragma unroll
            for (int m = 0; m < 4; ++m) rsv[ai][m] = rs ? rs[row0 + ai * HALF + m * 16] : 1.0f;
#pragma unroll
        for (int ai = 0; ai < 2; ++ai)
#pragma unroll
            for (int m = 0; m < 4; ++m) { const int row = row0 + ai * HALF + m * 16; float r = rsv[ai][m]; if (rs_sumsq) r = rsqrtf(r * (1.0f / 2048.0f) + 1e-6f); r *= tscale; bf16_t* rowp = base + (size_t)row * ldc + col0;
#pragma unroll
                for (int bj = 0; bj < 2; ++bj) { f32x4 v0 = acc[ai][bj][m][0] * r, v1 = acc[ai][bj][m][1] * r;
                    if (act) {
#pragma unroll
                        for (int j = 0; j < 4; ++j) { v0[j] = silu_f(v0[j]); v1[j] = silu_f(v1[j]); } }
                    if (dokm) {
#pragma unroll
                        for (int j = 0; j < 4; ++j) { cs[bj][j] += v0[j]; cs[bj][4 + j] += v1[j]; } }
                    u32x4 w; w.x = cvt_pk_bf16(v0[0], v0[1]); w.y = cvt_pk_bf16(v0[2], v0[3]); w.z = cvt_pk_bf16(v1[0], v1[1]); w.w = cvt_pk_bf16(v1[2], v1[3]);
                    *(u32x4*)(rowp + bj * HALF) = w; } }
        if (dokm) {
#pragma unroll
            for (int bj = 0; bj < 2; ++bj)
#pragma unroll
                for (int c = 0; c < 8; ++c) { float s = cs[bj][c]; s += __shfl_xor(s, 1); s += __shfl_xor(s, 2); s += __shfl_xor(s, 4); s += __shfl_xor(s, 8);
                    if (fr == 0) atomicAdd(km + (size_t)u.pm * 1024 + (u.pn - km_lo) * BM + bj * HALF + wc * 32 + 8 * fq + c, s * (1.0f / 256.0f)); } }
    }
};
struct EpiResidBf16 {
    static constexpr bool PERM = true, AFTER_DRAIN = false;
    const bf16_t* baseh; bf16_t* out; int ldc; float* rowsq; float accscale; unsigned char* q8;
    __device__ __forceinline__ void operator()(const f32x4 (&acc)[2][2][4][2], const Unit& u, int wr, int wc, int fr, int fq) const {
        const int row0 = u.pm * BM + wr * 64 + fr, col0 = u.pn * BM + wc * 32 + 8 * fq;
#pragma unroll
        for (int ai = 0; ai < 2; ++ai) {
            u32x4 hb[4][2];
#pragma unroll
            for (int m = 0; m < 4; ++m)
#pragma unroll
                for (int bj = 0; bj < 2; ++bj) hb[m][bj] = *(const u32x4*)(baseh + (size_t)(row0 + ai * HALF + m * 16) * ldc + col0 + bj * HALF);
#pragma unroll
            for (int m = 0; m < 4; ++m) { const int row = row0 + ai * HALF + m * 16; const size_t off = (size_t)row * ldc + col0; float ss = 0.f;
#pragma unroll
                for (int bj = 0; bj < 2; ++bj) { const u32x4 h = hb[m][bj];
                    const f32x4 b0 = (f32x4){__uint_as_float(h.x << 16), __uint_as_float(h.x & 0xffff0000u), __uint_as_float(h.y << 16), __uint_as_float(h.y & 0xffff0000u)};
                    const f32x4 b1 = (f32x4){__uint_as_float(h.z << 16), __uint_as_float(h.z & 0xffff0000u), __uint_as_float(h.w << 16), __uint_as_float(h.w & 0xffff0000u)};
                    const f32x4 v0 = b0 + acc[ai][bj][m][0] * accscale, v1 = b1 + acc[ai][bj][m][1] * accscale;
                    ss += (v0[0] * v0[0] + v0[1] * v0[1]) + (v0[2] * v0[2] + v0[3] * v0[3]) + (v1[0] * v1[0] + v1[1] * v1[1]) + (v1[2] * v1[2] + v1[3] * v1[3]);
                    u32x4 w; w.x = cvt_pk_bf16(v0[0], v0[1]); w.y = cvt_pk_bf16(v0[2], v0[3]); w.z = cvt_pk_bf16(v1[0], v1[1]); w.w = cvt_pk_bf16(v1[2], v1[3]);
                    *(u32x4*)(out + off + bj * HALF) = w;
                    if (q8) { int q0 = __builtin_amdgcn_cvt_pk_fp8_f32(v0[0], v0[1], 0, false); q0 = __builtin_amdgcn_cvt_pk_fp8_f32(v0[2], v0[3], q0, true);
                        int q1 = __builtin_amdgcn_cvt_pk_fp8_f32(v1[0], v1[1], 0, false); q1 = __builtin_amdgcn_cvt_pk_fp8_f32(v1[2], v1[3], q1, true);
                        typedef unsigned u32x2_ __attribute__((ext_vector_type(2))); *(u32x2_*)(q8 + off + bj * HALF) = (u32x2_){(unsigned)q0, (unsigned)q1}; } }
                ss += __shfl_xor(ss, 16); ss += __shfl_xor(ss, 32);
                if (fq == 0) atomicAdd(rowsq + row, ss); } }
    }
};

struct EpiFfn {
    static constexpr bool PERM = true, AFTER_DRAIN = false;
    unsigned char* H8; const float* rsq; const float* cw; const float* cb; bf16_t* halo; PG8_LAS float* X;
    float oscale;
    __device__ __forceinline__ void operator()(f32x4 (&acc)[2][2][4][2], const Unit& u, int wr, int wc, int fr_in, int fq_in) const {
        int fr = fr_in, fq = fq_in; asm volatile("" : "+v"(fr), "+v"(fq));
        const int wid = wr * 4 + wc, ch = u.pn * 128 + wc * 32 + 8 * fq, lane = fq * 16 + fr;
#pragma unroll
        for (int ai = 0; ai < 2; ++ai)
#pragma unroll
            for (int m = 0; m < 4; ++m) { const int row = u.pm * BM + ai * HALF + wr * 64 + m * 16 + fr; const float r = rsqrtf(rsq[row] * (1.0f / 2048.0f) + 1e-6f) * oscale;
#pragma unroll
                for (int bj = 0; bj < 2; ++bj) { acc[ai][bj][m][0] = acc[ai][bj][m][0] * r; acc[ai][bj][m][1] = acc[ai][bj][m][1] * r; } }
        if (fr >= 14) {
#pragma unroll
            for (int ai = 0; ai < 2; ++ai) { PG8_LAS f32x4* xp = (PG8_LAS f32x4*)(X + ((wid * 2 + ai) * 2 + (fr - 14)) * 64 + fq * 8); xp[0] = acc[ai][0][3][0]; xp[1] = acc[ai][0][3][1]; } }
        { bf16_t* hp = halo + (size_t)u.pm * 6 * 5632 + ch;
          if (wr == 1 && fr >= 14) { u32x4 w = {cvt_pk_bf16(acc[1][0][3][0][0], acc[1][0][3][0][1]), cvt_pk_bf16(acc[1][0][3][0][2], acc[1][0][3][0][3]), cvt_pk_bf16(acc[1][0][3][1][0], acc[1][0][3][1][1]), cvt_pk_bf16(acc[1][0][3][1][2], acc[1][0][3][1][3])};
              *(u32x4*)(hp + (size_t)(fr - 14) * 5632) = w; }
          if (wr == 0 && fr < 2) { u32x4 w = {cvt_pk_bf16(acc[0][0][0][0][0], acc[0][0][0][0][1]), cvt_pk_bf16(acc[0][0][0][0][2], acc[0][0][0][0][3]), cvt_pk_bf16(acc[0][0][0][1][0], acc[0][0][0][1][1]), cvt_pk_bf16(acc[0][0][0][1][2], acc[0][0][0][1][3])};
              *(u32x4*)(hp + (size_t)(2 + fr) * 5632) = w;
              u32x4 w2 = {cvt_pk_bf16(acc[0][1][0][0][0], acc[0][1][0][0][1]), cvt_pk_bf16(acc[0][1][0][0][2], acc[0][1][0][0][3]), cvt_pk_bf16(acc[0][1][0][1][0], acc[0][1][0][1][1]), cvt_pk_bf16(acc[0][1][0][1][2], acc[0][1][0][1][3])};
              *(u32x4*)(hp + (size_t)(4 + fr) * 5632) = w2; } }
        const f32x4 w0a = *(const f32x4*)(cw + ch), w0b = *(const f32x4*)(cw + ch + 4), w1a = *(const f32x4*)(cw + 5632 + ch), w1b = *(const f32x4*)(cw + 5632 + ch + 4);
        const f32x4 w2a = *(const f32x4*)(cw + 2 * 5632 + ch), w2b = *(const f32x4*)(cw + 2 * 5632 + ch + 4), ba = *(const f32x4*)(cb + ch), bb = *(const f32x4*)(cb + ch + 4);
        asm volatile("s_waitcnt lgkmcnt(0)" ::: "memory"); __builtin_amdgcn_s_barrier(); asm volatile("" ::: "memory");
#pragma unroll
        for (int ai = 1; ai >= 0; --ai)
#pragma unroll
            for (int m = 3; m >= 0; --m) {
                f32x4 pv0, pv1;
                if (m > 0) { pv0 = acc[ai][0][m - 1][0]; pv1 = acc[ai][0][m - 1][1]; }
                else { pv0 = (f32x4){0.f, 0.f, 0.f, 0.f}; pv1 = pv0;
                    if (!(wr == 0 && ai == 0) && fr >= 14) { const int pw = (1 - wr) * 4 + wc, pai = (wr == 1) ? ai : 0;
                        const PG8_LAS f32x4* xp = (const PG8_LAS f32x4*)(X + ((pw * 2 + pai) * 2 + (fr - 14)) * 64 + fq * 8); pv0 = xp[0]; pv1 = xp[1]; } }
                const f32x4 g0 = acc[ai][0][m][0], g1 = acc[ai][0][m][1], u0 = acc[ai][1][m][0], u1 = acc[ai][1][m][1];
                float hv[8];
#pragma unroll
                for (int c = 0; c < 8; ++c) { const float gc = c < 4 ? g0[c & 3] : g1[c & 3], pc = c < 4 ? pv0[c & 3] : pv1[c & 3];
                    const float x1 = __int_as_float(__builtin_amdgcn_update_dpp(0, __float_as_int(fr == 15 ? pc : gc), 0x121, 0xf, 0xf, true)), x2 = __int_as_float(__builtin_amdgcn_update_dpp(0, __float_as_int(fr >= 14 ? pc : gc), 0x122, 0xf, 0xf, true));
                    const float y = __builtin_fmaf(c < 4 ? w0a[c & 3] : w0b[c & 3], x2, __builtin_fmaf(c < 4 ? w1a[c & 3] : w1b[c & 3], x1, __builtin_fmaf(c < 4 ? w2a[c & 3] : w2b[c & 3], gc, c < 4 ? ba[c & 3] : bb[c & 3])));
                    hv[c] = y * __builtin_amdgcn_rcpf(1.0f + __expf(-y)) * (c < 4 ? u0[c & 3] : u1[c & 3]); }
                int q0 = __builtin_amdgcn_cvt_pk_fp8_f32(hv[0], hv[1], 0, false); q0 = __builtin_amdgcn_cvt_pk_fp8_f32(hv[2], hv[3], q0, true);
                int q1 = __builtin_amdgcn_cvt_pk_fp8_f32(hv[4], hv[5], 0, false); q1 = __builtin_amdgcn_cvt_pk_fp8_f32(hv[6], hv[7], q1, true);
                typedef unsigned u32x2_ __attribute__((ext_vector_type(2)));
                *(u32x2_*)(H8 + (size_t)(u.pm * BM + ai * HALF + wr * 64 + m * 16 + fr) * 5632 + ch) = (u32x2_){(unsigned)q0, (unsigned)q1}; }
    }
};

template <class Epi, class Sched, bool ALIGN_EPI = false, bool SP2 = false, bool F8 = false>
__device__ __forceinline__ void gemm_phase(PG8_LAS unsigned char* lds, const Gemm g, const Sched& S, const Epi& E, const int tid, const int wid) {
    const int lane = tid & 63, wr = wid >> 2, wc = wid & 3, fr = lane & 15, fq = lane >> 4;
    const int K = g.K, nt = K / BK;
    unsigned voffA[2], voffB[2];
#pragma unroll
    for (int i = 0; i < 2; ++i) { int R, C; stage_rc(tid * 16 + i * 8192, R, C); const int Rb = Epi::PERM ? ((R & ~31) + perm32(R & 31)) : R;
        voffA[i] = (unsigned)(R * K + C) * 2u; voffB[i] = (unsigned)(Rb * K + C) * 2u; }
    const size_t kstep = (size_t)(BK * 2);
    const size_t hstep = (size_t)HALF * K * 2;
    const size_t tstep = 2 * hstep;
    const unsigned ldsw = (unsigned)wid * 1024u;
    const int aoff = lds_byte(wr * 64 + fr, fq * 8), boff = lds_byte(wc * 32 + fr, fq * 8);
#define PG8_SA(b, h) (((b) * 2 + (h)) * HTB)
#define PG8_SB(b, h) ((4 + (b) * 2 + (h)) * HTB)
#define PG8_STAGE(bufoff, gbase, voff) do { _Pragma("unroll") for (int _i = 0; _i < 2; ++_i) { unsigned vo_ = (voff)[_i]; if constexpr (F8) asm volatile("" : "+v"(vo_));     \
        __builtin_amdgcn_global_load_lds((const unsigned*)((const char*)(gbase) + vo_), (PG8_LAS unsigned*)(lds + (bufoff) + ldsw + _i * 8192), 16, 0, 0); } } while (0)
#define PG8_LDA(dst, b, h) do { if constexpr (F8) { _Pragma("unroll") for (int m = 0; m < 4; ++m) { const pg8_v4i l_ = *(const PG8_LAS pg8_v4i*)(lds + PG8_SA(b, h) + aoff + m * 2048), h_ = *(const PG8_LAS pg8_v4i*)(lds + PG8_SA(b, h) + aoff + m * 2048 + 1024); \
            dst##8[m] = __builtin_shufflevector(l_, h_, 0, 1, 2, 3, 4, 5, 6, 7); } } \
        else { _Pragma("unroll") for (int m = 0; m < 4; ++m) _Pragma("unroll") for (int k = 0; k < 2; ++k) dst[m][k] = *(const PG8_LAS bf16x8*)(lds + PG8_SA(b, h) + aoff + m * 2048 + k * 1024); } } while (0)
#define PG8_LDB(dst, b, h) do { if constexpr (F8) { _Pragma("unroll") for (int n = 0; n < 2; ++n) { const pg8_v4i l_ = *(const PG8_LAS pg8_v4i*)(lds + PG8_SB(b, h) + boff + n * 2048), h_ = *(const PG8_LAS pg8_v4i*)(lds + PG8_SB(b, h) + boff + n * 2048 + 1024); \
            dst##8[n] = __builtin_shufflevector(l_, h_, 0, 1, 2, 3, 4, 5, 6, 7); } } \
        else { _Pragma("unroll") for (int n = 0; n < 2; ++n) _Pragma("unroll") for (int k = 0; k < 2; ++k) dst[n][k] = *(const PG8_LAS bf16x8*)(lds + PG8_SB(b, h) + boff + n * 2048 + k * 1024); } } while (0)
#define PG8_MMA(ai, bj, At, Bt) do { __builtin_amdgcn_s_setprio(1); \
        if constexpr (F8) { _Pragma("unroll") for (int m = 0; m < 4; ++m) _Pragma("unroll") for (int n = 0; n < 2; ++n) \
            acc[ai][bj][m][n] = __builtin_amdgcn_mfma_scale_f32_16x16x128_f8f6f4(Bt##8[n], At##8[m], acc[ai][bj][m][n], 0, 0, 0, 0x7f7f7f7f, 0, 0x7f7f7f7f); } \
        else { _Pragma("unroll") for (int m = 0; m < 4; ++m) _Pragma("unroll") for (int n = 0; n < 2; ++n) _Pragma("unroll") for (int k = 0; k < 2; ++k) \
            acc[ai][bj][m][n] = __builtin_amdgcn_mfma_f32_16x16x32_bf16(Bt[n][k], At[m][k], acc[ai][bj][m][n], 0, 0, 0); } \
        __builtin_amdgcn_s_setprio(0); } while (0)
#define PG8_WAIT_V(n) asm volatile("s_waitcnt vmcnt(" #n ")" ::: "memory")
#define PG8_WAIT_L(n) asm volatile("s_waitcnt lgkmcnt(" #n ")" ::: "memory")
#define PG8_BAR __builtin_amdgcn_s_barrier()
#define PG8_SCHED __builtin_amdgcn_sched_barrier(0)
    Unit cur, nxt; int ui = 0;
    if (!S.next(0, cur)) return;
    f32x4 acc[2][2][4][2];
#pragma unroll
    for (int a = 0; a < 2; ++a)
#pragma unroll
        for (int b = 0; b < 2; ++b)
#pragma unroll
            for (int m = 0; m < 4; ++m)
#pragma unroll
                for (int n = 0; n < 2; ++n) acc[a][b][m][n] = (f32x4){0.f, 0.f, 0.f, 0.f};
    bf16x8 At[4][2], B0[2][2], B1[2][2];
    pg8_v8i At8[4], B08[2], B18[2];
    const char* cA = (const char*)g.A + (size_t)cur.pm * tstep; const char* cB = (const char*)g.Bt + (size_t)cur.pn * tstep;
    S.a_ready(cur);
    if constexpr (SP2) {
        PG8_STAGE(PG8_SB(0, 0), cB, voffB); PG8_STAGE(PG8_SB(0, 1), cB + hstep, voffB); PG8_STAGE(PG8_SA(0, 0), cA, voffA); PG8_STAGE(PG8_SA(0, 1), cA + hstep, voffA);
        if (wr == 1) PG8_BAR;
        PG8_WAIT_V(2); PG8_BAR;
        PG8_STAGE(PG8_SB(1, 0), cB + kstep, voffB); PG8_STAGE(PG8_SA(1, 0), cA + kstep, voffA); PG8_STAGE(PG8_SB(1, 1), cB + hstep + kstep, voffB);
        PG8_WAIT_V(6); PG8_BAR;
    } else {
        PG8_STAGE(PG8_SB(0, 0), cB, voffB); PG8_STAGE(PG8_SA(0, 0), cA, voffA); PG8_STAGE(PG8_SB(0, 1), cB + hstep, voffB); PG8_STAGE(PG8_SA(0, 1), cA + hstep, voffA);
        if (wr == 1) PG8_BAR;
        PG8_WAIT_V(4); PG8_BAR;
        PG8_STAGE(PG8_SB(1, 0), cB + kstep, voffB); PG8_STAGE(PG8_SA(1, 0), cA + kstep, voffA); PG8_STAGE(PG8_SB(1, 1), cB + hstep + kstep, voffB);
        PG8_WAIT_V(6); PG8_BAR;
    }
    for (;;) {
        const bool has_next = S.next(ui + 1, nxt);
        const char* nA = has_next ? (const char*)g.A + (size_t)nxt.pm * tstep : cA; const char* nB = has_next ? (const char*)g.Bt + (size_t)nxt.pn * tstep : cB;
        for (int t = 0; t < nt; t += 2) {
            const bool last = (t == nt - 2);
            const char* a1 = cA + (size_t)(t + 1) * kstep;
            const char* a2 = last ? nA : cA + (size_t)(t + 2) * kstep; const char* b2 = last ? nB : cB + (size_t)(t + 2) * kstep;
            const char* a3 = a2 + kstep; const char* b3 = b2 + kstep;
            if (last && has_next) S.a_ready(nxt);
            if constexpr (SP2) {
            PG8_LDB(B0, 0, 0); PG8_LDB(B1, 0, 1); PG8_SCHED; PG8_LDA(At, 0, 0); PG8_STAGE(PG8_SA(1, 1), a1 + hstep, voffA);
            PG8_WAIT_V(8); PG8_WAIT_L(0); PG8_BAR; PG8_MMA(0, 0, At, B0); PG8_MMA(0, 1, At, B1); PG8_BAR; PG8_SCHED;
            PG8_LDA(At, 0, 1); PG8_STAGE(PG8_SB(0, 0), b2, voffB); PG8_STAGE(PG8_SB(0, 1), b2 + hstep, voffB); PG8_STAGE(PG8_SA(0, 0), a2, voffA);
            PG8_WAIT_V(8); PG8_WAIT_L(0); PG8_BAR; PG8_MMA(1, 0, At, B0); PG8_MMA(1, 1, At, B1); PG8_BAR; PG8_SCHED;
            PG8_LDB(B0, 1, 0); PG8_LDB(B1, 1, 1); PG8_SCHED; PG8_LDA(At, 1, 0); PG8_STAGE(PG8_SA(0, 1), a2 + hstep, voffA);
            PG8_WAIT_V(8); PG8_WAIT_L(0); PG8_BAR; PG8_MMA(0, 0, At, B0); PG8_MMA(0, 1, At, B1); PG8_BAR; PG8_SCHED;
            PG8_LDA(At, 1, 1); PG8_STAGE(PG8_SB(1, 0), b3, voffB); PG8_STAGE(PG8_SB(1, 1), b3 + hstep, voffB); PG8_STAGE(PG8_SA(1, 0), a3, voffA);
            PG8_WAIT_V(8); PG8_WAIT_L(0); PG8_BAR; PG8_MMA(1, 0, At, B0); PG8_MMA(1, 1, At, B1); PG8_BAR; PG8_SCHED;
            } else {
            PG8_LDB(B0, 0, 0); PG8_SCHED; PG8_LDA(At, 0, 0); PG8_STAGE(PG8_SA(1, 1), a1 + hstep, voffA);
            PG8_WAIT_L(8); PG8_BAR; PG8_WAIT_L(0); PG8_MMA(0, 0, At, B0); PG8_BAR; PG8_SCHED;
            PG8_LDB(B1, 0, 1); PG8_STAGE(PG8_SB(0, 0), b2, voffB);
            PG8_BAR; PG8_WAIT_L(0); PG8_MMA(0, 1, At, B1); PG8_BAR;
            PG8_LDA(At, 0, 1); PG8_STAGE(PG8_SA(0, 0), a2, voffA);
            PG8_BAR; PG8_WAIT_L(0); PG8_MMA(1, 0, At, B0); PG8_BAR; PG8_SCHED;
            PG8_STAGE(PG8_SB(0, 1), b2 + hstep, voffB);
            PG8_WAIT_V(6); PG8_BAR; PG8_MMA(1, 1, At, B1); PG8_BAR;
            PG8_LDB(B0, 1, 0); PG8_SCHED; PG8_LDA(At, 1, 0); PG8_STAGE(PG8_SA(0, 1), a2 + hstep, voffA);
            PG8_WAIT_L(8); PG8_BAR; PG8_WAIT_L(0); PG8_MMA(0, 0, At, B0); PG8_BAR; PG8_SCHED;
            PG8_LDB(B1, 1, 1); PG8_STAGE(PG8_SB(1, 0), b3, voffB);
            PG8_BAR; PG8_WAIT_L(0); PG8_MMA(0, 1, At, B1); PG8_BAR;
            PG8_LDA(At, 1, 1); PG8_STAGE(PG8_SA(1, 0), a3, voffA);
            PG8_BAR; PG8_WAIT_L(0); PG8_MMA(1, 0, At, B0); PG8_BAR; PG8_SCHED;
            PG8_STAGE(PG8_SB(1, 1), b3 + hstep, voffB);
            PG8_WAIT_V(6); PG8_BAR; PG8_MMA(1, 1, At, B1); PG8_BAR;
            }
        }
        if constexpr (ALIGN_EPI) { if (wr == 0) PG8_BAR; }
        if constexpr (!Epi::AFTER_DRAIN) { E(acc, cur, wr, wc, fr, fq); S.done(cur); }
        if (!has_next) break;
#pragma unroll
        for (int a = 0; a < 2; ++a)
#pragma unroll
            for (int b = 0; b < 2; ++b)
#pragma unroll
                for (int m = 0; m < 4; ++m)
#pragma unroll
                    for (int n = 0; n < 2; ++n) acc[a][b][m][n] = (f32x4){0.f, 0.f, 0.f, 0.f};
        cur = nxt; cA = nA; cB = nB; ++ui;
        if constexpr (ALIGN_EPI) { if (wr == 1) PG8_BAR; }
    }
    PG8_WAIT_V(0);
    if constexpr (!ALIGN_EPI) { if (wr == 0) PG8_BAR; }
    PG8_BAR;
    if constexpr (Epi::AFTER_DRAIN) { E.fused(acc, cur, wr, wc, fr, fq, lds, wid, lane); S.done(cur); }
#undef PG8_SA
#undef PG8_SB
#undef PG8_STAGE
#undef PG8_LDA
#undef PG8_LDB
#undef PG8_MMA
#undef PG8_WAIT_V
#undef PG8_WAIT_L
#undef PG8_BAR
#undef PG8_SCHED
}
}

namespace moba {
constexpr float SCALE = 0.08838834764831845f;
constexpr int NW = 8, QBLK = 32, KVBLK = 64, QB = NW * QBLK, D = 128;
struct CfgMoba { static constexpr int LDQ = 7232, LDK = 7232, LDO = 2048; static constexpr bool MOBA = true; };
struct CfgX { static constexpr int LDQ = 512, LDK = 1024, LDO = 512; static constexpr bool MOBA = false; };
constexpr int SHM_V = KVBLK * D * 2, SHM_K = KVBLK * D * 2;
constexpr int OFF_WS = 2 * SHM_V + 2 * SHM_K, OFF_BT = OFF_WS + NW * 64 * 4;
constexpr int OFF_KM = OFF_BT + 1024;
constexpr int OFF_Q = OFF_KM + 8192;
constexpr int LDS_BYTES = OFF_Q + NW * 8192;
constexpr float THR = 8.f;
constexpr float LOG2E = 1.4426950408889634f, QSCALE = LOG2E * SCALE, THR2 = THR * LOG2E;
typedef short bf16x8 __attribute__((ext_vector_type(8)));
typedef short s16x4 __attribute__((ext_vector_type(4)));
typedef float f32x16 __attribute__((ext_vector_type(16)));
typedef float f32x4 __attribute__((ext_vector_type(4)));
typedef unsigned u32x4 __attribute__((ext_vector_type(4)));
typedef unsigned short bf16;

#define KSWZ(row, colB) ((row) * 256 + ((colB) ^ (((row) & 7) << 4)))
#define SBAR() __builtin_amdgcn_sched_barrier(0)
__device__ __forceinline__ int v_st(int k, int c) { const int kk = (k & ~0xC) | ((k & 4) << 1) | ((k & 8) >> 1); return ((kk >> 3) * 4 + (c >> 5)) * 512 + ((kk & 7) * 32 + (c & 31)) * 2; }
__device__ __forceinline__ int v_rd_base(int lane) { return ((lane & 3) << 3) | (((lane >> 2) & 3) << 6) | (((lane >> 4) & 1) << 5) | (((lane >> 5) & 1) << 8); }
constexpr int v_rd_off(int d0, int ks, int half) { return d0 * 512 + ks * 4096 + half * 2048; }
__device__ __forceinline__ int crow(int r, int hi) { return (r & 3) + 8 * (r >> 2) + 4 * hi; }
__device__ __forceinline__ unsigned cvtpk(float lo, float hi) { unsigned r; asm volatile("v_cvt_pk_bf16_f32 %0, %1, %2" : "=v"(r) : "v"(lo), "v"(hi)); return r; }
__device__ __forceinline__ bf16x8 load8(const bf16* p) { return *reinterpret_cast<const bf16x8*>(p); }
__device__ __forceinline__ void mask_tile(f32x16& p0, f32x16& p1, int dq) {
    const float NEG = -__builtin_inff();
#pragma unroll
    for (int r = 0; r < 16; ++r) { const int c = (r & 3) + 8 * (r >> 2); if (dq - c < 0) p0[r] = NEG; if (dq - c - 32 < 0) p1[r] = NEG; }
}
__device__ __forceinline__ void bias_tile(f32x16& p0, f32x16& p1, int dq, const float* bt) {
#pragma unroll
    for (int r = 0; r < 16; ++r) { const int c = (r & 3) + 8 * (r >> 2); int n0 = dq - c, n1 = dq - c - 32; n0 = n0 < 0 ? 0 : n0; n1 = n1 < 0 ? 0 : n1; p0[r] += bt[n0]; p1[r] += bt[n1]; }
}
__device__ __forceinline__ void sel_tile(f32x16& p0, f32x16& p1, bool sel) {
    const float NEG = -__builtin_inff();
#pragma unroll
    for (int r = 0; r < 16; ++r) { p0[r] = sel ? p0[r] : NEG; p1[r] = sel ? p1[r] : NEG; }
}
template <bool FIRST>
__device__ __forceinline__ void partialSM(f32x16& p0, f32x16& p1, float& m_reg, float& alpha) {
    float pmax = p0[0]; for (int r = 1; r < 16; ++r) pmax = fmaxf(pmax, p0[r]); for (int r = 0; r < 16; ++r) pmax = fmaxf(pmax, p1[r]);
    { auto rr = __builtin_amdgcn_permlane32_swap(__float_as_uint(pmax), __float_as_uint(pmax), false, false);
      pmax = fmaxf(__uint_as_float(rr[0]), __uint_as_float(rr[1])); }
    if (!FIRST && __builtin_expect(__all(pmax <= THR2), 1)) { alpha = 1.f; }
    else { const float d = FIRST ? (pmax > -3.0e38f ? pmax : 0.f) : fmaxf(pmax, 0.f);
        alpha = __builtin_amdgcn_exp2f(-d); m_reg += d;
        for (int r = 0; r < 16; ++r) { p0[r] -= d; p1[r] -= d; } }
    for (int r = 0; r < 16; ++r) p0[r] = __builtin_amdgcn_exp2f(p0[r]);
}
__device__ __forceinline__ void finishSM(f32x16& p0, f32x16& p1, float alpha, float& l_reg, bf16x8& pa0, bf16x8& pa1, bf16x8& pa2, bf16x8& pa3) {
    for (int r = 0; r < 16; ++r) p1[r] = __builtin_amdgcn_exp2f(p1[r]);
    float ps;
    { typedef float f32x8_ __attribute__((ext_vector_type(8))); typedef float f32x2_ __attribute__((ext_vector_type(2)));
      const f32x16 t = p0 + p1; const f32x8_ a = __builtin_shufflevector(t, t, 0, 1, 2, 3, 4, 5, 6, 7) + __builtin_shufflevector(t, t, 8, 9, 10, 11, 12, 13, 14, 15);
      const f32x4 b = __builtin_shufflevector(a, a, 0, 1, 2, 3) + __builtin_shufflevector(a, a, 4, 5, 6, 7); const f32x2_ c = __builtin_shufflevector(b, b, 0, 1) + __builtin_shufflevector(b, b, 2, 3); ps = c.x + c.y; }
    { auto rr = __builtin_amdgcn_permlane32_swap(__float_as_uint(ps), __float_as_uint(ps), false, false);
      ps = __uint_as_float(rr[0]) + __uint_as_float(rr[1]); }
    l_reg = l_reg * alpha + ps;
#define PK4(P, B_, OUT) do { unsigned a0 = cvtpk(P[B_+0], P[B_+1]), a1 = cvtpk(P[B_+2], P[B_+3]);                          \
        unsigned b0 = cvtpk(P[B_+4], P[B_+5]), b1 = cvtpk(P[B_+6], P[B_+7]);                                             \
        auto r0 = __builtin_amdgcn_permlane32_swap(a0, b0, false, false); auto r1 = __builtin_amdgcn_permlane32_swap(a1, b1, false, false); \
        u32x4 w = {r0[0], r1[0], r0[1], r1[1]}; OUT = *reinterpret_cast<bf16x8*>(&w); } while (0)
    PK4(p0, 0, pa0); PK4(p0, 8, pa1); PK4(p1, 0, pa2); PK4(p1, 8, pa3);
#undef PK4
}
template <int KB>
__device__ __forceinline__ void qkt(f32x16& p0, f32x16& p1, const char* K_lds, int r32, int hi, const char* qf, float init) {
#pragma unroll
    for (int r = 0; r < 16; ++r) { p0[r] = init; p1[r] = init; }
    const char* kb[4];
#pragma unroll
    for (int dd = 0; dd < 4; ++dd) kb[dd] = K_lds + KB * SHM_K + KSWZ(r32, (dd * 16 + hi * 8) * 2);
#pragma unroll
    for (int d0 = 0; d0 < 8; ++d0) { const char* a = kb[d0 & 3] + (d0 >> 2) * 128;
        bf16x8 b0 = *reinterpret_cast<const bf16x8*>(a);
        bf16x8 b1 = *reinterpret_cast<const bf16x8*>(a + 32 * 256);
        const bf16x8 qv = *reinterpret_cast<const bf16x8*>(qf + d0 * 1024);
        p0 = __builtin_amdgcn_mfma_f32_32x32x16_bf16(b0, qv, p0, 0, 0, 0);
        p1 = __builtin_amdgcn_mfma_f32_32x32x16_bf16(b1, qv, p1, 0, 0, 0); }
}
template <int VB>
__device__ __forceinline__ void pv_tile(f32x16* o, int vb0, bf16x8 pa0, bf16x8 pa1, bf16x8 pa2, bf16x8 pa3) {
#define TRRD(dst, off) asm volatile("ds_read_b64_tr_b16 %0, %1 offset:%2" : "=&v"(dst) : "v"(vb0), "i"(off) : "memory")
#define PV_D0(d0) do { s16x4 l0, l1, l2, l3, h0, h1, h2, h3; constexpr int b_ = VB * SHM_V + v_rd_off(d0, 0, 0); \
        TRRD(l0, b_); TRRD(h0, b_ + 2048); TRRD(l1, b_ + 4096); TRRD(h1, b_ + 6144); TRRD(l2, b_ + 8192); TRRD(h2, b_ + 10240); TRRD(l3, b_ + 12288); TRRD(h3, b_ + 14336); \
        asm volatile("s_waitcnt lgkmcnt(0)" ::: "memory"); SBAR();   \
        o[d0] = __builtin_amdgcn_mfma_f32_32x32x16_bf16(pa0, (bf16x8){l0[0], l0[1], l0[2], l0[3], h0[0], h0[1], h0[2], h0[3]}, o[d0], 0, 0, 0);   \
        o[d0] = __builtin_amdgcn_mfma_f32_32x32x16_bf16(pa1, (bf16x8){l1[0], l1[1], l1[2], l1[3], h1[0], h1[1], h1[2], h1[3]}, o[d0], 0, 0, 0);   \
        o[d0] = __builtin_amdgcn_mfma_f32_32x32x16_bf16(pa2, (bf16x8){l2[0], l2[1], l2[2], l2[3], h2[0], h2[1], h2[2], h2[3]}, o[d0], 0, 0, 0);   \
        o[d0] = __builtin_amdgcn_mfma_f32_32x32x16_bf16(pa3, (bf16x8){l3[0], l3[1], l3[2], l3[3], h3[0], h3[1], h3[2], h3[3]}, o[d0], 0, 0, 0); } while (0)
    PV_D0(0); PV_D0(1); PV_D0(2); PV_D0(3);
#undef PV_D0
#undef TRRD
}
struct Head { const bf16* Q0; const bf16* K0; const bf16* V0; bf16* O0; const float* km; };
struct Seam { bf16x8 st_v0, st_v1, st_k0, st_k1; };
#define VMW() asm volatile("s_waitcnt vmcnt(0)" ::: "memory")
#define VMWN(n) asm volatile("s_waitcnt vmcnt(%0)" :: "i"(n) : "memory")
#define SLOAD_H(Kp, Vp, k0) do { const bf16* k_ = (Kp) + (size_t)(k0) * Cfg::LDK; const bf16* v_ = (Vp) + (size_t)(k0) * Cfg::LDK; unsigned vo_ = voff; asm volatile("" : "+v"(vo_));     \
                         S.st_v0 = load8(v_ + vo_); S.st_v1 = load8(v_ + 32 * Cfg::LDK + vo_);                                       \
                         S.st_k0 = load8(k_ + vo_); S.st_k1 = load8(k_ + 32 * Cfg::LDK + vo_); } while (0)
#define SWRITE_HK(bf) do { *(bf16x8*)(K_lds + (bf) * SHM_K + kws) = S.st_k0; *(bf16x8*)(K_lds + (bf) * SHM_K + kws + 32 * 256) = S.st_k1; } while (0)
#define SWRITE_HV(bf) do { *(bf16x8*)(V_lds + (bf) * SHM_V + vst0) = S.st_v0; *(bf16x8*)(V_lds + (bf) * SHM_V + vst1) = S.st_v1; } while (0)
#define SWRITE_H(bf) do { SWRITE_HV(bf); SWRITE_HK(bf); } while (0)
template <class Cfg>
__device__ __forceinline__ void prime(const Head& H, int P0, char* lds, Seam& S, const int tid, const int wid) {
    const int lane = tid & 63, r32 = lane & 31, hi = lane >> 5;
    const int sr = tid >> 4, sc = (tid & 15) * 8, kws = KSWZ(sr, sc * 2); char* K_lds = lds + 2 * SHM_V; const unsigned voff = (unsigned)(sr * Cfg::LDK + sc);
    SLOAD_H(H.K0, H.V0, 0);
    { const bf16* qb = H.Q0 + (size_t)(P0 + wid * QBLK) * Cfg::LDQ; const unsigned qoff = (unsigned)(r32 * Cfg::LDQ + hi * 8); char* qf = lds + OFF_Q + wid * 8192 + lane * 16;
      bf16x8 tq[8];
#pragma unroll
      for (int d0 = 0; d0 < 8; ++d0) tq[d0] = load8(qb + qoff + d0 * 16);
      VMW();
#pragma unroll
      for (int d0 = 0; d0 < 8; ++d0) *(bf16x8*)(qf + d0 * 1024) = tq[d0]; }
    SWRITE_HK(0);
    __syncthreads();
}
template <class Cfg>
__device__ __forceinline__ void block(const Head& H, int P0, int P0n, const float* rel_bias, int h, const float* gn, char* lds, Seam& S, const int tid_in, const int wid) {
    int tid = tid_in; asm volatile("" : "+v"(tid));
    const int lane = tid & 63, r32 = lane & 31, hi = lane >> 5;
    const int own = Cfg::MOBA ? (P0 >> 8) : 0;
    const int NT = Cfg::MOBA ? (P0 + QB) / KVBLK : 4;
    const int qlo = P0 + wid * QBLK, qm = qlo + r32 - 4 * hi;
    char* V_lds = lds; char* K_lds = lds + 2 * SHM_V;
    float* ws = (float*)(lds + OFF_WS) + wid * 64; float* li_l = ws, * al_l = ws + 32;
    float* bt = (float*)(lds + OFF_BT);
    char* qf = lds + OFF_Q + wid * 8192 + lane * 16;
    float m_reg = 0.f, l_reg = 0; f32x16 o[4] = {};
    const int sr = tid >> 4, sc = (tid & 15) * 8, vst0 = v_st(sr, sc), vst1 = v_st(32 + sr, sc), kws = KSWZ(sr, sc * 2); const unsigned voff = (unsigned)(sr * Cfg::LDK + sc);
    const int vb0 = (int)(uintptr_t)V_lds + v_rd_base(lane);
    const bf16* Kh = H.K0; const bf16* Vh = H.V0;
    const float b31 = Cfg::MOBA ? rel_bias[31 * 8 + h] : 0.f; const float cinit = b31 * LOG2E;
    if (Cfg::MOBA && tid < 256) { int bk = 31; if (tid < 16) bk = tid; else if (tid < 128) { const int l = 16 + (int)(logf((float)tid * 0.0625f) * 7.694155931f); bk = l < 31 ? l : 31; }
        bt[tid] = (rel_bias[bk * 8 + h] - b31) * LOG2E; }
    if (own >= 4 && tid < 128) { int t_ = tid; asm volatile("" : "+v"(t_));
        const int n = t_ >> 4, c = t_ & 15; const float* kp = H.km + (unsigned)(n * 1024 + c * 8); const f32x4 k0 = *(const f32x4*)kp, k1 = *(const f32x4*)(kp + 4);
        u32x4 w = {cvtpk(k0[0], k0[1]), cvtpk(k0[2], k0[3]), cvtpk(k1[0], k1[1]), cvtpk(k1[2], k1[3])}; *(u32x4*)(lds + OFF_KM + KSWZ(n, c * 16)) = w; }
    int mask = 0;
#define RESC(a) do { if (__any((a) < 1.f)) { if (hi == 0) al_l[r32] = (a); asm volatile("s_waitcnt lgkmcnt(0)" ::: "memory");              \
                     for (int d_ = 0; d_ < 4; ++d_) for (int r = 0; r < 16; ++r) o[d_][r] *= al_l[crow(r, hi)]; } } while (0)
#define KBASE(t) ((t) * KVBLK)
#define MASKT(P0_, P1_, t, SEL0) do { if (Cfg::MOBA) { const int kb_ = KBASE(t); \
        if (qlo - kb_ < 176) bias_tile(P0_, P1_, qm - kb_, bt); \
        if (SEL0 && own >= 4 && kb_ < P0) sel_tile(P0_, P1_, ((mask >> (kb_ >> 8)) & 1) != 0); \
        if (kb_ + KVBLK - 1 > qlo) mask_tile(P0_, P1_, qm - kb_); } } while (0)
#define AINIT(t) ((Cfg::MOBA && own >= 4 && KBASE(t) < P0 && (((mask >> (KBASE(t) >> 8)) & 1) == 0)) ? -__builtin_inff() : cinit - m_reg)
    constexpr int NQL = 8;
#define SEAM_K0() do { VMWN(NQL); SWRITE_HK(0); SBAR(); } while (0)
    f32x16 pA0, pA1, pB0, pB1; float alA, alB; bf16x8 pa0, pa1, pa2, pa3;
    SWRITE_HV(0); SBAR();
    if (NT > 1) { SLOAD_H(Kh, Vh, KBASE(1)); }
    SBAR(); qkt<0>(pA0, pA1, K_lds, r32, hi, qf, cinit);
    __syncthreads();
    if (own >= 4) {
        f32x16 gacc = {};
        const char* kmb[4];
#pragma unroll
        for (int dd = 0; dd < 4; ++dd) kmb[dd] = lds + OFF_KM + KSWZ(r32, (dd * 16 + hi * 8) * 2);
#pragma unroll
        for (int d0 = 0; d0 < 8; ++d0) { const bf16x8 b0 = *reinterpret_cast<const bf16x8*>(kmb[d0 & 3] + (d0 >> 2) * 128); gacc = __builtin_amdgcn_mfma_f32_32x32x16_bf16(b0, *reinterpret_cast<const bf16x8*>(qf + d0 * 1024), gacc, 0, 0, 0); }
        float g[8];
#pragma unroll
        for (int i = 0; i < 4; ++i) { const float mine = gacc[i], oth = __shfl_xor(mine, 32); g[i] = hi ? oth : mine; g[4 + i] = hi ? mine : oth; }
#pragma unroll
        for (int n = 0; n < 7; ++n) { int cnt = 0;
#pragma unroll
            for (int m = 0; m < 7; ++m) cnt += (m != n && m < own && (g[m] > g[n] || (g[m] == g[n] && m < n))) ? 1 : 0;
            mask |= (n < own && cnt < 3) ? (1 << n) : 0; }
    }
    MASKT(pA0, pA1, 0, true); partialSM<true>(pA0, pA1, m_reg, alA);
    if (NT > 1) { VMW(); SWRITE_HK(1); }
    __syncthreads();
#define HALF_STEP(PX0, PX1, alX, PY0, PY1, alY, t, KB, VB, SB) do {                                                      \
        SWRITE_HV(KB); SBAR();                                                                                                \
        if ((t) + 1 < NT) { SLOAD_H(Kh, Vh, KBASE((t) + 1)); SBAR(); }                                               \
        SBAR(); qkt<KB>(PX0, PX1, K_lds, r32, hi, qf, AINIT(t));                                          \
        finishSM(PY0, PY1, alY, l_reg, pa0, pa1, pa2, pa3); SBAR();                                                           \
        pv_tile<VB>(o, vb0, pa0, pa1, pa2, pa3); MASKT(PX0, PX1, (t), false); partialSM<false>(PX0, PX1, m_reg, alX);                                        \
        if ((t) + 1 < NT) { VMW(); SWRITE_HK(SB); }                                                                         \
        RESC(alX); __syncthreads(); } while (0)
    for (int t = 1; t + 1 < NT; t += 2) {
        HALF_STEP(pB0, pB1, alB, pA0, pA1, alA, t, 1, 0, 0);
        HALF_STEP(pA0, pA1, alA, pB0, pB1, alB, t + 1, 0, 1, 1);
    }
    SWRITE_HV(1); SBAR();
    { SBAR(); qkt<1>(pB0, pB1, K_lds, r32, hi, qf, AINIT(NT - 1)); SBAR(); }
    SLOAD_H(Kh, Vh, 0); SBAR();
    bf16x8 tq[8];
    { const bf16* qb = H.Q0 + (size_t)(P0n + wid * QBLK) * Cfg::LDQ; unsigned qoff = (unsigned)(r32 * Cfg::LDQ + hi * 8); asm volatile("" : "+v"(qoff));
#pragma unroll
      for (int d0 = 0; d0 < 8; ++d0) tq[d0] = load8(qb + qoff + d0 * 16); }
    SBAR();
    finishSM(pA0, pA1, alA, l_reg, pa0, pa1, pa2, pa3); SBAR();
    pv_tile<0>(o, vb0, pa0, pa1, pa2, pa3);
    { MASKT(pB0, pB1, NT - 1, false); partialSM<false>(pB0, pB1, m_reg, alB); __syncthreads(); RESC(alB);
      finishSM(pB0, pB1, alB, l_reg, pa0, pa1, pa2, pa3); SBAR(); pv_tile<1>(o, vb0, pa0, pa1, pa2, pa3); }
    SBAR(); SEAM_K0();
    if (hi == 0) li_l[r32] = l_reg; asm volatile("s_waitcnt lgkmcnt(0)" ::: "memory");
    float gnr[4];
    { unsigned go_ = (unsigned)r32; asm volatile("" : "+v"(go_));
#pragma unroll
      for (int d0 = 0; d0 < 4; ++d0) gnr[d0] = Cfg::MOBA ? (gn + go_)[d0 * 32] : 1.0f; }
    bf16* Ow = H.O0 + (size_t)(P0 + wid * QBLK) * Cfg::LDO;
#pragma unroll
    for (int r = 0; r < 16; ++r) { int orow = crow(r, hi); asm volatile("" : "+v"(orow));
        const float rl = __builtin_amdgcn_rcpf(li_l[orow]);
        float v0 = o[0][r] * rl, v1 = o[1][r] * rl, v2 = o[2][r] * rl, v3 = o[3][r] * rl;
        float ss = (v0 * v0 + v1 * v1) + (v2 * v2 + v3 * v3);
        ss += __shfl_xor(ss, 1); ss += __shfl_xor(ss, 2); ss += __shfl_xor(ss, 4); ss += __shfl_xor(ss, 8); ss += __shfl_xor(ss, 16);
        if (Cfg::MOBA) { const float rs = rsqrtf(ss * (1.0f / 128.0f) + 1e-6f); v0 *= rs * gnr[0]; v1 *= rs * gnr[1]; v2 *= rs * gnr[2]; v3 *= rs * gnr[3]; }
        const float n0 = __shfl_xor(v0, 1), n1 = __shfl_xor(v1, 1), n2 = __shfl_xor(v2, 1), n3 = __shfl_xor(v3, 1);
        if ((r32 & 1) == 0) { bf16* op = Ow + (unsigned)(orow * Cfg::LDO + r32);
            *(unsigned*)(op) = cvtpk(v0, n0); *(unsigned*)(op + 32) = cvtpk(v1, n1); *(unsigned*)(op + 64) = cvtpk(v2, n2); *(unsigned*)(op + 96) = cvtpk(v3, n3); } }
    VMW();
#pragma unroll
    for (int d0 = 0; d0 < 8; ++d0) *(bf16x8*)(qf + d0 * 1024) = tq[d0];
    __syncthreads();
#undef RESC
#undef KBASE
#undef MASKT
#undef AINIT
#undef SEAM_K0
#undef HALF_STEP
}
#undef ROW
#undef VMW
#undef VMWN
#undef SLOAD_H
#undef SWRITE_HK
#undef SWRITE_HV
#undef SWRITE_H
#undef KSWZ
#undef SBAR
}

namespace gdn {
typedef short bf16x8 __attribute__((ext_vector_type(8)));
typedef float f32x16 __attribute__((ext_vector_type(16)));
typedef float f32x4 __attribute__((ext_vector_type(4)));
typedef unsigned u32x4 __attribute__((ext_vector_type(4)));
typedef unsigned u32x2 __attribute__((ext_vector_type(2)));
typedef _Float16 f16x4 __attribute__((ext_vector_type(4)));
typedef _Float16 f16x8 __attribute__((ext_vector_type(8)));
#define GLAS __attribute__((address_space(3)))
constexpr int IMG_BYTES = 75776, IMG_W = 0, IMG_U = 16384, IMG_QD = 32768, IMG_KDT = 49152, IMG_QK = 65536, IMG_GL = 73728;
constexpr int IMG_IN_OUT = 1771;
__device__ __forceinline__ int sw256(int row, int cb) { return row * 256 + (cb ^ ((row & 15) << 4)); }
__device__ __forceinline__ int sw128(int row, int cb) { return row * 128 + (cb ^ (((row >> 1) & 7) << 4)); }
__device__ __forceinline__ unsigned cvtpk(float lo, float hi) { unsigned r; asm volatile("v_cvt_pk_bf16_f32 %0, %1, %2" : "=v"(r) : "v"(lo), "v"(hi)); return r; }
__device__ __forceinline__ float bfl(unsigned w) { return __uint_as_float(w << 16); }
__device__ __forceinline__ float bfh(unsigned w) { return __uint_as_float(w & 0xffff0000u); }
__device__ __forceinline__ unsigned char* img_ptr(unsigned char* out_bytes, unsigned char* ws_img, int chunk) {
    return chunk < IMG_IN_OUT ? out_bytes + (size_t)chunk * IMG_BYTES : ws_img + (size_t)(chunk - IMG_IN_OUT) * IMG_BYTES;
}
#define LBAR() asm volatile("s_waitcnt lgkmcnt(0)\n\ts_barrier" ::: "memory")
#define MFMA32(a, b, c) __builtin_amdgcn_mfma_f32_32x32x16_bf16((a), (b), (c), 0, 0, 0)

constexpr int RAWP = 784;
__device__ __forceinline__ void conv16(float (&a)[16], const GLAS unsigned char* rp, const GLAS float* wl) {
    typedef float f32x2 __attribute__((ext_vector_type(2)));
    f32x2 acc[8];
#pragma unroll
    for (int p = 0; p < 8; ++p) acc[p] = (f32x2){0.f, 0.f};
#pragma unroll
    for (int j = 0; j < 4; ++j) { const u32x4 x0 = *(const GLAS u32x4*)(rp + j * RAWP), x1 = *(const GLAS u32x4*)(rp + j * RAWP + 16);
        const GLAS f32x2* wv = (const GLAS f32x2*)(wl + j * 384);
        const unsigned xw[8] = {x0.x, x0.y, x0.z, x0.w, x1.x, x1.y, x1.z, x1.w};
#pragma unroll
        for (int p = 0; p < 8; ++p) { const f32x2 xv = {bfl(xw[p]), bfh(xw[p])}; acc[p] = __builtin_elementwise_fma(wv[p], xv, acc[p]); }
        __builtin_amdgcn_sched_barrier(0); }
#pragma unroll
    for (int p = 0; p < 8; ++p) { a[2 * p] = acc[p].x; a[2 * p + 1] = acc[p].y; }
#pragma unroll
    for (int e = 0; e < 16; ++e) a[e] = a[e] * __builtin_amdgcn_rcpf(1.0f + __expf(-a[e]));
}
__device__ __forceinline__ void raw_load(u32x4 (&rg)[7], const unsigned short* proj, int b, int h, int n, int tid) {
#pragma unroll
    for (int kq = 0; kq < 7; ++kq) { int p = tid + 512 * kq; p = p < 3216 ? p : 3215; const int r = p / 48, q = p - r * 48, pos = n * 64 - 3 + r, posc = pos < 0 ? 0 : pos;
        const u32x4 v = __builtin_nontemporal_load((const u32x4*)(proj + ((size_t)b * 2048 + posc) * 7232 + (q >> 4) * 1024 + h * 128 + (q & 15) * 8));
        rg[kq] = pos < 0 ? (u32x4){0u, 0u, 0u, 0u} : v; }
}
__device__ __forceinline__ void raw_store(const u32x4 (&rg)[7], GLAS unsigned char* raw, int tid) {
#pragma unroll
    for (int kq = 0; kq < 7; ++kq) { const int p = tid + 512 * kq; const int r = p / 48, q = p - r * 48; if (p < 3216) *(GLAS u32x4*)(raw + r * RAWP + q * 16) = rg[kq]; }
}
typedef _Float16 f16x2 __attribute__((ext_vector_type(2)));
template <int I, int K8> __device__ __forceinline__ void inv_k8(float& acc, float& acc1, const float (&tc)[64], const f16x2 (&tn)[32], const GLAS unsigned char* slot) {
    if constexpr (K8 * 8 < I) { const f16x8 av = *(const GLAS f16x8*)(slot + I * 128 + K8 * 16);
#pragma unroll
        for (int p = 0; p < 4; ++p) { const int k = K8 * 8 + 2 * p;
            if (k + 1 < I) { if (p & 1) acc1 = __builtin_amdgcn_fdot2((f16x2){av[2 * p], av[2 * p + 1]}, tn[k >> 1], acc1, false); else acc = __builtin_amdgcn_fdot2((f16x2){av[2 * p], av[2 * p + 1]}, tn[k >> 1], acc, false); }
            else if (k < I) acc1 -= (float)av[2 * p] * tc[k]; }
        inv_k8<I, K8 + 1>(acc, acc1, tc, tn, slot); }
}
template <int I> __device__ __forceinline__ void inv_row(float (&tc)[64], f16x2 (&tn)[32], const GLAS unsigned char* slot, int lane) {
    if constexpr (I < 64) { float acc = (I == lane) ? 1.0f : 0.0f, acc1 = 0.f; inv_k8<I, 0>(acc, acc1, tc, tn, slot); acc += acc1; tc[I] = acc;
        if constexpr (I & 1) tn[I >> 1] = (f16x2){(_Float16)(-tc[I - 1]), (_Float16)(-acc)};
        __builtin_amdgcn_sched_barrier(0);
        inv_row<I + 1>(tc, tn, slot, lane); }
}
__device__ __forceinline__ void prep(GLAS unsigned char* L, int tid, int lane, int wave, int wg, const unsigned short* proj, const float* beta, const float* gg, const float* conv_w,
                                     unsigned char* out_bytes, unsigned char* ws_img, unsigned char* scr) {
    const int r32 = lane & 31, hi = lane >> 5;
    const int bh = wg & 63, b = bh >> 3, h = bh & 7, cg0 = (wg >> 6) * 8;
    GLAS unsigned char* Kt = L; GLAS unsigned char* Qt = L + 16384; GLAS unsigned char* Vt = L + 32768;
    GLAS unsigned char* raw = L;
    GLAS float* Gs = (GLAS float*)(L + 53248); GLAS float* Bs = Gs + 64; GLAS float* gls = Gs + 128; GLAS float* cwL = Gs + 192;
    GLAS float* eRs = Gs + 192 + 1536; GLAS float* bgs = eRs + 64;
    GLAS unsigned char* As = L + 61440;
    for (int i = tid; i < 1536; i += 512) { const int j = i / 384, rem = i - j * 384; cwL[i] = conv_w[j * 3072 + (rem >> 7) * 1024 + h * 128 + (rem & 127)]; }
    u32x4 rg[7];
    raw_load(rg, proj, b, h, cg0, tid);
    float gpf = gg[((size_t)b * 2048 + cg0 * 64 + lane) * 8 + h], bpf = beta[((size_t)b * 2048 + cg0 * 64 + (tid >> 3)) * 8 + h];
    __syncthreads();
#pragma unroll 1
    for (int c = 0; c < 8; ++c) {
        int tt_ = tid; asm volatile("" : "+v"(tt_));
        const int t = tt_ >> 3, seg = tt_ & 7;
        const int n = cg0 + c, chunk = bh * 32 + n, pos = n * 64 + t; const size_t row = (size_t)b * 2048 + pos;
        unsigned char* img = img_ptr(out_bytes, ws_img, chunk);
        unsigned short* vbt = (unsigned short*)(scr + (size_t)chunk * 32768); unsigned short* kgt = vbt + 8192;
        raw_store(rg, raw, tid);
        if (wave == 0) { float g = gpf;
#pragma unroll
            for (int o = 1; o < 64; o <<= 1) { const float y = __shfl_up(g, o); if (lane >= o) g += y; }
            Gs[lane] = g; if (lane == 63) gls[c] = g; }
        if (seg == 0) Bs[t] = bpf;
        LBAR();
        const float G = Gs[t], GL = Gs[63], eG = __expf(G), eR = __expf(GL - G), bt = Bs[t], bg = bt * eG;
        float xq[16], xk[16], xv[16];
        { const GLAS unsigned char* rp = raw + t * RAWP + seg * 32;
          conv16(xq, rp, cwL + seg * 16); conv16(xk, rp + 256, cwL + 128 + seg * 16); conv16(xv, rp + 512, cwL + 256 + seg * 16); }
        { float sq = 0.f, sk = 0.f;
#pragma unroll
          for (int e = 0; e < 16; ++e) { sq += xq[e] * xq[e]; sk += xk[e] * xk[e]; }
          sq += __shfl_xor(sq, 1); sq += __shfl_xor(sq, 2); sq += __shfl_xor(sq, 4); sk += __shfl_xor(sk, 1); sk += __shfl_xor(sk, 2); sk += __shfl_xor(sk, 4);
          const float nq = rsqrtf(sq + 1e-6f) * 0.08838834764831845f, nk = rsqrtf(sk + 1e-6f);
#pragma unroll
          for (int e = 0; e < 16; ++e) { xq[e] *= nq; xk[e] *= nk; xv[e] *= bt; } }
        LBAR();
        { u32x4 w0, w1;
          w0 = (u32x4){cvtpk(xv[0], xv[1]), cvtpk(xv[2], xv[3]), cvtpk(xv[4], xv[5]), cvtpk(xv[6], xv[7])}; w1 = (u32x4){cvtpk(xv[8], xv[9]), cvtpk(xv[10], xv[11]), cvtpk(xv[12], xv[13]), cvtpk(xv[14], xv[15])};
          *(GLAS u32x4*)(Vt + sw256(t, seg * 32)) = w0; *(GLAS u32x4*)(Vt + sw256(t, seg * 32 + 16)) = w1;
          w0 = (u32x4){cvtpk(xk[0], xk[1]), cvtpk(xk[2], xk[3]), cvtpk(xk[4], xk[5]), cvtpk(xk[6], xk[7])}; w1 = (u32x4){cvtpk(xk[8], xk[9]), cvtpk(xk[10], xk[11]), cvtpk(xk[12], xk[13]), cvtpk(xk[14], xk[15])};
          *(GLAS u32x4*)(Kt + sw256(t, seg * 32)) = w0; *(GLAS u32x4*)(Kt + sw256(t, seg * 32 + 16)) = w1;
          w0 = (u32x4){cvtpk(xq[0], xq[1]), cvtpk(xq[2], xq[3]), cvtpk(xq[4], xq[5]), cvtpk(xq[6], xq[7])}; w1 = (u32x4){cvtpk(xq[8], xq[9]), cvtpk(xq[10], xq[11]), cvtpk(xq[12], xq[13]), cvtpk(xq[14], xq[15])};
          *(GLAS u32x4*)(Qt + sw256(t, seg * 32)) = w0; *(GLAS u32x4*)(Qt + sw256(t, seg * 32 + 16)) = w1;
          w0 = (u32x4){cvtpk(xq[0] * eG, xq[1] * eG), cvtpk(xq[2] * eG, xq[3] * eG), cvtpk(xq[4] * eG, xq[5] * eG), cvtpk(xq[6] * eG, xq[7] * eG)};
          w1 = (u32x4){cvtpk(xq[8] * eG, xq[9] * eG), cvtpk(xq[10] * eG, xq[11] * eG), cvtpk(xq[12] * eG, xq[13] * eG), cvtpk(xq[14] * eG, xq[15] * eG)};
          *(u32x4*)(img + IMG_QD + sw256(t, seg * 32)) = w0; *(u32x4*)(img + IMG_QD + sw256(t, seg * 32 + 16)) = w1; }
        if (seg == 0) { eRs[t] = eR; bgs[t] = bg; }
        raw_load(rg, proj, b, h, n < 31 ? n + 1 : n, tid);
        { const int n1 = n < 31 ? n + 1 : n; gpf = gg[((size_t)b * 2048 + n1 * 64 + (tt_ & 63)) * 8 + h]; bpf = beta[((size_t)b * 2048 + n1 * 64 + t) * 8 + h]; }
        LBAR();
        { const int prod = wave >> 2, mj = (wave >> 1) & 1, ni = wave & 1;
          f32x16 acc = {};
          if (!(mj == 1 && ni == 0)) { GLAS unsigned char* Xb = prod ? Qt : Kt;
#pragma unroll
              for (int s = 0; s < 8; ++s) { const bf16x8 a = *(const GLAS bf16x8*)(Kt + sw256(mj * 32 + r32, (16 * s + 8 * hi) * 2)); const bf16x8 bb = *(const GLAS bf16x8*)(Xb + sw256(ni * 32 + r32, (16 * s + 8 * hi) * 2));
                  acc = MFMA32(a, bb, acc); } }
          const int i = ni * 32 + r32; const float Gi = Gs[i], bi = prod ? 1.0f : Bs[i];
#pragma unroll
          for (int g4 = 0; g4 < 4; ++g4) { const int j0 = mj * 32 + 8 * g4 + 4 * hi; float v[4];
#pragma unroll
              for (int e = 0; e < 4; ++e) { const int j = j0 + e; const bool ok = prod ? (j <= i) : (j < i); const float d = ok ? __expf(Gi - Gs[j]) * bi : 0.f; v[e] = ok ? acc[4 * g4 + e] * d : 0.f; }
              if (prod == 0) { f16x4 hv = {(_Float16)v[0], (_Float16)v[1], (_Float16)v[2], (_Float16)v[3]}; *(GLAS f16x4*)(As + c * 8192 + i * 128 + j0 * 2) = hv; }
              else { u32x2 w = {cvtpk(v[0], v[1]), cvtpk(v[2], v[3])}; *(u32x2*)(img + IMG_QK + sw128(i, j0 * 2)) = w; } } }
        { const int ch = tt_ >> 2, tq = tt_ & 3; float kk[16], vk[16];
#pragma unroll
          for (int e = 0; e < 16; ++e) { const int tk = tq * 16 + e; kk[e] = bfl(*(const GLAS unsigned short*)(Kt + sw256(tk, ch * 2))); vk[e] = bfl(*(const GLAS unsigned short*)(Vt + sw256(tk, ch * 2))); }
          unsigned wa[8], wb[8], wc[8];
#pragma unroll
          for (int p = 0; p < 8; ++p) { const int t0 = tq * 16 + 2 * p; wa[p] = cvtpk(kk[2 * p] * eRs[t0], kk[2 * p + 1] * eRs[t0 + 1]); wb[p] = cvtpk(kk[2 * p] * bgs[t0], kk[2 * p + 1] * bgs[t0 + 1]); wc[p] = cvtpk(vk[2 * p], vk[2 * p + 1]); }
          *(u32x4*)(img + IMG_KDT + sw128(ch, tq * 32)) = (u32x4){wa[0], wa[1], wa[2], wa[3]}; *(u32x4*)(img + IMG_KDT + sw128(ch, tq * 32 + 16)) = (u32x4){wa[4], wa[5], wa[6], wa[7]};
          *(u32x4*)(kgt + ch * 64 + tq * 16) = (u32x4){wb[0], wb[1], wb[2], wb[3]}; *(u32x4*)(kgt + ch * 64 + tq * 16 + 8) = (u32x4){wb[4], wb[5], wb[6], wb[7]};
          *(u32x4*)(vbt + ch * 64 + tq * 16) = (u32x4){wc[0], wc[1], wc[2], wc[3]}; *(u32x4*)(vbt + ch * 64 + tq * 16 + 8) = (u32x4){wc[4], wc[5], wc[6], wc[7]}; }
        LBAR();
    }
    GLAS unsigned char* slot = As + wave * 8192;
    int lane2 = lane; asm volatile("" : "+v"(lane2));
    const int r32b = lane2 & 31, hib = lane2 >> 5;
    { float tc[64]; f16x2 tn[32];
      inv_row<0>(tc, tn, slot, lane2);
      asm volatile("s_waitcnt lgkmcnt(0)" ::: "memory");
#pragma unroll
      for (int i = 0; i < 64; ++i) *(GLAS unsigned short*)(slot + sw128(i, lane2 * 2)) = (unsigned short)(cvtpk(tc[i], 0.f) & 0xffffu); }
    asm volatile("s_waitcnt vmcnt(0) lgkmcnt(0)" ::: "memory");
    __syncthreads();
    { const int chunk = bh * 32 + cg0 + wave; unsigned char* img = img_ptr(out_bytes, ws_img, chunk);
      const unsigned short* vbt = (const unsigned short*)(scr + (size_t)chunk * 32768); const unsigned short* kgt = vbt + 8192;
      bf16x8 gf[4][4], gk[4][4];
#pragma unroll
      for (int dvt = 0; dvt < 4; ++dvt)
#pragma unroll
          for (int s = 0; s < 4; ++s) gf[dvt][s] = *(const bf16x8*)(vbt + (dvt * 32 + r32b) * 64 + 16 * s + 8 * hib);
#pragma unroll
      for (int dkt = 0; dkt < 4; ++dkt)
#pragma unroll
          for (int s = 0; s < 4; ++s) gk[dkt][s] = *(const bf16x8*)(kgt + (dkt * 32 + r32b) * 64 + 16 * s + 8 * hib);
#pragma unroll
      for (int tile = 0; tile < 8; ++tile) { const int ti = tile >> 2, dvt = tile & 3; f32x16 acc = {};
#pragma unroll
          for (int s = 0; s < 4; ++s) { if (s < 2 * (ti + 1)) { const bf16x8 a = *(const GLAS bf16x8*)(slot + sw128(ti * 32 + r32b, (16 * s + 8 * hib) * 2)); acc = MFMA32(a, gf[dvt][s], acc); } }
          u32x4 w0 = {pg8::cvt_pk_bf16_acc(acc[0], acc[1]), pg8::cvt_pk_bf16_acc(acc[2], acc[3]), pg8::cvt_pk_bf16_acc(acc[4], acc[5]), pg8::cvt_pk_bf16_acc(acc[6], acc[7])}, w1 = {pg8::cvt_pk_bf16_acc(acc[8], acc[9]), pg8::cvt_pk_bf16_acc(acc[10], acc[11]), pg8::cvt_pk_bf16_acc(acc[12], acc[13]), pg8::cvt_pk_bf16_acc(acc[14], acc[15])};
          *(u32x4*)(img + IMG_U + tile * 2048 + lane2 * 32) = w0; *(u32x4*)(img + IMG_U + tile * 2048 + lane2 * 32 + 16) = w1; }
#pragma unroll
      for (int tile = 0; tile < 8; ++tile) { const int dkt = tile >> 1, ni = tile & 1; f32x16 acc = {};
#pragma unroll
          for (int s = 0; s < 4; ++s) { if (s < 2 * (ni + 1)) { const bf16x8 bb = *(const GLAS bf16x8*)(slot + sw128(ni * 32 + r32b, (16 * s + 8 * hib) * 2)); acc = MFMA32(gk[dkt][s], bb, acc); } }
          { const unsigned a0 = pg8::cvt_pk_bf16_acc(acc[0], acc[1]), a1 = pg8::cvt_pk_bf16_acc(acc[2], acc[3]), b0 = pg8::cvt_pk_bf16_acc(acc[4], acc[5]), b1 = pg8::cvt_pk_bf16_acc(acc[6], acc[7]);
            const auto r0 = __builtin_amdgcn_permlane32_swap(a0, b0, false, false), r1 = __builtin_amdgcn_permlane32_swap(a1, b1, false, false);
            *(u32x4*)(img + IMG_W + ((ni * 8 + 2 * dkt) * 64 + lane2) * 16) = (u32x4){r0[0], r1[0], r0[1], r1[1]}; }
          { const unsigned a0 = pg8::cvt_pk_bf16_acc(acc[8], acc[9]), a1 = pg8::cvt_pk_bf16_acc(acc[10], acc[11]), b0 = pg8::cvt_pk_bf16_acc(acc[12], acc[13]), b1 = pg8::cvt_pk_bf16_acc(acc[14], acc[15]);
            const auto r0 = __builtin_amdgcn_permlane32_swap(a0, b0, false, false), r1 = __builtin_amdgcn_permlane32_swap(a1, b1, false, false);
            *(u32x4*)(img + IMG_W + ((ni * 8 + 2 * dkt + 1) * 64 + lane2) * 16) = (u32x4){r0[0], r1[0], r0[1], r1[1]}; } }
      if (lane2 == 0) *(float*)(img + IMG_GL) = __expf(gls[wave]); }
}

__device__ __forceinline__ void scan(GLAS unsigned char* L, int tid, int lane, int wave, int bh, unsigned char* out_bytes, unsigned char* ws_img, const unsigned short* proj, const float* gn, unsigned short* ob) {
    const int r32 = lane & 31, hi = lane >> 5, b = bh >> 3, h = bh & 7;
    GLAS unsigned char* ST = L + 75776; GLAS unsigned char* VNT = L + 108544; GLAS float* RED = (GLAS float*)(L + 124928); GLAS float* OT = (GLAS float*)L;
    const int ti = wave >> 2, dvt = wave & 3, dk0t = 2 * (wave >> 2);
    f32x16 s0 = {}, s1 = {};
    for (int i = tid; i < 2048; i += 512) ((GLAS u32x4*)ST)[i] = (u32x4){0u, 0u, 0u, 0u};
    const int tok = tid & 63, part = wave;
    float gnr[16];
#pragma unroll
    for (int e = 0; e < 16; ++e) gnr[e] = gn[part * 16 + e];
    u32x4 pf[10];
    { const u32x4* img0 = (const u32x4*)img_ptr(out_bytes, ws_img, bh * 32);
#pragma unroll
      for (int i = 0; i < 10; ++i) { const int p = tid + 512 * i; pf[i] = img0[p < 4624 ? p : 4623]; } }
#pragma unroll 1
    for (int n = 0; n < 32; ++n) {
#pragma unroll
        for (int i = 0; i < 10; ++i) { const int p = tid + 512 * i; if (p < 4624) ((GLAS u32x4*)L)[p] = pf[i]; }
        LBAR();
        { const u32x4* imgn = (const u32x4*)img_ptr(out_bytes, ws_img, bh * 32 + (n < 31 ? n + 1 : n));
#pragma unroll
          for (int i = 0; i < 10; ++i) { const int p = tid + 512 * i; pf[i] = imgn[p < 4624 ? p : 4623]; } }
        const size_t row = (size_t)b * 2048 + n * 64 + tok;
        const unsigned short* zp = proj + row * 7232 + 3072 + h * 128 + part * 16; const u32x4 z0 = *(const u32x4*)zp, z1 = *(const u32x4*)(zp + 8);
        { f32x16 acc = {};
#pragma unroll
          for (int s = 0; s < 8; ++s) { const bf16x8 a = *(const GLAS bf16x8*)(L + IMG_W + ((ti * 8 + s) * 64 + lane) * 16); const bf16x8 bb = *(const GLAS bf16x8*)(ST + sw256(dvt * 32 + r32, (16 * s + 8 * hi) * 2)); acc = MFMA32(a, bb, acc); }
          const u32x4 u0 = *(const GLAS u32x4*)(L + IMG_U + wave * 2048 + lane * 32), u1 = *(const GLAS u32x4*)(L + IMG_U + wave * 2048 + lane * 32 + 16);
          const unsigned uw[8] = {u0.x, u0.y, u0.z, u0.w, u1.x, u1.y, u1.z, u1.w};
#pragma unroll
          for (int g4 = 0; g4 < 4; ++g4) { const float v0 = bfl(uw[2 * g4]) - acc[4 * g4], v1 = bfh(uw[2 * g4]) - acc[4 * g4 + 1], v2 = bfl(uw[2 * g4 + 1]) - acc[4 * g4 + 2], v3 = bfh(uw[2 * g4 + 1]) - acc[4 * g4 + 3];
              u32x2 w = {cvtpk(v0, v1), cvtpk(v2, v3)}; *(GLAS u32x2*)(VNT + sw128(dvt * 32 + r32, (ti * 32 + 8 * g4 + 4 * hi) * 2)) = w; } }
        LBAR();
        { f32x16 acc = {};
#pragma unroll
          for (int s = 0; s < 8; ++s) { const bf16x8 a = *(const GLAS bf16x8*)(L + IMG_QD + sw256(ti * 32 + r32, (16 * s + 8 * hi) * 2)); const bf16x8 bb = *(const GLAS bf16x8*)(ST + sw256(dvt * 32 + r32, (16 * s + 8 * hi) * 2)); acc = MFMA32(a, bb, acc); }
#pragma unroll
          for (int s = 0; s < 4; ++s) { if (s < 2 * (ti + 1)) { const bf16x8 a = *(const GLAS bf16x8*)(L + IMG_QK + sw128(ti * 32 + r32, (16 * s + 8 * hi) * 2)); const bf16x8 bb = *(const GLAS bf16x8*)(VNT + sw128(dvt * 32 + r32, (16 * s + 8 * hi) * 2)); acc = MFMA32(a, bb, acc); } }
#pragma unroll
          for (int g4 = 0; g4 < 4; ++g4) { const f32x4 w = {acc[4 * g4], acc[4 * g4 + 1], acc[4 * g4 + 2], acc[4 * g4 + 3]}; const int dv = dvt * 32 + r32, chk = ti * 8 + 2 * g4 + hi;
              *(GLAS f32x4*)(OT + dv * 64 + ((chk ^ (dv & 15)) << 2)) = w; } }
        LBAR();
        float ov[16]; float ss = 0.f;
#pragma unroll
        for (int e = 0; e < 16; ++e) { const int dv = part * 16 + e; ov[e] = OT[dv * 64 + ((((tok >> 2) ^ (dv & 15)) << 2) | (tok & 3))]; ss += ov[e] * ov[e]; }
        RED[part * 64 + tok] = ss;
        { const float gl = *(const GLAS float*)(L + IMG_GL);
          s0 = s0 * gl; s1 = s1 * gl;
#pragma unroll
          for (int s = 0; s < 4; ++s) { const bf16x8 bb = *(const GLAS bf16x8*)(VNT + sw128(dvt * 32 + r32, (16 * s + 8 * hi) * 2));
              const bf16x8 a0 = *(const GLAS bf16x8*)(L + IMG_KDT + sw128(dk0t * 32 + r32, (16 * s + 8 * hi) * 2)), a1 = *(const GLAS bf16x8*)(L + IMG_KDT + sw128(dk0t * 32 + 32 + r32, (16 * s + 8 * hi) * 2));
              s0 = MFMA32(a0, bb, s0); s1 = MFMA32(a1, bb, s1); }
#pragma unroll
          for (int g4 = 0; g4 < 4; ++g4) { u32x2 w = {pg8::cvt_pk_bf16_acc(s0[4 * g4], s0[4 * g4 + 1]), pg8::cvt_pk_bf16_acc(s0[4 * g4 + 2], s0[4 * g4 + 3])}; *(GLAS u32x2*)(ST + sw256(dvt * 32 + r32, (dk0t * 32 + 8 * g4 + 4 * hi) * 2)) = w;
              u32x2 w2 = {pg8::cvt_pk_bf16_acc(s1[4 * g4], s1[4 * g4 + 1]), pg8::cvt_pk_bf16_acc(s1[4 * g4 + 2], s1[4 * g4 + 3])}; *(GLAS u32x2*)(ST + sw256(dvt * 32 + r32, (dk0t * 32 + 32 + 8 * g4 + 4 * hi) * 2)) = w2; } }
        LBAR();
        { float tot = 0.f;
#pragma unroll
          for (int p = 0; p < 8; ++p) tot += RED[p * 64 + tok];
          const float rs = rsqrtf(tot * (1.0f / 128.0f) + 1e-6f);
          const unsigned zw[8] = {z0.x, z0.y, z0.z, z0.w, z1.x, z1.y, z1.z, z1.w}; unsigned res[8];
#pragma unroll
          for (int k = 0; k < 8; ++k) res[k] = cvtpk(ov[2 * k] * rs * gnr[2 * k] * bfl(zw[k]), ov[2 * k + 1] * rs * gnr[2 * k + 1] * bfh(zw[k]));
          unsigned short* op = ob + row * 2048 + h * 128 + part * 16;
          *(u32x4*)op = (u32x4){res[0], res[1], res[2], res[3]}; *(u32x4*)(op + 8) = (u32x4){res[4], res[5], res[6], res[7]}; }
        LBAR();
    }
}
#undef MFMA32
#undef LBAR
#undef GLAS
}

constexpr int NB = 8, SEQ = 2048, DM = 2048, MTOK = NB * SEQ;
constexpr int HD = 128, NPROJ = 7168, PROJ_LD = 7232;
constexpr int DFF = 5632, MEMLEN = 256, MROWS = NB * MEMLEN, XW = 512;
constexpr float EPS = 1e-6f;
constexpr int NWAVES = 8, NTHREADS = 512;
constexpr int LDS_BYTES = 147456;
constexpr int LDS_MISC = 147200;
constexpr int CW_BAR = 4096;

constexpr size_t MiB = 1u << 20;
constexpr size_t WS_RSQ2 = 768 * 1024, WS_RSQ3 = 832 * 1024, WS_RSQ4 = 896 * 1024;
constexpr size_t WS_PCNT = 960 * 1024;
constexpr size_t WS_HID = 162 * MiB;
constexpr size_t WS_KMEAN = 512 * 1024;
constexpr size_t WS_WGU = 1 * MiB, WS_WDOWN = 23 * MiB, WS_X2Q = 34 * MiB, WS_SMALL = 67 * MiB, WS_XB = 70 * MiB;
constexpr float WGU_SCALE = 32.0f, WDOWN_SCALE = 64.0f;
constexpr size_t WS_GATE = 134 * MiB;
constexpr size_t WS_WINB = 142 * MiB;
constexpr size_t WS_WIN = 134 * MiB, WS_PROJ = 162 * MiB, WS_O = 388 * MiB;
constexpr size_t WS_QX = 162 * MiB, WS_OX = 178 * MiB, WS_KVX = 194 * MiB;
constexpr size_t WS_WXQ = 486 * MiB, WS_WXKV = 488 * MiB, WS_WXO = 492 * MiB, WS_WOUT = 494 * MiB, WS_MEMB = 502 * MiB, WS_END = 510 * MiB;
constexpr size_t SM_RSTD1 = 0, SM_RSTD2 = 65536, SM_RSTD3 = 131072, SM_RSTDM = 196608, SM_W16 = 262144, SM_KMEAN = 327680, SM_BETA = 1 * MiB, SM_G = 1 * MiB + 524288;

#define LAS __attribute__((address_space(3)))
typedef unsigned short bf16_t;
typedef float f32x4 __attribute__((ext_vector_type(4)));
typedef unsigned u32x4 __attribute__((ext_vector_type(4)));
typedef unsigned u32x2 __attribute__((ext_vector_type(2)));

__device__ __forceinline__ float bf2f(unsigned v) { return __uint_as_float(v << 16); }
__device__ __forceinline__ unsigned f2bf(float f) { unsigned u = __float_as_uint(f); return (u + 0x7fffu + ((u >> 16) & 1u)) >> 16; }
__device__ __forceinline__ unsigned pk2(float lo, float hi) { return f2bf(lo) | (f2bf(hi) << 16); }
__device__ __forceinline__ float wave_sum(float v) {
#pragma unroll
    for (int o = 1; o < 64; o <<= 1) v += __shfl_xor(v, o);
    return v;
}
__device__ __forceinline__ float silu_acc(float v) { return v * __builtin_amdgcn_rcpf(1.0f + __expf(-v)); }

#define XB_TMO      128
#define XB_XCNT(j)  (256  + 64 * (j))
#define XB_XSUB(j)  (1280 + 64 * (j))
#define XB_XGEN(j)  (2304 + 64 * (j))
#define XB_TOP      3328
#define XB_TOPGEN   3392
#define XCD_BAR_WORDS 3456
#define XB_SPIN_CAP (1u << 18)

__device__ __forceinline__ unsigned xb_ld(unsigned* p)              { return __hip_atomic_load(p, __ATOMIC_RELAXED, __HIP_MEMORY_SCOPE_AGENT); }
__device__ __forceinline__ unsigned xb_add(unsigned* p, unsigned v) { return __hip_atomic_fetch_add(p, v, __ATOMIC_RELAXED, __HIP_MEMORY_SCOPE_AGENT); }
__device__ __forceinline__ unsigned xb_xcc_id() { return (unsigned)__builtin_amdgcn_s_getreg((3 << 11) | 20) & 0xFu; }
#define XB_SPIN(cond, bar) do { unsigned _sp = 0; while (cond) { __builtin_amdgcn_s_sleep(1); \
    if ((++_sp & 255u) == 0u) { if (xb_ld(&(bar)[XB_TMO])) break; if (_sp > XB_SPIN_CAP) { atomicAdd(&(bar)[XB_TMO], 1u); break; } } } } while (0)

struct XcdBarrier {
    unsigned* bar; unsigned x;
    volatile LAS unsigned* st;
};

__device__ __forceinline__ XcdBarrier xcd_barrier_post(unsigned* bar, volatile LAS unsigned* st, int tid) {
    XcdBarrier b; b.bar = bar; b.x = xb_xcc_id(); b.st = st;
    if (tid == 0) (void)xb_add(&bar[XB_XCNT(b.x)], 1u);
    return b;
}
__device__ __forceinline__ void xcd_barrier_complete(unsigned* bar, unsigned x, unsigned& nloc, unsigned& nx) {
    const unsigned G = gridDim.x * gridDim.y * gridDim.z;
    unsigned sum, cnt, mine, sp = 0u;
    for (;;) {
        sum = 0u; cnt = 0u; mine = 0u;
#pragma unroll
        for (unsigned j = 0; j < 16; ++j) { const unsigned c = xb_ld(&bar[XB_XCNT(j)]); sum += c; cnt += (c > 0u) ? 1u : 0u; mine = (j == x) ? c : mine; }
        if (sum == G) break;
        __builtin_amdgcn_s_sleep(1);
        if ((++sp & 255u) == 0u) { if (xb_ld(&bar[XB_TMO])) break; if (sp > XB_SPIN_CAP) { atomicAdd(&bar[XB_TMO], 1u); break; } }
    }
    nloc = mine > 0u ? mine : 1u; nx = cnt > 0u ? cnt : 1u;
}

__device__ __forceinline__ void xcd_barrier(const XcdBarrier& b, int tid) {
    asm volatile("s_waitcnt vmcnt(0)" ::: "memory");
    __syncthreads();
    if (tid == 0) {
        unsigned* bar = b.bar;
        __builtin_amdgcn_s_waitcnt(0);
        unsigned nloc = b.st[0], nx = b.st[1];
        if (nloc == 0u) { xcd_barrier_complete(bar, b.x, nloc, nx); b.st[0] = nloc; b.st[1] = nx; }
        const unsigned seq = b.st[2]; b.st[2] = seq + 1u;
        const unsigned old = xb_add(&bar[XB_XSUB(b.x)], 1u);
        const unsigned gen = old / nloc;
        if (old + 1u == (gen + 1u) * nloc) {
            __builtin_amdgcn_fence(__ATOMIC_RELEASE, "agent");
            asm volatile("s_waitcnt vmcnt(0)" ::: "memory");
            const unsigned og = xb_add(&bar[XB_TOP], 1u);
            const unsigned tg = og / nx;
            if (og + 1u == (tg + 1u) * nx) xb_add(&bar[XB_TOPGEN], 1u);
        }
        XB_SPIN(xb_ld(&bar[XB_TOPGEN]) <= seq, bar);
        __builtin_amdgcn_fence(__ATOMIC_ACQUIRE, "agent");
        asm volatile("s_waitcnt vmcnt(0)" ::: "memory");
    }
    __syncthreads();
}


struct EpiFinal {
    static constexpr bool PERM = true, AFTER_DRAIN = false;
    const bf16_t* baseh; float* out; int ldc; float* rowsq; float accscale; const float* gain; unsigned* pcnt; unsigned* bar;
    __device__ __forceinline__ void operator()(f32x4 (&acc)[2][2][4][2], const pg8::Unit& u, int wr, int wc, int, int) const {
        int l_; asm volatile("v_mbcnt_lo_u32_b32 %0, -1, 0\n\tv_mbcnt_hi_u32_b32 %0, -1, %0" : "=v"(l_));
        const int fr = l_ & 15, fq = l_ >> 4;
        const int row0 = u.pm * 256 + wr * 64 + fr, col0 = u.pn * 256 + wc * 32 + 8 * fq;
#pragma unroll
        for (int am = 0; am < 4; ++am) { const int ai = am >> 1, mh = (am & 1) * 2;
            u32x4 hb[2][2];
#pragma unroll
            for (int m2 = 0; m2 < 2; ++m2)
#pragma unroll
                for (int bj = 0; bj < 2; ++bj) hb[m2][bj] = *(const u32x4*)(baseh + (size_t)(row0 + ai * 128 + (mh + m2) * 16) * ldc + col0 + bj * 128);
#pragma unroll
            for (int m2 = 0; m2 < 2; ++m2) { const int m = mh + m2; const int row = row0 + ai * 128 + m * 16; float ss = 0.f;
#pragma unroll
                for (int bj = 0; bj < 2; ++bj) { const u32x4 h = hb[m2][bj];
                    const f32x4 b0 = (f32x4){__uint_as_float(h.x << 16), __uint_as_float(h.x & 0xffff0000u), __uint_as_float(h.y << 16), __uint_as_float(h.y & 0xffff0000u)};
                    const f32x4 b1 = (f32x4){__uint_as_float(h.z << 16), __uint_as_float(h.z & 0xffff0000u), __uint_as_float(h.w << 16), __uint_as_float(h.w & 0xffff0000u)};
#pragma unroll
                    for (int e = 0; e < 4; ++e) { const float v0 = __builtin_fmaf(acc[ai][bj][m][0][e], accscale, b0[e]), v1 = __builtin_fmaf(acc[ai][bj][m][1][e], accscale, b1[e]);
                        acc[ai][bj][m][0][e] = v0; acc[ai][bj][m][1][e] = v1; ss = __builtin_fmaf(v0, v0, ss); ss = __builtin_fmaf(v1, v1, ss); } }
                ss += __shfl_xor(ss, 16); ss += __shfl_xor(ss, 32);
                if (fq == 0) atomicAdd(rowsq + row, ss); } }
        asm volatile("s_waitcnt vmcnt(0)" ::: "memory");
        asm volatile("s_waitcnt lgkmcnt(0)" ::: "memory"); __builtin_amdgcn_s_barrier(); asm volatile("" ::: "memory");
        if (wr == 0 && wc == 0 && fr == 0 && fq == 0) { unsigned* pw = pcnt + 16 * u.pm;
            (void)xb_add(pw, 1u);
            XB_SPIN(xb_ld(pw) < 8u, bar);
            __builtin_amdgcn_fence(__ATOMIC_ACQUIRE, "agent"); asm volatile("s_waitcnt vmcnt(0)" ::: "memory"); }
        asm volatile("" ::: "memory"); __builtin_amdgcn_s_barrier(); asm volatile("" ::: "memory");
        f32x4 g0[2], g1[2];
#pragma unroll
        for (int bj = 0; bj < 2; ++bj) { g0[bj] = *(const f32x4*)(gain + col0 + bj * 128); g1[bj] = *(const f32x4*)(gain + col0 + bj * 128 + 4); }
#pragma unroll
        for (int ai = 0; ai < 2; ++ai)
#pragma unroll
            for (int m = 0; m < 4; ++m) { int row = row0 + ai * 128 + m * 16; asm volatile("" : "+v"(row));
                const float sq = __uint_as_float(__hip_atomic_load((unsigned*)(rowsq + row), __ATOMIC_RELAXED, __HIP_MEMORY_SCOPE_AGENT)), r = rsqrtf(sq * (1.0f / 2048.0f) + 1e-6f);
                const unsigned ob = ((unsigned)row * (unsigned)ldc + (unsigned)col0) * 4u;
#pragma unroll
                for (int bj = 0; bj < 2; ++bj) { f32x4* o = (f32x4*)((char*)out + ob + bj * 512);
                    o[0] = acc[ai][bj][m][0] * r * g0[bj]; o[1] = acc[ai][bj][m][1] * r * g1[bj]; } }
    }
};

struct Args { const float* in[23]; float* out; unsigned char* ws; int ph_lo, ph_hi; };
#define ARGP(A, k) ((A).in[k])
#define TABP(F, k) ((const float*)(((const __attribute__((address_space(1))) float* const*)((F).ws + 256))[k]))
struct Frame {
    LAS unsigned char* lds;
    int tid, lane, wave, G, bid;
    float* out; unsigned char* ws;
};

__device__ __forceinline__ void transpose_item(const float* W, int ldw, int col0, int K, const float* gain, bf16_t* WT, int row_off, int nblk, LAS float* scr, int item, int lane) {
    const int kb = item / nblk, nb = item % nblk, k0 = 64 * kb, n0 = 64 * nb;
    const float* src = W + (size_t)(k0 + (lane >> 4)) * ldw + col0 + n0 + (lane & 15) * 4;
    f32x4 v[16];
#pragma unroll
    for (int i = 0; i < 16; ++i) v[i] = __builtin_nontemporal_load((const f32x4*)(src + (size_t)(4 * i) * ldw));
#pragma unroll
    for (int i = 0; i < 16; ++i) { const int kk = 4 * i + (lane >> 4); const float g = gain ? gain[k0 + kk] : 1.0f; LAS float* d = scr + kk * 65 + (lane & 15) * 4;
        d[0] = v[i].x * g; d[1] = v[i].y * g; d[2] = v[i].z * g; d[3] = v[i].w * g; }
    asm volatile("s_waitcnt lgkmcnt(0)" ::: "memory");
    const int c = lane & 7;
#pragma unroll
    for (int j = 0; j < 8; ++j) { const int n = (lane >> 3) + 8 * j; const LAS float* s = scr + (8 * c) * 65 + n;
        u32x4 o; o.x = pk2(s[0 * 65], s[1 * 65]); o.y = pk2(s[2 * 65], s[3 * 65]); o.z = pk2(s[4 * 65], s[5 * 65]); o.w = pk2(s[6 * 65], s[7 * 65]);
        *(u32x4*)(WT + (size_t)(row_off + n0 + n) * K + k0 + 8 * c) = o; }
    asm volatile("s_waitcnt lgkmcnt(0)" ::: "memory");
}
__device__ __forceinline__ void transpose_item8(const float* W, int ldw, int col0, int K, const float* gain, float scale, unsigned char* WT8, int row_off, int nblk, LAS float* scr, int item, int lane) {
    const int kb = item / nblk, nb = item % nblk, k0 = 64 * kb, n0 = 64 * nb;
    const float* src = W + (size_t)(k0 + (lane >> 4)) * ldw + col0 + n0 + (lane & 15) * 4;
    f32x4 v[16];
#pragma unroll
    for (int i = 0; i < 16; ++i) v[i] = __builtin_nontemporal_load((const f32x4*)(src + (size_t)(4 * i) * ldw));
#pragma unroll
    for (int i = 0; i < 16; ++i) { const int kk = 4 * i + (lane >> 4); const float g = (gain ? gain[k0 + kk] : 1.0f) * scale; LAS float* d = scr + kk * 65 + (lane & 15) * 4;
        d[0] = v[i].x * g; d[1] = v[i].y * g; d[2] = v[i].z * g; d[3] = v[i].w * g; }
    asm volatile("s_waitcnt lgkmcnt(0)" ::: "memory");
    const int c = lane & 7;
#pragma unroll
    for (int j = 0; j < 8; ++j) { const int n = (lane >> 3) + 8 * j; const LAS float* s = scr + (8 * c) * 65 + n;
        int w0 = __builtin_amdgcn_cvt_pk_fp8_f32(s[0 * 65], s[1 * 65], 0, false); w0 = __builtin_amdgcn_cvt_pk_fp8_f32(s[2 * 65], s[3 * 65], w0, true);
        int w1 = __builtin_amdgcn_cvt_pk_fp8_f32(s[4 * 65], s[5 * 65], 0, false); w1 = __builtin_amdgcn_cvt_pk_fp8_f32(s[6 * 65], s[7 * 65], w1, true);
        *(u32x2*)(WT8 + (size_t)(row_off + n0 + n) * K + k0 + 8 * c) = (u32x2){(unsigned)w0, (unsigned)w1}; }
    asm volatile("s_waitcnt lgkmcnt(0)" ::: "memory");
}
__device__ __forceinline__ void row_to_bf16(const float* xrow, bf16_t* orow, float* rstd_out, int lane, unsigned char* q8row = nullptr) {
    const f32x4* xr = (const f32x4*)xrow + lane;
    f32x4 v[8]; float s = 0.f;
#pragma unroll
    for (int j = 0; j < 8; ++j) { v[j] = __builtin_nontemporal_load(xr + 64 * j); s += (v[j].x * v[j].x + v[j].y * v[j].y) + (v[j].z * v[j].z + v[j].w * v[j].w); }
    s = wave_sum(s);
    if (lane == 0) *rstd_out = rsqrtf(s * (1.0f / DM) + EPS);
    u32x2* o8 = (u32x2*)orow + lane;
#pragma unroll
    for (int j = 0; j < 8; ++j) { u32x2 w; w.x = pk2(v[j].x, v[j].y); w.y = pk2(v[j].z, v[j].w); o8[64 * j] = w; }
    if (q8row) { unsigned* q4 = (unsigned*)q8row + lane;
#pragma unroll
        for (int j = 0; j < 8; ++j) { int q = __builtin_amdgcn_cvt_pk_fp8_f32(v[j].x, v[j].y, 0, false); q = __builtin_amdgcn_cvt_pk_fp8_f32(v[j].z, v[j].w, q, true); q4[64 * j] = (unsigned)q; } }
}
__device__ __forceinline__ void phase_prologue(const Frame& F, const Args& A) {
    if (F.bid == 0 && F.tid < 23) ((const float**)(F.ws + 256))[F.tid] = A.in[F.tid];
    LAS float* scr = (LAS float*)(F.lds + F.wave * 17408);
    const int gw = F.bid * NWAVES + F.wave, NGW = F.G * NWAVES;
    bf16_t* Win_t = (bf16_t*)(F.ws + WS_WIN); bf16_t* Wout_t = (bf16_t*)(F.ws + WS_WOUT); bf16_t* Wxq_t = (bf16_t*)(F.ws + WS_WXQ); bf16_t* Wxkv_t = (bf16_t*)(F.ws + WS_WXKV);
    bf16_t* Wxo_t = (bf16_t*)(F.ws + WS_WXO); bf16_t* Wgu_t = (bf16_t*)(F.ws + WS_WGU); bf16_t* Wdown_t = (bf16_t*)(F.ws + WS_WDOWN);
    constexpr int I_INA = 32 * 64, I_INB = 32 * 48, I_OUT = 32 * 32, I_XQ = 32 * 8, I_XKV = 32 * 16, I_XO = 8 * 32, I_G = 32 * 88, I_D = 88 * 32;
    constexpr int NITEMS = I_INA + I_INB + I_OUT + I_XQ + I_XKV + I_XO;
    for (int it = gw; it < NITEMS; it += NGW) {
        int r = it;
        if (r < I_INA) { transpose_item8(ARGP(A, 3), 7184, 0, DM, ARGP(A, 2), WGU_SCALE, (unsigned char*)Win_t, 0, 64, scr, r, F.lane); continue; } r -= I_INA;
        if (r < I_INB) { transpose_item(ARGP(A, 3), 7184, 4112, DM, ARGP(A, 2), (bf16_t*)(F.ws + WS_WINB), 0, 48, scr, r, F.lane); continue; } r -= I_INB;
        if (r < I_OUT) { transpose_item(ARGP(A, 10), DM, 0, DM, nullptr, Wout_t, 0, 32, scr, r, F.lane); continue; } r -= I_OUT;
        if (r < I_XQ) { transpose_item(ARGP(A, 13), XW, 0, DM, ARGP(A, 11), Wxq_t, 0, 8, scr, r, F.lane); continue; } r -= I_XQ;
        if (r < I_XKV) { transpose_item(ARGP(A, 14), 2 * XW, 0, DM, ARGP(A, 12), Wxkv_t, 0, 16, scr, r, F.lane); continue; } r -= I_XKV;
        transpose_item(ARGP(A, 15), DM, 0, XW, nullptr, Wxo_t, 0, 32, scr, r, F.lane);
    }
    { bf16_t* W16 = (bf16_t*)(F.ws + WS_SMALL + SM_W16);
      for (int i = F.bid * NTHREADS + F.tid; i < 16 * DM; i += F.G * NTHREADS) { const int j = i >> 11, k = i & 2047; W16[i] = (bf16_t)f2bf(ARGP(A, 3)[(size_t)k * 7184 + 4096 + j] * ARGP(A, 2)[k]); } }
    { bf16_t* xb = (bf16_t*)(F.ws + WS_XB); float* rstd1 = (float*)(F.ws + WS_SMALL + SM_RSTD1);
      for (int m = gw; m < MTOK; m += NGW) row_to_bf16(ARGP(A, 0) + (size_t)m * DM, xb + (size_t)m * DM, rstd1 + m, F.lane, F.ws + WS_X2Q + (size_t)m * DM);
      bf16_t* memb = (bf16_t*)(F.ws + WS_MEMB); float* rstdm = (float*)(F.ws + WS_SMALL + SM_RSTDM);
      for (int m = gw; m < MROWS; m += NGW) row_to_bf16(ARGP(A, 1) + (size_t)m * DM, memb + (size_t)m * DM, rstdm + m, F.lane); }
}
__device__ __forceinline__ void phase_ffn_weights(const Frame& F, int iw, int nwg) {
    LAS float* scr = (LAS float*)(F.lds + F.wave * 17408);
    unsigned char* Wgu8 = F.ws + WS_WGU; unsigned char* Wdown8 = F.ws + WS_WDOWN;
    constexpr int I_G = 32 * 88, I_D = 88 * 32;
    for (int it = iw * NWAVES + F.wave; it < 2 * I_G + I_D; it += nwg * NWAVES) {
        int r = it;
        if (r < I_G) { const int c0 = 64 * (r % 88); transpose_item8(TABP(F, 17), DFF, 0, DM, TABP(F, 16), WGU_SCALE, Wgu8, ((c0 >> 7) << 8) + (c0 & 127) - c0, 88, scr, r, F.lane); continue; } r -= I_G;
        if (r < I_G) { const int c0 = 64 * (r % 88); transpose_item8(TABP(F, 18), DFF, 0, DM, TABP(F, 16), WGU_SCALE, Wgu8, ((c0 >> 7) << 8) + (c0 & 127) - c0 + 128, 88, scr, r, F.lane); continue; } r -= I_G;
        transpose_item8(TABP(F, 21), DM, 0, DFF, nullptr, WDOWN_SCALE, Wdown8, 0, 32, scr, r, F.lane);
    }
}
__device__ __forceinline__ void phase_final_norm(const Frame& F, const Args& A) {
    const int gw = F.bid * NWAVES + F.wave, NGW = F.G * NWAVES; const f32x4* g4 = (const f32x4*)TABP(F, 22) + 2 * F.lane;
    const bf16_t* xb = (const bf16_t*)(F.ws + WS_XB); const float* rsq = (const float*)(F.ws + WS_RSQ4);
    for (int m = gw; m < MTOK; m += NGW) {
        const float r = rsqrtf(rsq[m] * (1.0f / DM) + EPS);
        const u32x4* xr = (const u32x4*)(xb + (size_t)m * DM) + F.lane; f32x4* orow = (f32x4*)(F.out + (size_t)m * DM) + 2 * F.lane;
#pragma unroll
        for (int j = 0; j < 4; ++j) { const u32x4 h = __builtin_nontemporal_load(xr + 64 * j);
            const f32x4 a = {bf2f(h.x & 0xffffu), bf2f(h.x >> 16), bf2f(h.y & 0xffffu), bf2f(h.y >> 16)}, b = {bf2f(h.z & 0xffffu), bf2f(h.z >> 16), bf2f(h.w & 0xffffu), bf2f(h.w >> 16)};
            orow[128 * j] = a * r * g4[128 * j]; orow[128 * j + 1] = b * r * g4[128 * j + 1]; }
    }
}
typedef short mk_bf16x8 __attribute__((ext_vector_type(8)));
__device__ __forceinline__ void ba_item(const Frame& F, int item, int khalf) {
    const int lane = F.lane, r = lane & 15, q = lane >> 4, row0 = item * 16;
    const bf16_t* xa = (const bf16_t*)(F.ws + WS_XB) + (size_t)(row0 + r) * DM + khalf * 1024 + q * 8; const bf16_t* wb = (const bf16_t*)(F.ws + WS_SMALL + SM_W16) + (size_t)r * DM + khalf * 1024 + q * 8;
    f32x4 acc = {0.f, 0.f, 0.f, 0.f};
#pragma unroll 16
    for (int s = 0; s < 32; ++s) { const mk_bf16x8 a = *(const mk_bf16x8*)(xa + 32 * s), b = *(const mk_bf16x8*)(wb + 32 * s); acc = __builtin_amdgcn_mfma_f32_16x16x32_bf16(a, b, acc, 0, 0, 0); }
    LAS f32x4* xch = (LAS f32x4*)F.lds + (F.wave & 3) * 64 + lane;
    if (khalf) *xch = acc;
    __syncthreads();
    if (khalf) return;
    acc += *xch;
    const float* rstd1 = (const float*)(F.ws + WS_SMALL + SM_RSTD1); float* beta = (float*)(F.ws + WS_SMALL + SM_BETA); float* gg = (float*)(F.ws + WS_SMALL + SM_G);
    const int c = lane & 15, h = c & 7; const float alog = TABP(F, 5)[h], dtb = TABP(F, 6)[h];
#pragma unroll
    for (int i = 0; i < 4; ++i) { const int row = row0 + 4 * q + i; const float y = acc[i] * rstd1[row];
        if (c < 8) beta[(size_t)row * 8 + h] = 1.0f / (1.0f + expf(-y));
        else { const float z = y + dtb; const float sp = z > 20.f ? z : log1pf(expf(z)); gg[(size_t)row * 8 + h] = -expf(alog) * sp; } }
}
__device__ __forceinline__ void phase_moba(const Frame& F, const Args& A, char* lds, int cu) {
    const int grp = cu >> 6, bh = cu & 63, b = bh >> 3, h = bh & 7;
    const unsigned list = grp == 0 ? 0x37u : (grp == 1 ? 0x46u : 0x0125u); const int cnt = grp == 2 ? 4 : 2;
    moba::Head H; H.Q0 = (const bf16_t*)(F.ws + WS_PROJ) + (size_t)(b * SEQ) * PROJ_LD + 4096 + h * 128; H.K0 = H.Q0 + 1024; H.V0 = H.Q0 + 2048; H.O0 = (bf16_t*)(F.ws + WS_O) + (size_t)(b * SEQ) * DM + 1024 + h * 128;
    H.km = (const float*)(F.ws + WS_KMEAN) + (size_t)(b * 8) * 1024 + h * 128;
    moba::Seam S; int P0 = (int)(list & 15u) * 256;
    moba::prime<moba::CfgMoba>(H, P0, lds, S, F.tid, F.wave);
    for (int i = 0; i < cnt; ++i) { const int P0n = (i + 1 < cnt) ? (int)((list >> (4 * (i + 1))) & 15u) * 256 : P0; moba::block<moba::CfgMoba>(H, P0, P0n, TABP(F, 9), h, TABP(F, 8), lds, S, F.tid, F.wave); P0 = P0n; }
}
__device__ __forceinline__ void phase_xattn(const Frame& F, char* lds, int item) {
    const int qb = item & 7, h = (item >> 3) & 3, b = item >> 5;
    moba::Head H; H.Q0 = (const bf16_t*)(F.ws + WS_QX) + (size_t)(b * SEQ) * XW + h * 128; H.K0 = (const bf16_t*)(F.ws + WS_KVX) + (size_t)(b * MEMLEN) * (2 * XW) + h * 128; H.V0 = H.K0 + XW;
    H.O0 = (bf16_t*)(F.ws + WS_OX) + (size_t)(b * SEQ) * XW + h * 128; H.km = nullptr;
    moba::Seam S; const int P0 = qb * 256;
    moba::prime<moba::CfgX>(H, P0, lds, S, F.tid, F.wave);
    moba::block<moba::CfgX>(H, P0, P0, nullptr, h, nullptr, lds, S, F.tid, F.wave);
}
static_assert(moba::LDS_BYTES <= LDS_MISC && LDS_MISC + 128 <= LDS_BYTES, "LDS map");

__device__ __forceinline__ void ffn_fixup(const Frame& F, int pm) {
    const bf16_t* halo = (const bf16_t*)(F.ws + WS_GATE); const float* cw = TABP(F, 19); const float* cb = TABP(F, 20); unsigned char* H8 = F.ws + WS_HID;
    u32x4 a2[3], a1[3], a0[3], au[3];
#pragma unroll
    for (int k = 0; k < 3; ++k) { int idx = F.tid + k * NTHREADS; idx = idx < 2 * 704 ? idx : 2 * 704 - 1; const int R = idx / 704, c = (idx - R * 704) * 8;
        const bf16_t* hp = halo + (size_t)(pm - 1) * 6 * 5632 + c; const bf16_t* hc = halo + (size_t)pm * 6 * 5632 + c;
        a2[k] = *(const u32x4*)(hp + (R == 0 ? 0 : 1) * 5632); a1[k] = *(const u32x4*)(R == 0 ? hp + 5632 : hc + 2 * 5632); a0[k] = *(const u32x4*)(hc + (2 + R) * 5632); au[k] = *(const u32x4*)(hc + (4 + R) * 5632); }
#pragma unroll
    for (int k = 0; k < 3; ++k) { const int idx = F.tid + k * NTHREADS; if (idx >= 2 * 704) break; const int R = idx / 704, c = (idx - R * 704) * 8;
        const unsigned v2[4] = {a2[k].x, a2[k].y, a2[k].z, a2[k].w}, v1[4] = {a1[k].x, a1[k].y, a1[k].z, a1[k].w}, v0[4] = {a0[k].x, a0[k].y, a0[k].z, a0[k].w}, vu[4] = {au[k].x, au[k].y, au[k].z, au[k].w}; float hv[8];
#pragma unroll
        for (int e = 0; e < 8; ++e) { const unsigned sh = (e & 1) ? 16u : 0u; const int kq = e >> 1, chn = c + e;
            const float x2 = bf2f((v2[kq] >> sh) & 0xffffu), x1 = bf2f((v1[kq] >> sh) & 0xffffu), gc = bf2f((v0[kq] >> sh) & 0xffffu), uu = bf2f((vu[kq] >> sh) & 0xffffu);
            const float y = cw[chn] * x2 + cw[DFF + chn] * x1 + cw[2 * DFF + chn] * gc + cb[chn]; hv[e] = y * __builtin_amdgcn_rcpf(1.0f + __expf(-y)) * uu; }
        int q0 = __builtin_amdgcn_cvt_pk_fp8_f32(hv[0], hv[1], 0, false); q0 = __builtin_amdgcn_cvt_pk_fp8_f32(hv[2], hv[3], q0, true);
        int q1 = __builtin_amdgcn_cvt_pk_fp8_f32(hv[4], hv[5], 0, false); q1 = __builtin_amdgcn_cvt_pk_fp8_f32(hv[6], hv[7], q1, true);
        *(u32x2*)(H8 + (size_t)(pm * 256 + R) * DFF + c) = (u32x2){(unsigned)q0, (unsigned)q1}; }
}
constexpr int N_PHASES = 14;
constexpr int WGM_IN1 = 8, WGM_IN2 = 8, WGM_OUT = 4, WGM_XQ = 4, WGM_XO = 4, WGM_GU = 4, WGM_DOWN = 4;

__global__ void __launch_bounds__(NTHREADS, 2) mk_fwd(Args args) {
    const Args& A = args;
    extern __shared__ __attribute__((aligned(16))) unsigned char lds_raw[];
    Frame F;
    F.lds = (LAS unsigned char*)lds_raw;
    F.wave = __builtin_amdgcn_readfirstlane((int)threadIdx.x >> 6); F.lane = 0; F.tid = 0;
#define FRESH_IDS() do { int l_; asm volatile("v_mbcnt_lo_u32_b32 %0, -1, 0\n\tv_mbcnt_hi_u32_b32 %0, -1, %0" : "=v"(l_)); F.lane = l_; F.tid = F.wave * 64 + l_; } while (0)
    F.G = gridDim.x; F.bid = blockIdx.x;
    F.out = args.out; F.ws = args.ws;
    const int lo = args.ph_lo, hi = args.ph_hi;
    unsigned char* ws = args.ws;
    const float* rstd1 = (const float*)(ws + WS_SMALL + SM_RSTD1); float* rstd2 = (float*)(ws + WS_SMALL + SM_RSTD2); float* rstd3 = (float*)(ws + WS_SMALL + SM_RSTD3);
    const float* rstdm = (const float*)(ws + WS_SMALL + SM_RSTDM);
    bf16_t* xb = (bf16_t*)(ws + WS_XB);
#define IN(k) (lo <= (k) && (k) < hi)
    volatile LAS unsigned* MISC = (volatile LAS unsigned*)(F.lds + LDS_MISC);
    XcdBarrier bar; bar.bar = (unsigned*)ws + CW_BAR; bar.x = 0; bar.st = nullptr;
    if (hi - lo > 1) { FRESH_IDS(); if (F.tid < 32) MISC[F.tid] = 0u; __syncthreads(); bar = xcd_barrier_post((unsigned*)ws + CW_BAR, MISC + 8, F.tid); }
#define SEAM(k) do { if (IN(k) && IN((k) + 1)) { FRESH_IDS(); xcd_barrier(bar, F.tid); } } while (0)

    if (IN(0)) { FRESH_IDS(); phase_prologue(F, A); }
    if (lo < 0) cg::this_grid().sync();
    SEAM(0);
    if (IN(1)) { FRESH_IDS();
        if ((F.bid & 1) == 0) { ba_item(F, (F.wave & 3) * 256 + F.bid, F.wave >> 2);
            __syncthreads();
            FRESH_IDS(); }
        { pg8::Gemm g{(const bf16_t*)(ws + WS_X2Q), (const bf16_t*)(ws + WS_WIN), MTOK, 4096, DM / 2}; pg8::StaticOrder S; S.init(MTOK, 4096, F.G, F.bid, WGM_IN1);
          pg8::EpiScaleBf16 E{(bf16_t*)(ws + WS_PROJ), PROJ_LD, rstd1, 12, 16, 0, 0, nullptr, 0, 0, 0, 1.0f / WGU_SCALE};
          pg8::gemm_phase<pg8::EpiScaleBf16, pg8::StaticOrder, true, true, true>(F.lds, g, S, E, F.tid, F.wave); }
        FRESH_IDS();
        { pg8::Gemm g{xb, (const bf16_t*)(ws + WS_WINB), MTOK, 3072, DM}; pg8::StaticOrder S; S.init(MTOK, 3072, F.G, F.bid, WGM_IN2);
          pg8::EpiScaleBf16 E{(bf16_t*)(ws + WS_PROJ) + 4096, PROJ_LD, rstd1, 0, 0, 0, 0, (float*)(ws + WS_KMEAN), 4, 8, 0, 1.0f, 0, 4, moba::QSCALE};
          pg8::gemm_phase<pg8::EpiScaleBf16, pg8::StaticOrder, true, true>(F.lds, g, S, E, F.tid, F.wave); }
        if (F.bid & 1) { __syncthreads(); FRESH_IDS(); ba_item(F, (F.wave & 3) * 256 + F.bid, F.wave >> 2); }
    } SEAM(1);
    if (IN(2)) { FRESH_IDS();
        gdn::prep((__attribute__((address_space(3))) unsigned char*)F.lds, F.tid, F.lane, F.wave, F.bid, (const unsigned short*)(ws + WS_PROJ), (const float*)(ws + WS_SMALL + SM_BETA), (const float*)(ws + WS_SMALL + SM_G), TABP(F, 4),
                  (unsigned char*)F.out, ws + WS_WIN, ws + WS_O); } SEAM(2);
    if (IN(3)) { FRESH_IDS();
        if (F.bid < 64) gdn::scan((__attribute__((address_space(3))) unsigned char*)F.lds, F.tid, F.lane, F.wave, F.bid, (unsigned char*)F.out, ws + WS_WIN, (const unsigned short*)(ws + WS_PROJ), TABP(F, 7), (unsigned short*)(ws + WS_O));
        else if (F.bid < 256) phase_moba(F, A, (char*)lds_raw, F.bid - 64);
    } SEAM(3);
    if (IN(4)) { FRESH_IDS();
        pg8::Gemm g{(const bf16_t*)(ws + WS_O), (const bf16_t*)(ws + WS_WOUT), MTOK, DM, DM}; pg8::StaticOrder S; S.init(MTOK, DM, F.G, F.bid, WGM_OUT);
        pg8::EpiResidBf16 E{xb, xb, DM, (float*)(ws + WS_RSQ2), 1.0f, nullptr};
        pg8::gemm_phase<pg8::EpiResidBf16, pg8::StaticOrder, true, true>(F.lds, g, S, E, F.tid, F.wave);
    } SEAM(4);
    if (IN(6)) { FRESH_IDS();
        { pg8::Gemm g{xb, (const bf16_t*)(ws + WS_WXQ), MTOK, XW, DM}; pg8::StaticOrder S; S.init(MTOK, XW, F.G, F.bid, WGM_XQ);
          pg8::EpiScaleBf16 E{(bf16_t*)(ws + WS_QX), XW, (const float*)(ws + WS_RSQ2), 0, 0, 0, 0, nullptr, 0, 0, 1, moba::QSCALE};
          pg8::gemm_phase<pg8::EpiScaleBf16, pg8::StaticOrder, true, true>(F.lds, g, S, E, F.tid, F.wave); }
        { pg8::Gemm g{(const bf16_t*)(ws + WS_MEMB), (const bf16_t*)(ws + WS_WXKV), MROWS, 2 * XW, DM}; pg8::StaticOrder S; S.init(MROWS, 2 * XW, F.G, (F.bid + F.G - 128) % F.G);
          pg8::EpiScaleBf16 E{(bf16_t*)(ws + WS_KVX), 2 * XW, rstdm, 0, 0, 0, 0, nullptr, 0, 0, 0, 1.0f};
          pg8::gemm_phase<pg8::EpiScaleBf16, pg8::StaticOrder, true, true>(F.lds, g, S, E, F.tid, F.wave); }
        if (F.bid >= 160 && F.bid < 256) { FRESH_IDS(); phase_ffn_weights(F, F.bid - 160, 96); }
    } SEAM(6);
    if (IN(7)) { FRESH_IDS(); if (F.bid < 256) phase_xattn(F, (char*)lds_raw, F.bid); } SEAM(7);
    if (IN(8)) { FRESH_IDS();
        pg8::Gemm g{(const bf16_t*)(ws + WS_OX), (const bf16_t*)(ws + WS_WXO), MTOK, DM, XW}; pg8::StaticOrder S; S.init(MTOK, DM, F.G, F.bid, WGM_XO);
        pg8::EpiResidBf16 E{xb, xb, DM, (float*)(ws + WS_RSQ3), 1.0f, ws + WS_X2Q};
        pg8::gemm_phase<pg8::EpiResidBf16, pg8::StaticOrder, true, true>(F.lds, g, S, E, F.tid, F.wave);
    } SEAM(8);
    if (IN(10)) { FRESH_IDS();
        pg8::Gemm g{(const bf16_t*)(ws + WS_X2Q), (const bf16_t*)(ws + WS_WGU), MTOK, 2 * DFF, DM / 2}; pg8::StaticOrder S; S.init(MTOK, 2 * DFF, F.G, F.bid, WGM_GU);
        pg8::EpiFfn E{ws + WS_HID, (const float*)(ws + WS_RSQ3), TABP(F, 19), TABP(F, 20), (bf16_t*)(ws + WS_GATE), (__attribute__((address_space(3))) float*)(F.lds + 131072), 1.0f / WGU_SCALE};
        pg8::gemm_phase<pg8::EpiFfn, pg8::StaticOrder, true, true, true>(F.lds, g, S, E, F.tid, F.wave);
    } SEAM(10);
    if (IN(12)) { FRESH_IDS();
        { pg8::StaticOrder S0; S0.init(MTOK, DM, F.G, F.bid, WGM_DOWN); pg8::Unit u0;
          if (S0.next(0, u0) && (u0.pm & 7)) ffn_fixup(F, u0.pm);
          if (S0.next(1, u0) && (u0.pm & 7)) ffn_fixup(F, u0.pm);
          asm volatile("s_waitcnt vmcnt(0)" ::: "memory"); __syncthreads(); FRESH_IDS(); }
        pg8::Gemm g{(const bf16_t*)(ws + WS_HID), (const bf16_t*)(ws + WS_WDOWN), MTOK, DM, DFF / 2};     pg8::StaticOrder S; S.init(MTOK, DM, F.G, F.bid, WGM_DOWN);
        static_assert(WGM_DOWN == 4, "EpiFinal: all 8 units of a row panel must run in the same round");
        const float* gfin; { const unsigned long long gi_ = (unsigned long long)TABP(F, 22);
            gfin = (const float*)(((unsigned long long)(unsigned)__builtin_amdgcn_readfirstlane((int)(gi_ >> 32)) << 32) | (unsigned)__builtin_amdgcn_readfirstlane((int)gi_)); }
        EpiFinal E{xb, F.out, DM, (float*)(ws + WS_RSQ4), 1.0f / WDOWN_SCALE, gfin, (unsigned*)(ws + WS_PCNT), (unsigned*)ws + CW_BAR};
        pg8::gemm_phase<EpiFinal, pg8::StaticOrder, true, true, true>(F.lds, g, S, E, F.tid, F.wave);
    }
#undef IN
#undef SEAM
}

extern "C" void kernel_launch(void* const* d_in, const int* in_sizes, int n_in, void* d_out, int out_size, void* d_ws, size_t ws_size, hipStream_t stream) {
    static int grid = 0;
    if (grid == 0) {
        if (n_in != 23 || in_sizes[0] != MTOK * DM || out_size != MTOK * DM || ws_size < WS_END) {
            fprintf(stderr, "kernel_launch: unexpected shapes: n_in %d, in0 %d, out %d, ws %zu (need >= %zu); nothing launched\n", n_in, n_in > 0 ? in_sizes[0] : -1, out_size, ws_size, (size_t)WS_END); grid = -1; return; }
        int dev = 0, cus = 0, per_cu = 0;
        if (hipGetDevice(&dev) != hipSuccess || hipDeviceGetAttribute(&cus, hipDeviceAttributeMultiprocessorCount, dev) != hipSuccess) { fprintf(stderr, "kernel_launch: device query failed\n"); grid = -1; return; }
        if (hipFuncSetAttribute((const void*)mk_fwd, hipFuncAttributeMaxDynamicSharedMemorySize, LDS_BYTES) != hipSuccess) { fprintf(stderr, "kernel_launch: hipFuncSetAttribute failed\n"); grid = -1; return; }
        if (hipOccupancyMaxActiveBlocksPerMultiprocessor(&per_cu, (const void*)mk_fwd, NTHREADS, LDS_BYTES) != hipSuccess || per_cu < 1) { fprintf(stderr, "kernel_launch: occupancy query says %d blocks per CU\n", per_cu); per_cu = 1; }
        (void)hipGetLastError();
        if (per_cu > 1) per_cu = 1;
        grid = cus * per_cu;
        if (grid != 256) { fprintf(stderr, "kernel_launch: built for a 256-CU device (grid %d); nothing launched\n", grid); grid = -1; return; }
    }
    if (grid < 0) return;
    if (hipMemsetAsync(d_ws, 0, 1u << 20, stream) != hipSuccess) { fprintf(stderr, "kernel_launch: hipMemsetAsync failed\n"); return; }
    Args a{};
    for (int i = 0; i < 23; ++i) a.in[i] = (const float*)d_in[i];
    a.out = (float*)d_out; a.ws = (unsigned char*)d_ws;
#if MK_MULTI
    for (int p = 0; p < N_PHASES; ++p) { a.ph_lo = p; a.ph_hi = p + 1; hipLaunchKernelGGL(mk_fwd, dim3(grid), dim3(NTHREADS), LDS_BYTES, stream, a); }
#else
    a.ph_lo = 0; a.ph_hi = N_PHASES;
    void* kargs[] = {&a};
    hipError_t e = hipLaunchCooperativeKernel((const void*)mk_fwd, dim3(grid), dim3(NTHREADS), kargs, LDS_BYTES, stream);
    if (e != hipSuccess) fprintf(stderr, "kernel_launch: cooperative launch failed: %s (grid %d)\n", hipGetErrorString(e), grid);
#endif
}
```
